# Optimizing an MI355X kernel written in HIP

```python
import math
import jax, jax.numpy as jnp
from jax import lax
import numpy as np

D_MODEL = 1024
BATCH = 4
SEQ = 4096
DEPTH = 1

NSA_HEAD_DIM = 64
NSA_HEADS = D_MODEL // (2 * NSA_HEAD_DIM)
NSA_KV_GROUPS = 2
NSA_Q_PER_KV = NSA_HEADS // NSA_KV_GROUPS
NSA_WIDTH = NSA_HEADS * NSA_HEAD_DIM
NSA_KV_WIDTH = NSA_KV_GROUPS * NSA_HEAD_DIM
CMP_BLOCK = 32
CMP_STRIDE = 16
CMP_HIDDEN = 2 * NSA_HEAD_DIM
SEL_BLOCK = 64
SEL_TOP = 8
WINDOW = 512
Q_BLOCK = 128
FORCE_BONUS = 1.0e4
RET_HEAD_DIM = 128
RET_HEADS = (D_MODEL - NSA_WIDTH) // RET_HEAD_DIM
RET_WIDTH = RET_HEADS * RET_HEAD_DIM
RET_CHUNK = 128
ROPE_THETA = 10000.0
RMS_EPS = 1e-6
N_EXPERTS = 256
N_EXPERT_GROUPS = 8
TOPK_GROUPS = 4
TOP_K = 8
EXPERT_DIM = D_MODEL // 4
ROUTED_SCALE = 2.5
MOE_BLOCK = 128
IN_SIZES = (NSA_WIDTH,
            NSA_KV_WIDTH, NSA_KV_WIDTH,
            NSA_KV_WIDTH, NSA_KV_WIDTH,
            NSA_KV_WIDTH, NSA_KV_WIDTH,
            NSA_HEADS * 3,
            RET_WIDTH, RET_WIDTH, RET_WIDTH, RET_WIDTH)
IN_WIDTH = sum(IN_SIZES)
IN_SPLITS = tuple(int(v) for v in np.cumsum(IN_SIZES)[:-1])

kernel_name = 'hybrid_nsa_retention_moe_block'


def _rmsnorm(x, g, eps=RMS_EPS):
    xf = x.astype(jnp.float32)
    y = xf * lax.rsqrt(jnp.mean(xf * xf, axis=-1, keepdims=True) + eps)
    return (y * g.astype(jnp.float32)).astype(x.dtype)


def _heads(t, n):
    B, S, _ = t.shape
    return t.reshape(B, S, n, -1).transpose(0, 2, 1, 3)


def _rope(x, pos):
    d = x.shape[-1]
    inv = ROPE_THETA ** (-jnp.arange(0, d, 2, dtype=jnp.float32) / d)
    ang = pos.astype(jnp.float32)[:, None, :, None] * inv
    cos, sin = jnp.cos(ang), jnp.sin(ang)
    x1, x2 = jnp.split(x.astype(jnp.float32), 2, axis=-1)
    return jnp.concatenate([x1 * cos - x2 * sin, x1 * sin + x2 * cos], axis=-1).astype(x.dtype)


def _masked_softmax(s, mask):
    s = jnp.where(mask, s, -1e30)
    m = jnp.max(s, axis=-1, keepdims=True)
    e = jnp.where(mask, jnp.exp(s - m), 0.0)
    return e / jnp.maximum(jnp.sum(e, axis=-1, keepdims=True), 1e-20)


def _compress(k, pos_emb, w1, w2):
    B, G, S, dh = k.shape
    n_cmp = (S - CMP_BLOCK) // CMP_STRIDE + 1
    idx = np.arange(n_cmp)[:, None] * CMP_STRIDE + np.arange(CMP_BLOCK)[None, :]
    blocks = k[:, :, idx] + pos_emb
    flat = blocks.reshape(B, G, n_cmp, CMP_BLOCK * dh)
    return jax.nn.gelu(flat @ w1) @ w2


def _nsa(q, kc, vc, ks, vs, kw, vw, gates):
    B, H, S, dh = q.shape
    G, R = NSA_KV_GROUPS, NSA_Q_PER_KV
    n_q = S // Q_BLOCK
    n_sel = S // SEL_BLOCK
    n_top = min(SEL_TOP, n_sel)
    n_cmp = kc.shape[2]
    scale = dh ** -0.5
    cmp_start = np.arange(n_cmp) * CMP_STRIDE
    cmp_end = jnp.asarray(cmp_start + CMP_BLOCK - 1, jnp.int32)
    sel_start = np.arange(n_sel) * SEL_BLOCK
    overlap = jnp.asarray((cmp_start[:, None] < sel_start[None, :] + SEL_BLOCK)
                          & (cmp_start[:, None] + CMP_BLOCK > sel_start[None, :]), jnp.float32)
    kcf, vcf = kc.astype(jnp.float32), vc.astype(jnp.float32)
    ks_blocks = ks.reshape(B, G, n_sel, SEL_BLOCK, dh)
    vs_blocks = vs.reshape(B, G, n_sel, SEL_BLOCK, dh)
    pad = jnp.zeros((B, G, WINDOW, dh), kw.dtype)
    kw_p = jnp.concatenate([pad, kw], axis=2)
    vw_p = jnp.concatenate([pad, vw], axis=2)
    bi = jnp.arange(B)[:, None, None, None]
    gi = jnp.arange(G)[None, :, None, None]
    j = jnp.arange(n_sel)

    def one_block(qb):
        t0 = qb * Q_BLOCK
        t = t0 + jnp.arange(Q_BLOCK)
        qblk = lax.dynamic_slice_in_dim(q, t0, Q_BLOCK, axis=2).astype(jnp.float32)
        qblk = qblk.reshape(B, G, R, Q_BLOCK, dh) * scale
        s_c = jnp.einsum('bgrtd,bgcd->bgrtc', qblk, kcf)
        p_c = _masked_softmax(s_c, cmp_end[None, :] <= t[:, None])
        o_c = jnp.einsum('bgrtc,bgcd->bgrtd', p_c, vcf)
        imp = jnp.einsum('bgrtc,cj->bgtj', p_c, overlap)
        cur = t // SEL_BLOCK
        valid = j[None, :] * SEL_BLOCK <= t[:, None]
        forced = (j[None, :] == 0) | (j[None, :] == cur[:, None]) | (j[None, :] == cur[:, None] - 1)
        imp = jnp.where(valid, imp + FORCE_BONUS * forced, -1.0)
        _, sel = lax.top_k(imp, n_top)
        k_sel = ks_blocks[bi, gi, sel].reshape(B, G, Q_BLOCK, n_top * SEL_BLOCK, dh)
        v_sel = vs_blocks[bi, gi, sel].reshape(B, G, Q_BLOCK, n_top * SEL_BLOCK, dh)
        pos_sel = (sel[..., None] * SEL_BLOCK + jnp.arange(SEL_BLOCK)).reshape(B, G, Q_BLOCK, -1)
        s_s = jnp.einsum('bgrtd,bgtnd->bgrtn', qblk, k_sel.astype(jnp.float32))
        p_s = _masked_softmax(s_s, (pos_sel <= t[None, None, :, None])[:, :, None])
        o_s = jnp.einsum('bgrtn,bgtnd->bgrtd', p_s, v_sel.astype(jnp.float32))
        k_w = lax.dynamic_slice_in_dim(kw_p, t0, Q_BLOCK + WINDOW, axis=2).astype(jnp.float32)
        v_w = lax.dynamic_slice_in_dim(vw_p, t0, Q_BLOCK + WINDOW, axis=2).astype(jnp.float32)
        spos = t0 - WINDOW + jnp.arange(Q_BLOCK + WINDOW)
        m_w = (spos[None, :] <= t[:, None]) & (spos[None, :] > t[:, None] - WINDOW) & (spos[None, :] >= 0)
        s_w = jnp.einsum('bgrtd,bgsd->bgrts', qblk, k_w)
        o_w = jnp.einsum('bgrts,bgsd->bgrtd', _masked_softmax(s_w, m_w), v_w)
        g = lax.dynamic_slice_in_dim(gates, t0, Q_BLOCK, axis=1)
        g = g.transpose(0, 2, 1, 3).reshape(B, G, R, Q_BLOCK, 3)
        o = g[..., 0:1] * o_c + g[..., 1:2] * o_s + g[..., 2:3] * o_w
        return o.reshape(B, H, Q_BLOCK, dh)

    out = lax.map(one_block, jnp.arange(n_q))
    return out.transpose(1, 0, 3, 2, 4).reshape(B, S, H * dh)


def _retention(q, k, v, pos):
    B, H, S, dk = q.shape
    C = RET_CHUNK
    N = S // C
    q = _rope(q, pos).astype(jnp.float32)
    k = _rope(k, pos).astype(jnp.float32) * (dk ** -0.5)
    v = v.astype(jnp.float32)
    log_g = jnp.log(1.0 - 2.0 ** (-5.0 - jnp.arange(H, dtype=jnp.float32)))
    i = jnp.arange(C, dtype=jnp.float32)
    diff = i[:, None] - i[None, :]
    causal = diff >= 0
    dec_in = jnp.where(causal, jnp.exp(log_g[:, None, None] * jnp.where(causal, diff, 0.0)), 0.0)
    xi = jnp.exp(log_g[:, None] * (i + 1.0))
    zeta = jnp.exp(log_g[:, None] * (C - 1.0 - i))
    g_chunk = jnp.exp(log_g * C)
    qc = q.reshape(B, H, N, C, dk)
    kc = k.reshape(B, H, N, C, dk)
    vc = v.reshape(B, H, N, C, -1)
    scores = jnp.einsum('bhncd,bhnsd->bhncs', qc, kc) * dec_in[None, :, None]
    inner = jnp.einsum('bhncs,bhnse->bhnce', scores, vc)
    kv = jnp.einsum('bhnsd,bhnse->nbhde', kc * zeta[None, :, None, :, None], vc)

    def step(state, kv_n):
        return state * g_chunk[None, :, None, None] + kv_n, state

    _, state_prev = lax.scan(step, jnp.zeros(kv.shape[1:], jnp.float32), kv)
    cross = jnp.einsum('bhncd,nbhde->bhnce', qc * xi[None, :, None, :, None], state_prev)
    return (inner + cross).reshape(B, H, S, -1)


def _swiglu(h, wg, wu, wd):
    return (jax.nn.silu(h @ wg) * (h @ wu)) @ wd


def _moe(h2, w_router, router_bias, w_gate_e, w_up_e, w_down_e, w_gate_s, w_up_s, w_down_s):
    T, D = h2.shape
    s = jax.nn.sigmoid(h2.astype(jnp.float32) @ w_router.astype(jnp.float32))
    sb = s + router_bias.astype(jnp.float32)
    grp_score = lax.top_k(sb.reshape(T, N_EXPERT_GROUPS, -1), 2)[0].sum(-1)
    _, gidx = lax.top_k(grp_score, TOPK_GROUPS)
    gmask = jax.nn.one_hot(gidx, N_EXPERT_GROUPS, dtype=jnp.float32).sum(1) > 0
    emask = jnp.repeat(gmask, N_EXPERTS // N_EXPERT_GROUPS, axis=1)
    _, idx = lax.top_k(jnp.where(emask, sb, -1e30), TOP_K)
    w = jnp.take_along_axis(s, idx, axis=1)
    w = w / jnp.sum(w, axis=-1, keepdims=True) * ROUTED_SCALE
    A = T * TOP_K
    flat_e = idx.reshape(-1)
    flat_tok = jnp.repeat(jnp.arange(T, dtype=jnp.int32), TOP_K)
    order = jnp.argsort(flat_e)
    e_sorted, tok_sorted, w_sorted = flat_e[order], flat_tok[order], w.reshape(-1)[order]
    counts = jnp.bincount(flat_e, length=N_EXPERTS)
    padded = ((counts + MOE_BLOCK - 1) // MOE_BLOCK) * MOE_BLOCK
    ends_pad = jnp.cumsum(padded)
    starts_pad = ends_pad - padded
    starts = jnp.cumsum(counts) - counts
    dest = starts_pad[e_sorted] + (jnp.arange(A) - starts[e_sorted])
    n_blocks = -(-A // MOE_BLOCK) + N_EXPERTS
    P = n_blocks * MOE_BLOCK
    buf_tok = jnp.zeros((P,), jnp.int32).at[dest].set(tok_sorted)
    buf_w = jnp.zeros((P,), jnp.float32).at[dest].set(w_sorted)
    blk_e = jnp.minimum(jnp.searchsorted(ends_pad, jnp.arange(n_blocks) * MOE_BLOCK, side='right'),
                        N_EXPERTS - 1)

    def expert_step(acc, blk):
        tok, wt, e = blk
        yb = _swiglu(h2[tok], w_gate_e[e], w_up_e[e], w_down_e[e]).astype(jnp.float32)
        return acc.at[tok].add(yb * wt[:, None]), None

    routed, _ = lax.scan(expert_step, jnp.zeros((T, D), jnp.float32),
                         (buf_tok.reshape(n_blocks, MOE_BLOCK), buf_w.reshape(n_blocks, MOE_BLOCK), blk_e))
    shared = _swiglu(h2, w_gate_s, w_up_s, w_down_s).astype(jnp.float32)
    return (shared + routed).astype(h2.dtype)


def setup_inputs(seed: int = 0) -> dict:
    key = jax.random.key(seed)
    ks = jax.random.split(key, 26)
    f32 = jnp.float32
    nrm = lambda k, shape, fan: jax.random.normal(k, shape, f32) * (fan ** -0.5)
    gain = lambda k, shape: 1.0 + 0.02 * jax.random.normal(k, shape, f32)
    L, D, dh = DEPTH, D_MODEL, NSA_HEAD_DIM
    offset = jax.random.randint(ks[2], (BATCH, 1), 0, 2048, dtype=jnp.int32)
    return {
        'x': jax.random.normal(ks[0], (BATCH, SEQ, D), f32),
        'c': jax.random.normal(ks[1], (BATCH, D), f32),
        'positions': offset + jnp.arange(SEQ, dtype=jnp.int32)[None, :],
        'w_ada': 0.5 * nrm(ks[3], (L, D, 6 * D), D),
        'b_ada': 0.02 * jax.random.normal(ks[4], (L, 6 * D), f32),
        'g_norm_mix': gain(ks[5], (L, D)),
        'w_in': nrm(ks[6], (L, D, IN_WIDTH), D),
        'cmp_pos_k': 0.02 * jax.random.normal(ks[7], (L, CMP_BLOCK, dh), f32),
        'cmp_w1_k': nrm(ks[8], (L, CMP_BLOCK * dh, CMP_HIDDEN), CMP_BLOCK * dh),
        'cmp_w2_k': nrm(ks[9], (L, CMP_HIDDEN, dh), CMP_HIDDEN),
        'cmp_pos_v': 0.02 * jax.random.normal(ks[10], (L, CMP_BLOCK, dh), f32),
        'cmp_w1_v': nrm(ks[11], (L, CMP_BLOCK * dh, CMP_HIDDEN), CMP_BLOCK * dh),
        'cmp_w2_v': nrm(ks[12], (L, CMP_HIDDEN, dh), CMP_HIDDEN),
        'g_nsa_out': gain(ks[13], (L, NSA_WIDTH)),
        'g_ret_out': gain(ks[14], (L, RET_HEADS, RET_HEAD_DIM)),
        'w_out': nrm(ks[15], (L, D, D), D),
        'g_norm_ffn': gain(ks[16], (L, D)),
        'w_router': nrm(ks[17], (L, D, N_EXPERTS), D),
        'router_bias': 0.01 * jax.random.normal(ks[18], (L, N_EXPERTS), f32),
        'w_gate_e': nrm(ks[19], (L, N_EXPERTS, D, EXPERT_DIM), D),
        'w_up_e': nrm(ks[20], (L, N_EXPERTS, D, EXPERT_DIM), D),
        'w_down_e': nrm(ks[21], (L, N_EXPERTS, EXPERT_DIM, D), EXPERT_DIM),
        'w_gate_s': nrm(ks[22], (L, D, EXPERT_DIM), D),
        'w_up_s': nrm(ks[23], (L, D, EXPERT_DIM), D),
        'w_down_s': nrm(ks[24], (L, EXPERT_DIM, D), EXPERT_DIM),
        'g_norm_final': gain(ks[25], (D,)),
    }


def reference(x, c, positions, w_ada, b_ada, g_norm_mix, w_in, cmp_pos_k, cmp_w1_k, cmp_w2_k,
              cmp_pos_v, cmp_w1_v, cmp_w2_v, g_nsa_out, g_ret_out, w_out, g_norm_ffn,
              w_router, router_bias, w_gate_e, w_up_e, w_down_e, w_gate_s, w_up_s, w_down_s,
              g_norm_final):
    B, S, D = x.shape
    n_cmp = (S - CMP_BLOCK) // CMP_STRIDE + 1
    cmp_end = np.arange(n_cmp) * CMP_STRIDE + CMP_BLOCK - 1
    pos_cmp = positions[:, cmp_end]
    for l in range(DEPTH):
        mod = jax.nn.silu(c) @ w_ada[l] + b_ada[l]
        sh_a, sc_a, gt_a, sh_m, sc_m, gt_m = [m[:, None, :] for m in jnp.split(mod, 6, axis=-1)]
        h = _rmsnorm(x, g_norm_mix[l]) * (1.0 + sc_a) + sh_a
        proj = h @ w_in[l]
        (q_n, kc_n, vc_n, ks_n, vs_n, kw_n, vw_n, gate_n,
         q_r, k_r, v_r, gate_r) = jnp.split(proj, IN_SPLITS, axis=-1)
        q_nsa = _rope(_heads(q_n, NSA_HEADS), positions)
        k_cmp = _rope(_compress(_heads(kc_n, NSA_KV_GROUPS), cmp_pos_k[l], cmp_w1_k[l], cmp_w2_k[l]), pos_cmp)
        v_cmp = _compress(_heads(vc_n, NSA_KV_GROUPS), cmp_pos_v[l], cmp_w1_v[l], cmp_w2_v[l])
        k_sel = _rope(_heads(ks_n, NSA_KV_GROUPS), positions)
        k_win = _rope(_heads(kw_n, NSA_KV_GROUPS), positions)
        gates = jax.nn.sigmoid(gate_n.astype(jnp.float32)).reshape(B, S, NSA_HEADS, 3)
        o_nsa = _nsa(q_nsa, k_cmp, v_cmp, k_sel, _heads(vs_n, NSA_KV_GROUPS),
                     k_win, _heads(vw_n, NSA_KV_GROUPS), gates)
        o_nsa = _rmsnorm(o_nsa, g_nsa_out[l])
        o_ret = _retention(_heads(q_r, RET_HEADS), _heads(k_r, RET_HEADS), _heads(v_r, RET_HEADS), positions)
        o_ret = _rmsnorm(o_ret.transpose(0, 2, 1, 3), g_ret_out[l]).reshape(B, S, RET_WIDTH)
        o_ret = jax.nn.silu(gate_r.astype(jnp.float32)) * o_ret
        mix = jnp.concatenate([o_nsa, o_ret], axis=-1).astype(x.dtype) @ w_out[l]
        x = x + gt_a * mix
        h = _rmsnorm(x, g_norm_ffn[l]) * (1.0 + sc_m) + sh_m
        y = _moe(h.reshape(B * S, D), w_router[l], router_bias[l], w_gate_e[l], w_up_e[l], w_down_e[l],
                 w_gate_s[l], w_up_s[l], w_down_s[l])
        x = x + gt_m * y.reshape(B, S, D)
    return _rmsnorm(x, g_norm_final)
```

```cpp
#include <hip/hip_runtime.h>
#include <cstdint>
#include <cstdio>

namespace {
constexpr int D = 1024, BATCH = 4, SEQ = 4096, T = BATCH * SEQ;
constexpr int INW = 3352;
constexpr int C_QN = 0, C_KC = 512, C_VC = 640, C_KS = 768, C_VS = 896, C_KW = 1024, C_VW = 1152, C_GN = 1280,
              C_QR = 1304, C_KR = 1816, C_VR = 2328, C_GR = 2840;
constexpr int NC = 255, NCR = BATCH * 2 * NC;
constexpr int NE = 256, ECAP = 16384;
constexpr float EPS = 1e-6f;

struct P {
  const float *x, *c; const int* pos;
  const float *w_ada, *b_ada, *g_mix, *w_in, *cpk, *cw1k, *cw2k, *cpv, *cw1v, *cw2v, *g_nsa, *g_ret, *w_out, *g_ffn,
      *w_router, *rbias, *wg_e, *wu_e, *wd_e, *wg_s, *wu_s, *wd_s, *g_final;
  float* out;
  float *mod, *h, *proj, *hidk, *hidv, *kcmp, *vcmp, *onsa, *Sc, *kv, *retout, *mixin, *x1, *logits, *wts, *Gs, *acts,
      *G, *act, *yacc;
  int *cnt, *list, *tile_e, *tile_off, *ntiles;
};

__device__ __forceinline__ float wave_sum(float v) {
#pragma unroll
  for (int o = 1; o < 64; o <<= 1) v += __shfl_xor(v, o);
  return v;
}
__device__ __forceinline__ float wave_max(float v) {
#pragma unroll
  for (int o = 1; o < 64; o <<= 1) v = fmaxf(v, __shfl_xor(v, o));
  return v;
}
__device__ __forceinline__ float silu(float v) { return v / (1.f + expf(-v)); }
__device__ __forceinline__ float sigm(float v) { return 1.f / (1.f + expf(-v)); }
__device__ __forceinline__ float gelu_tanh(float v) { return 0.5f * v * (1.f + tanhf(0.7978845608028654f * (v + 0.044715f * v * v * v))); }

__global__ __launch_bounds__(256) void k_mod(P p) {
  const int id = blockIdx.x * 256 + threadIdx.x;
  const int b = id / 6144, j = id % 6144;
  float a = 0.f;
  for (int k = 0; k < D; ++k) a += silu(p.c[b * D + k]) * p.w_ada[(size_t)k * 6144 + j];
  p.mod[id] = a + p.b_ada[j];
}

__global__ __launch_bounds__(256) void k_norm(const float* in, const float* g, const float* sc, const float* sh, float* out) {
  const int row = blockIdx.x * 4 + (threadIdx.x >> 6), lane = threadIdx.x & 63, b = row / SEQ;
  const float* xr = in + (size_t)row * D;
  float v[16], s = 0.f;
#pragma unroll
  for (int i = 0; i < 16; ++i) { v[i] = xr[i * 64 + lane]; s += v[i] * v[i]; }
  s = wave_sum(s);
  const float r = rsqrtf(s * (1.f / D) + EPS);
#pragma unroll
  for (int i = 0; i < 16; ++i) {
    const int k = i * 64 + lane;
    float y = v[i] * r * g[k];
    if (sc) y = y * (1.f + sc[b * 6144 + k]) + sh[b * 6144 + k];
    out[(size_t)row * D + k] = y;
  }
}

template <class F>
__global__ __launch_bounds__(256) void k_gemm(F f) {
  __shared__ __attribute__((aligned(16))) float As[16][68];
  __shared__ __attribute__((aligned(16))) float Bs[16][68];
  __shared__ int rid[64];
  const int tid = threadIdx.x, mt = blockIdx.y, n0 = blockIdx.x * 64;
  typename F::Tile ti;
  if (!f.tile(mt, ti)) return;
  if (tid < 64) rid[tid] = f.row(ti, tid);
  __syncthreads();
  float acc[4][4];
#pragma unroll
  for (int i = 0; i < 4; ++i)
#pragma unroll
    for (int j = 0; j < 4; ++j) acc[i][j] = 0.f;
  const int ty = tid >> 4, tx = tid & 15;
  const int ar = tid >> 2, ak = (tid & 3) * 4, bk = tid >> 4, bn = (tid & 15) * 4;
  const int arid = rid[ar];
  for (int k0 = 0; k0 < f.K; k0 += 16) {
#pragma unroll
    for (int i = 0; i < 4; ++i) As[ak + i][ar] = arid >= 0 ? f.a(ti, arid, k0 + ak + i) : 0.f;
#pragma unroll
    for (int j = 0; j < 4; ++j) { const int n = n0 + bn + j; Bs[bk][bn + j] = n < f.N ? f.b(ti, k0 + bk, n) : 0.f; }
    __syncthreads();
#pragma unroll
    for (int kk = 0; kk < 16; ++kk) {
      const float4 a = *(const float4*)&As[kk][ty * 4];
      const float4 b = *(const float4*)&Bs[kk][tx * 4];
      const float av[4] = {a.x, a.y, a.z, a.w}, bv[4] = {b.x, b.y, b.z, b.w};
#pragma unroll
      for (int i = 0; i < 4; ++i)
#pragma unroll
        for (int j = 0; j < 4; ++j) acc[i][j] += av[i] * bv[j];
    }
    __syncthreads();
  }
#pragma unroll
  for (int i = 0; i < 4; ++i) {
    const int r = rid[ty * 4 + i];
    if (r < 0) continue;
#pragma unroll
    for (int j = 0; j < 4; ++j) { const int n = n0 + tx * 4 + j; if (n < f.N) f.epi(ti, r, n, acc[i][j]); }
  }
}

struct DenseTile { int m0; };
struct FProj {
  typedef DenseTile Tile; P p; int N, K;
  __device__ bool tile(int mt, Tile& t) const { t.m0 = mt * 64; return true; }
  __device__ int row(const Tile& t, int i) const { return t.m0 + i; }
  __device__ float a(const Tile&, int r, int k) const { return p.h[(size_t)r * D + k]; }
  __device__ float b(const Tile&, int k, int n) const { return p.w_in[(size_t)k * INW + n]; }
  __device__ void epi(const Tile&, int r, int n, float v) const { p.proj[(size_t)r * INW + n] = v; }
};
struct FCmp1 {
  typedef DenseTile Tile; P p; int N, K; int col, pad; const float *pe, *w1; float* hid;
  __device__ bool tile(int mt, Tile& t) const { t.m0 = mt * 64; return true; }
  __device__ int row(const Tile& t, int i) const { const int r = t.m0 + i; return r < NCR ? r : -1; }
  __device__ float a(const Tile&, int r, int k) const {
    const int b = r / (2 * NC), g = (r / NC) & 1, c = r % NC, l = k >> 6, d = k & 63;
    return p.proj[(size_t)(b * SEQ + 16 * c + l) * INW + col + g * 64 + d] + pe[k];
  }
  __device__ float b(const Tile&, int k, int n) const { return w1[k * 128 + n]; }
  __device__ void epi(const Tile&, int r, int n, float v) const { hid[r * 128 + n] = gelu_tanh(v); }
};
struct FCmp2 {
  typedef DenseTile Tile; P p; int N, K; const float *hid, *w2; float* outp;
  __device__ bool tile(int mt, Tile& t) const { t.m0 = mt * 64; return true; }
  __device__ int row(const Tile& t, int i) const { const int r = t.m0 + i; return r < NCR ? r : -1; }
  __device__ float a(const Tile&, int r, int k) const { return hid[r * 128 + k]; }
  __device__ float b(const Tile&, int k, int n) const { return w2[k * 64 + n]; }
  __device__ void epi(const Tile&, int r, int n, float v) const { outp[r * 64 + n] = v; }
};
__device__ __forceinline__ float ret_logg(int h) { return logf(1.f - exp2f(-5.f - (float)h)); }
struct RetTile { int chunk, i0, b, h, s0; };
__device__ __forceinline__ void ret_tile(int mt, RetTile& t) { t.chunk = mt >> 1; t.i0 = (mt & 1) * 64; const int bh = t.chunk >> 5; t.b = bh >> 2; t.h = bh & 3; t.s0 = (t.chunk & 31) * 128; }
struct FRet1 {
  typedef RetTile Tile; P p; int N, K;
  __device__ bool tile(int mt, Tile& t) const { ret_tile(mt, t); return true; }
  __device__ int row(const Tile& t, int i) const { return t.i0 + i; }
  __device__ float a(const Tile& t, int r, int k) const { return p.proj[(size_t)(t.b * SEQ + t.s0 + r) * INW + C_QR + t.h * 128 + k]; }
  __device__ float b(const Tile& t, int k, int n) const { return p.proj[(size_t)(t.b * SEQ + t.s0 + n) * INW + C_KR + t.h * 128 + k]; }
  __device__ void epi(const Tile& t, int r, int n, float v) const { p.Sc[((size_t)t.chunk * 128 + r) * 128 + n] = r >= n ? v * expf(ret_logg(t.h) * (float)(r - n)) : 0.f; }
};
struct FRet2 {
  typedef RetTile Tile; P p; int N, K;
  __device__ bool tile(int mt, Tile& t) const { ret_tile(mt, t); return true; }
  __device__ int row(const Tile& t, int i) const { return t.i0 + i; }
  __device__ float a(const Tile& t, int r, int k) const { return p.proj[(size_t)(t.b * SEQ + t.s0 + k) * INW + C_KR + t.h * 128 + r] * expf(ret_logg(t.h) * (float)(127 - k)); }
  __device__ float b(const Tile& t, int k, int n) const { return p.proj[(size_t)(t.b * SEQ + t.s0 + k) * INW + C_VR + t.h * 128 + n]; }
  __device__ void epi(const Tile& t, int r, int n, float v) const { p.kv[((size_t)t.chunk * 128 + r) * 128 + n] = v; }
};
struct FRet3 {
  typedef RetTile Tile; P p; int N, K;
  __device__ bool tile(int mt, Tile& t) const { ret_tile(mt, t); return true; }
  __device__ int row(const Tile& t, int i) const { return t.i0 + i; }
  __device__ float a(const Tile& t, int r, int k) const {
    if (k < 128) return p.Sc[((size_t)t.chunk * 128 + r) * 128 + k];
    return p.proj[(size_t)(t.b * SEQ + t.s0 + r) * INW + C_QR + t.h * 128 + (k - 128)] * expf(ret_logg(t.h) * (float)(r + 1));
  }
  __device__ float b(const Tile& t, int k, int n) const {
    if (k < 128) return p.proj[(size_t)(t.b * SEQ + t.s0 + k) * INW + C_VR + t.h * 128 + n];
    return p.kv[((size_t)t.chunk * 128 + (k - 128)) * 128 + n];
  }
  __device__ void epi(const Tile& t, int r, int n, float v) const { p.retout[(size_t)(t.b * SEQ + t.s0 + r) * 512 + t.h * 128 + n] = v; }
};
struct FOut {
  typedef DenseTile Tile; P p; int N, K;
  __device__ bool tile(int mt, Tile& t) const { t.m0 = mt * 64; return true; }
  __device__ int row(const Tile& t, int i) const { return t.m0 + i; }
  __device__ float a(const Tile&, int r, int k) const { return p.mixin[(size_t)r * D + k]; }
  __device__ float b(const Tile&, int k, int n) const { return p.w_out[(size_t)k * D + n]; }
  __device__ void epi(const Tile&, int r, int n, float v) const { const int b = r / SEQ; p.x1[(size_t)r * D + n] = p.x[(size_t)r * D + n] + p.mod[b * 6144 + 2048 + n] * v; }
};
struct FRouter {
  typedef DenseTile Tile; P p; int N, K;
  __device__ bool tile(int mt, Tile& t) const { t.m0 = mt * 64; return true; }
  __device__ int row(const Tile& t, int i) const { return t.m0 + i; }
  __device__ float a(const Tile&, int r, int k) const { return p.h[(size_t)r * D + k]; }
  __device__ float b(const Tile&, int k, int n) const { return p.w_router[k * NE + n]; }
  __device__ void epi(const Tile&, int r, int n, float v) const { p.logits[r * NE + n] = v; }
};
template <int MODE> struct FShared {
  typedef DenseTile Tile; P p; int N, K;
  __device__ bool tile(int mt, Tile& t) const { t.m0 = mt * 64; return true; }
  __device__ int row(const Tile& t, int i) const { return t.m0 + i; }
  __device__ float a(const Tile&, int r, int k) const { return MODE == 2 ? p.acts[(size_t)r * 256 + k] : p.h[(size_t)r * D + k]; }
  __device__ float b(const Tile&, int k, int n) const { return MODE == 0 ? p.wg_s[k * 256 + n] : MODE == 1 ? p.wu_s[k * 256 + n] : p.wd_s[k * D + n]; }
  __device__ void epi(const Tile&, int r, int n, float v) const {
    if (MODE == 0) p.Gs[(size_t)r * 256 + n] = v;
    else if (MODE == 1) p.acts[(size_t)r * 256 + n] = silu(p.Gs[(size_t)r * 256 + n]) * v;
    else p.yacc[(size_t)r * D + n] = v;
  }
};
struct MoeTile { int e, off, cnt; };
template <int MODE> struct FMoe {
  typedef MoeTile Tile; P p; int N, K;
  __device__ bool tile(int mt, Tile& t) const { if (mt >= *p.ntiles) return false; t.e = p.tile_e[mt]; t.off = p.tile_off[mt]; t.cnt = p.cnt[t.e]; return true; }
  __device__ int row(const Tile& t, int i) const { return t.off + i < t.cnt ? p.list[t.e * ECAP + t.off + i] : -1; }
  __device__ float a(const Tile&, int sid, int k) const { return MODE == 2 ? p.act[(size_t)sid * 256 + k] : p.h[(size_t)(sid >> 3) * D + k]; }
  __device__ float b(const Tile& t, int k, int n) const {
    return MODE == 0 ? p.wg_e[((size_t)t.e * D + k) * 256 + n] : MODE == 1 ? p.wu_e[((size_t)t.e * D + k) * 256 + n] : p.wd_e[((size_t)t.e * 256 + k) * D + n];
  }
  __device__ void epi(const Tile&, int sid, int n, float v) const {
    if (MODE == 0) p.G[(size_t)sid * 256 + n] = v;
    else if (MODE == 1) p.act[(size_t)sid * 256 + n] = silu(p.G[(size_t)sid * 256 + n]) * v;
    else atomicAdd(&p.yacc[(size_t)(sid >> 3) * D + n], v * p.wts[sid]);
  }
};

__global__ __launch_bounds__(256) void k_rope(P p) {
  const int id = blockIdx.x * 256 + threadIdx.x;
  const int tok = id / 896, pr = id % 896;
  int col, half, i; float sc = 1.f;
  if (pr < 256) { col = C_QN + (pr >> 5) * 64; i = pr & 31; half = 32; }
  else if (pr < 320) { const int q = pr - 256; col = C_KS + (q >> 5) * 64; i = q & 31; half = 32; }
  else if (pr < 384) { const int q = pr - 320; col = C_KW + (q >> 5) * 64; i = q & 31; half = 32; }
  else if (pr < 640) { const int q = pr - 384; col = C_QR + (q >> 6) * 128; i = q & 63; half = 64; }
  else { const int q = pr - 640; col = C_KR + (q >> 6) * 128; i = q & 63; half = 64; sc = 0.08838834764831845f; }
  const float inv = powf(10000.f, -(float)(2 * i) / (float)(2 * half));
  const float ang = (float)p.pos[tok] * inv;
  float sn, cs; sincosf(ang, &sn, &cs);
  float* q = p.proj + (size_t)tok * INW + col;
  const float x1 = q[i], x2 = q[i + half];
  q[i] = (x1 * cs - x2 * sn) * sc; q[i + half] = (x1 * sn + x2 * cs) * sc;
}
__global__ __launch_bounds__(256) void k_rope_cmp(P p) {
  const int id = blockIdx.x * 256 + threadIdx.x;
  if (id >= NCR * 32) return;
  const int r = id >> 5, i = id & 31, b = r / (2 * NC), c = r % NC;
  const float inv = powf(10000.f, -(float)(2 * i) / 64.f);
  const float ang = (float)p.pos[b * SEQ + 16 * c + 31] * inv;
  float sn, cs; sincosf(ang, &sn, &cs);
  float* q = p.kcmp + r * 64;
  const float x1 = q[i], x2 = q[i + 32];
  q[i] = x1 * cs - x2 * sn; q[i + 32] = x1 * sn + x2 * cs;
}

__global__ __launch_bounds__(256) void k_nsa(P p) {
  const int bt = blockIdx.x, g = blockIdx.y, b = bt / SEQ, t = bt % SEQ;
  const int tid = threadIdx.x, r = tid >> 6, lane = tid & 63, h = g * 4 + r;
  __shared__ float qs[4][64];
  __shared__ float pc[4][256];
  __shared__ float ps[4][512];
  __shared__ float impv[64];
  __shared__ int sel[8];
  qs[r][lane] = p.proj[(size_t)bt * INW + C_QN + h * 64 + lane] * 0.125f;
  __syncthreads();
  float sc[4], mx = -1e30f;
#pragma unroll
  for (int i = 0; i < 4; ++i) {
    const int c = i * 64 + lane; float s = -1e30f;
    if (c < NC && 16 * c + 31 <= t) { const float* kr = p.kcmp + ((size_t)(b * 2 + g) * NC + c) * 64; float a = 0.f; for (int d = 0; d < 64; ++d) a += qs[r][d] * kr[d]; s = a; }
    sc[i] = s; mx = fmaxf(mx, s);
  }
  mx = wave_max(mx);
  float sum = 0.f;
#pragma unroll
  for (int i = 0; i < 4; ++i) { const int c = i * 64 + lane; const bool v = c < NC && 16 * c + 31 <= t; const float e = v ? expf(sc[i] - mx) : 0.f; sc[i] = e; sum += e; }
  sum = wave_sum(sum);
  float inv = 1.f / fmaxf(sum, 1e-20f);
#pragma unroll
  for (int i = 0; i < 4; ++i) pc[r][i * 64 + lane] = sc[i] * inv;
  __syncthreads();
  float oc = 0.f;
  { const int nv = t >= 31 ? min(NC, (t - 31) / 16 + 1) : 0;
    for (int c = 0; c < nv; ++c) oc += pc[r][c] * p.vcmp[((size_t)(b * 2 + g) * NC + c) * 64 + lane]; }
  if (tid < 64) {
    const int j = tid; float im = 0.f;
    const int c0 = max(0, 4 * j - 1), c1 = min(NC - 1, 4 * j + 3);
    for (int rr = 0; rr < 4; ++rr) for (int c = c0; c <= c1; ++c) im += pc[rr][c];
    const int cur = t >> 6; const bool valid = j * 64 <= t, forced = (j == 0) || (j == cur) || (j == cur - 1);
    impv[j] = valid ? im + (forced ? 1e4f : 0.f) : -1.f;
  }
  __syncthreads();
  if (tid == 0) {
    for (int k = 0; k < 8; ++k) { int best = 0; float bv = impv[0]; for (int j = 1; j < 64; ++j) if (impv[j] > bv) { bv = impv[j]; best = j; } sel[k] = best; impv[best] = -INFINITY; }
  }
  __syncthreads();
  float ss[8]; mx = -1e30f;
#pragma unroll
  for (int i = 0; i < 8; ++i) {
    const int q = sel[i] * 64 + lane; float s = -1e30f;
    if (q <= t) { const float* kr = p.proj + (size_t)(b * SEQ + q) * INW + C_KS + g * 64; float a = 0.f; for (int d = 0; d < 64; ++d) a += qs[r][d] * kr[d]; s = a; }
    ss[i] = s; mx = fmaxf(mx, s);
  }
  mx = wave_max(mx); sum = 0.f;
#pragma unroll
  for (int i = 0; i < 8; ++i) { const int q = sel[i] * 64 + lane; const float e = q <= t ? expf(ss[i] - mx) : 0.f; ss[i] = e; sum += e; }
  sum = wave_sum(sum); inv = 1.f / fmaxf(sum, 1e-20f);
#pragma unroll
  for (int i = 0; i < 8; ++i) ps[r][i * 64 + lane] = ss[i] * inv;
  __syncthreads();
  float os = 0.f;
  for (int i = 0; i < 8; ++i) { const int q0 = sel[i] * 64;
    for (int l = 0; l < 64; ++l) { const int q = q0 + l; if (q <= t) os += ps[r][i * 64 + l] * p.proj[(size_t)(b * SEQ + q) * INW + C_VS + g * 64 + lane]; } }
  __syncthreads();
  mx = -1e30f;
#pragma unroll
  for (int i = 0; i < 8; ++i) {
    const int q = t - 511 + i * 64 + lane; float s = -1e30f;
    if (q >= 0) { const float* kr = p.proj + (size_t)(b * SEQ + q) * INW + C_KW + g * 64; float a = 0.f; for (int d = 0; d < 64; ++d) a += qs[r][d] * kr[d]; s = a; }
    ss[i] = s; mx = fmaxf(mx, s);
  }
  mx = wave_max(mx); sum = 0.f;
#pragma unroll
  for (int i = 0; i < 8; ++i) { const int q = t - 511 + i * 64 + lane; const float e = q >= 0 ? expf(ss[i] - mx) : 0.f; ss[i] = e; sum += e; }
  sum = wave_sum(sum); inv = 1.f / fmaxf(sum, 1e-20f);
#pragma unroll
  for (int i = 0; i < 8; ++i) ps[r][i * 64 + lane] = ss[i] * inv;
  __syncthreads();
  float ow = 0.f;
  for (int i = 0; i < 512; ++i) { const int q = t - 511 + i; if (q >= 0) ow += ps[r][i] * p.proj[(size_t)(b * SEQ + q) * INW + C_VW + g * 64 + lane]; }
  const float* gp = p.proj + (size_t)bt * INW + C_GN + h * 3;
  p.onsa[(size_t)bt * 512 + h * 64 + lane] = sigm(gp[0]) * oc + sigm(gp[1]) * os + sigm(gp[2]) * ow;
}

__global__ __launch_bounds__(256) void k_mixin(P p) {
  const int tok = blockIdx.x * 4 + (threadIdx.x >> 6), lane = threadIdx.x & 63;
  float v[8], s = 0.f;
#pragma unroll
  for (int i = 0; i < 8; ++i) { v[i] = p.onsa[(size_t)tok * 512 + i * 64 + lane]; s += v[i] * v[i]; }
  s = wave_sum(s);
  float r = rsqrtf(s * (1.f / 512.f) + EPS);
#pragma unroll
  for (int i = 0; i < 8; ++i) p.mixin[(size_t)tok * D + i * 64 + lane] = v[i] * r * p.g_nsa[i * 64 + lane];
#pragma unroll
  for (int hh = 0; hh < 4; ++hh) {
    const float a = p.retout[(size_t)tok * 512 + hh * 128 + lane], b = p.retout[(size_t)tok * 512 + hh * 128 + 64 + lane];
    const float q = wave_sum(a * a + b * b);
    r = rsqrtf(q * (1.f / 128.f) + EPS);
    const float* gr = p.proj + (size_t)tok * INW + C_GR + hh * 128;
    p.mixin[(size_t)tok * D + 512 + hh * 128 + lane] = silu(gr[lane]) * a * r * p.g_ret[hh * 128 + lane];
    p.mixin[(size_t)tok * D + 512 + hh * 128 + 64 + lane] = silu(gr[64 + lane]) * b * r * p.g_ret[hh * 128 + 64 + lane];
  }
}

__global__ __launch_bounds__(256) void k_ret_scan(P p) {
  const int id = blockIdx.x * 256 + threadIdx.x;
  const int bh = id >> 14, de = id & 16383, h = bh & 3;
  const float gc = expf(ret_logg(h) * 128.f);
  float st = 0.f;
  for (int n = 0; n < 32; ++n) { float* q = p.kv + ((size_t)(bh * 32 + n) * 16384 + de); const float kvn = *q; *q = st; st = st * gc + kvn; }
}

__global__ __launch_bounds__(256) void k_route(P p) {
  const int t = blockIdx.x * 256 + threadIdx.x;
  const float* lg = p.logits + (size_t)t * NE;
  unsigned gmask = 0;
  { float pv = INFINITY; int pg = -1;
    for (int k = 0; k < 4; ++k) {
      float bv = -INFINITY; int bg = -1;
      for (int g = 0; g < 8; ++g) {
        float m1 = -INFINITY, m2 = -INFINITY;
        for (int e = 0; e < 32; ++e) { const float v = sigm(lg[g * 32 + e]) + p.rbias[g * 32 + e]; if (v > m1) { m2 = m1; m1 = v; } else if (v > m2) m2 = v; }
        const float gs = m1 + m2;
        const bool after = (gs < pv) || (gs == pv && g > pg);
        if (after && gs > bv) { bv = gs; bg = g; }
      }
      gmask |= 1u << bg; pv = bv; pg = bg;
    } }
  float pv = INFINITY; int pe = -1; int ids[8]; float ws[8]; float wsum = 0.f;
#pragma unroll
  for (int k = 0; k < 8; ++k) {
    float bv = -INFINITY; int be = -1; float bs = 0.f;
    for (int e = 0; e < NE; ++e) {
      if (!((gmask >> (e >> 5)) & 1u)) continue;
      const float s = sigm(lg[e]), v = s + p.rbias[e];
      const bool after = (v < pv) || (v == pv && e > pe);
      if (after && v > bv) { bv = v; be = e; bs = s; }
    }
    ids[k] = be; ws[k] = bs; wsum += bs; pv = bv; pe = be;
  }
#pragma unroll
  for (int k = 0; k < 8; ++k) {
    const int e = ids[k]; const int pos = atomicAdd(&p.cnt[e], 1);
    p.list[e * ECAP + pos] = t * 8 + k; p.wts[t * 8 + k] = ws[k] / wsum * 2.5f;
  }
}
__global__ void k_moe_tiles(P p) {
  int nt = 0;
  for (int e = 0; e < NE; ++e) for (int off = 0; off < p.cnt[e]; off += 64) { p.tile_e[nt] = e; p.tile_off[nt] = off; ++nt; }
  *p.ntiles = nt;
}

__global__ __launch_bounds__(256) void k_final(P p) {
  const int row = blockIdx.x * 4 + (threadIdx.x >> 6), lane = threadIdx.x & 63, b = row / SEQ;
  float v[16], s = 0.f;
#pragma unroll
  for (int i = 0; i < 16; ++i) { const int k = i * 64 + lane; v[i] = p.x1[(size_t)row * D + k] + p.mod[b * 6144 + 5120 + k] * p.yacc[(size_t)row * D + k]; s += v[i] * v[i]; }
  s = wave_sum(s);
  const float r = rsqrtf(s * (1.f / D) + EPS);
#pragma unroll
  for (int i = 0; i < 16; ++i) { const int k = i * 64 + lane; p.out[(size_t)row * D + k] = v[i] * r * p.g_final[k]; }
}
}

extern "C" void kernel_launch(void* const* d_in, const int* in_sizes, int n_in, void* d_out, int out_size, void* d_ws, size_t ws_size, hipStream_t stream) {
  P p{};
  p.x = (const float*)d_in[0]; p.c = (const float*)d_in[1]; p.pos = (const int*)d_in[2];
  p.w_ada = (const float*)d_in[3]; p.b_ada = (const float*)d_in[4]; p.g_mix = (const float*)d_in[5]; p.w_in = (const float*)d_in[6];
  p.cpk = (const float*)d_in[7]; p.cw1k = (const float*)d_in[8]; p.cw2k = (const float*)d_in[9];
  p.cpv = (const float*)d_in[10]; p.cw1v = (const float*)d_in[11]; p.cw2v = (const float*)d_in[12];
  p.g_nsa = (const float*)d_in[13]; p.g_ret = (const float*)d_in[14]; p.w_out = (const float*)d_in[15]; p.g_ffn = (const float*)d_in[16];
  p.w_router = (const float*)d_in[17]; p.rbias = (const float*)d_in[18]; p.wg_e = (const float*)d_in[19]; p.wu_e = (const float*)d_in[20];
  p.wd_e = (const float*)d_in[21]; p.wg_s = (const float*)d_in[22]; p.wu_s = (const float*)d_in[23]; p.wd_s = (const float*)d_in[24];
  p.g_final = (const float*)d_in[25];
  p.out = (float*)d_out;
  char* w = (char*)d_ws; size_t off = 0;
  auto take = [&](size_t bytes) { char* r = w + off; off += (bytes + 255) & ~(size_t)255; return r; };
  p.cnt = (int*)take(NE * 4); p.ntiles = (int*)take(4);
  const size_t zero_bytes = off;
  p.mod = (float*)take(BATCH * 6144 * 4);
  p.h = (float*)take((size_t)T * D * 4);
  p.proj = (float*)take((size_t)T * INW * 4);
  p.G = p.proj;
  p.hidk = (float*)take(2048 * 128 * 4); p.hidv = (float*)take(2048 * 128 * 4);
  p.kcmp = (float*)take(2048 * 64 * 4); p.vcmp = (float*)take(2048 * 64 * 4);
  p.onsa = (float*)take((size_t)T * 512 * 4);
  p.Sc = (float*)take((size_t)512 * 16384 * 4); p.kv = (float*)take((size_t)512 * 16384 * 4);
  p.retout = (float*)take((size_t)T * 512 * 4);
  p.mixin = (float*)take((size_t)T * D * 4);
  p.x1 = (float*)take((size_t)T * D * 4);
  p.logits = (float*)take((size_t)T * NE * 4);
  p.wts = (float*)take((size_t)T * 8 * 4);
  p.Gs = (float*)take((size_t)T * 256 * 4); p.acts = (float*)take((size_t)T * 256 * 4);
  p.act = (float*)take((size_t)T * 8 * 256 * 4);
  p.yacc = (float*)take((size_t)T * D * 4);
  p.list = (int*)take((size_t)NE * ECAP * 4);
  p.tile_e = (int*)take(4096 * 4); p.tile_off = (int*)take(4096 * 4);
  if (off > ws_size) { fprintf(stderr, "kernel_launch: workspace too small: need %zu have %zu\n", off, ws_size); return; }
  (void)hipMemsetAsync(d_ws, 0, zero_bytes, stream);

  k_mod<<<BATCH * 6144 / 256, 256, 0, stream>>>(p);
  k_norm<<<T / 4, 256, 0, stream>>>(p.x, p.g_mix, p.mod + 1024, p.mod + 0, p.h);
  { FProj f{p, INW, D}; k_gemm<<<dim3((INW + 63) / 64, T / 64), 256, 0, stream>>>(f); }
  k_rope<<<T * 896 / 256, 256, 0, stream>>>(p);
  { FCmp1 f{p, 128, 2048, C_KC, 0, p.cpk, p.cw1k, p.hidk}; k_gemm<<<dim3(2, 32), 256, 0, stream>>>(f); }
  { FCmp1 f{p, 128, 2048, C_VC, 0, p.cpv, p.cw1v, p.hidv}; k_gemm<<<dim3(2, 32), 256, 0, stream>>>(f); }
  { FCmp2 f{p, 64, 128, p.hidk, p.cw2k, p.kcmp}; k_gemm<<<dim3(1, 32), 256, 0, stream>>>(f); }
  { FCmp2 f{p, 64, 128, p.hidv, p.cw2v, p.vcmp}; k_gemm<<<dim3(1, 32), 256, 0, stream>>>(f); }
  k_rope_cmp<<<(NCR * 32 + 255) / 256, 256, 0, stream>>>(p);
  k_nsa<<<dim3(T, 2), 256, 0, stream>>>(p);
  { FRet1 f{p, 128, 128}; k_gemm<<<dim3(2, 1024), 256, 0, stream>>>(f); }
  { FRet2 f{p, 128, 128}; k_gemm<<<dim3(2, 1024), 256, 0, stream>>>(f); }
  k_ret_scan<<<16 * 16384 / 256, 256, 0, stream>>>(p);
  { FRet3 f{p, 128, 256}; k_gemm<<<dim3(2, 1024), 256, 0, stream>>>(f); }
  k_mixin<<<T / 4, 256, 0, stream>>>(p);
  { FOut f{p, D, D}; k_gemm<<<dim3(D / 64, T / 64), 256, 0, stream>>>(f); }
  k_norm<<<T / 4, 256, 0, stream>>>(p.x1, p.g_ffn, p.mod + 4096, p.mod + 3072, p.h);
  { FRouter f{p, NE, D}; k_gemm<<<dim3(NE / 64, T / 64), 256, 0, stream>>>(f); }
  k_route<<<T / 256, 256, 0, stream>>>(p);
  k_moe_tiles<<<1, 1, 0, stream>>>(p);
  { FShared<0> f{p, 256, D}; k_gemm<<<dim3(4, T / 64), 256, 0, stream>>>(f); }
  { FShared<1> f{p, 256, D}; k_gemm<<<dim3(4, T / 64), 256, 0, stream>>>(f); }
  { FShared<2> f{p, D, 256}; k_gemm<<<dim3(16, T / 64), 256, 0, stream>>>(f); }
  { FMoe<0> f{p, 256, D}; k_gemm<<<dim3(4, 2304), 256, 0, stream>>>(f); }
  { FMoe<1> f{p, 256, D}; k_gemm<<<dim3(4, 2304), 256, 0, stream>>>(f); }
  { FMoe<2> f{p, D, 256}; k_gemm<<<dim3(16, 2304), 256, 0, stream>>>(f); }
  k_final<<<T / 4, 256, 0, stream>>>(p);
}
```

```cpp
#include <hip/hip_runtime.h>
#include <cstdint>
#include <cstdio>

namespace {
constexpr int D = 1024, BATCH = 4, SEQ = 4096, T = BATCH * SEQ;
constexpr int INW = 3352;
constexpr int C_QN = 0, C_KC = 512, C_VC = 640, C_KS = 768, C_VS = 896, C_KW = 1024, C_VW = 1152, C_GN = 1280,
              C_QR = 1304, C_KR = 1816, C_VR = 2328, C_GR = 2840;
constexpr int NC = 255, NCR = BATCH * 2 * NC;
constexpr int NE = 256, ECAP = 16384;
constexpr float EPS = 1e-6f;

struct P {
  const float *x, *c; const int* pos;
  const float *w_ada, *b_ada, *g_mix, *w_in, *cpk, *cw1k, *cw2k, *cpv, *cw1v, *cw2v, *g_nsa, *g_ret, *w_out, *g_ffn,
      *w_router, *rbias, *wg_e, *wu_e, *wd_e, *wg_s, *wu_s, *wd_s, *g_final;
  float* out;
  float *mod, *h, *proj, *hidk, *hidv, *kcmp, *vcmp, *onsa, *Sc, *kv, *retout, *mixin, *x1, *logits, *wts, *Gs, *acts,
      *G, *act, *yacc;
  int *cnt, *list, *tile_e, *tile_off, *ntiles;
};

__device__ __forceinline__ float wave_sum(float v) {
#pragma unroll
  for (int o = 1; o < 64; o <<= 1) v += __shfl_xor(v, o);
  return v;
}
__device__ __forceinline__ float wave_max(float v) {
#pragma unroll
  for (int o = 1; o < 64; o <<= 1) v = fmaxf(v, __shfl_xor(v, o));
  return v;
}
__device__ __forceinline__ float silu(float v) { return v / (1.f + expf(-v)); }
__device__ __forceinline__ float sigm(float v) { return 1.f / (1.f + expf(-v)); }
__device__ __forceinline__ float gelu_tanh(float v) { return 0.5f * v * (1.f + tanhf(0.7978845608028654f * (v + 0.044715f * v * v * v))); }

__device__ __forceinline__ void d_mod(const P& p, int bx) {
  const int id = bx * 256 + threadIdx.x;
  const int b = id / 6144, j = id % 6144;
  float a = 0.f;
  for (int k = 0; k < D; ++k) a += silu(p.c[b * D + k]) * p.w_ada[(size_t)k * 6144 + j];
  p.mod[id] = a + p.b_ada[j];
}

__device__ __forceinline__ void d_norm(const float* in, const float* g, const float* sc, const float* sh, float* out, int bx) {
  const int row = bx * 4 + (threadIdx.x >> 6), lane = threadIdx.x & 63, b = row / SEQ;
  const float* xr = in + (size_t)row * D;
  float v[16], s = 0.f;
#pragma unroll
  for (int i = 0; i < 16; ++i) { v[i] = xr[i * 64 + lane]; s += v[i] * v[i]; }
  s = wave_sum(s);
  const float r = rsqrtf(s * (1.f / D) + EPS);
#pragma unroll
  for (int i = 0; i < 16; ++i) {
    const int k = i * 64 + lane;
    float y = v[i] * r * g[k];
    if (sc) y = y * (1.f + sc[b * 6144 + k]) + sh[b * 6144 + k];
    out[(size_t)row * D + k] = y;
  }
}

template <class F>
__device__ __forceinline__ void d_gemm(const F& f, int bx, int by, char* smem) {
  float (*As)[68] = (float (*)[68])smem;
  float (*Bs)[68] = (float (*)[68])(smem + 16 * 68 * 4);
  int* rid = (int*)(smem + 2 * 16 * 68 * 4);
  const int tid = threadIdx.x, mt = by, n0 = bx * 64;
  typename F::Tile ti;
  if (!f.tile(mt, ti)) return;
  if (tid < 64) rid[tid] = f.row(ti, tid);
  __syncthreads();
  float acc[4][4];
#pragma unroll
  for (int i = 0; i < 4; ++i)
#pragma unroll
    for (int j = 0; j < 4; ++j) acc[i][j] = 0.f;
  const int ty = tid >> 4, tx = tid & 15;
  const int ar = tid >> 2, ak = (tid & 3) * 4, bk = tid >> 4, bn = (tid & 15) * 4;
  const int arid = rid[ar];
  for (int k0 = 0; k0 < f.K; k0 += 16) {
#pragma unroll
    for (int i = 0; i < 4; ++i) As[ak + i][ar] = arid >= 0 ? f.a(ti, arid, k0 + ak + i) : 0.f;
#pragma unroll
    for (int j = 0; j < 4; ++j) { const int n = n0 + bn + j; Bs[bk][bn + j] = n < f.N ? f.b(ti, k0 + bk, n) : 0.f; }
    __syncthreads();
#pragma unroll
    for (int kk = 0; kk < 16; ++kk) {
      const float4 a = *(const float4*)&As[kk][ty * 4];
      const float4 b = *(const float4*)&Bs[kk][tx * 4];
      const float av[4] = {a.x, a.y, a.z, a.w}, bv[4] = {b.x, b.y, b.z, b.w};
#pragma unroll
      for (int i = 0; i < 4; ++i)
#pragma unroll
        for (int j = 0; j < 4; ++j) acc[i][j] += av[i] * bv[j];
    }
    __syncthreads();
  }
#pragma unroll
  for (int i = 0; i < 4; ++i) {
    const int r = rid[ty * 4 + i];
    if (r < 0) continue;
#pragma unroll
    for (int j = 0; j < 4; ++j) { const int n = n0 + tx * 4 + j; if (n < f.N) f.epi(ti, r, n, acc[i][j]); }
  }
}

struct DenseTile { int m0; };
struct FProj {
  typedef DenseTile Tile; P p; int N, K;
  __device__ bool tile(int mt, Tile& t) const { t.m0 = mt * 64; return true; }
  __device__ int row(const Tile& t, int i) const { return t.m0 + i; }
  __device__ float a(const Tile&, int r, int k) const { return p.h[(size_t)r * D + k]; }
  __device__ float b(const Tile&, int k, int n) const { return p.w_in[(size_t)k * INW + n]; }
  __device__ void epi(const Tile&, int r, int n, float v) const { p.proj[(size_t)r * INW + n] = v; }
};
struct FCmp1 {
  typedef DenseTile Tile; P p; int N, K; int col, pad; const float *pe, *w1; float* hid;
  __device__ bool tile(int mt, Tile& t) const { t.m0 = mt * 64; return true; }
  __device__ int row(const Tile& t, int i) const { const int r = t.m0 + i; return r < NCR ? r : -1; }
  __device__ float a(const Tile&, int r, int k) const {
    const int b = r / (2 * NC), g = (r / NC) & 1, c = r % NC, l = k >> 6, d = k & 63;
    return p.proj[(size_t)(b * SEQ + 16 * c + l) * INW + col + g * 64 + d] + pe[k];
  }
  __device__ float b(const Tile&, int k, int n) const { return w1[k * 128 + n]; }
  __device__ void epi(const Tile&, int r, int n, float v) const { hid[r * 128 + n] = gelu_tanh(v); }
};
struct FCmp2 {
  typedef DenseTile Tile; P p; int N, K; const float *hid, *w2; float* outp;
  __device__ bool tile(int mt, Tile& t) const { t.m0 = mt * 64; return true; }
  __device__ int row(const Tile& t, int i) const { const int r = t.m0 + i; return r < NCR ? r : -1; }
  __device__ float a(const Tile&, int r, int k) const { return hid[r * 128 + k]; }
  __device__ float b(const Tile&, int k, int n) const { return w2[k * 64 + n]; }
  __device__ void epi(const Tile&, int r, int n, float v) const { outp[r * 64 + n] = v; }
};
__device__ __forceinline__ float ret_logg(int h) { return logf(1.f - exp2f(-5.f - (float)h)); }
struct RetTile { int chunk, i0, b, h, s0; };
__device__ __forceinline__ void ret_tile(int mt, RetTile& t) { t.chunk = mt >> 1; t.i0 = (mt & 1) * 64; const int bh = t.chunk >> 5; t.b = bh >> 2; t.h = bh & 3; t.s0 = (t.chunk & 31) * 128; }
struct FRet1 {
  typedef RetTile Tile; P p; int N, K;
  __device__ bool tile(int mt, Tile& t) const { ret_tile(mt, t); return true; }
  __device__ int row(const Tile& t, int i) const { return t.i0 + i; }
  __device__ float a(const Tile& t, int r, int k) const { return p.proj[(size_t)(t.b * SEQ + t.s0 + r) * INW + C_QR + t.h * 128 + k]; }
  __device__ float b(const Tile& t, int k, int n) const { return p.proj[(size_t)(t.b * SEQ + t.s0 + n) * INW + C_KR + t.h * 128 + k]; }
  __device__ void epi(const Tile& t, int r, int n, float v) const { p.Sc[((size_t)t.chunk * 128 + r) * 128 + n] = r >= n ? v * expf(ret_logg(t.h) * (float)(r - n)) : 0.f; }
};
struct FRet2 {
  typedef RetTile Tile; P p; int N, K;
  __device__ bool tile(int mt, Tile& t) const { ret_tile(mt, t); return true; }
  __device__ int row(const Tile& t, int i) const { return t.i0 + i; }
  __device__ float a(const Tile& t, int r, int k) const { return p.proj[(size_t)(t.b * SEQ + t.s0 + k) * INW + C_KR + t.h * 128 + r] * expf(ret_logg(t.h) * (float)(127 - k)); }
  __device__ float b(const Tile& t, int k, int n) const { return p.proj[(size_t)(t.b * SEQ + t.s0 + k) * INW + C_VR + t.h * 128 + n]; }
  __device__ void epi(const Tile& t, int r, int n, float v) const { p.kv[((size_t)t.chunk * 128 + r) * 128 + n] = v; }
};
struct FRet3 {
  typedef RetTile Tile; P p; int N, K;
  __device__ bool tile(int mt, Tile& t) const { ret_tile(mt, t); return true; }
  __device__ int row(const Tile& t, int i) const { return t.i0 + i; }
  __device__ float a(const Tile& t, int r, int k) const {
    if (k < 128) return p.Sc[((size_t)t.chunk * 128 + r) * 128 + k];
    return p.proj[(size_t)(t.b * SEQ + t.s0 + r) * INW + C_QR + t.h * 128 + (k - 128)] * expf(ret_logg(t.h) * (float)(r + 1));
  }
  __device__ float b(const Tile& t, int k, int n) const {
    if (k < 128) return p.proj[(size_t)(t.b * SEQ + t.s0 + k) * INW + C_VR + t.h * 128 + n];
    return p.kv[((size_t)t.chunk * 128 + (k - 128)) * 128 + n];
  }
  __device__ void epi(const Tile& t, int r, int n, float v) const { p.retout[(size_t)(t.b * SEQ + t.s0 + r) * 512 + t.h * 128 + n] = v; }
};
struct FOut {
  typedef DenseTile Tile; P p; int N, K;
  __device__ bool tile(int mt, Tile& t) const { t.m0 = mt * 64; return true; }
  __device__ int row(const Tile& t, int i) const { return t.m0 + i; }
  __device__ float a(const Tile&, int r, int k) const { return p.mixin[(size_t)r * D + k]; }
  __device__ float b(const Tile&, int k, int n) const { return p.w_out[(size_t)k * D + n]; }
  __device__ void epi(const Tile&, int r, int n, float v) const { const int b = r / SEQ; p.x1[(size_t)r * D + n] = p.x[(size_t)r * D + n] + p.mod[b * 6144 + 2048 + n] * v; }
};
struct FRouter {
  typedef DenseTile Tile; P p; int N, K;
  __device__ bool tile(int mt, Tile& t) const { t.m0 = mt * 64; return true; }
  __device__ int row(const Tile& t, int i) const { return t.m0 + i; }
  __device__ float a(const Tile&, int r, int k) const { return p.h[(size_t)r * D + k]; }
  __device__ float b(const Tile&, int k, int n) const { return p.w_router[k * NE + n]; }
  __device__ void epi(const Tile&, int r, int n, float v) const { p.logits[r * NE + n] = v; }
};
template <int MODE> struct FShared {
  typedef DenseTile Tile; P p; int N, K;
  __device__ bool tile(int mt, Tile& t) const { t.m0 = mt * 64; return true; }
  __device__ int row(const Tile& t, int i) const { return t.m0 + i; }
  __device__ float a(const Tile&, int r, int k) const { return MODE == 2 ? p.acts[(size_t)r * 256 + k] : p.h[(size_t)r * D + k]; }
  __device__ float b(const Tile&, int k, int n) const { return MODE == 0 ? p.wg_s[k * 256 + n] : MODE == 1 ? p.wu_s[k * 256 + n] : p.wd_s[k * D + n]; }
  __device__ void epi(const Tile&, int r, int n, float v) const {
    if (MODE == 0) p.Gs[(size_t)r * 256 + n] = v;
    else if (MODE == 1) p.acts[(size_t)r * 256 + n] = silu(p.Gs[(size_t)r * 256 + n]) * v;
    else p.yacc[(size_t)r * D + n] = v;
  }
};
struct MoeTile { int e, off, cnt; };
template <int MODE> struct FMoe {
  typedef MoeTile Tile; P p; int N, K;
  __device__ bool tile(int mt, Tile& t) const { if (mt >= *p.ntiles) return false; t.e = p.tile_e[mt]; t.off = p.tile_off[mt]; t.cnt = p.cnt[t.e]; return true; }
  __device__ int row(const Tile& t, int i) const { return t.off + i < t.cnt ? p.list[t.e * ECAP + t.off + i] : -1; }
  __device__ float a(const Tile&, int sid, int k) const { return MODE == 2 ? p.act[(size_t)sid * 256 + k] : p.h[(size_t)(sid >> 3) * D + k]; }
  __device__ float b(const Tile& t, int k, int n) const {
    return MODE == 0 ? p.wg_e[((size_t)t.e * D + k) * 256 + n] : MODE == 1 ? p.wu_e[((size_t)t.e * D + k) * 256 + n] : p.wd_e[((size_t)t.e * 256 + k) * D + n];
  }
  __device__ void epi(const Tile&, int sid, int n, float v) const {
    if (MODE == 0) p.G[(size_t)sid * 256 + n] = v;
    else if (MODE == 1) p.act[(size_t)sid * 256 + n] = silu(p.G[(size_t)sid * 256 + n]) * v;
    else atomicAdd(&p.yacc[(size_t)(sid >> 3) * D + n], v * p.wts[sid]);
  }
};

__device__ __forceinline__ void d_rope(const P& p, int bx) {
  const int id = bx * 256 + threadIdx.x;
  const int tok = id / 896, pr = id % 896;
  int col, half, i; float sc = 1.f;
  if (pr < 256) { col = C_QN + (pr >> 5) * 64; i = pr & 31; half = 32; }
  else if (pr < 320) { const int q = pr - 256; col = C_KS + (q >> 5) * 64; i = q & 31; half = 32; }
  else if (pr < 384) { const int q = pr - 320; col = C_KW + (q >> 5) * 64; i = q & 31; half = 32; }
  else if (pr < 640) { const int q = pr - 384; col = C_QR + (q >> 6) * 128; i = q & 63; half = 64; }
  else { const int q = pr - 640; col = C_KR + (q >> 6) * 128; i = q & 63; half = 64; sc = 0.08838834764831845f; }
  const float inv = powf(10000.f, -(float)(2 * i) / (float)(2 * half));
  const float ang = (float)p.pos[tok] * inv;
  float sn, cs; sincosf(ang, &sn, &cs);
  float* q = p.proj + (size_t)tok * INW + col;
  const float x1 = q[i], x2 = q[i + half];
  q[i] = (x1 * cs - x2 * sn) * sc; q[i + half] = (x1 * sn + x2 * cs) * sc;
}
__device__ __forceinline__ void d_rope_cmp(const P& p, int bx) {
  const int id = bx * 256 + threadIdx.x;
  if (id >= NCR * 32) return;
  const int r = id >> 5, i = id & 31, b = r / (2 * NC), c = r % NC;
  const float inv = powf(10000.f, -(float)(2 * i) / 64.f);
  const float ang = (float)p.pos[b * SEQ + 16 * c + 31] * inv;
  float sn, cs; sincosf(ang, &sn, &cs);
  float* q = p.kcmp + r * 64;
  const float x1 = q[i], x2 = q[i + 32];
  q[i] = x1 * cs - x2 * sn; q[i + 32] = x1 * sn + x2 * cs;
}

__device__ __forceinline__ void d_nsa(const P& p, int bx, int by, char* smem) {
  const int bt = bx, g = by, b = bt / SEQ, t = bt % SEQ;
  const int tid = threadIdx.x, r = tid >> 6, lane = tid & 63, h = g * 4 + r;
  float (*qs)[64] = (float (*)[64])smem;
  float (*pc)[256] = (float (*)[256])(smem + 1024);
  float (*ps)[512] = (float (*)[512])(smem + 1024 + 4096);
  float* impv = (float*)(smem + 1024 + 4096 + 8192);
  int* sel = (int*)(smem + 1024 + 4096 + 8192 + 256);
  qs[r][lane] = p.proj[(size_t)bt * INW + C_QN + h * 64 + lane] * 0.125f;
  __syncthreads();
  float sc[4], mx = -1e30f;
#pragma unroll
  for (int i = 0; i < 4; ++i) {
    const int c = i * 64 + lane; float s = -1e30f;
    if (c < NC && 16 * c + 31 <= t) { const float* kr = p.kcmp + ((size_t)(b * 2 + g) * NC + c) * 64; float a = 0.f; for (int d = 0; d < 64; ++d) a += qs[r][d] * kr[d]; s = a; }
    sc[i] = s; mx = fmaxf(mx, s);
  }
  mx = wave_max(mx);
  float sum = 0.f;
#pragma unroll
  for (int i = 0; i < 4; ++i) { const int c = i * 64 + lane; const bool v = c < NC && 16 * c + 31 <= t; const float e = v ? expf(sc[i] - mx) : 0.f; sc[i] = e; sum += e; }
  sum = wave_sum(sum);
  float inv = 1.f / fmaxf(sum, 1e-20f);
#pragma unroll
  for (int i = 0; i < 4; ++i) pc[r][i * 64 + lane] = sc[i] * inv;
  __syncthreads();
  float oc = 0.f;
  { const int nv = t >= 31 ? min(NC, (t - 31) / 16 + 1) : 0;
    for (int c = 0; c < nv; ++c) oc += pc[r][c] * p.vcmp[((size_t)(b * 2 + g) * NC + c) * 64 + lane]; }
  if (tid < 64) {
    const int j = tid; float im = 0.f;
    const int c0 = max(0, 4 * j - 1), c1 = min(NC - 1, 4 * j + 3);
    for (int rr = 0; rr < 4; ++rr) for (int c = c0; c <= c1; ++c) im += pc[rr][c];
    const int cur = t >> 6; const bool valid = j * 64 <= t, forced = (j == 0) || (j == cur) || (j == cur - 1);
    impv[j] = valid ? im + (forced ? 1e4f : 0.f) : -1.f;
  }
  __syncthreads();
  if (tid == 0) {
    for (int k = 0; k < 8; ++k) { int best = 0; float bv = impv[0]; for (int j = 1; j < 64; ++j) if (impv[j] > bv) { bv = impv[j]; best = j; } sel[k] = best; impv[best] = -INFINITY; }
  }
  __syncthreads();
  float ss[8]; mx = -1e30f;
#pragma unroll
  for (int i = 0; i < 8; ++i) {
    const int q = sel[i] * 64 + lane; float s = -1e30f;
    if (q <= t) { const float* kr = p.proj + (size_t)(b * SEQ + q) * INW + C_KS + g * 64; float a = 0.f; for (int d = 0; d < 64; ++d) a += qs[r][d] * kr[d]; s = a; }
    ss[i] = s; mx = fmaxf(mx, s);
  }
  mx = wave_max(mx); sum = 0.f;
#pragma unroll
  for (int i = 0; i < 8; ++i) { const int q = sel[i] * 64 + lane; const float e = q <= t ? expf(ss[i] - mx) : 0.f; ss[i] = e; sum += e; }
  sum = wave_sum(sum); inv = 1.f / fmaxf(sum, 1e-20f);
#pragma unroll
  for (int i = 0; i < 8; ++i) ps[r][i * 64 + lane] = ss[i] * inv;
  __syncthreads();
  float os = 0.f;
  for (int i = 0; i < 8; ++i) { const int q0 = sel[i] * 64;
    for (int l = 0; l < 64; ++l) { const int q = q0 + l; if (q <= t) os += ps[r][i * 64 + l] * p.proj[(size_t)(b * SEQ + q) * INW + C_VS + g * 64 + lane]; } }
  __syncthreads();
  mx = -1e30f;
#pragma unroll
  for (int i = 0; i < 8; ++i) {
    const int q = t - 511 + i * 64 + lane; float s = -1e30f;
    if (q >= 0) { const float* kr = p.proj + (size_t)(b * SEQ + q) * INW + C_KW + g * 64; float a = 0.f; for (int d = 0; d < 64; ++d) a += qs[r][d] * kr[d]; s = a; }
    ss[i] = s; mx = fmaxf(mx, s);
  }
  mx = wave_max(mx); sum = 0.f;
#pragma unroll
  for (int i = 0; i < 8; ++i) { const int q = t - 511 + i * 64 + lane; const float e = q >= 0 ? expf(ss[i] - mx) : 0.f; ss[i] = e; sum += e; }
  sum = wave_sum(sum); inv = 1.f / fmaxf(sum, 1e-20f);
#pragma unroll
  for (int i = 0; i < 8; ++i) ps[r][i * 64 + lane] = ss[i] * inv;
  __syncthreads();
  float ow = 0.f;
  for (int i = 0; i < 512; ++i) { const int q = t - 511 + i; if (q >= 0) ow += ps[r][i] * p.proj[(size_t)(b * SEQ + q) * INW + C_VW + g * 64 + lane]; }
  const float* gp = p.proj + (size_t)bt * INW + C_GN + h * 3;
  p.onsa[(size_t)bt * 512 + h * 64 + lane] = sigm(gp[0]) * oc + sigm(gp[1]) * os + sigm(gp[2]) * ow;
}

__device__ __forceinline__ void d_mixin(const P& p, int bx) {
  const int tok = bx * 4 + (threadIdx.x >> 6), lane = threadIdx.x & 63;
  float v[8], s = 0.f;
#pragma unroll
  for (int i = 0; i < 8; ++i) { v[i] = p.onsa[(size_t)tok * 512 + i * 64 + lane]; s += v[i] * v[i]; }
  s = wave_sum(s);
  float r = rsqrtf(s * (1.f / 512.f) + EPS);
#pragma unroll
  for (int i = 0; i < 8; ++i) p.mixin[(size_t)tok * D + i * 64 + lane] = v[i] * r * p.g_nsa[i * 64 + lane];
#pragma unroll
  for (int hh = 0; hh < 4; ++hh) {
    const float a = p.retout[(size_t)tok * 512 + hh * 128 + lane], b = p.retout[(size_t)tok * 512 + hh * 128 + 64 + lane];
    const float q = wave_sum(a * a + b * b);
    r = rsqrtf(q * (1.f / 128.f) + EPS);
    const float* gr = p.proj + (size_t)tok * INW + C_GR + hh * 128;
    p.mixin[(size_t)tok * D + 512 + hh * 128 + lane] = silu(gr[lane]) * a * r * p.g_ret[hh * 128 + lane];
    p.mixin[(size_t)tok * D + 512 + hh * 128 + 64 + lane] = silu(gr[64 + lane]) * b * r * p.g_ret[hh * 128 + 64 + lane];
  }
}

__device__ __forceinline__ void d_ret_scan(const P& p, int bx) {
  const int id = bx * 256 + threadIdx.x;
  const int bh = id >> 14, de = id & 16383, h = bh & 3;
  const float gc = expf(ret_logg(h) * 128.f);
  float st = 0.f;
  for (int n = 0; n < 32; ++n) { float* q = p.kv + ((size_t)(bh * 32 + n) * 16384 + de); const float kvn = *q; *q = st; st = st * gc + kvn; }
}

__device__ __forceinline__ void d_route(const P& p, int bx) {
  const int t = bx * 256 + threadIdx.x;
  const float* lg = p.logits + (size_t)t * NE;
  unsigned gmask = 0;
  { float pv = INFINITY; int pg = -1;
    for (int k = 0; k < 4; ++k) {
      float bv = -INFINITY; int bg = -1;
      for (int g = 0; g < 8; ++g) {
        float m1 = -INFINITY, m2 = -INFINITY;
        for (int e = 0; e < 32; ++e) { const float v = sigm(lg[g * 32 + e]) + p.rbias[g * 32 + e]; if (v > m1) { m2 = m1; m1 = v; } else if (v > m2) m2 = v; }
        const float gs = m1 + m2;
        const bool after = (gs < pv) || (gs == pv && g > pg);
        if (after && gs > bv) { bv = gs; bg = g; }
      }
      gmask |= 1u << bg; pv = bv; pg = bg;
    } }
  float pv = INFINITY; int pe = -1; int ids[8]; float ws[8]; float wsum = 0.f;
#pragma unroll
  for (int k = 0; k < 8; ++k) {
    float bv = -INFINITY; int be = -1; float bs = 0.f;
    for (int e = 0; e < NE; ++e) {
      if (!((gmask >> (e >> 5)) & 1u)) continue;
      const float s = sigm(lg[e]), v = s + p.rbias[e];
      const bool after = (v < pv) || (v == pv && e > pe);
      if (after && v > bv) { bv = v; be = e; bs = s; }
    }
    ids[k] = be; ws[k] = bs; wsum += bs; pv = bv; pe = be;
  }
#pragma unroll
  for (int k = 0; k < 8; ++k) {
    const int e = ids[k]; const int pos = atomicAdd(&p.cnt[e], 1);
    p.list[e * ECAP + pos] = t * 8 + k; p.wts[t * 8 + k] = ws[k] / wsum * 2.5f;
  }
}
__device__ __forceinline__ void d_moe_tiles(const P& p) {
  if (threadIdx.x != 0) return;
  int nt = 0;
  for (int e = 0; e < NE; ++e) for (int off = 0; off < p.cnt[e]; off += 64) { p.tile_e[nt] = e; p.tile_off[nt] = off; ++nt; }
  *p.ntiles = nt;
}

__device__ __forceinline__ void d_final(const P& p, int bx) {
  const int row = bx * 4 + (threadIdx.x >> 6), lane = threadIdx.x & 63, b = row / SEQ;
  float v[16], s = 0.f;
#pragma unroll
  for (int i = 0; i < 16; ++i) { const int k = i * 64 + lane; v[i] = p.x1[(size_t)row * D + k] + p.mod[b * 6144 + 5120 + k] * p.yacc[(size_t)row * D + k]; s += v[i] * v[i]; }
  s = wave_sum(s);
  const float r = rsqrtf(s * (1.f / D) + EPS);
#pragma unroll
  for (int i = 0; i < 16; ++i) { const int k = i * 64 + lane; p.out[(size_t)row * D + k] = v[i] * r * p.g_final[k]; }
}

#define XB_TMO      128
#define XB_XCNT(j)  (256  + 64 * (j))
#define XB_XSUB(j)  (1280 + 64 * (j))
#define XB_XGEN(j)  (2304 + 64 * (j))
#define XB_TOP      3328
#define XB_TOPGEN   3392
#define XCD_BAR_WORDS 3456
#define XB_SPIN_CAP (1u << 18)
#define LAS __attribute__((address_space(3)))
__device__ __forceinline__ unsigned xb_ld(unsigned* p)              { return __hip_atomic_load(p, __ATOMIC_RELAXED, __HIP_MEMORY_SCOPE_AGENT); }
__device__ __forceinline__ unsigned xb_add(unsigned* p, unsigned v) { return __hip_atomic_fetch_add(p, v, __ATOMIC_RELAXED, __HIP_MEMORY_SCOPE_AGENT); }
__device__ __forceinline__ unsigned xb_xcc_id() { return (unsigned)__builtin_amdgcn_s_getreg((3 << 11) | 20) & 0xFu; }
#define XB_SPIN(cond, bar) do { unsigned _sp = 0; while (cond) { __builtin_amdgcn_s_sleep(1); \
    if ((++_sp & 255u) == 0u) { if (xb_ld(&(bar)[XB_TMO])) break; if (_sp > XB_SPIN_CAP) { atomicAdd(&(bar)[XB_TMO], 1u); break; } } } } while (0)
struct XcdBarrier { unsigned* bar; unsigned x; volatile LAS unsigned* st; };
__device__ __forceinline__ XcdBarrier xcd_barrier_post(unsigned* bar, volatile LAS unsigned* st) {
    XcdBarrier b; b.bar = bar; b.x = xb_xcc_id(); b.st = st;
    if (threadIdx.x == 0) (void)xb_add(&bar[XB_XCNT(b.x)], 1u);
    return b;
}
__device__ __forceinline__ void xcd_barrier_complete(unsigned* bar, unsigned x, unsigned& nloc, unsigned& nx) {
    const unsigned G = gridDim.x * gridDim.y * gridDim.z;
    unsigned sum, cnt, mine, sp = 0u;
    for (;;) {
        sum = 0u; cnt = 0u; mine = 0u;
#pragma unroll
        for (unsigned j = 0; j < 16; ++j) { const unsigned c = xb_ld(&bar[XB_XCNT(j)]); sum += c; cnt += (c > 0u) ? 1u : 0u; mine = (j == x) ? c : mine; }
        if (sum == G) break;
        __builtin_amdgcn_s_sleep(1);
        if ((++sp & 255u) == 0u) { if (xb_ld(&bar[XB_TMO])) break; if (sp > XB_SPIN_CAP) { atomicAdd(&bar[XB_TMO], 1u); break; } }
    }
    nloc = mine > 0u ? mine : 1u; nx = cnt > 0u ? cnt : 1u;
}
__device__ __forceinline__ void xcd_barrier(const XcdBarrier& b) {
    asm volatile("s_waitcnt vmcnt(0)" ::: "memory");
    __syncthreads();
    if (threadIdx.x == 0) {
        unsigned* bar = b.bar;
        __builtin_amdgcn_s_waitcnt(0);
        unsigned nloc = b.st[0], nx = b.st[1];
        if (nloc == 0u) { xcd_barrier_complete(bar, b.x, nloc, nx); b.st[0] = nloc; b.st[1] = nx; }
        const unsigned old = xb_add(&bar[XB_XSUB(b.x)], 1u);
        const unsigned gen = old / nloc;
        if (old + 1u == (gen + 1u) * nloc) {
            __builtin_amdgcn_fence(__ATOMIC_RELEASE, "agent");
            asm volatile("s_waitcnt vmcnt(0)" ::: "memory");
            const unsigned og = xb_add(&bar[XB_TOP], 1u);
            const unsigned tg = og / nx;
            if (og + 1u == (tg + 1u) * nx) xb_add(&bar[XB_TOPGEN], 1u);
            else XB_SPIN(xb_ld(&bar[XB_TOPGEN]) == tg, bar);
            __builtin_amdgcn_fence(__ATOMIC_ACQUIRE, "agent");
            xb_add(&bar[XB_XGEN(b.x)], 1u);
            asm volatile("s_waitcnt vmcnt(0)" ::: "memory");
        } else {
            XB_SPIN(xb_ld(&bar[XB_XGEN(b.x)]) == gen, bar);
            __builtin_amdgcn_fence(__ATOMIC_ACQUIRE, "agent");
            asm volatile("s_waitcnt vmcnt(0)" ::: "memory");
        }
    }
    __syncthreads();
}

#define FOR_VB(n) for (int vb = blockIdx.x; vb < (n); vb += gridDim.x)
#define GEMM_PHASE(FT, INIT, nx, ny) do { FT f INIT; FOR_VB((nx) * (ny)) { d_gemm(f, vb % (nx), vb / (nx), smem); __syncthreads(); } } while (0)
__global__ void __launch_bounds__(256) mega(P p, unsigned* bar) {
  __shared__ __attribute__((aligned(16))) char smem[16384];
  __shared__ uint4 xb_words;
  if (threadIdx.x == 0) xb_words = make_uint4(0u, 0u, 0u, 0u);
  __syncthreads();
  const XcdBarrier xb = xcd_barrier_post(bar, (volatile LAS unsigned*)&xb_words);
  FOR_VB(BATCH * 6144 / 256) d_mod(p, vb);
  xcd_barrier(xb);
  FOR_VB(T / 4) d_norm(p.x, p.g_mix, p.mod + 1024, p.mod + 0, p.h, vb);
  xcd_barrier(xb);
  GEMM_PHASE(FProj, ({p, INW, D}), (INW + 63) / 64, T / 64);
  xcd_barrier(xb);
  FOR_VB(T * 896 / 256) d_rope(p, vb);
  xcd_barrier(xb);
  GEMM_PHASE(FCmp1, ({p, 128, 2048, C_KC, 0, p.cpk, p.cw1k, p.hidk}), 2, 32);
  GEMM_PHASE(FCmp1, ({p, 128, 2048, C_VC, 0, p.cpv, p.cw1v, p.hidv}), 2, 32);
  GEMM_PHASE(FRet1, ({p, 128, 128}), 2, 1024);
  GEMM_PHASE(FRet2, ({p, 128, 128}), 2, 1024);
  xcd_barrier(xb);
  GEMM_PHASE(FCmp2, ({p, 64, 128, p.hidk, p.cw2k, p.kcmp}), 1, 32);
  GEMM_PHASE(FCmp2, ({p, 64, 128, p.hidv, p.cw2v, p.vcmp}), 1, 32);
  FOR_VB(16 * 16384 / 256) d_ret_scan(p, vb);
  xcd_barrier(xb);
  FOR_VB((NCR * 32 + 255) / 256) d_rope_cmp(p, vb);
  GEMM_PHASE(FRet3, ({p, 128, 256}), 2, 1024);
  xcd_barrier(xb);
  FOR_VB(T * 2) { d_nsa(p, vb >> 1, vb & 1, smem); __syncthreads(); }
  xcd_barrier(xb);
  FOR_VB(T / 4) d_mixin(p, vb);
  xcd_barrier(xb);
  GEMM_PHASE(FOut, ({p, D, D}), D / 64, T / 64);
  xcd_barrier(xb);
  FOR_VB(T / 4) d_norm(p.x1, p.g_ffn, p.mod + 4096, p.mod + 3072, p.h, vb);
  xcd_barrier(xb);
  GEMM_PHASE(FRouter, ({p, NE, D}), NE / 64, T / 64);
  GEMM_PHASE(FShared<0>, ({p, 256, D}), 4, T / 64);
  xcd_barrier(xb);
  FOR_VB(T / 256) d_route(p, vb);
  GEMM_PHASE(FShared<1>, ({p, 256, D}), 4, T / 64);
  xcd_barrier(xb);
  if (blockIdx.x == 0) d_moe_tiles(p);
  GEMM_PHASE(FShared<2>, ({p, D, 256}), 16, T / 64);
  xcd_barrier(xb);
  GEMM_PHASE(FMoe<0>, ({p, 256, D}), 4, 2304);
  xcd_barrier(xb);
  GEMM_PHASE(FMoe<1>, ({p, 256, D}), 4, 2304);
  xcd_barrier(xb);
  GEMM_PHASE(FMoe<2>, ({p, D, 256}), 16, 2304);
  xcd_barrier(xb);
  FOR_VB(T / 4) d_final(p, vb);
}
}

extern "C" void kernel_launch(void* const* d_in, const int* in_sizes, int n_in, void* d_out, int out_size, void* d_ws, size_t ws_size, hipStream_t stream) {
  P p{};
  p.x = (const float*)d_in[0]; p.c = (const float*)d_in[1]; p.pos = (const int*)d_in[2];
  p.w_ada = (const float*)d_in[3]; p.b_ada = (const float*)d_in[4]; p.g_mix = (const float*)d_in[5]; p.w_in = (const float*)d_in[6];
  p.cpk = (const float*)d_in[7]; p.cw1k = (const float*)d_in[8]; p.cw2k = (const float*)d_in[9];
  p.cpv = (const float*)d_in[10]; p.cw1v = (const float*)d_in[11]; p.cw2v = (const float*)d_in[12];
  p.g_nsa = (const float*)d_in[13]; p.g_ret = (const float*)d_in[14]; p.w_out = (const float*)d_in[15]; p.g_ffn = (const float*)d_in[16];
  p.w_router = (const float*)d_in[17]; p.rbias = (const float*)d_in[18]; p.wg_e = (const float*)d_in[19]; p.wu_e = (const float*)d_in[20];
  p.wd_e = (const float*)d_in[21]; p.wg_s = (const float*)d_in[22]; p.wu_s = (const float*)d_in[23]; p.wd_s = (const float*)d_in[24];
  p.g_final = (const float*)d_in[25];
  p.out = (float*)d_out;
  char* w = (char*)d_ws; size_t off = 0;
  auto take = [&](size_t bytes) { char* r = w + off; off += (bytes + 255) & ~(size_t)255; return r; };
  unsigned* bar = (unsigned*)take(XCD_BAR_WORDS * 4);
  p.cnt = (int*)take(NE * 4); p.ntiles = (int*)take(4);
  const size_t zero_bytes = off;
  p.mod = (float*)take(BATCH * 6144 * 4);
  p.h = (float*)take((size_t)T * D * 4);
  p.proj = (float*)take((size_t)T * INW * 4);
  p.G = p.proj;
  p.hidk = (float*)take(2048 * 128 * 4); p.hidv = (float*)take(2048 * 128 * 4);
  p.kcmp = (float*)take(2048 * 64 * 4); p.vcmp = (float*)take(2048 * 64 * 4);
  p.onsa = (float*)take((size_t)T * 512 * 4);
  p.Sc = (float*)take((size_t)512 * 16384 * 4); p.kv = (float*)take((size_t)512 * 16384 * 4);
  p.retout = (float*)take((size_t)T * 512 * 4);
  p.mixin = (float*)take((size_t)T * D * 4);
  p.x1 = (float*)take((size_t)T * D * 4);
  p.logits = (float*)take((size_t)T * NE * 4);
  p.wts = (float*)take((size_t)T * 8 * 4);
  p.Gs = (float*)take((size_t)T * 256 * 4); p.acts = (float*)take((size_t)T * 256 * 4);
  p.act = (float*)take((size_t)T * 8 * 256 * 4);
  p.yacc = (float*)take((size_t)T * D * 4);
  p.list = (int*)take((size_t)NE * ECAP * 4);
  p.tile_e = (int*)take(4096 * 4); p.tile_off = (int*)take(4096 * 4);
  if (off > ws_size) { fprintf(stderr, "kernel_launch: workspace too small: need %zu have %zu\n", off, ws_size); return; }
  (void)hipMemsetAsync(d_ws, 0, zero_bytes, stream);
  static int grid = 0;
  if (!grid) {
    int dev = 0, cus = 0, per_cu = 0;
    (void)hipGetDevice(&dev);
    (void)hipDeviceGetAttribute(&cus, hipDeviceAttributeMultiprocessorCount, dev);
    (void)hipOccupancyMaxActiveBlocksPerMultiprocessor(&per_cu, (const void*)mega, 256, 0);
    if (per_cu < 1) { fprintf(stderr, "kernel_launch: occupancy query says %d blocks per CU\n", per_cu); per_cu = 1; }
    grid = cus * (per_cu < 2 ? per_cu : 2);
  }
  hipLaunchKernelGGL(mega, dim3(grid), dim3(256), 0, stream, p, bar);
}
```

```cpp
#include <hip/hip_runtime.h>
#include <cstdint>
#include <cstdio>

namespace {
constexpr int D = 1024, BATCH = 4, SEQ = 4096, T = BATCH * SEQ;
constexpr int INW = 3352;
constexpr int C_QN = 0, C_KC = 512, C_VC = 640, C_KS = 768, C_VS = 896, C_KW = 1024, C_VW = 1152, C_GN = 1280,
              C_QR = 1304, C_KR = 1816, C_VR = 2328, C_GR = 2840;
constexpr int PJW = 3328, J_QN = 0, J_KC = 512, J_VC = 640, J_KS = 768, J_VS = 896, J_KW = 1024, J_VW = 1152, J_QR = 1280, J_KR = 1792, J_VR = 2304, J_GR = 2816;
constexpr int NC = 255, NCR = BATCH * 2 * NC;
constexpr int NE = 256, ECAP = 16384;
constexpr float EPS = 1e-6f;
typedef unsigned short bf16_t;

struct P {
  const float *x, *c; const int* pos;
  const float *w_ada, *b_ada, *g_mix, *w_in, *cpk, *cw1k, *cw2k, *cpv, *cw1v, *cw2v, *g_nsa, *g_ret, *w_out, *g_ffn,
      *w_router, *rbias, *wg_e, *wu_e, *wd_e, *wg_s, *wu_s, *wd_s, *g_final;
  float* out;
  float *mod, *h, *proj, *hidk, *hidv, *kcmp, *vcmp, *onsa, *Sc, *kv, *retout, *mixin, *x1, *logits, *wts, *Gs, *acts,
      *G, *act, *yacc, *gates;
  int *cnt, *list, *tile_e, *tile_off, *ntiles;
  bf16_t *winb, *woutb, *wrb, *wgsb, *wusb, *wdsb, *cw1kb, *cw1vb, *cw2kb, *cw2vb, *hb, *projb;
  unsigned* bar;
};

#define LAS __attribute__((address_space(3)))
typedef LAS char* lptr;
typedef short bf16x8 __attribute__((ext_vector_type(8)));
typedef short v4i16_t __attribute__((ext_vector_type(4)));
typedef float f32x16 __attribute__((ext_vector_type(16)));
typedef float f32x4 __attribute__((ext_vector_type(4)));
typedef float f32x2_t __attribute__((ext_vector_type(2)));
typedef __bf16 bf16x2_t __attribute__((ext_vector_type(2)));
typedef unsigned u32x4 __attribute__((ext_vector_type(4)));
typedef unsigned u32x2 __attribute__((ext_vector_type(2)));

__device__ __forceinline__ float wave_sum(float v) {
#pragma unroll
  for (int o = 1; o < 64; o <<= 1) v += __shfl_xor(v, o);
  return v;
}
__device__ __forceinline__ float wave_max(float v) {
#pragma unroll
  for (int o = 1; o < 64; o <<= 1) v = fmaxf(v, __shfl_xor(v, o));
  return v;
}
__device__ __forceinline__ float silu(float v) { return v / (1.f + expf(-v)); }
__device__ __forceinline__ float sigm(float v) { return 1.f / (1.f + expf(-v)); }
__device__ __forceinline__ float gelu_tanh(float v) { return 0.5f * v * (1.f + tanhf(0.7978845608028654f * (v + 0.044715f * v * v * v))); }
__device__ __forceinline__ unsigned pk2(float lo, float hi) { f32x2_t v = {lo, hi}; bf16x2_t b = __builtin_convertvector(v, bf16x2_t); return __builtin_bit_cast(unsigned, b); }
__device__ __forceinline__ float bf2f(bf16_t u) { return __uint_as_float((unsigned)u << 16); }
__device__ __forceinline__ float bflo(unsigned u) { return __uint_as_float(u << 16); }
__device__ __forceinline__ float bfhi(unsigned u) { return __uint_as_float(u & 0xffff0000u); }

#define XB_TMO      128
#define XB_XCNT(j)  (256  + 64 * (j))
#define XB_XSUB(j)  (1280 + 64 * (j))
#define XB_XGEN(j)  (2304 + 64 * (j))
#define XB_TOP      3328
#define XB_TOPGEN   3392
#define XCD_BAR_WORDS 3456
#define XB_SPIN_CAP (1u << 18)
__device__ __forceinline__ unsigned xb_ld(unsigned* p)              { return __hip_atomic_load(p, __ATOMIC_RELAXED, __HIP_MEMORY_SCOPE_AGENT); }
__device__ __forceinline__ unsigned xb_add(unsigned* p, unsigned v) { return __hip_atomic_fetch_add(p, v, __ATOMIC_RELAXED, __HIP_MEMORY_SCOPE_AGENT); }
__device__ __forceinline__ unsigned xb_xcc_id() { return (unsigned)__builtin_amdgcn_s_getreg((3 << 11) | 20) & 0xFu; }
#define XB_SPIN(cond, bar) do { unsigned _sp = 0; while (cond) { __builtin_amdgcn_s_sleep(1); \
    if ((++_sp & 255u) == 0u) { if (xb_ld(&(bar)[XB_TMO])) break; if (_sp > XB_SPIN_CAP) { atomicAdd(&(bar)[XB_TMO], 1u); break; } } } } while (0)
struct XcdBarrier { unsigned* bar; unsigned x; volatile LAS unsigned* st; };
__device__ __forceinline__ XcdBarrier xcd_barrier_post(unsigned* bar, volatile LAS unsigned* st) {
    XcdBarrier b; b.bar = bar; b.x = xb_xcc_id(); b.st = st;
    if (threadIdx.x == 0) (void)xb_add(&bar[XB_XCNT(b.x)], 1u);
    return b;
}
__device__ __forceinline__ void xcd_barrier_complete(unsigned* bar, unsigned x, unsigned& nloc, unsigned& nx) {
    const unsigned G = gridDim.x * gridDim.y * gridDim.z;
    unsigned sum, cnt, mine, sp = 0u;
    for (;;) {
        sum = 0u; cnt = 0u; mine = 0u;
#pragma unroll
        for (unsigned j = 0; j < 16; ++j) { const unsigned c = xb_ld(&bar[XB_XCNT(j)]); sum += c; cnt += (c > 0u) ? 1u : 0u; mine = (j == x) ? c : mine; }
        if (sum == G) break;
        __builtin_amdgcn_s_sleep(1);
        if ((++sp & 255u) == 0u) { if (xb_ld(&bar[XB_TMO])) break; if (sp > XB_SPIN_CAP) { atomicAdd(&bar[XB_TMO], 1u); break; } }
    }
    nloc = mine > 0u ? mine : 1u; nx = cnt > 0u ? cnt : 1u;
}
__device__ __forceinline__ void xcd_barrier(const XcdBarrier& b) {
    asm volatile("s_waitcnt vmcnt(0)" ::: "memory");
    __syncthreads();
    if (threadIdx.x == 0) {
        unsigned* bar = b.bar;
        __builtin_amdgcn_s_waitcnt(0);
        unsigned nloc = b.st[0], nx = b.st[1];
        if (nloc == 0u) { xcd_barrier_complete(bar, b.x, nloc, nx); b.st[0] = nloc; b.st[1] = nx; }
        const unsigned old = xb_add(&bar[XB_XSUB(b.x)], 1u);
        const unsigned gen = old / nloc;
        if (old + 1u == (gen + 1u) * nloc) {
            __builtin_amdgcn_fence(__ATOMIC_RELEASE, "agent");
            asm volatile("s_waitcnt vmcnt(0)" ::: "memory");
            const unsigned og = xb_add(&bar[XB_TOP], 1u);
            const unsigned tg = og / nx;
            if (og + 1u == (tg + 1u) * nx) xb_add(&bar[XB_TOPGEN], 1u);
            else XB_SPIN(xb_ld(&bar[XB_TOPGEN]) == tg, bar);
            __builtin_amdgcn_fence(__ATOMIC_ACQUIRE, "agent");
            xb_add(&bar[XB_XGEN(b.x)], 1u);
            asm volatile("s_waitcnt vmcnt(0)" ::: "memory");
        } else {
            XB_SPIN(xb_ld(&bar[XB_XGEN(b.x)]) == gen, bar);
            __builtin_amdgcn_fence(__ATOMIC_ACQUIRE, "agent");
            asm volatile("s_waitcnt vmcnt(0)" ::: "memory");
        }
    }
    __syncthreads();
}

__device__ __forceinline__ bf16x8 frag_kmaj(lptr img, int rs, int o, int s, int lane) {
  const int h = lane >> 5, blk = (lane >> 4) & 1, q = (lane & 15) >> 2, pp = lane & 3;
  lptr a = img + (16 * s + 8 * h + q) * rs + (o + 16 * blk + 4 * pp) * 2;
  const v4i16_t lo = __builtin_amdgcn_ds_read_tr16_b64_v4i16((LAS v4i16_t*)a);
  const v4i16_t hi = __builtin_amdgcn_ds_read_tr16_b64_v4i16((LAS v4i16_t*)(a + 4 * rs));
  return (bf16x8){lo[0], lo[1], lo[2], lo[3], hi[0], hi[1], hi[2], hi[3]};
}
__device__ __forceinline__ bf16x8 frag_kmin(lptr img, int o, int s, int lane) {
  const int row = o + (lane & 31), c = 2 * s + (lane >> 5);
  return *(LAS bf16x8*)(img + row * 64 + ((c ^ ((row >> 2) & 3)) << 4));
}
__device__ __forceinline__ int kmin_off(int row, int c) { return row * 64 + ((c ^ ((row >> 2) & 3)) << 4); }

template <int TM, int TN, bool WKMAJ, bool XKMAJ>
__device__ __forceinline__ void mma_step(f32x16 (&acc)[TM][TN], lptr wimg, int wrs, int wn0, lptr ximg, int xrs, int xt0, int lane) {
#pragma unroll
  for (int s = 0; s < 2; ++s) {
    bf16x8 wf[TM], xf[TN];
#pragma unroll
    for (int tm = 0; tm < TM; ++tm) wf[tm] = WKMAJ ? frag_kmaj(wimg, wrs, wn0 + 32 * tm, s, lane) : frag_kmin(wimg, wn0 + 32 * tm, s, lane);
#pragma unroll
    for (int tn = 0; tn < TN; ++tn) xf[tn] = XKMAJ ? frag_kmaj(ximg, xrs, xt0 + 32 * tn, s, lane) : frag_kmin(ximg, xt0 + 32 * tn, s, lane);
#pragma unroll
    for (int tm = 0; tm < TM; ++tm)
#pragma unroll
      for (int tn = 0; tn < TN; ++tn) acc[tm][tn] = __builtin_amdgcn_mfma_f32_32x32x16_bf16(wf[tm], xf[tn], acc[tm][tn], 0, 0, 0);
    if (s == 0) __builtin_amdgcn_sched_barrier(0);
  }
}

template <int BNT> struct WRegB16 { u32x4 r[BNT / 128]; };
template <int BNT> __device__ __forceinline__ void wload_b16(WRegB16<BNT>& R, const bf16_t* src  , int ld, int tid) {
  constexpr int C8 = BNT / 8, KPR = 512 / C8;
  const int c8 = tid % C8, kr = tid / C8;
#pragma unroll
  for (int r = 0; r < BNT / 128; ++r) R.r[r] = *(const u32x4*)(src + (size_t)(kr + r * KPR) * ld + c8 * 8);
}
template <int BNT> __device__ __forceinline__ void wstore_b16(const WRegB16<BNT>& R, lptr img, int rs, int tid) {
  constexpr int C8 = BNT / 8, KPR = 512 / C8;
  const int c8 = tid % C8, kr = tid / C8;
#pragma unroll
  for (int r = 0; r < BNT / 128; ++r) *(LAS u32x4*)(img + (kr + r * KPR) * rs + c8 * 16) = R.r[r];
}
template <int BMT> struct XRegB16 { u32x4 r[(BMT + 127) / 128]; };
template <int BMT> __device__ __forceinline__ void xload_b16(XRegB16<BMT>& R, const bf16_t* const (&rowp)[(BMT + 127) / 128], int k0, int tid) {
#pragma unroll
  for (int r = 0; r < (BMT + 127) / 128; ++r) if (BMT >= 128 || tid < BMT * 4) R.r[r] = *(const u32x4*)(rowp[r] + k0 + (tid & 3) * 8);
}
template <int BMT> __device__ __forceinline__ void xstore_b16(const XRegB16<BMT>& R, lptr img, int tid) {
#pragma unroll
  for (int r = 0; r < (BMT + 127) / 128; ++r) if (BMT >= 128 || tid < BMT * 4) *(LAS u32x4*)(img + kmin_off((tid >> 2) + 128 * r, tid & 3)) = R.r[r];
}

constexpr int LDS_INV64 = 150 * 1024, LDS_INV128 = LDS_INV64 + 128, LDS_XB = LDS_INV128 + 256, LDS_BYTES = 152 * 1024;

__device__ __forceinline__ void cvt_items(const float* src, bf16_t* dst, size_t n8, int gtid, int gthreads) {
  for (size_t i = gtid; i < n8; i += gthreads) {
    const f32x4 a = *(const f32x4*)(src + i * 8), b = *(const f32x4*)(src + i * 8 + 4);
    u32x4 o; o.x = pk2(a.x, a.y); o.y = pk2(a.z, a.w); o.z = pk2(b.x, b.y); o.w = pk2(b.z, b.w);
    *(u32x4*)(dst + i * 8) = o;
  }
}
__device__ __forceinline__ void phase0a(const P& p, lptr lds, int vcu, int G) {
  const int tid = threadIdx.x, wid = tid >> 6, lane = tid & 63;
  if (vcu < 96) {
    const int j = vcu * 64 + lane;
    float a0 = 0.f, a1 = 0.f, a2 = 0.f, a3 = 0.f;
    for (int k = wid * 128; k < wid * 128 + 128; ++k) {
      const float w = p.w_ada[(size_t)k * 6144 + j];
      a0 += silu(p.c[k]) * w; a1 += silu(p.c[D + k]) * w; a2 += silu(p.c[2 * D + k]) * w; a3 += silu(p.c[3 * D + k]) * w;
    }
    LAS float* part = (LAS float*)lds;
    part[(wid * 4 + 0) * 64 + lane] = a0; part[(wid * 4 + 1) * 64 + lane] = a1; part[(wid * 4 + 2) * 64 + lane] = a2; part[(wid * 4 + 3) * 64 + lane] = a3;
    __syncthreads();
    if (wid < 4) { float s = p.b_ada[j];
#pragma unroll
      for (int w = 0; w < 8; ++w) s += part[(w * 4 + wid) * 64 + lane];
      p.mod[wid * 6144 + j] = s; }
    __syncthreads();
  }
  const int gtid = vcu * 512 + tid, gth = G * 512;
  cvt_items(p.w_in, p.winb, (size_t)D * INW / 8, gtid, gth);
  cvt_items(p.w_out, p.woutb, (size_t)D * D / 8, gtid, gth);
  cvt_items(p.w_router, p.wrb, (size_t)D * NE / 8, gtid, gth);
  cvt_items(p.wg_s, p.wgsb, (size_t)D * 256 / 8, gtid, gth);
  cvt_items(p.wu_s, p.wusb, (size_t)D * 256 / 8, gtid, gth);
  cvt_items(p.wd_s, p.wdsb, (size_t)256 * D / 8, gtid, gth);
  cvt_items(p.cw1k, p.cw1kb, (size_t)2048 * 128 / 8, gtid, gth);
  cvt_items(p.cw1v, p.cw1vb, (size_t)2048 * 128 / 8, gtid, gth);
  cvt_items(p.cw2k, p.cw2kb, (size_t)128 * 64 / 8, gtid, gth);
  cvt_items(p.cw2v, p.cw2vb, (size_t)128 * 64 / 8, gtid, gth);
}

__device__ __forceinline__ void phase0b(const P& p, lptr lds, int vcu, int G) {
  const int tid = threadIdx.x, wid = tid >> 6, lane = tid & 63;
  LAS float* wg = (LAS float*)lds;
  for (int i = tid; i < D * 24; i += 512) wg[i] = p.w_in[(size_t)(i / 24) * INW + C_GN + (i % 24)];
  __syncthreads();
  for (int row = vcu * 8 + wid; row < T; row += G * 8) {
    const int b = row / SEQ;
    f32x4 v[4]; float s = 0.f;
#pragma unroll
    for (int j = 0; j < 4; ++j) { v[j] = *(const f32x4*)(p.x + (size_t)row * D + j * 256 + lane * 4); s += v[j].x * v[j].x + v[j].y * v[j].y + v[j].z * v[j].z + v[j].w * v[j].w; }
    s = wave_sum(s);
    const float r = rsqrtf(s * (1.f / D) + EPS);
    f32x4 y[4];
#pragma unroll
    for (int j = 0; j < 4; ++j) {
      const int k = j * 256 + lane * 4;
      const f32x4 g = *(const f32x4*)(p.g_mix + k), sc = *(const f32x4*)(p.mod + b * 6144 + 1024 + k), sh = *(const f32x4*)(p.mod + b * 6144 + k);
      y[j].x = v[j].x * r * g.x * (1.f + sc.x) + sh.x; y[j].y = v[j].y * r * g.y * (1.f + sc.y) + sh.y;
      y[j].z = v[j].z * r * g.z * (1.f + sc.z) + sh.z; y[j].w = v[j].w * r * g.w * (1.f + sc.w) + sh.w;
      u32x2 o; o.x = pk2(y[j].x, y[j].y); o.y = pk2(y[j].z, y[j].w);
      *(u32x2*)(p.hb + (size_t)row * D + k) = o;
    }
#pragma unroll
    for (int half = 0; half < 2; ++half) {
      float ga[12];
#pragma unroll
      for (int q = 0; q < 12; ++q) ga[q] = 0.f;
#pragma unroll
      for (int j = 0; j < 4; ++j) {
        const float yy[4] = {y[j].x, y[j].y, y[j].z, y[j].w};
#pragma unroll
        for (int e = 0; e < 4; ++e) {
          const LAS f32x4* wr = (const LAS f32x4*)(wg + (j * 256 + lane * 4 + e) * 24 + half * 12);
#pragma unroll
          for (int q4 = 0; q4 < 3; ++q4) { const f32x4 w = wr[q4]; ga[q4 * 4] += yy[e] * w.x; ga[q4 * 4 + 1] += yy[e] * w.y; ga[q4 * 4 + 2] += yy[e] * w.z; ga[q4 * 4 + 3] += yy[e] * w.w; }
          __builtin_amdgcn_sched_barrier(0);
        }
      }
#pragma unroll
      for (int q = 0; q < 12; ++q) { const float t = wave_sum(ga[q]); if (lane == q) p.gates[(size_t)row * 24 + half * 12 + q] = sigm(t); __builtin_amdgcn_sched_barrier(0); }
    }
  }
  __syncthreads();
}

#define ROPE_PAIR(X1, X2, posf, invrev, sc) do { float pf_ = (posf); asm volatile("" : "+v"(pf_)); const float fr_ = __builtin_amdgcn_fractf(pf_ * (invrev)); \
    const float sn_ = __builtin_amdgcn_sinf(fr_), cs_ = __builtin_amdgcn_cosf(fr_); const float a_ = (X1), b_ = (X2); \
    float o1_ = (a_ * cs_ - b_ * sn_) * (sc), o2_ = (a_ * sn_ + b_ * cs_) * (sc); asm volatile("" : "+v"(o1_), "+v"(o2_)); (X1) = o1_; (X2) = o2_; } while (0)
__device__ __forceinline__ void phase1(const P& p, lptr lds, int vcu, int G) {
  const int tid = threadIdx.x, wid = __builtin_amdgcn_readfirstlane(tid >> 6), lane = tid & 63, wn = wid >> 2, wt = wid & 3, h = lane >> 5;
  constexpr int WRS = 256 * 2 + 64;
  lptr wimg = lds, ximg = lds + 32 * WRS;
  const LAS float* inv64 = (const LAS float*)(lds + LDS_INV64);
  const LAS float* inv128 = (const LAS float*)(lds + LDS_INV128);
  for (int u = vcu; u < 13 * 64; u += G) {
    const int j = u % 13, mt = u / 13, t0 = mt * 256;
    const int wcol = j < 5 ? j * 256 : C_QR + (j - 5) * 256;
    const bf16_t* wsrc = p.winb + wcol;
    const bf16_t* rowp[2] = {p.hb + (size_t)(t0 + (tid >> 2)) * D, p.hb + (size_t)(t0 + 128 + (tid >> 2)) * D};
    f32x16 acc[4][2];
#pragma unroll
    for (int a = 0; a < 4; ++a)
#pragma unroll
      for (int b = 0; b < 2; ++b)
#pragma unroll
        for (int r = 0; r < 16; ++r) acc[a][b][r] = 0.f;
    WRegB16<256> wr; XRegB16<256> xr;
    wload_b16<256>(wr, wsrc, INW, tid); xload_b16<256>(xr, rowp, 0, tid);
    for (int k0 = 0; k0 < D; k0 += 32) {
      wstore_b16<256>(wr, wimg, WRS, tid); xstore_b16<256>(xr, ximg, tid);
      __syncthreads();
      if (k0 + 32 < D) { wload_b16<256>(wr, wsrc + (size_t)(k0 + 32) * INW, INW, tid); xload_b16<256>(xr, rowp, k0 + 32, tid); }
      mma_step<4, 2, true, false>(acc, wimg, WRS, wn * 128, ximg, 0, wt * 64, lane);
      __syncthreads();
    }
    const int kind = (j < 2) ? 0 : (j == 2) ? 3 : (j < 5) ? (wn == 0 ? 1 : 3) : (j < 7) ? 2 : (j < 9) ? 4 : (j < 11) ? 3 : 5;
#pragma unroll
    for (int tn = 0; tn < 2; ++tn) {
      const int tok = t0 + wt * 64 + tn * 32 + (lane & 31);
      const float posf = (float)p.pos[tok];
      if (kind == 0 || kind == 1) {
        const float sc = kind == 0 ? 0.125f : 1.f;
#pragma unroll
        for (int r = 0; r < 16; ++r) { const float iv = inv64[(r & 3) + 8 * (r >> 2) + 4 * h];
          ROPE_PAIR(acc[0][tn][r], acc[1][tn][r], posf, iv, sc); ROPE_PAIR(acc[2][tn][r], acc[3][tn][r], posf, iv, sc); if ((r & 3) == 3) __builtin_amdgcn_sched_barrier(0); }
      } else if (kind == 2 || kind == 4) {
        const float sc = kind == 4 ? 0.08838834764831845f : 1.f;
#pragma unroll
        for (int r = 0; r < 16; ++r) { const int i = (r & 3) + 8 * (r >> 2) + 4 * h;
          ROPE_PAIR(acc[0][tn][r], acc[2][tn][r], posf, inv128[i], sc); ROPE_PAIR(acc[1][tn][r], acc[3][tn][r], posf, inv128[32 + i], sc); if ((r & 3) == 3) __builtin_amdgcn_sched_barrier(0); }
      } else if (kind == 5) {
#pragma unroll
        for (int tm = 0; tm < 4; ++tm)
#pragma unroll
          for (int r = 0; r < 16; ++r) { float v = acc[tm][tn][r]; asm volatile("" : "+v"(v)); float o = v * __builtin_amdgcn_rcpf(1.f + __builtin_amdgcn_exp2f(-1.4426950408889634f * v)); asm volatile("" : "+v"(o)); acc[tm][tn][r] = o; }
      }
      bf16_t* orow = p.projb + (size_t)tok * PJW + j * 256 + wn * 128 + 4 * h;
#pragma unroll
      for (int tm = 0; tm < 4; ++tm)
#pragma unroll
        for (int a = 0; a < 4; ++a) { u32x2 o; o.x = pk2(acc[tm][tn][4 * a], acc[tm][tn][4 * a + 1]); o.y = pk2(acc[tm][tn][4 * a + 2], acc[tm][tn][4 * a + 3]);
          *(u32x2*)(orow + tm * 32 + a * 8) = o; __builtin_amdgcn_sched_barrier(0); }
    }
  }
}

constexpr int NPHASE_FAST = 3;
__global__ void __launch_bounds__(512) mega(P p, int lo, int hi) {
  extern __shared__ __attribute__((aligned(16))) char lds_raw[];
  lptr lds = (lptr)lds_raw;
  const int tid = threadIdx.x, G = gridDim.x;
  const int vcu = (G % 8 == 0) ? ((int)blockIdx.x % 8) * (G / 8) + (int)blockIdx.x / 8 : (int)blockIdx.x;
  if (tid < 32) ((LAS float*)(lds + LDS_INV64))[tid] = exp2f(-(float)(2 * tid) / 64.f * 13.287712379549449f) * 0.15915494309189535f;
  if (tid < 64) ((LAS float*)(lds + LDS_INV128))[tid] = exp2f(-(float)(2 * tid) / 128.f * 13.287712379549449f) * 0.15915494309189535f;
  if (tid < 4) ((LAS unsigned*)(lds + LDS_XB))[tid] = 0u;
  __syncthreads();
  XcdBarrier xb; xb.bar = p.bar; xb.x = 0; xb.st = (volatile LAS unsigned*)(lds + LDS_XB);
  if (hi - lo > 1) xb = xcd_barrier_post(p.bar, (volatile LAS unsigned*)(lds + LDS_XB));
#define PH(k, call) if (lo <= (k) && (k) < hi) { call; if ((k) + 1 < hi) xcd_barrier(xb); }
  PH(0, phase0a(p, lds, vcu, G));
  PH(1, phase0b(p, lds, vcu, G));
  PH(2, phase1(p, lds, vcu, G));
#undef PH
}

__global__ __launch_bounds__(256) void k_adapt_proj(P p) {
  const int tok = blockIdx.x;
  for (int c = threadIdx.x; c < PJW; c += 256) {
    const int dst = c < 1280 ? c : C_QR + (c - 1280);
    p.proj[(size_t)tok * INW + dst] = bf2f(p.projb[(size_t)tok * PJW + c]);
  }
}
template <class F>
__global__ __launch_bounds__(256) void k_gemm(F f) {
  __shared__ __attribute__((aligned(16))) float As[16][68];
  __shared__ __attribute__((aligned(16))) float Bs[16][68];
  __shared__ int rid[64];
  const int tid = threadIdx.x, mt = blockIdx.y, n0 = blockIdx.x * 64;
  typename F::Tile ti;
  if (!f.tile(mt, ti)) return;
  if (tid < 64) rid[tid] = f.row(ti, tid);
  __syncthreads();
  float acc[4][4];
#pragma unroll
  for (int i = 0; i < 4; ++i)
#pragma unroll
    for (int j = 0; j < 4; ++j) acc[i][j] = 0.f;
  const int ty = tid >> 4, tx = tid & 15;
  const int ar = tid >> 2, ak = (tid & 3) * 4, bk = tid >> 4, bn = (tid & 15) * 4;
  const int arid = rid[ar];
  for (int k0 = 0; k0 < f.K; k0 += 16) {
#pragma unroll
    for (int i = 0; i < 4; ++i) As[ak + i][ar] = arid >= 0 ? f.a(ti, arid, k0 + ak + i) : 0.f;
#pragma unroll
    for (int j = 0; j < 4; ++j) { const int n = n0 + bn + j; Bs[bk][bn + j] = n < f.N ? f.b(ti, k0 + bk, n) : 0.f; }
    __syncthreads();
#pragma unroll
    for (int kk = 0; kk < 16; ++kk) {
      const float4 a = *(const float4*)&As[kk][ty * 4];
      const float4 b = *(const float4*)&Bs[kk][tx * 4];
      const float av[4] = {a.x, a.y, a.z, a.w}, bv[4] = {b.x, b.y, b.z, b.w};
#pragma unroll
      for (int i = 0; i < 4; ++i)
#pragma unroll
        for (int j = 0; j < 4; ++j) acc[i][j] += av[i] * bv[j];
    }
    __syncthreads();
  }
#pragma unroll
  for (int i = 0; i < 4; ++i) {
    const int r = rid[ty * 4 + i];
    if (r < 0) continue;
#pragma unroll
    for (int j = 0; j < 4; ++j) { const int n = n0 + tx * 4 + j; if (n < f.N) f.epi(ti, r, n, acc[i][j]); }
  }
}

struct DenseTile { int m0; };
struct FProj {
  typedef DenseTile Tile; P p; int N, K;
  __device__ bool tile(int mt, Tile& t) const { t.m0 = mt * 64; return true; }
  __device__ int row(const Tile& t, int i) const { return t.m0 + i; }
  __device__ float a(const Tile&, int r, int k) const { return p.h[(size_t)r * D + k]; }
  __device__ float b(const Tile&, int k, int n) const { return p.w_in[(size_t)k * INW + n]; }
  __device__ void epi(const Tile&, int r, int n, float v) const { p.proj[(size_t)r * INW + n] = v; }
};
struct FCmp1 {
  typedef DenseTile Tile; P p; int N, K; int col, pad; const float *pe, *w1; float* hid;
  __device__ bool tile(int mt, Tile& t) const { t.m0 = mt * 64; return true; }
  __device__ int row(const Tile& t, int i) const { const int r = t.m0 + i; return r < NCR ? r : -1; }
  __device__ float a(const Tile&, int r, int k) const {
    const int b = r / (2 * NC), g = (r / NC) & 1, c = r % NC, l = k >> 6, d = k & 63;
    return p.proj[(size_t)(b * SEQ + 16 * c + l) * INW + col + g * 64 + d] + pe[k];
  }
  __device__ float b(const Tile&, int k, int n) const { return w1[k * 128 + n]; }
  __device__ void epi(const Tile&, int r, int n, float v) const { hid[r * 128 + n] = gelu_tanh(v); }
};
struct FCmp2 {
  typedef DenseTile Tile; P p; int N, K; const float *hid, *w2; float* outp;
  __device__ bool tile(int mt, Tile& t) const { t.m0 = mt * 64; return true; }
  __device__ int row(const Tile& t, int i) const { const int r = t.m0 + i; return r < NCR ? r : -1; }
  __device__ float a(const Tile&, int r, int k) const { return hid[r * 128 + k]; }
  __device__ float b(const Tile&, int k, int n) const { return w2[k * 64 + n]; }
  __device__ void epi(const Tile&, int r, int n, float v) const { outp[r * 64 + n] = v; }
};
__device__ __forceinline__ float ret_logg(int h) { return logf(1.f - exp2f(-5.f - (float)h)); }
struct RetTile { int chunk, i0, b, h, s0; };
__device__ __forceinline__ void ret_tile(int mt, RetTile& t) { t.chunk = mt >> 1; t.i0 = (mt & 1) * 64; const int bh = t.chunk >> 5; t.b = bh >> 2; t.h = bh & 3; t.s0 = (t.chunk & 31) * 128; }
struct FRet1 {
  typedef RetTile Tile; P p; int N, K;
  __device__ bool tile(int mt, Tile& t) const { ret_tile(mt, t); return true; }
  __device__ int row(const Tile& t, int i) const { return t.i0 + i; }
  __device__ float a(const Tile& t, int r, int k) const { return p.proj[(size_t)(t.b * SEQ + t.s0 + r) * INW + C_QR + t.h * 128 + k]; }
  __device__ float b(const Tile& t, int k, int n) const { return p.proj[(size_t)(t.b * SEQ + t.s0 + n) * INW + C_KR + t.h * 128 + k]; }
  __device__ void epi(const Tile& t, int r, int n, float v) const { p.Sc[((size_t)t.chunk * 128 + r) * 128 + n] = r >= n ? v * expf(ret_logg(t.h) * (float)(r - n)) : 0.f; }
};
struct FRet2 {
  typedef RetTile Tile; P p; int N, K;
  __device__ bool tile(int mt, Tile& t) const { ret_tile(mt, t); return true; }
  __device__ int row(const Tile& t, int i) const { return t.i0 + i; }
  __device__ float a(const Tile& t, int r, int k) const { return p.proj[(size_t)(t.b * SEQ + t.s0 + k) * INW + C_KR + t.h * 128 + r] * expf(ret_logg(t.h) * (float)(127 - k)); }
  __device__ float b(const Tile& t, int k, int n) const { return p.proj[(size_t)(t.b * SEQ + t.s0 + k) * INW + C_VR + t.h * 128 + n]; }
  __device__ void epi(const Tile& t, int r, int n, float v) const { p.kv[((size_t)t.chunk * 128 + r) * 128 + n] = v; }
};
struct FRet3 {
  typedef RetTile Tile; P p; int N, K;
  __device__ bool tile(int mt, Tile& t) const { ret_tile(mt, t); return true; }
  __device__ int row(const Tile& t, int i) const { return t.i0 + i; }
  __device__ float a(const Tile& t, int r, int k) const {
    if (k < 128) return p.Sc[((size_t)t.chunk * 128 + r) * 128 + k];
    return p.proj[(size_t)(t.b * SEQ + t.s0 + r) * INW + C_QR + t.h * 128 + (k - 128)] * expf(ret_logg(t.h) * (float)(r + 1));
  }
  __device__ float b(const Tile& t, int k, int n) const {
    if (k < 128) return p.proj[(size_t)(t.b * SEQ + t.s0 + k) * INW + C_VR + t.h * 128 + n];
    return p.kv[((size_t)t.chunk * 128 + (k - 128)) * 128 + n];
  }
  __device__ void epi(const Tile& t, int r, int n, float v) const { p.retout[(size_t)(t.b * SEQ + t.s0 + r) * 512 + t.h * 128 + n] = v; }
};
struct FOut {
  typedef DenseTile Tile; P p; int N, K;
  __device__ bool tile(int mt, Tile& t) const { t.m0 = mt * 64; return true; }
  __device__ int row(const Tile& t, int i) const { return t.m0 + i; }
  __device__ float a(const Tile&, int r, int k) const { return p.mixin[(size_t)r * D + k]; }
  __device__ float b(const Tile&, int k, int n) const { return p.w_out[(size_t)k * D + n]; }
  __device__ void epi(const Tile&, int r, int n, float v) const { const int b = r / SEQ; p.x1[(size_t)r * D + n] = p.x[(size_t)r * D + n] + p.mod[b * 6144 + 2048 + n] * v; }
};
struct FRouter {
  typedef DenseTile Tile; P p; int N, K;
  __device__ bool tile(int mt, Tile& t) const { t.m0 = mt * 64; return true; }
  __device__ int row(const Tile& t, int i) const { return t.m0 + i; }
  __device__ float a(const Tile&, int r, int k) const { return p.h[(size_t)r * D + k]; }
  __device__ float b(const Tile&, int k, int n) const { return p.w_router[k * NE + n]; }
  __device__ void epi(const Tile&, int r, int n, float v) const { p.logits[r * NE + n] = v; }
};
template <int MODE> struct FShared {
  typedef DenseTile Tile; P p; int N, K;
  __device__ bool tile(int mt, Tile& t) const { t.m0 = mt * 64; return true; }
  __device__ int row(const Tile& t, int i) const { return t.m0 + i; }
  __device__ float a(const Tile&, int r, int k) const { return MODE == 2 ? p.acts[(size_t)r * 256 + k] : p.h[(size_t)r * D + k]; }
  __device__ float b(const Tile&, int k, int n) const { return MODE == 0 ? p.wg_s[k * 256 + n] : MODE == 1 ? p.wu_s[k * 256 + n] : p.wd_s[k * D + n]; }
  __device__ void epi(const Tile&, int r, int n, float v) const {
    if (MODE == 0) p.Gs[(size_t)r * 256 + n] = v;
    else if (MODE == 1) p.acts[(size_t)r * 256 + n] = silu(p.Gs[(size_t)r * 256 + n]) * v;
    else p.yacc[(size_t)r * D + n] = v;
  }
};
struct MoeTile { int e, off, cnt; };
template <int MODE> struct FMoe {
  typedef MoeTile Tile; P p; int N, K;
  __device__ bool tile(int mt, Tile& t) const { if (mt >= *p.ntiles) return false; t.e = p.tile_e[mt]; t.off = p.tile_off[mt]; t.cnt = p.cnt[t.e]; return true; }
  __device__ int row(const Tile& t, int i) const { return t.off + i < t.cnt ? p.list[t.e * ECAP + t.off + i] : -1; }
  __device__ float a(const Tile&, int sid, int k) const { return MODE == 2 ? p.act[(size_t)sid * 256 + k] : p.h[(size_t)(sid >> 3) * D + k]; }
  __device__ float b(const Tile& t, int k, int n) const {
    return MODE == 0 ? p.wg_e[((size_t)t.e * D + k) * 256 + n] : MODE == 1 ? p.wu_e[((size_t)t.e * D + k) * 256 + n] : p.wd_e[((size_t)t.e * 256 + k) * D + n];
  }
  __device__ void epi(const Tile&, int sid, int n, float v) const {
    if (MODE == 0) p.G[(size_t)sid * 256 + n] = v;
    else if (MODE == 1) p.act[(size_t)sid * 256 + n] = silu(p.G[(size_t)sid * 256 + n]) * v;
    else atomicAdd(&p.yacc[(size_t)(sid >> 3) * D + n], v * p.wts[sid]);
  }
};

__global__ __launch_bounds__(256) void k_rope(P p) {
  const int id = blockIdx.x * 256 + threadIdx.x;
  const int tok = id / 896, pr = id % 896;
  int col, half, i; float sc = 1.f;
  if (pr < 256) { col = C_QN + (pr >> 5) * 64; i = pr & 31; half = 32; }
  else if (pr < 320) { const int q = pr - 256; col = C_KS + (q >> 5) * 64; i = q & 31; half = 32; }
  else if (pr < 384) { const int q = pr - 320; col = C_KW + (q >> 5) * 64; i = q & 31; half = 32; }
  else if (pr < 640) { const int q = pr - 384; col = C_QR + (q >> 6) * 128; i = q & 63; half = 64; }
  else { const int q = pr - 640; col = C_KR + (q >> 6) * 128; i = q & 63; half = 64; sc = 0.08838834764831845f; }
  const float inv = powf(10000.f, -(float)(2 * i) / (float)(2 * half));
  const float ang = (float)p.pos[tok] * inv;
  float sn, cs; sincosf(ang, &sn, &cs);
  float* q = p.proj + (size_t)tok * INW + col;
  const float x1 = q[i], x2 = q[i + half];
  q[i] = (x1 * cs - x2 * sn) * sc; q[i + half] = (x1 * sn + x2 * cs) * sc;
}
__global__ __launch_bounds__(256) void k_rope_cmp(P p) {
  const int id = blockIdx.x * 256 + threadIdx.x;
  if (id >= NCR * 32) return;
  const int r = id >> 5, i = id & 31, b = r / (2 * NC), c = r % NC;
  const float inv = powf(10000.f, -(float)(2 * i) / 64.f);
  const float ang = (float)p.pos[b * SEQ + 16 * c + 31] * inv;
  float sn, cs; sincosf(ang, &sn, &cs);
  float* q = p.kcmp + r * 64;
  const float x1 = q[i], x2 = q[i + 32];
  q[i] = x1 * cs - x2 * sn; q[i + 32] = x1 * sn + x2 * cs;
}

__global__ __launch_bounds__(256) void k_nsa(P p) {
  const int bt = blockIdx.x, g = blockIdx.y, b = bt / SEQ, t = bt % SEQ;
  const int tid = threadIdx.x, r = tid >> 6, lane = tid & 63, h = g * 4 + r;
  __shared__ float qs[4][64];
  __shared__ float pc[4][256];
  __shared__ float ps[4][512];
  __shared__ float impv[64];
  __shared__ int sel[8];
  qs[r][lane] = p.proj[(size_t)bt * INW + C_QN + h * 64 + lane];
  __syncthreads();
  float sc[4], mx = -1e30f;
#pragma unroll
  for (int i = 0; i < 4; ++i) {
    const int c = i * 64 + lane; float s = -1e30f;
    if (c < NC && 16 * c + 31 <= t) { const float* kr = p.kcmp + ((size_t)(b * 2 + g) * NC + c) * 64; float a = 0.f; for (int d = 0; d < 64; ++d) a += qs[r][d] * kr[d]; s = a; }
    sc[i] = s; mx = fmaxf(mx, s);
  }
  mx = wave_max(mx);
  float sum = 0.f;
#pragma unroll
  for (int i = 0; i < 4; ++i) { const int c = i * 64 + lane; const bool v = c < NC && 16 * c + 31 <= t; const float e = v ? expf(sc[i] - mx) : 0.f; sc[i] = e; sum += e; }
  sum = wave_sum(sum);
  float inv = 1.f / fmaxf(sum, 1e-20f);
#pragma unroll
  for (int i = 0; i < 4; ++i) pc[r][i * 64 + lane] = sc[i] * inv;
  __syncthreads();
  float oc = 0.f;
  { const int nv = t >= 31 ? min(NC, (t - 31) / 16 + 1) : 0;
    for (int c = 0; c < nv; ++c) oc += pc[r][c] * p.vcmp[((size_t)(b * 2 + g) * NC + c) * 64 + lane]; }
  if (tid < 64) {
    const int j = tid; float im = 0.f;
    const int c0 = max(0, 4 * j - 1), c1 = min(NC - 1, 4 * j + 3);
    for (int rr = 0; rr < 4; ++rr) for (int c = c0; c <= c1; ++c) im += pc[rr][c];
    const int cur = t >> 6; const bool valid = j * 64 <= t, forced = (j == 0) || (j == cur) || (j == cur - 1);
    impv[j] = valid ? im + (forced ? 1e4f : 0.f) : -1.f;
  }
  __syncthreads();
  if (tid == 0) {
    for (int k = 0; k < 8; ++k) { int best = 0; float bv = impv[0]; for (int j = 1; j < 64; ++j) if (impv[j] > bv) { bv = impv[j]; best = j; } sel[k] = best; impv[best] = -INFINITY; }
  }
  __syncthreads();
  float ss[8]; mx = -1e30f;
#pragma unroll
  for (int i = 0; i < 8; ++i) {
    const int q = sel[i] * 64 + lane; float s = -1e30f;
    if (q <= t) { const float* kr = p.proj + (size_t)(b * SEQ + q) * INW + C_KS + g * 64; float a = 0.f; for (int d = 0; d < 64; ++d) a += qs[r][d] * kr[d]; s = a; }
    ss[i] = s; mx = fmaxf(mx, s);
  }
  mx = wave_max(mx); sum = 0.f;
#pragma unroll
  for (int i = 0; i < 8; ++i) { const int q = sel[i] * 64 + lane; const float e = q <= t ? expf(ss[i] - mx) : 0.f; ss[i] = e; sum += e; }
  sum = wave_sum(sum); inv = 1.f / fmaxf(sum, 1e-20f);
#pragma unroll
  for (int i = 0; i < 8; ++i) ps[r][i * 64 + lane] = ss[i] * inv;
  __syncthreads();
  float os = 0.f;
  for (int i = 0; i < 8; ++i) { const int q0 = sel[i] * 64;
    for (int l = 0; l < 64; ++l) { const int q = q0 + l; if (q <= t) os += ps[r][i * 64 + l] * p.proj[(size_t)(b * SEQ + q) * INW + C_VS + g * 64 + lane]; } }
  __syncthreads();
  mx = -1e30f;
#pragma unroll
  for (int i = 0; i < 8; ++i) {
    const int q = t - 511 + i * 64 + lane; float s = -1e30f;
    if (q >= 0) { const float* kr = p.proj + (size_t)(b * SEQ + q) * INW + C_KW + g * 64; float a = 0.f; for (int d = 0; d < 64; ++d) a += qs[r][d] * kr[d]; s = a; }
    ss[i] = s; mx = fmaxf(mx, s);
  }
  mx = wave_max(mx); sum = 0.f;
#pragma unroll
  for (int i = 0; i < 8; ++i) { const int q = t - 511 + i * 64 + lane; const float e = q >= 0 ? expf(ss[i] - mx) : 0.f; ss[i] = e; sum += e; }
  sum = wave_sum(sum); inv = 1.f / fmaxf(sum, 1e-20f);
#pragma unroll
  for (int i = 0; i < 8; ++i) ps[r][i * 64 + lane] = ss[i] * inv;
  __syncthreads();
  float ow = 0.f;
  for (int i = 0; i < 512; ++i) { const int q = t - 511 + i; if (q >= 0) ow += ps[r][i] * p.proj[(size_t)(b * SEQ + q) * INW + C_VW + g * 64 + lane]; }
  const float* gp = p.gates + (size_t)bt * 24 + h * 3;
  p.onsa[(size_t)bt * 512 + h * 64 + lane] = gp[0] * oc + gp[1] * os + gp[2] * ow;
}

__global__ __launch_bounds__(256) void k_mixin(P p) {
  const int tok = blockIdx.x * 4 + (threadIdx.x >> 6), lane = threadIdx.x & 63;
  float v[8], s = 0.f;
#pragma unroll
  for (int i = 0; i < 8; ++i) { v[i] = p.onsa[(size_t)tok * 512 + i * 64 + lane]; s += v[i] * v[i]; }
  s = wave_sum(s);
  float r = rsqrtf(s * (1.f / 512.f) + EPS);
#pragma unroll
  for (int i = 0; i < 8; ++i) p.mixin[(size_t)tok * D + i * 64 + lane] = v[i] * r * p.g_nsa[i * 64 + lane];
#pragma unroll
  for (int hh = 0; hh < 4; ++hh) {
    const float a = p.retout[(size_t)tok * 512 + hh * 128 + lane], b = p.retout[(size_t)tok * 512 + hh * 128 + 64 + lane];
    const float q = wave_sum(a * a + b * b);
    r = rsqrtf(q * (1.f / 128.f) + EPS);
    const float* gr = p.proj + (size_t)tok * INW + C_GR + hh * 128;
    p.mixin[(size_t)tok * D + 512 + hh * 128 + lane] = gr[lane] * a * r * p.g_ret[hh * 128 + lane];
    p.mixin[(size_t)tok * D + 512 + hh * 128 + 64 + lane] = gr[64 + lane] * b * r * p.g_ret[hh * 128 + 64 + lane];
  }
}

__global__ __launch_bounds__(256) void k_ret_scan(P p) {
  const int id = blockIdx.x * 256 + threadIdx.x;
  const int bh = id >> 14, de = id & 16383, h = bh & 3;
  const float gc = expf(ret_logg(h) * 128.f);
  float st = 0.f;
  for (int n = 0; n < 32; ++n) { float* q = p.kv + ((size_t)(bh * 32 + n) * 16384 + de); const float kvn = *q; *q = st; st = st * gc + kvn; }
}

__global__ __launch_bounds__(256) void k_route(P p) {
  const int t = blockIdx.x * 256 + threadIdx.x;
  const float* lg = p.logits + (size_t)t * NE;
  unsigned gmask = 0;
  { float pv = INFINITY; int pg = -1;
    for (int k = 0; k < 4; ++k) {
      float bv = -INFINITY; int bg = -1;
      for (int g = 0; g < 8; ++g) {
        float m1 = -INFINITY, m2 = -INFINITY;
        for (int e = 0; e < 32; ++e) { const float v = sigm(lg[g * 32 + e]) + p.rbias[g * 32 + e]; if (v > m1) { m2 = m1; m1 = v; } else if (v > m2) m2 = v; }
        const float gs = m1 + m2;
        const bool after = (gs < pv) || (gs == pv && g > pg);
        if (after && gs > bv) { bv = gs; bg = g; }
      }
      gmask |= 1u << bg; pv = bv; pg = bg;
    } }
  float pv = INFINITY; int pe = -1; int ids[8]; float ws[8]; float wsum = 0.f;
#pragma unroll
  for (int k = 0; k < 8; ++k) {
    float bv = -INFINITY; int be = -1; float bs = 0.f;
    for (int e = 0; e < NE; ++e) {
      if (!((gmask >> (e >> 5)) & 1u)) continue;
      const float s = sigm(lg[e]), v = s + p.rbias[e];
      const bool after = (v < pv) || (v == pv && e > pe);
      if (after && v > bv) { bv = v; be = e; bs = s; }
    }
    ids[k] = be; ws[k] = bs; wsum += bs; pv = bv; pe = be;
  }
#pragma unroll
  for (int k = 0; k < 8; ++k) {
    const int e = ids[k]; const int pos = atomicAdd(&p.cnt[e], 1);
    p.list[e * ECAP + pos] = t * 8 + k; p.wts[t * 8 + k] = ws[k] / wsum * 2.5f;
  }
}
__global__ void k_moe_tiles(P p) {
  int nt = 0;
  for (int e = 0; e < NE; ++e) for (int off = 0; off < p.cnt[e]; off += 64) { p.tile_e[nt] = e; p.tile_off[nt] = off; ++nt; }
  *p.ntiles = nt;
}

__global__ __launch_bounds__(256) void k_final(P p) {
  const int row = blockIdx.x * 4 + (threadIdx.x >> 6), lane = threadIdx.x & 63, b = row / SEQ;
  float v[16], s = 0.f;
#pragma unroll
  for (int i = 0; i < 16; ++i) { const int k = i * 64 + lane; v[i] = p.x1[(size_t)row * D + k] + p.mod[b * 6144 + 5120 + k] * p.yacc[(size_t)row * D + k]; s += v[i] * v[i]; }
  s = wave_sum(s);
  const float r = rsqrtf(s * (1.f / D) + EPS);
#pragma unroll
  for (int i = 0; i < 16; ++i) { const int k = i * 64 + lane; p.out[(size_t)row * D + k] = v[i] * r * p.g_final[k]; }
}
__global__ __launch_bounds__(256) void k_norm(const float* in, const float* g, const float* sc, const float* sh, float* out) {
  const int row = blockIdx.x * 4 + (threadIdx.x >> 6), lane = threadIdx.x & 63, b = row / SEQ;
  const float* xr = in + (size_t)row * D;
  float v[16], s = 0.f;
#pragma unroll
  for (int i = 0; i < 16; ++i) { v[i] = xr[i * 64 + lane]; s += v[i] * v[i]; }
  s = wave_sum(s);
  const float r = rsqrtf(s * (1.f / D) + EPS);
#pragma unroll
  for (int i = 0; i < 16; ++i) {
    const int k = i * 64 + lane;
    float y = v[i] * r * g[k];
    if (sc) y = y * (1.f + sc[b * 6144 + k]) + sh[b * 6144 + k];
    out[(size_t)row * D + k] = y;
  }
}
}

extern "C" void kernel_launch(void* const* d_in, const int* in_sizes, int n_in, void* d_out, int out_size, void* d_ws, size_t ws_size, hipStream_t stream) {
  P p{};
  p.x = (const float*)d_in[0]; p.c = (const float*)d_in[1]; p.pos = (const int*)d_in[2];
  p.w_ada = (const float*)d_in[3]; p.b_ada = (const float*)d_in[4]; p.g_mix = (const float*)d_in[5]; p.w_in = (const float*)d_in[6];
  p.cpk = (const float*)d_in[7]; p.cw1k = (const float*)d_in[8]; p.cw2k = (const float*)d_in[9];
  p.cpv = (const float*)d_in[10]; p.cw1v = (const float*)d_in[11]; p.cw2v = (const float*)d_in[12];
  p.g_nsa = (const float*)d_in[13]; p.g_ret = (const float*)d_in[14]; p.w_out = (const float*)d_in[15]; p.g_ffn = (const float*)d_in[16];
  p.w_router = (const float*)d_in[17]; p.rbias = (const float*)d_in[18]; p.wg_e = (const float*)d_in[19]; p.wu_e = (const float*)d_in[20];
  p.wd_e = (const float*)d_in[21]; p.wg_s = (const float*)d_in[22]; p.wu_s = (const float*)d_in[23]; p.wd_s = (const float*)d_in[24];
  p.g_final = (const float*)d_in[25];
  p.out = (float*)d_out;
  char* w = (char*)d_ws; size_t off = 0;
  auto take = [&](size_t bytes) { char* r = w + off; off += (bytes + 255) & ~(size_t)255; return r; };
  p.bar = (unsigned*)take(XCD_BAR_WORDS * 4);
  p.cnt = (int*)take(NE * 4); p.ntiles = (int*)take(4);
  const size_t zero_bytes = off;
  p.mod = (float*)take(BATCH * 6144 * 4);
  p.h = (float*)take((size_t)T * D * 4);
  p.proj = (float*)take((size_t)T * INW * 4);
  p.G = p.proj;
  p.hidk = (float*)take(2048 * 128 * 4); p.hidv = (float*)take(2048 * 128 * 4);
  p.kcmp = (float*)take(2048 * 64 * 4); p.vcmp = (float*)take(2048 * 64 * 4);
  p.onsa = (float*)take((size_t)T * 512 * 4);
  p.Sc = (float*)take((size_t)512 * 16384 * 4); p.kv = (float*)take((size_t)512 * 16384 * 4);
  p.retout = (float*)take((size_t)T * 512 * 4);
  p.mixin = (float*)take((size_t)T * D * 4);
  p.x1 = (float*)take((size_t)T * D * 4);
  p.logits = (float*)take((size_t)T * NE * 4);
  p.wts = (float*)take((size_t)T * 8 * 4);
  p.Gs = (float*)take((size_t)T * 256 * 4); p.acts = (float*)take((size_t)T * 256 * 4);
  p.act = (float*)take((size_t)T * 8 * 256 * 4);
  p.yacc = (float*)take((size_t)T * D * 4);
  p.list = (int*)take((size_t)NE * ECAP * 4);
  p.tile_e = (int*)take(4096 * 4); p.tile_off = (int*)take(4096 * 4);
  p.gates = (float*)take((size_t)T * 24 * 4);
  p.winb = (bf16_t*)take((size_t)D * INW * 2); p.woutb = (bf16_t*)take((size_t)D * D * 2); p.wrb = (bf16_t*)take((size_t)D * NE * 2);
  p.wgsb = (bf16_t*)take((size_t)D * 256 * 2); p.wusb = (bf16_t*)take((size_t)D * 256 * 2); p.wdsb = (bf16_t*)take((size_t)256 * D * 2);
  p.cw1kb = (bf16_t*)take(2048 * 128 * 2); p.cw1vb = (bf16_t*)take(2048 * 128 * 2); p.cw2kb = (bf16_t*)take(128 * 64 * 2); p.cw2vb = (bf16_t*)take(128 * 64 * 2);
  p.hb = (bf16_t*)take((size_t)T * D * 2);
  p.projb = (bf16_t*)take((size_t)T * PJW * 2);
  if (off > ws_size) { fprintf(stderr, "kernel_launch: workspace too small: need %zu have %zu\n", off, ws_size); return; }
  static int grid = 0;
  if (!grid) {
    int dev = 0, cus = 0, per_cu = 0;
    (void)hipGetDevice(&dev);
    (void)hipDeviceGetAttribute(&cus, hipDeviceAttributeMultiprocessorCount, dev);
    (void)hipFuncSetAttribute((const void*)mega, hipFuncAttributeMaxDynamicSharedMemorySize, LDS_BYTES);
    (void)hipOccupancyMaxActiveBlocksPerMultiprocessor(&per_cu, (const void*)mega, 512, LDS_BYTES);
    if (per_cu < 1) fprintf(stderr, "kernel_launch: occupancy query says %d blocks per CU\n", per_cu);
    grid = cus;
  }
  (void)hipMemsetAsync(d_ws, 0, zero_bytes, stream);
  for (int ph = 0; ph < NPHASE_FAST; ++ph) hipLaunchKernelGGL(mega, dim3(grid), dim3(512), LDS_BYTES, stream, p, ph, ph + 1);
  k_adapt_proj<<<T, 256, 0, stream>>>(p);
  { FCmp1 f{p, 128, 2048, C_KC, 0, p.cpk, p.cw1k, p.hidk}; k_gemm<<<dim3(2, 32), 256, 0, stream>>>(f); }
  { FCmp1 f{p, 128, 2048, C_VC, 0, p.cpv, p.cw1v, p.hidv}; k_gemm<<<dim3(2, 32), 256, 0, stream>>>(f); }
  { FCmp2 f{p, 64, 128, p.hidk, p.cw2k, p.kcmp}; k_gemm<<<dim3(1, 32), 256, 0, stream>>>(f); }
  { FCmp2 f{p, 64, 128, p.hidv, p.cw2v, p.vcmp}; k_gemm<<<dim3(1, 32), 256, 0, stream>>>(f); }
  k_rope_cmp<<<(NCR * 32 + 255) / 256, 256, 0, stream>>>(p);
  k_nsa<<<dim3(T, 2), 256, 0, stream>>>(p);
  { FRet1 f{p, 128, 128}; k_gemm<<<dim3(2, 1024), 256, 0, stream>>>(f); }
  { FRet2 f{p, 128, 128}; k_gemm<<<dim3(2, 1024), 256, 0, stream>>>(f); }
  k_ret_scan<<<16 * 16384 / 256, 256, 0, stream>>>(p);
  { FRet3 f{p, 128, 256}; k_gemm<<<dim3(2, 1024), 256, 0, stream>>>(f); }
  k_mixin<<<T / 4, 256, 0, stream>>>(p);
  { FOut f{p, D, D}; k_gemm<<<dim3(D / 64, T / 64), 256, 0, stream>>>(f); }
  k_norm<<<T / 4, 256, 0, stream>>>(p.x1, p.g_ffn, p.mod + 4096, p.mod + 3072, p.h);
  { FRouter f{p, NE, D}; k_gemm<<<dim3(NE / 64, T / 64), 256, 0, stream>>>(f); }
  k_route<<<T / 256, 256, 0, stream>>>(p);
  k_moe_tiles<<<1, 1, 0, stream>>>(p);
  { FShared<0> f{p, 256, D}; k_gemm<<<dim3(4, T / 64), 256, 0, stream>>>(f); }
  { FShared<1> f{p, 256, D}; k_gemm<<<dim3(4, T / 64), 256, 0, stream>>>(f); }
  { FShared<2> f{p, D, 256}; k_gemm<<<dim3(16, T / 64), 256, 0, stream>>>(f); }
  { FMoe<0> f{p, 256, D}; k_gemm<<<dim3(4, 2304), 256, 0, stream>>>(f); }
  { FMoe<1> f{p, 256, D}; k_gemm<<<dim3(4, 2304), 256, 0, stream>>>(f); }
  { FMoe<2> f{p, D, 256}; k_gemm<<<dim3(16, 2304), 256, 0, stream>>>(f); }
  k_final<<<T / 4, 256, 0, stream>>>(p);
}
```

```cpp
#include <hip/hip_runtime.h>
#include <cstdint>
#include <cstdio>

namespace {
constexpr int D = 1024, BATCH = 4, SEQ = 4096, T = BATCH * SEQ;
constexpr int INW = 3352;
constexpr int C_QN = 0, C_KC = 512, C_VC = 640, C_KS = 768, C_VS = 896, C_KW = 1024, C_VW = 1152, C_GN = 1280,
              C_QR = 1304, C_KR = 1816, C_VR = 2328, C_GR = 2840;
constexpr int PJW = 3328, J_QN = 0, J_KC = 512, J_VC = 640, J_KS = 768, J_VS = 896, J_KW = 1024, J_VW = 1152, J_QR = 1280, J_KR = 1792, J_VR = 2304, J_GR = 2816;
constexpr int NC = 255, NCR = BATCH * 2 * NC;
constexpr int NE = 256, ECAP = 16384;
constexpr float EPS = 1e-6f;
typedef unsigned short bf16_t;

struct P {
  const float *x, *c; const int* pos;
  const float *w_ada, *b_ada, *g_mix, *w_in, *cpk, *cw1k, *cw2k, *cpv, *cw1v, *cw2v, *g_nsa, *g_ret, *w_out, *g_ffn,
      *w_router, *rbias, *wg_e, *wu_e, *wd_e, *wg_s, *wu_s, *wd_s, *g_final;
  float* out;
  float *mod, *h, *proj, *hidk, *hidv, *kcmp, *vcmp, *onsa, *Sc, *kv, *retout, *mixin, *x1, *logits, *wts, *Gs, *acts,
      *G, *act, *yacc, *gates;
  int *cnt, *list, *tile_e, *tile_off, *ntiles;
  bf16_t *winb, *woutb, *wrb, *wgsb, *wusb, *wdsb, *cw1kb, *cw1vb, *cw2kb, *cw2vb, *hb, *projb, *mixb, *h2b, *slab;
  unsigned* bar;
};

#define LAS __attribute__((address_space(3)))
typedef LAS char* lptr;
typedef short bf16x8 __attribute__((ext_vector_type(8)));
typedef short v4i16_t __attribute__((ext_vector_type(4)));
typedef float f32x16 __attribute__((ext_vector_type(16)));
typedef float f32x4 __attribute__((ext_vector_type(4)));
typedef float f32x2_t __attribute__((ext_vector_type(2)));
typedef __bf16 bf16x2_t __attribute__((ext_vector_type(2)));
typedef unsigned u32x4 __attribute__((ext_vector_type(4)));
typedef unsigned u32x2 __attribute__((ext_vector_type(2)));

__device__ __forceinline__ float wave_sum(float v) {
#pragma unroll
  for (int o = 1; o < 64; o <<= 1) v += __shfl_xor(v, o);
  return v;
}
__device__ __forceinline__ float wave_max(float v) {
#pragma unroll
  for (int o = 1; o < 64; o <<= 1) v = fmaxf(v, __shfl_xor(v, o));
  return v;
}
__device__ __forceinline__ float silu(float v) { return v / (1.f + expf(-v)); }
__device__ __forceinline__ float sigm(float v) { return 1.f / (1.f + expf(-v)); }
__device__ __forceinline__ float gelu_tanh(float v) { return 0.5f * v * (1.f + tanhf(0.7978845608028654f * (v + 0.044715f * v * v * v))); }
__device__ __forceinline__ unsigned pk2(float lo, float hi) { f32x2_t v = {lo, hi}; bf16x2_t b = __builtin_convertvector(v, bf16x2_t); return __builtin_bit_cast(unsigned, b); }
__device__ __forceinline__ float bf2f(bf16_t u) { return __uint_as_float((unsigned)u << 16); }
__device__ __forceinline__ float bflo(unsigned u) { return __uint_as_float(u << 16); }
__device__ __forceinline__ float bfhi(unsigned u) { return __uint_as_float(u & 0xffff0000u); }

#define XB_TMO      128
#define XB_XCNT(j)  (256  + 64 * (j))
#define XB_XSUB(j)  (1280 + 64 * (j))
#define XB_XGEN(j)  (2304 + 64 * (j))
#define XB_TOP      3328
#define XB_TOPGEN   3392
#define XCD_BAR_WORDS 3456
#define XB_SPIN_CAP (1u << 18)
__device__ __forceinline__ unsigned xb_ld(unsigned* p)              { return __hip_atomic_load(p, __ATOMIC_RELAXED, __HIP_MEMORY_SCOPE_AGENT); }
__device__ __forceinline__ unsigned xb_add(unsigned* p, unsigned v) { return __hip_atomic_fetch_add(p, v, __ATOMIC_RELAXED, __HIP_MEMORY_SCOPE_AGENT); }
__device__ __forceinline__ unsigned xb_xcc_id() { return (unsigned)__builtin_amdgcn_s_getreg((3 << 11) | 20) & 0xFu; }
#define XB_SPIN(cond, bar) do { unsigned _sp = 0; while (cond) { __builtin_amdgcn_s_sleep(1); \
    if ((++_sp & 255u) == 0u) { if (xb_ld(&(bar)[XB_TMO])) break; if (_sp > XB_SPIN_CAP) { atomicAdd(&(bar)[XB_TMO], 1u); break; } } } } while (0)
struct XcdBarrier { unsigned* bar; unsigned x; volatile LAS unsigned* st; };
__device__ __forceinline__ XcdBarrier xcd_barrier_post(unsigned* bar, volatile LAS unsigned* st) {
    XcdBarrier b; b.bar = bar; b.x = xb_xcc_id(); b.st = st;
    if (threadIdx.x == 0) (void)xb_add(&bar[XB_XCNT(b.x)], 1u);
    return b;
}
__device__ __forceinline__ void xcd_barrier_complete(unsigned* bar, unsigned x, unsigned& nloc, unsigned& nx) {
    const unsigned G = gridDim.x * gridDim.y * gridDim.z;
    unsigned sum, cnt, mine, sp = 0u;
    for (;;) {
        sum = 0u; cnt = 0u; mine = 0u;
#pragma unroll
        for (unsigned j = 0; j < 16; ++j) { const unsigned c = xb_ld(&bar[XB_XCNT(j)]); sum += c; cnt += (c > 0u) ? 1u : 0u; mine = (j == x) ? c : mine; }
        if (sum == G) break;
        __builtin_amdgcn_s_sleep(1);
        if ((++sp & 255u) == 0u) { if (xb_ld(&bar[XB_TMO])) break; if (sp > XB_SPIN_CAP) { atomicAdd(&bar[XB_TMO], 1u); break; } }
    }
    nloc = mine > 0u ? mine : 1u; nx = cnt > 0u ? cnt : 1u;
}
__device__ __forceinline__ void xcd_barrier(const XcdBarrier& b) {
    asm volatile("s_waitcnt vmcnt(0)" ::: "memory");
    __syncthreads();
    if (threadIdx.x == 0) {
        unsigned* bar = b.bar;
        __builtin_amdgcn_s_waitcnt(0);
        unsigned nloc = b.st[0], nx = b.st[1];
        if (nloc == 0u) { xcd_barrier_complete(bar, b.x, nloc, nx); b.st[0] = nloc; b.st[1] = nx; }
        const unsigned old = xb_add(&bar[XB_XSUB(b.x)], 1u);
        const unsigned gen = old / nloc;
        if (old + 1u == (gen + 1u) * nloc) {
            __builtin_amdgcn_fence(__ATOMIC_RELEASE, "agent");
            asm volatile("s_waitcnt vmcnt(0)" ::: "memory");
            const unsigned og = xb_add(&bar[XB_TOP], 1u);
            const unsigned tg = og / nx;
            if (og + 1u == (tg + 1u) * nx) xb_add(&bar[XB_TOPGEN], 1u);
            else XB_SPIN(xb_ld(&bar[XB_TOPGEN]) == tg, bar);
            __builtin_amdgcn_fence(__ATOMIC_ACQUIRE, "agent");
            xb_add(&bar[XB_XGEN(b.x)], 1u);
            asm volatile("s_waitcnt vmcnt(0)" ::: "memory");
        } else {
            XB_SPIN(xb_ld(&bar[XB_XGEN(b.x)]) == gen, bar);
            __builtin_amdgcn_fence(__ATOMIC_ACQUIRE, "agent");
            asm volatile("s_waitcnt vmcnt(0)" ::: "memory");
        }
    }
    __syncthreads();
}

__device__ __forceinline__ bf16x8 frag_kmaj(lptr img, int rs, int o, int s, int lane) {
  const int h = lane >> 5, blk = (lane >> 4) & 1, q = (lane & 15) >> 2, pp = lane & 3;
  lptr a = img + (16 * s + 8 * h + q) * rs + (o + 16 * blk + 4 * pp) * 2;
  const v4i16_t lo = __builtin_amdgcn_ds_read_tr16_b64_v4i16((LAS v4i16_t*)a);
  const v4i16_t hi = __builtin_amdgcn_ds_read_tr16_b64_v4i16((LAS v4i16_t*)(a + 4 * rs));
  return (bf16x8){lo[0], lo[1], lo[2], lo[3], hi[0], hi[1], hi[2], hi[3]};
}
__device__ __forceinline__ bf16x8 frag_kmin(lptr img, int o, int s, int lane) {
  const int row = o + (lane & 31), c = 2 * s + (lane >> 5);
  return *(LAS bf16x8*)(img + row * 64 + ((c ^ ((row >> 2) & 3)) << 4));
}
__device__ __forceinline__ int kmin_off(int row, int c) { return row * 64 + ((c ^ ((row >> 2) & 3)) << 4); }

template <int TM, int TN, bool WKMAJ, bool XKMAJ>
__device__ __forceinline__ void mma_step(f32x16 (&acc)[TM][TN], lptr wimg, int wrs, int wn0, lptr ximg, int xrs, int xt0, int lane) {
#pragma unroll
  for (int s = 0; s < 2; ++s) {
    bf16x8 wf[TM], xf[TN];
#pragma unroll
    for (int tm = 0; tm < TM; ++tm) wf[tm] = WKMAJ ? frag_kmaj(wimg, wrs, wn0 + 32 * tm, s, lane) : frag_kmin(wimg, wn0 + 32 * tm, s, lane);
#pragma unroll
    for (int tn = 0; tn < TN; ++tn) xf[tn] = XKMAJ ? frag_kmaj(ximg, xrs, xt0 + 32 * tn, s, lane) : frag_kmin(ximg, xt0 + 32 * tn, s, lane);
#pragma unroll
    for (int tm = 0; tm < TM; ++tm)
#pragma unroll
      for (int tn = 0; tn < TN; ++tn) acc[tm][tn] = __builtin_amdgcn_mfma_f32_32x32x16_bf16(wf[tm], xf[tn], acc[tm][tn], 0, 0, 0);
    if (s == 0) __builtin_amdgcn_sched_barrier(0);
  }
}

template <int BNT> struct WRegB16 { u32x4 r[BNT / 128]; };
template <int BNT> __device__ __forceinline__ void wload_b16(WRegB16<BNT>& R, const bf16_t* src  , int ld, int tid) {
  constexpr int C8 = BNT / 8, KPR = 512 / C8;
  const int c8 = tid % C8, kr = tid / C8;
#pragma unroll
  for (int r = 0; r < BNT / 128; ++r) R.r[r] = *(const u32x4*)(src + (size_t)(kr + r * KPR) * ld + c8 * 8);
}
template <int BNT> __device__ __forceinline__ void wstore_b16(const WRegB16<BNT>& R, lptr img, int rs, int tid) {
  constexpr int C8 = BNT / 8, KPR = 512 / C8;
  const int c8 = tid % C8, kr = tid / C8;
#pragma unroll
  for (int r = 0; r < BNT / 128; ++r) *(LAS u32x4*)(img + (kr + r * KPR) * rs + c8 * 16) = R.r[r];
}
template <int BMT> struct XRegB16 { u32x4 r[(BMT + 127) / 128]; };
template <int BMT> __device__ __forceinline__ void xload_b16(XRegB16<BMT>& R, const bf16_t* const (&rowp)[(BMT + 127) / 128], int k0, int tid) {
#pragma unroll
  for (int r = 0; r < (BMT + 127) / 128; ++r) if (BMT >= 128 || tid < BMT * 4) R.r[r] = *(const u32x4*)(rowp[r] + k0 + (tid & 3) * 8);
}
template <int BMT> __device__ __forceinline__ void xstore_b16(const XRegB16<BMT>& R, lptr img, int tid) {
#pragma unroll
  for (int r = 0; r < (BMT + 127) / 128; ++r) if (BMT >= 128 || tid < BMT * 4) *(LAS u32x4*)(img + kmin_off((tid >> 2) + 128 * r, tid & 3)) = R.r[r];
}

template <int BNT> struct WLb16 {
  typedef WRegB16<BNT> Regs; const bf16_t* src; int ld;
  __device__ __forceinline__ void load(Regs& R, int k0, int tid) const { wload_b16<BNT>(R, src + (size_t)k0 * ld, ld, tid); }
  __device__ __forceinline__ void store(const Regs& R, lptr img, int rs, int tid) const { wstore_b16<BNT>(R, img, rs, tid); }
};
struct WLgu {
  typedef WRegB16<512> Regs; const bf16_t *g, *u;
  __device__ __forceinline__ void load(Regs& R, int k0, int tid) const {
    const int c8 = tid & 63, kr = tid >> 6, col = c8 * 8, grp = col >> 6, w = col & 63;
    const unsigned long long ga = (unsigned long long)g, ua = (unsigned long long)u;
    const bf16_t* s = (const bf16_t*)(w < 32 ? ga : ua) + grp * 32 + (w & 31);
#pragma unroll
    for (int r = 0; r < 4; ++r) R.r[r] = *(const u32x4*)(s + (size_t)(k0 + kr + r * 8) * 256);
  }
  __device__ __forceinline__ void store(const Regs& R, lptr img, int rs, int tid) const { wstore_b16<512>(R, img, rs, tid); }
};
struct WReg32x8 { f32x4 r[8]; };
__device__ __forceinline__ void wstore_f32_512(const WReg32x8& R, lptr img, int rs, int tid) {
  const int c4 = tid & 127, kr = tid >> 7;
#pragma unroll
  for (int r = 0; r < 8; ++r) { u32x2 o; o.x = pk2(R.r[r].x, R.r[r].y); o.y = pk2(R.r[r].z, R.r[r].w); *(LAS u32x2*)(img + (kr + 4 * r) * rs + c4 * 8) = o; }
}
struct WLf32 {
  typedef WReg32x8 Regs; const float* src; int ld;
  __device__ __forceinline__ void load(Regs& R, int k0, int tid) const {
    const float* s = src + (size_t)(k0 + (tid >> 7)) * ld + (tid & 127) * 4;
#pragma unroll
    for (int r = 0; r < 8; ++r) R.r[r] = *(const f32x4*)(s + (size_t)(4 * r) * ld);
  }
  __device__ __forceinline__ void store(const Regs& R, lptr img, int rs, int tid) const { wstore_f32_512(R, img, rs, tid); }
};
struct WLf32gu {
  typedef WReg32x8 Regs; const float *g, *u;
  __device__ __forceinline__ void load(Regs& R, int k0, int tid) const {
    const int col = (tid & 127) * 4, grp = col >> 7, w = col & 127;
    const unsigned long long ga = (unsigned long long)g, ua = (unsigned long long)u;
    const float* s = (const float*)(w < 64 ? ga : ua) + (size_t)(k0 + (tid >> 7)) * 256 + grp * 64 + (w & 63);
#pragma unroll
    for (int r = 0; r < 8; ++r) R.r[r] = *(const f32x4*)(s + (size_t)(4 * r) * 256);
  }
  __device__ __forceinline__ void store(const Regs& R, lptr img, int rs, int tid) const { wstore_f32_512(R, img, rs, tid); }
};
template <int BMT> struct XLrows {
  typedef XRegB16<BMT> Regs; const bf16_t* rowp[(BMT + 127) / 128]; lptr ximg;
  __device__ __forceinline__ void load(Regs& R, int k0, int tid) const { xload_b16<BMT>(R, rowp, k0, tid); }
  __device__ __forceinline__ void store(const Regs& R, int tid) const { xstore_b16<BMT>(R, ximg, tid); }
  __device__ __forceinline__ lptr img(int) const { return ximg; }
};
struct XLres {
  struct Regs {}; lptr base; int bytes;
  __device__ __forceinline__ void load(Regs&, int, int) const {}
  __device__ __forceinline__ void store(const Regs&, int) const {}
  __device__ __forceinline__ lptr img(int k0) const { return base + (k0 >> 5) * bytes; }
};
template <int TM, int TN, class WL, class XL>
__device__ __forceinline__ void gemm_loop(f32x16 (&acc)[TM][TN], int K, const WL& wl, const XL& xl, lptr wimg, int wrs, int wn0, int xt0, int tid, int lane) {
  asm volatile("" : "+v"(tid), "+v"(lane));
  typename WL::Regs wr; typename XL::Regs xr;
  wl.load(wr, 0, tid); xl.load(xr, 0, tid);
  for (int k0 = 0; k0 < K; k0 += 32) {
    wl.store(wr, wimg, wrs, tid); xl.store(xr, tid);
    __syncthreads();
    if (k0 + 32 < K) { wl.load(wr, k0 + 32, tid); xl.load(xr, k0 + 32, tid); }
    mma_step<TM, TN, true, false>(acc, wimg, wrs, wn0, xl.img(k0), 0, xt0, lane);
    __syncthreads();
  }
}
template <int TM, int TN> __device__ __forceinline__ void acc_zero(f32x16 (&acc)[TM][TN]) {
#pragma unroll
  for (int a = 0; a < TM; ++a)
#pragma unroll
    for (int b = 0; b < TN; ++b)
#pragma unroll
      for (int r = 0; r < 16; ++r) acc[a][b][r] = 0.f;
}

constexpr int LDS_INV64 = 150 * 1024, LDS_INV128 = LDS_INV64 + 128, LDS_XB = LDS_INV128 + 256, LDS_BYTES = 152 * 1024;

__device__ __forceinline__ void cvt_items(const float* src, bf16_t* dst, size_t n8, int gtid, int gthreads) {
  for (size_t i = gtid; i < n8; i += gthreads) {
    const f32x4 a = *(const f32x4*)(src + i * 8), b = *(const f32x4*)(src + i * 8 + 4);
    u32x4 o; o.x = pk2(a.x, a.y); o.y = pk2(a.z, a.w); o.z = pk2(b.x, b.y); o.w = pk2(b.z, b.w);
    *(u32x4*)(dst + i * 8) = o;
  }
}
__device__ __forceinline__ void phase0a(const P& p, lptr lds, int vcu, int G) {
  const int tid = threadIdx.x, wid = tid >> 6, lane = tid & 63;
  if (vcu < 96) {
    const int j = vcu * 64 + lane;
    float a0 = 0.f, a1 = 0.f, a2 = 0.f, a3 = 0.f;
    for (int k = wid * 128; k < wid * 128 + 128; ++k) {
      const float w = p.w_ada[(size_t)k * 6144 + j];
      a0 += silu(p.c[k]) * w; a1 += silu(p.c[D + k]) * w; a2 += silu(p.c[2 * D + k]) * w; a3 += silu(p.c[3 * D + k]) * w;
    }
    LAS float* part = (LAS float*)lds;
    part[(wid * 4 + 0) * 64 + lane] = a0; part[(wid * 4 + 1) * 64 + lane] = a1; part[(wid * 4 + 2) * 64 + lane] = a2; part[(wid * 4 + 3) * 64 + lane] = a3;
    __syncthreads();
    if (wid < 4) { float s = p.b_ada[j];
#pragma unroll
      for (int w = 0; w < 8; ++w) s += part[(w * 4 + wid) * 64 + lane];
      p.mod[wid * 6144 + j] = s; }
    __syncthreads();
  }
  const int gtid = vcu * 512 + tid, gth = G * 512;
  cvt_items(p.w_in, p.winb, (size_t)D * INW / 8, gtid, gth);
  cvt_items(p.w_out, p.woutb, (size_t)D * D / 8, gtid, gth);
  cvt_items(p.w_router, p.wrb, (size_t)D * NE / 8, gtid, gth);
  cvt_items(p.wg_s, p.wgsb, (size_t)D * 256 / 8, gtid, gth);
  cvt_items(p.wu_s, p.wusb, (size_t)D * 256 / 8, gtid, gth);
  cvt_items(p.wd_s, p.wdsb, (size_t)256 * D / 8, gtid, gth);
  cvt_items(p.cw1k, p.cw1kb, (size_t)2048 * 128 / 8, gtid, gth);
  cvt_items(p.cw1v, p.cw1vb, (size_t)2048 * 128 / 8, gtid, gth);
  cvt_items(p.cw2k, p.cw2kb, (size_t)128 * 64 / 8, gtid, gth);
  cvt_items(p.cw2v, p.cw2vb, (size_t)128 * 64 / 8, gtid, gth);
}

__device__ __forceinline__ void phase0b(const P& p, lptr lds, int vcu, int G) {
  const int tid = threadIdx.x, wid = tid >> 6, lane = tid & 63;
  LAS float* wg = (LAS float*)lds;
  for (int i = tid; i < D * 24; i += 512) wg[i] = p.w_in[(size_t)(i / 24) * INW + C_GN + (i % 24)];
  __syncthreads();
  for (int row = vcu * 8 + wid; row < T; row += G * 8) {
    const int b = row / SEQ;
    f32x4 v[4]; float s = 0.f;
#pragma unroll
    for (int j = 0; j < 4; ++j) { v[j] = *(const f32x4*)(p.x + (size_t)row * D + j * 256 + lane * 4); s += v[j].x * v[j].x + v[j].y * v[j].y + v[j].z * v[j].z + v[j].w * v[j].w; }
    s = wave_sum(s);
    const float r = rsqrtf(s * (1.f / D) + EPS);
    f32x4 y[4];
#pragma unroll
    for (int j = 0; j < 4; ++j) {
      const int k = j * 256 + lane * 4;
      const f32x4 g = *(const f32x4*)(p.g_mix + k), sc = *(const f32x4*)(p.mod + b * 6144 + 1024 + k), sh = *(const f32x4*)(p.mod + b * 6144 + k);
      y[j].x = v[j].x * r * g.x * (1.f + sc.x) + sh.x; y[j].y = v[j].y * r * g.y * (1.f + sc.y) + sh.y;
      y[j].z = v[j].z * r * g.z * (1.f + sc.z) + sh.z; y[j].w = v[j].w * r * g.w * (1.f + sc.w) + sh.w;
      u32x2 o; o.x = pk2(y[j].x, y[j].y); o.y = pk2(y[j].z, y[j].w);
      *(u32x2*)(p.hb + (size_t)row * D + k) = o;
    }
#pragma unroll
    for (int half = 0; half < 2; ++half) {
      float ga[12];
#pragma unroll
      for (int q = 0; q < 12; ++q) ga[q] = 0.f;
#pragma unroll
      for (int j = 0; j < 4; ++j) {
        const float yy[4] = {y[j].x, y[j].y, y[j].z, y[j].w};
#pragma unroll
        for (int e = 0; e < 4; ++e) {
          const LAS f32x4* wr = (const LAS f32x4*)(wg + (j * 256 + lane * 4 + e) * 24 + half * 12);
#pragma unroll
          for (int q4 = 0; q4 < 3; ++q4) { const f32x4 w = wr[q4]; ga[q4 * 4] += yy[e] * w.x; ga[q4 * 4 + 1] += yy[e] * w.y; ga[q4 * 4 + 2] += yy[e] * w.z; ga[q4 * 4 + 3] += yy[e] * w.w; }
          __builtin_amdgcn_sched_barrier(0);
        }
      }
#pragma unroll
      for (int q = 0; q < 12; ++q) { const float t = wave_sum(ga[q]); if (lane == q) p.gates[(size_t)row * 24 + half * 12 + q] = sigm(t); __builtin_amdgcn_sched_barrier(0); }
    }
  }
  __syncthreads();
}

#define ROPE_PAIR(X1, X2, posf, invrev, sc) do { float pf_ = (posf); asm volatile("" : "+v"(pf_)); const float fr_ = __builtin_amdgcn_fractf(pf_ * (invrev)); \
    const float sn_ = __builtin_amdgcn_sinf(fr_), cs_ = __builtin_amdgcn_cosf(fr_); const float a_ = (X1), b_ = (X2); \
    float o1_ = (a_ * cs_ - b_ * sn_) * (sc), o2_ = (a_ * sn_ + b_ * cs_) * (sc); asm volatile("" : "+v"(o1_), "+v"(o2_)); (X1) = o1_; (X2) = o2_; } while (0)
__device__ __forceinline__ void phase1(const P& p, lptr lds, int vcu, int G) {
  const int tid = threadIdx.x, wid = __builtin_amdgcn_readfirstlane(tid >> 6), lane = tid & 63, wn = wid >> 2, wt = wid & 3, h = lane >> 5;
  constexpr int WRS = 256 * 2 + 64;
  lptr wimg = lds, ximg = lds + 32 * WRS;
  const LAS float* inv64 = (const LAS float*)(lds + LDS_INV64);
  const LAS float* inv128 = (const LAS float*)(lds + LDS_INV128);
  for (int u = vcu; u < 13 * 64; u += G) {
    const int j = u % 13, mt = u / 13, t0 = mt * 256;
    const int wcol = j < 5 ? j * 256 : C_QR + (j - 5) * 256;
    const bf16_t* wsrc = p.winb + wcol;
    const bf16_t* rowp[2] = {p.hb + (size_t)(t0 + (tid >> 2)) * D, p.hb + (size_t)(t0 + 128 + (tid >> 2)) * D};
    f32x16 acc[4][2];
#pragma unroll
    for (int a = 0; a < 4; ++a)
#pragma unroll
      for (int b = 0; b < 2; ++b)
#pragma unroll
        for (int r = 0; r < 16; ++r) acc[a][b][r] = 0.f;
    WRegB16<256> wr; XRegB16<256> xr;
    wload_b16<256>(wr, wsrc, INW, tid); xload_b16<256>(xr, rowp, 0, tid);
    for (int k0 = 0; k0 < D; k0 += 32) {
      wstore_b16<256>(wr, wimg, WRS, tid); xstore_b16<256>(xr, ximg, tid);
      __syncthreads();
      if (k0 + 32 < D) { wload_b16<256>(wr, wsrc + (size_t)(k0 + 32) * INW, INW, tid); xload_b16<256>(xr, rowp, k0 + 32, tid); }
      mma_step<4, 2, true, false>(acc, wimg, WRS, wn * 128, ximg, 0, wt * 64, lane);
      __syncthreads();
    }
    const int kind = (j < 2) ? 0 : (j == 2) ? 3 : (j < 5) ? (wn == 0 ? 1 : 3) : (j < 7) ? 2 : (j < 9) ? 4 : (j < 11) ? 3 : 5;
#pragma unroll
    for (int tn = 0; tn < 2; ++tn) {
      const int tok = t0 + wt * 64 + tn * 32 + (lane & 31);
      const float posf = (float)p.pos[tok];
      if (kind == 0 || kind == 1) {
        const float sc = kind == 0 ? 0.125f : 1.f;
#pragma unroll
        for (int r = 0; r < 16; ++r) { const float iv = inv64[(r & 3) + 8 * (r >> 2) + 4 * h];
          ROPE_PAIR(acc[0][tn][r], acc[1][tn][r], posf, iv, sc); ROPE_PAIR(acc[2][tn][r], acc[3][tn][r], posf, iv, sc); if ((r & 3) == 3) __builtin_amdgcn_sched_barrier(0); }
      } else if (kind == 2 || kind == 4) {
        const float sc = kind == 4 ? 0.08838834764831845f : 1.f;
#pragma unroll
        for (int r = 0; r < 16; ++r) { const int i = (r & 3) + 8 * (r >> 2) + 4 * h;
          ROPE_PAIR(acc[0][tn][r], acc[2][tn][r], posf, inv128[i], sc); ROPE_PAIR(acc[1][tn][r], acc[3][tn][r], posf, inv128[32 + i], sc); if ((r & 3) == 3) __builtin_amdgcn_sched_barrier(0); }
      } else if (kind == 5) {
#pragma unroll
        for (int tm = 0; tm < 4; ++tm)
#pragma unroll
          for (int r = 0; r < 16; ++r) { float v = acc[tm][tn][r]; asm volatile("" : "+v"(v)); float o = v * __builtin_amdgcn_rcpf(1.f + __builtin_amdgcn_exp2f(-1.4426950408889634f * v)); asm volatile("" : "+v"(o)); acc[tm][tn][r] = o; }
      }
      bf16_t* orow = p.projb + (size_t)tok * PJW + j * 256 + wn * 128 + 4 * h;
#pragma unroll
      for (int tm = 0; tm < 4; ++tm)
#pragma unroll
        for (int a = 0; a < 4; ++a) { u32x2 o; o.x = pk2(acc[tm][tn][4 * a], acc[tm][tn][4 * a + 1]); o.y = pk2(acc[tm][tn][4 * a + 2], acc[tm][tn][4 * a + 3]);
          *(u32x2*)(orow + tm * 32 + a * 8) = o; __builtin_amdgcn_sched_barrier(0); }
    }
  }
}

__device__ __forceinline__ void phase5(const P& p, lptr lds, int vcu, int G) {
  const int tid = threadIdx.x, wid = __builtin_amdgcn_readfirstlane(tid >> 6), lane = tid & 63, h = lane >> 5, l31 = lane & 31;
  constexpr int WRS1 = 1024 * 2 + 64;
  lptr wimg = lds, ximg = lds + 32 * WRS1;
  lptr lgb = lds + 72 * 1024;
  LAS float* part = (LAS float*)(lds + 138 * 1024);
  LAS float* rstd = part + 512;
  for (int u = vcu; u < T / 64; u += G) {
    const int t0 = u * 64, b = t0 / SEQ;
    f32x16 acc[4][2];
    acc_zero<4, 2>(acc);
    { WLb16<1024> wl; wl.src = p.woutb; wl.ld = D;
      XLrows<64> xl; xl.rowp[0] = p.mixb + (size_t)(t0 + ((tid >> 2) & 63)) * D; xl.ximg = ximg;
      gemm_loop<4, 2>(acc, D, wl, xl, wimg, WRS1, wid * 128, 0, tid, lane); }
    int nb = wid * 128 + 4 * h, tb = t0 + l31;
    asm volatile("" : "+v"(nb), "+v"(tb));
#pragma unroll
    for (int tn = 0; tn < 2; ++tn) {
      const int tok = tb + tn * 32; float ss = 0.f;
#pragma unroll
      for (int tm = 0; tm < 4; ++tm)
#pragma unroll
        for (int a = 0; a < 4; ++a) {
          const int n = nb + tm * 32 + a * 8;
          const f32x4 xv = *(const f32x4*)(p.x + (size_t)tok * D + n), gt = *(const f32x4*)(p.mod + b * 6144 + 2048 + n);
          f32x4 v; v.x = xv.x + gt.x * acc[tm][tn][4 * a]; v.y = xv.y + gt.y * acc[tm][tn][4 * a + 1]; v.z = xv.z + gt.z * acc[tm][tn][4 * a + 2]; v.w = xv.w + gt.w * acc[tm][tn][4 * a + 3];
          acc[tm][tn][4 * a] = v.x; acc[tm][tn][4 * a + 1] = v.y; acc[tm][tn][4 * a + 2] = v.z; acc[tm][tn][4 * a + 3] = v.w;
          *(f32x4*)(p.x1 + (size_t)tok * D + n) = v;
          ss += v.x * v.x + v.y * v.y + v.z * v.z + v.w * v.w;
          if (a == 3) __builtin_amdgcn_sched_barrier(0);
        }
      ss += __shfl_xor(ss, 32);
      if (h == 0) part[wid * 64 + tn * 32 + l31] = ss;
    }
    __syncthreads();
    if (tid < 64) { float q = 0.f;
#pragma unroll
      for (int w = 0; w < 8; ++w) q += part[w * 64 + tid];
      rstd[tid] = rsqrtf(q * (1.f / D) + EPS); }
    __syncthreads();
    asm volatile("" : "+v"(nb), "+v"(tb));
#pragma unroll
    for (int tn = 0; tn < 2; ++tn) {
      const int tok = tb + tn * 32; const float r = rstd[tn * 32 + l31];
#pragma unroll
      for (int tm = 0; tm < 4; ++tm)
#pragma unroll
        for (int a = 0; a < 4; ++a) {
          const int n = nb + tm * 32 + a * 8;
          const f32x4 g = *(const f32x4*)(p.g_ffn + n), sc = *(const f32x4*)(p.mod + b * 6144 + 4096 + n), sh = *(const f32x4*)(p.mod + b * 6144 + 3072 + n);
          u32x2 o;
          o.x = pk2(acc[tm][tn][4 * a] * r * g.x * (1.f + sc.x) + sh.x, acc[tm][tn][4 * a + 1] * r * g.y * (1.f + sc.y) + sh.y);
          o.y = pk2(acc[tm][tn][4 * a + 2] * r * g.z * (1.f + sc.z) + sh.z, acc[tm][tn][4 * a + 3] * r * g.w * (1.f + sc.w) + sh.w);
          *(u32x2*)(p.h2b + (size_t)tok * D + n) = o;
          if (a == 3) __builtin_amdgcn_sched_barrier(0);
        }
    }
    asm volatile("s_waitcnt vmcnt(0)" ::: "memory");
    __syncthreads();
    { f32x16 a2[1][2]; acc_zero<1, 2>(a2);
      WLb16<256> wl; wl.src = p.wrb; wl.ld = NE;
      XLrows<64> xl; xl.rowp[0] = p.h2b + (size_t)(t0 + ((tid >> 2) & 63)) * D; xl.ximg = ximg;
      gemm_loop<1, 2>(a2, D, wl, xl, wimg, 256 * 2 + 64, wid * 32, 0, tid, lane);
      int lo = ((l31 * 256 + wid * 32 + 4 * h) * 4);
      asm volatile("" : "+v"(lo));
#pragma unroll
      for (int tn = 0; tn < 2; ++tn)
#pragma unroll
        for (int a = 0; a < 4; ++a) { f32x4 v = {a2[0][tn][4 * a], a2[0][tn][4 * a + 1], a2[0][tn][4 * a + 2], a2[0][tn][4 * a + 3]};
          *(LAS f32x4*)(lgb + lo + (tn * 32 * 256 + a * 8) * 4) = v; } }
    __syncthreads();
    { int lane_ = lane; asm volatile("" : "+v"(lane_));
      const int lane = lane_;
      const f32x4 rb = *(const f32x4*)(p.rbias + lane * 4);
      for (int i = 0; i < 8; ++i) {
        const int tl = wid * 8 + i, tok = t0 + tl;
        const f32x4 lv = *(const LAS f32x4*)(lgb + (tl * 256 + lane * 4) * 4);
        const float s0 = sigm(lv.x), s1 = sigm(lv.y), s2 = sigm(lv.z), s3 = sigm(lv.w);
        float c0 = s0 + rb.x, c1 = s1 + rb.y, c2 = s2 + rb.z, c3 = s3 + rb.w;
        float m1, m2;
        { const float h1 = fmaxf(c0, c1), l1 = fminf(c0, c1), h2 = fmaxf(c2, c3), l2 = fminf(c2, c3); m1 = fmaxf(h1, h2); m2 = fmaxf(fminf(h1, h2), fmaxf(l1, l2)); }
#pragma unroll
        for (int o = 1; o < 8; o <<= 1) { const float o1 = __shfl_xor(m1, o), o2 = __shfl_xor(m2, o); const float n1 = fmaxf(m1, o1), n2 = fmaxf(fminf(m1, o1), fmaxf(m2, o2)); m1 = n1; m2 = n2; }
        const float gs = m1 + m2; const int myg = lane >> 3; int rank = 0;
#pragma unroll
        for (int g2 = 0; g2 < 8; ++g2) { const float og = __shfl(gs, g2 * 8); rank += (og > gs || (og == gs && g2 < myg)) ? 1 : 0; }
        if (rank >= 4) { c0 = -INFINITY; c1 = -INFINITY; c2 = -INFINITY; c3 = -INFINITY; }
        int my_e = 0; float my_s = 0.f;
#pragma unroll
        for (int k = 0; k < 8; ++k) {
          float bv = c0; int li = lane * 4;
          if (c1 > bv) { bv = c1; li = lane * 4 + 1; }
          if (c2 > bv) { bv = c2; li = lane * 4 + 2; }
          if (c3 > bv) { bv = c3; li = lane * 4 + 3; }
#pragma unroll
          for (int o = 1; o < 64; o <<= 1) { const float ov = __shfl_xor(bv, o); const int oi = __shfl_xor(li, o); if (ov > bv || (ov == bv && oi < li)) { bv = ov; li = oi; } }
          const int j = li & 3; const float sj = j == 0 ? s0 : j == 1 ? s1 : j == 2 ? s2 : s3;
          const float sv = __shfl(sj, li >> 2);
          if (lane * 4 == li) c0 = -INFINITY;
          if (lane * 4 + 1 == li) c1 = -INFINITY;
          if (lane * 4 + 2 == li) c2 = -INFINITY;
          if (lane * 4 + 3 == li) c3 = -INFINITY;
          if (lane == k) { my_e = li; my_s = sv; }
        }
        const float wsum = wave_sum(lane < 8 ? my_s : 0.f);
        if (lane < 8) { const int pos = atomicAdd(&p.cnt[my_e], 1); p.list[my_e * ECAP + pos] = tok * 8 + lane; p.wts[tok * 8 + lane] = my_s / wsum * 2.5f; }
      } }
    __syncthreads();
    { f32x16 a3[2][2]; acc_zero<2, 2>(a3);
      WLgu wl; wl.g = p.wgsb; wl.u = p.wusb;
      XLrows<64> xl; xl.rowp[0] = p.h2b + (size_t)(t0 + ((tid >> 2) & 63)) * D; xl.ximg = ximg;
      gemm_loop<2, 2>(a3, D, wl, xl, wimg, 512 * 2 + 64, wid * 64, 0, tid, lane);
      int l31_ = l31, h_ = h; asm volatile("" : "+v"(l31_), "+v"(h_));
#pragma unroll
      for (int tn = 0; tn < 2; ++tn)
#pragma unroll
        for (int a = 0; a < 4; ++a) {
          float o[4];
#pragma unroll
          for (int e = 0; e < 4; ++e) { const float gv = a3[0][tn][4 * a + e], uv = a3[1][tn][4 * a + e]; o[e] = gv * __builtin_amdgcn_rcpf(1.f + __builtin_amdgcn_exp2f(-1.4426950408889634f * gv)) * uv; }
          const int col = wid * 32 + a * 8 + 4 * h_;
          u32x2 w2; w2.x = pk2(o[0], o[1]); w2.y = pk2(o[2], o[3]);
          *(LAS u32x2*)(lgb + (col >> 5) * 4096 + kmin_off(tn * 32 + l31_, (col & 31) >> 3) + (col & 7) * 2) = w2;
        } }
    __syncthreads();
    acc_zero<4, 2>(acc);
    { WLb16<1024> wl; wl.src = p.wdsb; wl.ld = D;
      XLres xl; xl.base = lgb; xl.bytes = 4096;
      gemm_loop<4, 2>(acc, 256, wl, xl, wimg, WRS1, wid * 128, 0, tid, lane); }
    asm volatile("" : "+v"(nb), "+v"(tb));
#pragma unroll
    for (int tn = 0; tn < 2; ++tn) {
      const int tok = tb + tn * 32;
#pragma unroll
      for (int tm = 0; tm < 4; ++tm)
#pragma unroll
        for (int a = 0; a < 4; ++a) {
          const int n = nb + tm * 32 + a * 8;
          f32x4 v = *(const f32x4*)(p.x1 + (size_t)tok * D + n); const f32x4 gt = *(const f32x4*)(p.mod + b * 6144 + 5120 + n);
          v.x += gt.x * acc[tm][tn][4 * a]; v.y += gt.y * acc[tm][tn][4 * a + 1]; v.z += gt.z * acc[tm][tn][4 * a + 2]; v.w += gt.w * acc[tm][tn][4 * a + 3];
          *(f32x4*)(p.x1 + (size_t)tok * D + n) = v;
          if (a == 3) __builtin_amdgcn_sched_barrier(0);
        }
    }
    __syncthreads();
  }
}

__device__ __forceinline__ void phase6(const P& p, lptr lds, int vcu, int G) {
  const int tid = threadIdx.x, wid = __builtin_amdgcn_readfirstlane(tid >> 6), lane = tid & 63, h = lane >> 5, l31 = lane & 31, wn = wid >> 1, wt = wid & 1;
  constexpr int WRS = 512 * 2 + 64;
  lptr wimg = lds, ximg = lds + 32 * WRS;
  lptr actb = lds + 44 * 1024;
  LAS int* pre = (LAS int*)(lds + 110 * 1024);
  LAS int* sidl = pre + 320;
  if (tid < NE) pre[tid + 1] = (p.cnt[tid] + 127) >> 7;
  if (tid == 0) pre[0] = 0;
  __syncthreads();
  if (tid == 0) { int a = 0; for (int e = 1; e <= NE; ++e) { a += pre[e]; pre[e] = a; } }
  __syncthreads();
  const int nunits = pre[NE];
  for (int u = vcu; u < nunits; u += G) {
    int lo = 0, hi = NE;
    while (hi - lo > 1) { const int mid = (lo + hi) >> 1; if (pre[mid] <= u) lo = mid; else hi = mid; }
    const int e = lo, off = (u - pre[e]) * 128, cnt = p.cnt[e];
    if (tid < 128) sidl[tid] = off + tid < cnt ? p.list[e * ECAP + off + tid] : -1;
    __syncthreads();
    f32x16 acc[4][2];
    acc_zero<4, 2>(acc);
    { WLf32gu wl; wl.g = p.wg_e + (size_t)e * D * 256; wl.u = p.wu_e + (size_t)e * D * 256;
      XLrows<128> xl; { const int sd = sidl[(tid >> 2) & 127]; xl.rowp[0] = p.h2b + (size_t)(sd < 0 ? 0 : sd >> 3) * D; } xl.ximg = ximg;
      gemm_loop<4, 2>(acc, D, wl, xl, wimg, WRS, wn * 128, wt * 64, tid, lane); }
    { int l31_ = l31, h_ = h; asm volatile("" : "+v"(l31_), "+v"(h_));
#pragma unroll
      for (int tn = 0; tn < 2; ++tn)
#pragma unroll
        for (int tm = 0; tm < 2; ++tm)
#pragma unroll
          for (int a = 0; a < 4; ++a) {
            float o[4];
#pragma unroll
            for (int q = 0; q < 4; ++q) { const float gv = acc[tm][tn][4 * a + q], uv = acc[tm + 2][tn][4 * a + q]; o[q] = gv * __builtin_amdgcn_rcpf(1.f + __builtin_amdgcn_exp2f(-1.4426950408889634f * gv)) * uv; }
            const int col = wn * 64 + tm * 32 + a * 8 + 4 * h_;
            u32x2 w2; w2.x = pk2(o[0], o[1]); w2.y = pk2(o[2], o[3]);
            *(LAS u32x2*)(actb + (col >> 5) * 8192 + kmin_off(wt * 64 + tn * 32 + l31_, (col & 31) >> 3) + (col & 7) * 2) = w2;
          } }
    __syncthreads();
#pragma unroll 1
    for (int pass = 0; pass < 2; ++pass) {
      acc_zero<4, 2>(acc);
      { WLf32 wl; wl.src = p.wd_e + (size_t)e * 256 * D + pass * 512; wl.ld = D;
        XLres xl; xl.base = actb; xl.bytes = 8192;
        gemm_loop<4, 2>(acc, 256, wl, xl, wimg, WRS, wn * 128, wt * 64, tid, lane); }
      int nb = pass * 512 + wn * 128 + 4 * h, sl = wt * 64 + l31;
      asm volatile("" : "+v"(nb), "+v"(sl));
#pragma unroll
      for (int tn = 0; tn < 2; ++tn) {
        const int sd = sidl[sl + tn * 32];
        if (sd >= 0) {
          const float wgt = p.wts[sd];
          bf16_t* orow = p.slab + (size_t)sd * D + nb;
#pragma unroll
          for (int tm = 0; tm < 4; ++tm)
#pragma unroll
            for (int a = 0; a < 4; ++a) { u32x2 o; o.x = pk2(acc[tm][tn][4 * a] * wgt, acc[tm][tn][4 * a + 1] * wgt); o.y = pk2(acc[tm][tn][4 * a + 2] * wgt, acc[tm][tn][4 * a + 3] * wgt);
              *(u32x2*)(orow + tm * 32 + a * 8) = o; }
        }
      }
    }
    __syncthreads();
  }
}

__device__ __forceinline__ void phase7(const P& p, lptr lds, int vcu, int G) {
  const int tid = threadIdx.x, wid = tid >> 6, lane = tid & 63;
  for (int tok = vcu * 8 + wid; tok < T; tok += G * 8) {
    const int b = tok / SEQ;
    float v[16]; float ss = 0.f;
#pragma unroll
    for (int j = 0; j < 2; ++j) {
      const int n = j * 512 + lane * 8;
      float a[8];
#pragma unroll
      for (int q = 0; q < 8; ++q) a[q] = 0.f;
#pragma unroll
      for (int k = 0; k < 8; ++k) { const u32x4 w = *(const u32x4*)(p.slab + ((size_t)tok * 8 + k) * D + n);
        a[0] += bflo(w.x); a[1] += bfhi(w.x); a[2] += bflo(w.y); a[3] += bfhi(w.y); a[4] += bflo(w.z); a[5] += bfhi(w.z); a[6] += bflo(w.w); a[7] += bfhi(w.w); }
#pragma unroll
      for (int q4 = 0; q4 < 2; ++q4) {
        const f32x4 xv = *(const f32x4*)(p.x1 + (size_t)tok * D + n + q4 * 4), gt = *(const f32x4*)(p.mod + b * 6144 + 5120 + n + q4 * 4);
        const float y0 = xv.x + gt.x * a[q4 * 4], y1 = xv.y + gt.y * a[q4 * 4 + 1], y2 = xv.z + gt.z * a[q4 * 4 + 2], y3 = xv.w + gt.w * a[q4 * 4 + 3];
        v[j * 8 + q4 * 4] = y0; v[j * 8 + q4 * 4 + 1] = y1; v[j * 8 + q4 * 4 + 2] = y2; v[j * 8 + q4 * 4 + 3] = y3;
        ss += y0 * y0 + y1 * y1 + y2 * y2 + y3 * y3;
      }
    }
    ss = wave_sum(ss);
    const float r = rsqrtf(ss * (1.f / D) + EPS);
#pragma unroll
    for (int j = 0; j < 2; ++j)
#pragma unroll
      for (int q4 = 0; q4 < 2; ++q4) {
        const int n = j * 512 + lane * 8 + q4 * 4;
        const f32x4 g = *(const f32x4*)(p.g_final + n);
        f32x4 o; o.x = v[j * 8 + q4 * 4] * r * g.x; o.y = v[j * 8 + q4 * 4 + 1] * r * g.y; o.z = v[j * 8 + q4 * 4 + 2] * r * g.z; o.w = v[j * 8 + q4 * 4 + 3] * r * g.w;
        *(f32x4*)(p.out + (size_t)tok * D + n) = o;
      }
  }
}

template <class F>
__device__ __forceinline__ void d_gemm(const F& f, int bx, int by, char* smem, int tid) {
  float (*As)[68] = (float (*)[68])smem;
  float (*Bs)[68] = (float (*)[68])(smem + 16 * 68 * 4);
  int* rid = (int*)(smem + 2 * 16 * 68 * 4);
  const int mt = by, n0 = bx * 64;
  typename F::Tile ti;
  f.tile(mt, ti);
  if (tid < 64) rid[tid] = f.row(ti, tid);
  __syncthreads();
  float acc[4][4];
#pragma unroll
  for (int i = 0; i < 4; ++i)
#pragma unroll
    for (int j = 0; j < 4; ++j) acc[i][j] = 0.f;
  const int ty = tid >> 4, tx = tid & 15;
  const int ar = tid >> 2, ak = (tid & 3) * 4, bk = tid >> 4, bn = (tid & 15) * 4;
  const int arid = rid[ar];
  for (int k0 = 0; k0 < f.K; k0 += 16) {
#pragma unroll
    for (int i = 0; i < 4; ++i) As[ak + i][ar] = arid >= 0 ? f.a(ti, arid, k0 + ak + i) : 0.f;
#pragma unroll
    for (int j = 0; j < 4; ++j) { const int n = n0 + bn + j; Bs[bk][bn + j] = n < f.N ? f.b(ti, k0 + bk, n) : 0.f; }
    __syncthreads();
#pragma unroll
    for (int kk = 0; kk < 16; ++kk) {
      const float4 a = *(const float4*)&As[kk][ty * 4];
      const float4 b = *(const float4*)&Bs[kk][tx * 4];
      const float av[4] = {a.x, a.y, a.z, a.w}, bv[4] = {b.x, b.y, b.z, b.w};
#pragma unroll
      for (int i = 0; i < 4; ++i)
#pragma unroll
        for (int j = 0; j < 4; ++j) acc[i][j] += av[i] * bv[j];
    }
    __syncthreads();
  }
#pragma unroll
  for (int i = 0; i < 4; ++i) {
    const int r = rid[ty * 4 + i];
    if (r < 0) continue;
#pragma unroll
    for (int j = 0; j < 4; ++j) { const int n = n0 + tx * 4 + j; if (n < f.N) f.epi(ti, r, n, acc[i][j]); }
  }
}

struct DenseTile { int m0; };
struct FCmp1 {
  typedef DenseTile Tile; P p; int N, K; int col, pad; const float *pe, *w1; float* hid;
  __device__ bool tile(int mt, Tile& t) const { t.m0 = mt * 64; return true; }
  __device__ int row(const Tile& t, int i) const { const int r = t.m0 + i; return r < NCR ? r : -1; }
  __device__ float a(const Tile&, int r, int k) const {
    const int b = r / (2 * NC), g = (r / NC) & 1, c = r % NC, l = k >> 6, d = k & 63;
    return bf2f(p.projb[(size_t)(b * SEQ + 16 * c + l) * PJW + col + g * 64 + d]) + pe[k];
  }
  __device__ float b(const Tile&, int k, int n) const { return w1[k * 128 + n]; }
  __device__ void epi(const Tile&, int r, int n, float v) const { hid[r * 128 + n] = gelu_tanh(v); }
};
struct FCmp2 {
  typedef DenseTile Tile; P p; int N, K; const float *hid, *w2; float* outp;
  __device__ bool tile(int mt, Tile& t) const { t.m0 = mt * 64; return true; }
  __device__ int row(const Tile& t, int i) const { const int r = t.m0 + i; return r < NCR ? r : -1; }
  __device__ float a(const Tile&, int r, int k) const { return hid[r * 128 + k]; }
  __device__ float b(const Tile&, int k, int n) const { return w2[k * 64 + n]; }
  __device__ void epi(const Tile&, int r, int n, float v) const { outp[r * 64 + n] = v; }
};
__device__ __forceinline__ float ret_logg(int h) { return logf(1.f - exp2f(-5.f - (float)h)); }
struct RetTile { int chunk, i0, b, h, s0; };
__device__ __forceinline__ void ret_tile(int mt, RetTile& t) { t.chunk = mt >> 1; t.i0 = (mt & 1) * 64; const int bh = t.chunk >> 5; t.b = bh >> 2; t.h = bh & 3; t.s0 = (t.chunk & 31) * 128; }
struct FRet1 {
  typedef RetTile Tile; P p; int N, K;
  __device__ bool tile(int mt, Tile& t) const { ret_tile(mt, t); return true; }
  __device__ int row(const Tile& t, int i) const { return t.i0 + i; }
  __device__ float a(const Tile& t, int r, int k) const { return bf2f(p.projb[(size_t)(t.b * SEQ + t.s0 + r) * PJW + J_QR + t.h * 128 + k]); }
  __device__ float b(const Tile& t, int k, int n) const { return bf2f(p.projb[(size_t)(t.b * SEQ + t.s0 + n) * PJW + J_KR + t.h * 128 + k]); }
  __device__ void epi(const Tile& t, int r, int n, float v) const { p.Sc[((size_t)t.chunk * 128 + r) * 128 + n] = r >= n ? v * expf(ret_logg(t.h) * (float)(r - n)) : 0.f; }
};
struct FRet2 {
  typedef RetTile Tile; P p; int N, K;
  __device__ bool tile(int mt, Tile& t) const { ret_tile(mt, t); return true; }
  __device__ int row(const Tile& t, int i) const { return t.i0 + i; }
  __device__ float a(const Tile& t, int r, int k) const { return bf2f(p.projb[(size_t)(t.b * SEQ + t.s0 + k) * PJW + J_KR + t.h * 128 + r]) * expf(ret_logg(t.h) * (float)(127 - k)); }
  __device__ float b(const Tile& t, int k, int n) const { return bf2f(p.projb[(size_t)(t.b * SEQ + t.s0 + k) * PJW + J_VR + t.h * 128 + n]); }
  __device__ void epi(const Tile& t, int r, int n, float v) const { p.kv[((size_t)t.chunk * 128 + r) * 128 + n] = v; }
};
struct FRet3 {
  typedef RetTile Tile; P p; int N, K;
  __device__ bool tile(int mt, Tile& t) const { ret_tile(mt, t); return true; }
  __device__ int row(const Tile& t, int i) const { return t.i0 + i; }
  __device__ float a(const Tile& t, int r, int k) const {
    if (k < 128) return p.Sc[((size_t)t.chunk * 128 + r) * 128 + k];
    return bf2f(p.projb[(size_t)(t.b * SEQ + t.s0 + r) * PJW + J_QR + t.h * 128 + (k - 128)]) * expf(ret_logg(t.h) * (float)(r + 1));
  }
  __device__ float b(const Tile& t, int k, int n) const {
    if (k < 128) return bf2f(p.projb[(size_t)(t.b * SEQ + t.s0 + k) * PJW + J_VR + t.h * 128 + n]);
    return p.kv[((size_t)t.chunk * 128 + (k - 128)) * 128 + n];
  }
  __device__ void epi(const Tile& t, int r, int n, float v) const { p.retout[(size_t)(t.b * SEQ + t.s0 + r) * 512 + t.h * 128 + n] = v; }
};
__device__ __forceinline__ void d_rope_cmp(const P& p, int bx, int tid) {
  const int id = bx * 256 + tid;
  if (id >= NCR * 32) return;
  const int r = id >> 5, i = id & 31, b = r / (2 * NC), c = r % NC;
  const float inv = powf(10000.f, -(float)(2 * i) / 64.f);
  const float ang = (float)p.pos[b * SEQ + 16 * c + 31] * inv;
  float sn, cs; sincosf(ang, &sn, &cs);
  float* q = p.kcmp + r * 64;
  const float x1 = q[i], x2 = q[i + 32];
  q[i] = x1 * cs - x2 * sn; q[i + 32] = x1 * sn + x2 * cs;
}

__device__ __forceinline__ void d_nsa(const P& p, int bx, int by, char* smem, int tid) {
  const int bt = bx, g = by, b = bt / SEQ, t = bt % SEQ;
  const int r = tid >> 6, lane = tid & 63, h = g * 4 + r;
  float (*qs)[64] = (float (*)[64])smem;
  float (*pc)[256] = (float (*)[256])(smem + 1024);
  float (*ps)[512] = (float (*)[512])(smem + 1024 + 4096);
  float* impv = (float*)(smem + 1024 + 4096 + 8192);
  int* sel = (int*)(smem + 1024 + 4096 + 8192 + 256);
  qs[r][lane] = bf2f(p.projb[(size_t)bt * PJW + J_QN + h * 64 + lane]);
  __syncthreads();
  float sc[4], mx = -1e30f;
#pragma unroll
  for (int i = 0; i < 4; ++i) {
    const int c = i * 64 + lane; float s = -1e30f;
    if (c < NC && 16 * c + 31 <= t) { const float* kr = p.kcmp + ((size_t)(b * 2 + g) * NC + c) * 64; float a = 0.f; for (int d = 0; d < 64; ++d) a += qs[r][d] * kr[d]; s = a; }
    sc[i] = s; mx = fmaxf(mx, s);
  }
  mx = wave_max(mx);
  float sum = 0.f;
#pragma unroll
  for (int i = 0; i < 4; ++i) { const int c = i * 64 + lane; const bool v = c < NC && 16 * c + 31 <= t; const float e = v ? expf(sc[i] - mx) : 0.f; sc[i] = e; sum += e; }
  sum = wave_sum(sum);
  float inv = 1.f / fmaxf(sum, 1e-20f);
#pragma unroll
  for (int i = 0; i < 4; ++i) pc[r][i * 64 + lane] = sc[i] * inv;
  __syncthreads();
  float oc = 0.f;
  { const int nv = t >= 31 ? min(NC, (t - 31) / 16 + 1) : 0;
    for (int c = 0; c < nv; ++c) oc += pc[r][c] * p.vcmp[((size_t)(b * 2 + g) * NC + c) * 64 + lane]; }
  if (tid < 64) {
    const int j = tid; float im = 0.f;
    const int c0 = max(0, 4 * j - 1), c1 = min(NC - 1, 4 * j + 3);
    for (int rr = 0; rr < 4; ++rr) for (int c = c0; c <= c1; ++c) im += pc[rr][c];
    const int cur = t >> 6; const bool valid = j * 64 <= t, forced = (j == 0) || (j == cur) || (j == cur - 1);
    impv[j] = valid ? im + (forced ? 1e4f : 0.f) : -1.f;
  }
  __syncthreads();
  if (tid == 0) {
    for (int k = 0; k < 8; ++k) { int best = 0; float bv = impv[0]; for (int j = 1; j < 64; ++j) if (impv[j] > bv) { bv = impv[j]; best = j; } sel[k] = best; impv[best] = -INFINITY; }
  }
  __syncthreads();
  float ss[8]; mx = -1e30f;
#pragma unroll
  for (int i = 0; i < 8; ++i) {
    const int q = sel[i] * 64 + lane; float s = -1e30f;
    if (q <= t) { const bf16_t* kr = p.projb + (size_t)(b * SEQ + q) * PJW + J_KS + g * 64; float a = 0.f; for (int d = 0; d < 64; ++d) a += qs[r][d] * bf2f(kr[d]); s = a; }
    ss[i] = s; mx = fmaxf(mx, s);
  }
  mx = wave_max(mx); sum = 0.f;
#pragma unroll
  for (int i = 0; i < 8; ++i) { const int q = sel[i] * 64 + lane; const float e = q <= t ? expf(ss[i] - mx) : 0.f; ss[i] = e; sum += e; }
  sum = wave_sum(sum); inv = 1.f / fmaxf(sum, 1e-20f);
#pragma unroll
  for (int i = 0; i < 8; ++i) ps[r][i * 64 + lane] = ss[i] * inv;
  __syncthreads();
  float os = 0.f;
  for (int i = 0; i < 8; ++i) { const int q0 = sel[i] * 64;
    for (int l = 0; l < 64; ++l) { const int q = q0 + l; if (q <= t) os += ps[r][i * 64 + l] * bf2f(p.projb[(size_t)(b * SEQ + q) * PJW + J_VS + g * 64 + lane]); } }
  __syncthreads();
  mx = -1e30f;
#pragma unroll
  for (int i = 0; i < 8; ++i) {
    const int q = t - 511 + i * 64 + lane; float s = -1e30f;
    if (q >= 0) { const bf16_t* kr = p.projb + (size_t)(b * SEQ + q) * PJW + J_KW + g * 64; float a = 0.f; for (int d = 0; d < 64; ++d) a += qs[r][d] * bf2f(kr[d]); s = a; }
    ss[i] = s; mx = fmaxf(mx, s);
  }
  mx = wave_max(mx); sum = 0.f;
#pragma unroll
  for (int i = 0; i < 8; ++i) { const int q = t - 511 + i * 64 + lane; const float e = q >= 0 ? expf(ss[i] - mx) : 0.f; ss[i] = e; sum += e; }
  sum = wave_sum(sum); inv = 1.f / fmaxf(sum, 1e-20f);
#pragma unroll
  for (int i = 0; i < 8; ++i) ps[r][i * 64 + lane] = ss[i] * inv;
  __syncthreads();
  float ow = 0.f;
  for (int i = 0; i < 512; ++i) { const int q = t - 511 + i; if (q >= 0) ow += ps[r][i] * bf2f(p.projb[(size_t)(b * SEQ + q) * PJW + J_VW + g * 64 + lane]); }
  const float* gp = p.gates + (size_t)bt * 24 + h * 3;
  p.onsa[(size_t)bt * 512 + h * 64 + lane] = gp[0] * oc + gp[1] * os + gp[2] * ow;
}

__device__ __forceinline__ void d_mixin(const P& p, int bx, int tid) {
  const int tok = bx * 4 + (tid >> 6), lane = tid & 63;
  float v[8], s = 0.f;
#pragma unroll
  for (int i = 0; i < 8; ++i) { v[i] = p.onsa[(size_t)tok * 512 + i * 64 + lane]; s += v[i] * v[i]; }
  s = wave_sum(s);
  float r = rsqrtf(s * (1.f / 512.f) + EPS);
#pragma unroll
  for (int i = 0; i < 8; ++i) p.mixb[(size_t)tok * D + i * 64 + lane] = (bf16_t)(pk2(v[i] * r * p.g_nsa[i * 64 + lane], 0.f) & 0xffffu);
#pragma unroll
  for (int hh = 0; hh < 4; ++hh) {
    const float a = p.retout[(size_t)tok * 512 + hh * 128 + lane], b = p.retout[(size_t)tok * 512 + hh * 128 + 64 + lane];
    const float q = wave_sum(a * a + b * b);
    r = rsqrtf(q * (1.f / 128.f) + EPS);
    const bf16_t* gr = p.projb + (size_t)tok * PJW + J_GR + hh * 128;
    p.mixb[(size_t)tok * D + 512 + hh * 128 + lane] = (bf16_t)(pk2(bf2f(gr[lane]) * a * r * p.g_ret[hh * 128 + lane], 0.f) & 0xffffu);
    p.mixb[(size_t)tok * D + 512 + hh * 128 + 64 + lane] = (bf16_t)(pk2(bf2f(gr[64 + lane]) * b * r * p.g_ret[hh * 128 + 64 + lane], 0.f) & 0xffffu);
  }
}

__device__ __forceinline__ void d_ret_scan(const P& p, int bx, int tid) {
  const int id = bx * 256 + tid;
  const int bh = id >> 14, de = id & 16383, h = bh & 3;
  const float gc = expf(ret_logg(h) * 128.f);
  float st = 0.f;
  for (int n = 0; n < 32; ++n) { float* q = p.kv + ((size_t)(bh * 32 + n) * 16384 + de); const float kvn = *q; *q = st; st = st * gc + kvn; }
}

constexpr int NPHASE = 11;
#define FOR_VP(n) for (int vp = vcu; vp < ((n) + 1) / 2; vp += G)
#define VBI(n) (vp * 2 + hb < (n) ? vp * 2 + hb : (n) - 1)
#define NGEMM(FT, INIT, nx, ny) do { const FT f INIT; FOR_VP((nx) * (ny)) { const int vb = VBI((nx) * (ny)); d_gemm(f, vb % (nx), vb / (nx), smem, t256); __syncthreads(); } } while (0)
__global__ void __launch_bounds__(512) mega(P p, int lo, int hi) {
  extern __shared__ __attribute__((aligned(16))) char lds_raw[];
  lptr lds = (lptr)lds_raw;
  const int tid = threadIdx.x, G = gridDim.x, hb = tid >> 8, t256 = tid & 255;
  char* smem = lds_raw + hb * 16384;
  const int vcu = (G % 8 == 0) ? ((int)blockIdx.x % 8) * (G / 8) + (int)blockIdx.x / 8 : (int)blockIdx.x;
  if (tid < 32) ((LAS float*)(lds + LDS_INV64))[tid] = exp2f(-(float)(2 * tid) / 64.f * 13.287712379549449f) * 0.15915494309189535f;
  if (tid < 64) ((LAS float*)(lds + LDS_INV128))[tid] = exp2f(-(float)(2 * tid) / 128.f * 13.287712379549449f) * 0.15915494309189535f;
  if (tid < 4) ((LAS unsigned*)(lds + LDS_XB))[tid] = 0u;
  __syncthreads();
  XcdBarrier xb; xb.bar = p.bar; xb.x = 0; xb.st = (volatile LAS unsigned*)(lds + LDS_XB);
  if (hi - lo > 1) xb = xcd_barrier_post(p.bar, (volatile LAS unsigned*)(lds + LDS_XB));
#define PH(k, call) if (lo <= (k) && (k) < hi) { call; if ((k) + 1 < hi) xcd_barrier(xb); }
  PH(0, phase0a(p, lds, vcu, G));
  PH(1, phase0b(p, lds, vcu, G));
  PH(2, phase1(p, lds, vcu, G));
  PH(3, { NGEMM(FCmp1, ({p, 128, 2048, J_KC, 0, p.cpk, p.cw1k, p.hidk}), 2, 32); NGEMM(FCmp1, ({p, 128, 2048, J_VC, 0, p.cpv, p.cw1v, p.hidv}), 2, 32);
          NGEMM(FRet1, ({p, 128, 128}), 2, 1024); NGEMM(FRet2, ({p, 128, 128}), 2, 1024); });
  PH(4, { NGEMM(FCmp2, ({p, 64, 128, p.hidk, p.cw2k, p.kcmp}), 1, 32); NGEMM(FCmp2, ({p, 64, 128, p.hidv, p.cw2v, p.vcmp}), 1, 32);
          FOR_VP(16 * 16384 / 256) d_ret_scan(p, VBI(16 * 16384 / 256), t256); });
  PH(5, { FOR_VP((NCR * 32 + 255) / 256) d_rope_cmp(p, VBI((NCR * 32 + 255) / 256), t256); NGEMM(FRet3, ({p, 128, 256}), 2, 1024); });
  PH(6, { FOR_VP(T * 2) { const int vb = VBI(T * 2); d_nsa(p, vb >> 1, vb & 1, smem, t256); __syncthreads(); } });
  PH(7, { FOR_VP(T / 4) d_mixin(p, VBI(T / 4), t256); });
  PH(8, phase5(p, lds, vcu, G));
  PH(9, phase6(p, lds, vcu, G));
  PH(10, phase7(p, lds, vcu, G));
#undef PH
}
}

extern "C" void kernel_launch(void* const* d_in, const int* in_sizes, int n_in, void* d_out, int out_size, void* d_ws, size_t ws_size, hipStream_t stream) {
  P p{};
  p.x = (const float*)d_in[0]; p.c = (const float*)d_in[1]; p.pos = (const int*)d_in[2];
  p.w_ada = (const float*)d_in[3]; p.b_ada = (const float*)d_in[4]; p.g_mix = (const float*)d_in[5]; p.w_in = (const float*)d_in[6];
  p.cpk = (const float*)d_in[7]; p.cw1k = (const float*)d_in[8]; p.cw2k = (const float*)d_in[9];
  p.cpv = (const float*)d_in[10]; p.cw1v = (const float*)d_in[11]; p.cw2v = (const float*)d_in[12];
  p.g_nsa = (const float*)d_in[13]; p.g_ret = (const float*)d_in[14]; p.w_out = (const float*)d_in[15]; p.g_ffn = (const float*)d_in[16];
  p.w_router = (const float*)d_in[17]; p.rbias = (const float*)d_in[18]; p.wg_e = (const float*)d_in[19]; p.wu_e = (const float*)d_in[20];
  p.wd_e = (const float*)d_in[21]; p.wg_s = (const float*)d_in[22]; p.wu_s = (const float*)d_in[23]; p.wd_s = (const float*)d_in[24];
  p.g_final = (const float*)d_in[25];
  p.out = (float*)d_out;
  char* w = (char*)d_ws; size_t off = 0;
  auto take = [&](size_t bytes) { char* r = w + off; off += (bytes + 255) & ~(size_t)255; return r; };
  p.bar = (unsigned*)take(XCD_BAR_WORDS * 4);
  p.cnt = (int*)take(NE * 4);
  const size_t zero_bytes = off;
  p.mod = (float*)take(BATCH * 6144 * 4);
  p.hidk = (float*)take(2048 * 128 * 4); p.hidv = (float*)take(2048 * 128 * 4);
  p.kcmp = (float*)take(2048 * 64 * 4); p.vcmp = (float*)take(2048 * 64 * 4);
  p.onsa = (float*)take((size_t)T * 512 * 4);
  p.Sc = (float*)take((size_t)512 * 16384 * 4); p.kv = (float*)take((size_t)512 * 16384 * 4);
  p.retout = (float*)take((size_t)T * 512 * 4);
  p.x1 = (float*)take((size_t)T * D * 4);
  p.wts = (float*)take((size_t)T * 8 * 4);
  p.list = (int*)take((size_t)NE * ECAP * 4);
  p.gates = (float*)take((size_t)T * 24 * 4);
  p.winb = (bf16_t*)take((size_t)D * INW * 2); p.woutb = (bf16_t*)take((size_t)D * D * 2); p.wrb = (bf16_t*)take((size_t)D * NE * 2);
  p.wgsb = (bf16_t*)take((size_t)D * 256 * 2); p.wusb = (bf16_t*)take((size_t)D * 256 * 2); p.wdsb = (bf16_t*)take((size_t)256 * D * 2);
  p.cw1kb = (bf16_t*)take(2048 * 128 * 2); p.cw1vb = (bf16_t*)take(2048 * 128 * 2); p.cw2kb = (bf16_t*)take(128 * 64 * 2); p.cw2vb = (bf16_t*)take(128 * 64 * 2);
  p.hb = (bf16_t*)take((size_t)T * D * 2);
  p.projb = (bf16_t*)take((size_t)T * PJW * 2);
  p.mixb = (bf16_t*)take((size_t)T * D * 2); p.h2b = (bf16_t*)take((size_t)T * D * 2);
  p.slab = (bf16_t*)take((size_t)T * 8 * D * 2);
  if (off > ws_size) { fprintf(stderr, "kernel_launch: workspace too small: need %zu have %zu\n", off, ws_size); return; }
  static int grid = 0;
  if (!grid) {
    int dev = 0, cus = 0, per_cu = 0;
    (void)hipGetDevice(&dev);
    (void)hipDeviceGetAttribute(&cus, hipDeviceAttributeMultiprocessorCount, dev);
    (void)hipFuncSetAttribute((const void*)mega, hipFuncAttributeMaxDynamicSharedMemorySize, LDS_BYTES);
    (void)hipOccupancyMaxActiveBlocksPerMultiprocessor(&per_cu, (const void*)mega, 512, LDS_BYTES);
    if (per_cu < 1) fprintf(stderr, "kernel_launch: occupancy query says %d blocks per CU\n", per_cu);
    grid = cus;
  }
  (void)hipMemsetAsync(d_ws, 0, zero_bytes, stream);
  hipLaunchKernelGGL(mega, dim3(grid), dim3(512), LDS_BYTES, stream, p, 0, NPHASE);
}
```

```cpp
#include <hip/hip_runtime.h>
#include <cstdint>
#include <cstdio>

namespace {
constexpr int D = 1024, BATCH = 4, SEQ = 4096, T = BATCH * SEQ;
constexpr int INW = 3352;
constexpr int C_QN = 0, C_KC = 512, C_VC = 640, C_KS = 768, C_VS = 896, C_KW = 1024, C_VW = 1152, C_GN = 1280,
              C_QR = 1304, C_KR = 1816, C_VR = 2328, C_GR = 2840;
constexpr int PJW = 3328, J_QN = 0, J_KC = 512, J_VC = 640, J_KS = 768, J_VS = 896, J_KW = 1024, J_VW = 1152, J_QR = 1280, J_KR = 1792, J_VR = 2304, J_GR = 2816;
constexpr int NC = 255, NCR = BATCH * 2 * NC;
constexpr int NE = 256, ECAP = 16384;
constexpr float EPS = 1e-6f;
typedef unsigned short bf16_t;

struct P {
  const float *x, *c; const int* pos;
  const float *w_ada, *b_ada, *g_mix, *w_in, *cpk, *cw1k, *cw2k, *cpv, *cw1v, *cw2v, *g_nsa, *g_ret, *w_out, *g_ffn,
      *w_router, *rbias, *wg_e, *wu_e, *wd_e, *wg_s, *wu_s, *wd_s, *g_final;
  float* out;
  float *mod, *h, *proj, *hidk, *hidv, *kcmp, *vcmp, *onsa, *Sc, *kv, *retout, *mixin, *x1, *logits, *wts, *Gs, *acts,
      *G, *act, *yacc, *gates;
  int *cnt, *list, *tile_e, *tile_off, *ntiles;
  bf16_t *winb, *woutb, *wrb, *wgsb, *wusb, *wdsb, *cw1kb, *cw1vb, *cw2kb, *cw2vb, *hb, *projb, *mixb, *h2b, *slab, *kcmpb, *vcmpb, *onsab;
  unsigned* bar;
};

#define LAS __attribute__((address_space(3)))
typedef LAS char* lptr;
typedef short bf16x8 __attribute__((ext_vector_type(8)));
typedef short v4i16_t __attribute__((ext_vector_type(4)));
typedef float f32x16 __attribute__((ext_vector_type(16)));
typedef float f32x4 __attribute__((ext_vector_type(4)));
typedef float f32x2_t __attribute__((ext_vector_type(2)));
typedef __bf16 bf16x2_t __attribute__((ext_vector_type(2)));
typedef unsigned u32x4 __attribute__((ext_vector_type(4)));
typedef unsigned u32x2 __attribute__((ext_vector_type(2)));

__device__ __forceinline__ float wave_sum(float v) {
#pragma unroll
  for (int o = 1; o < 64; o <<= 1) v += __shfl_xor(v, o);
  return v;
}
__device__ __forceinline__ float wave_max(float v) {
#pragma unroll
  for (int o = 1; o < 64; o <<= 1) v = fmaxf(v, __shfl_xor(v, o));
  return v;
}
__device__ __forceinline__ float silu(float v) { return v / (1.f + expf(-v)); }
__device__ __forceinline__ float sigm(float v) { return 1.f / (1.f + expf(-v)); }
__device__ __forceinline__ float gelu_tanh(float v) { return 0.5f * v * (1.f + tanhf(0.7978845608028654f * (v + 0.044715f * v * v * v))); }
__device__ __forceinline__ unsigned pk2(float lo, float hi) { f32x2_t v = {lo, hi}; bf16x2_t b = __builtin_convertvector(v, bf16x2_t); return __builtin_bit_cast(unsigned, b); }
__device__ __forceinline__ float bf2f(bf16_t u) { return __uint_as_float((unsigned)u << 16); }
__device__ __forceinline__ float bflo(unsigned u) { return __uint_as_float(u << 16); }
__device__ __forceinline__ float bfhi(unsigned u) { return __uint_as_float(u & 0xffff0000u); }

#define XB_TMO      128
#define XB_XCNT(j)  (256  + 64 * (j))
#define XB_XSUB(j)  (1280 + 64 * (j))
#define XB_XGEN(j)  (2304 + 64 * (j))
#define XB_TOP      3328
#define XB_TOPGEN   3392
#define XCD_BAR_WORDS 3456
#define XB_SPIN_CAP (1u << 18)
__device__ __forceinline__ unsigned xb_ld(unsigned* p)              { return __hip_atomic_load(p, __ATOMIC_RELAXED, __HIP_MEMORY_SCOPE_AGENT); }
__device__ __forceinline__ unsigned xb_add(unsigned* p, unsigned v) { return __hip_atomic_fetch_add(p, v, __ATOMIC_RELAXED, __HIP_MEMORY_SCOPE_AGENT); }
__device__ __forceinline__ unsigned xb_xcc_id() { return (unsigned)__builtin_amdgcn_s_getreg((3 << 11) | 20) & 0xFu; }
#define XB_SPIN(cond, bar) do { unsigned _sp = 0; while (cond) { __builtin_amdgcn_s_sleep(1); \
    if ((++_sp & 255u) == 0u) { if (xb_ld(&(bar)[XB_TMO])) break; if (_sp > XB_SPIN_CAP) { atomicAdd(&(bar)[XB_TMO], 1u); break; } } } } while (0)
struct XcdBarrier { unsigned* bar; unsigned x; volatile LAS unsigned* st; };
__device__ __forceinline__ XcdBarrier xcd_barrier_post(unsigned* bar, volatile LAS unsigned* st) {
    XcdBarrier b; b.bar = bar; b.x = xb_xcc_id(); b.st = st;
    if (threadIdx.x == 0) (void)xb_add(&bar[XB_XCNT(b.x)], 1u);
    return b;
}
__device__ __forceinline__ void xcd_barrier_complete(unsigned* bar, unsigned x, unsigned& nloc, unsigned& nx) {
    const unsigned G = gridDim.x * gridDim.y * gridDim.z;
    unsigned sum, cnt, mine, sp = 0u;
    for (;;) {
        sum = 0u; cnt = 0u; mine = 0u;
#pragma unroll
        for (unsigned j = 0; j < 16; ++j) { const unsigned c = xb_ld(&bar[XB_XCNT(j)]); sum += c; cnt += (c > 0u) ? 1u : 0u; mine = (j == x) ? c : mine; }
        if (sum == G) break;
        __builtin_amdgcn_s_sleep(1);
        if ((++sp & 255u) == 0u) { if (xb_ld(&bar[XB_TMO])) break; if (sp > XB_SPIN_CAP) { atomicAdd(&bar[XB_TMO], 1u); break; } }
    }
    nloc = mine > 0u ? mine : 1u; nx = cnt > 0u ? cnt : 1u;
}
__device__ __forceinline__ void xcd_barrier(const XcdBarrier& b) {
    asm volatile("s_waitcnt vmcnt(0)" ::: "memory");
    __syncthreads();
    if (threadIdx.x == 0) {
        unsigned* bar = b.bar;
        __builtin_amdgcn_s_waitcnt(0);
        unsigned nloc = b.st[0], nx = b.st[1];
        if (nloc == 0u) { xcd_barrier_complete(bar, b.x, nloc, nx); b.st[0] = nloc; b.st[1] = nx; }
        const unsigned old = xb_add(&bar[XB_XSUB(b.x)], 1u);
        const unsigned gen = old / nloc;
        if (old + 1u == (gen + 1u) * nloc) {
            __builtin_amdgcn_fence(__ATOMIC_RELEASE, "agent");
            asm volatile("s_waitcnt vmcnt(0)" ::: "memory");
            const unsigned og = xb_add(&bar[XB_TOP], 1u);
            const unsigned tg = og / nx;
            if (og + 1u == (tg + 1u) * nx) xb_add(&bar[XB_TOPGEN], 1u);
            else XB_SPIN(xb_ld(&bar[XB_TOPGEN]) == tg, bar);
            __builtin_amdgcn_fence(__ATOMIC_ACQUIRE, "agent");
            xb_add(&bar[XB_XGEN(b.x)], 1u);
            asm volatile("s_waitcnt vmcnt(0)" ::: "memory");
        } else {
            XB_SPIN(xb_ld(&bar[XB_XGEN(b.x)]) == gen, bar);
            __builtin_amdgcn_fence(__ATOMIC_ACQUIRE, "agent");
            asm volatile("s_waitcnt vmcnt(0)" ::: "memory");
        }
    }
    __syncthreads();
}

__device__ __forceinline__ bf16x8 frag_kmaj(lptr img, int rs, int o, int s, int lane) {
  const int h = lane >> 5, blk = (lane >> 4) & 1, q = (lane & 15) >> 2, pp = lane & 3;
  lptr a = img + (16 * s + 8 * h + q) * rs + (o + 16 * blk + 4 * pp) * 2;
  const v4i16_t lo = __builtin_amdgcn_ds_read_tr16_b64_v4i16((LAS v4i16_t*)a);
  const v4i16_t hi = __builtin_amdgcn_ds_read_tr16_b64_v4i16((LAS v4i16_t*)(a + 4 * rs));
  return (bf16x8){lo[0], lo[1], lo[2], lo[3], hi[0], hi[1], hi[2], hi[3]};
}
__device__ __forceinline__ bf16x8 frag_kmin(lptr img, int o, int s, int lane) {
  const int row = o + (lane & 31), c = 2 * s + (lane >> 5);
  return *(LAS bf16x8*)(img + row * 64 + ((c ^ ((row >> 2) & 3)) << 4));
}
__device__ __forceinline__ int kmin_off(int row, int c) { return row * 64 + ((c ^ ((row >> 2) & 3)) << 4); }

template <int TM, int TN, bool WKMAJ, bool XKMAJ>
__device__ __forceinline__ void mma_step(f32x16 (&acc)[TM][TN], lptr wimg, int wrs, int wn0, lptr ximg, int xrs, int xt0, int lane) {
#pragma unroll
  for (int s = 0; s < 2; ++s) {
    bf16x8 wf[TM], xf[TN];
#pragma unroll
    for (int tm = 0; tm < TM; ++tm) wf[tm] = WKMAJ ? frag_kmaj(wimg, wrs, wn0 + 32 * tm, s, lane) : frag_kmin(wimg, wn0 + 32 * tm, s, lane);
#pragma unroll
    for (int tn = 0; tn < TN; ++tn) xf[tn] = XKMAJ ? frag_kmaj(ximg, xrs, xt0 + 32 * tn, s, lane) : frag_kmin(ximg, xt0 + 32 * tn, s, lane);
#pragma unroll
    for (int tm = 0; tm < TM; ++tm)
#pragma unroll
      for (int tn = 0; tn < TN; ++tn) acc[tm][tn] = __builtin_amdgcn_mfma_f32_32x32x16_bf16(wf[tm], xf[tn], acc[tm][tn], 0, 0, 0);
    if (s == 0) __builtin_amdgcn_sched_barrier(0);
  }
}

template <int BNT> struct WRegB16 { u32x4 r[BNT / 128]; };
template <int BNT> __device__ __forceinline__ void wload_b16(WRegB16<BNT>& R, const bf16_t* src  , int ld, int tid) {
  constexpr int C8 = BNT / 8, KPR = 512 / C8;
  const int c8 = tid % C8, kr = tid / C8;
#pragma unroll
  for (int r = 0; r < BNT / 128; ++r) R.r[r] = *(const u32x4*)(src + (size_t)(kr + r * KPR) * ld + c8 * 8);
}
template <int BNT> __device__ __forceinline__ void wstore_b16(const WRegB16<BNT>& R, lptr img, int rs, int tid) {
  constexpr int C8 = BNT / 8, KPR = 512 / C8;
  const int c8 = tid % C8, kr = tid / C8;
#pragma unroll
  for (int r = 0; r < BNT / 128; ++r) *(LAS u32x4*)(img + (kr + r * KPR) * rs + c8 * 16) = R.r[r];
}
template <int BMT> struct XRegB16 { u32x4 r[(BMT + 127) / 128]; };
template <int BMT> __device__ __forceinline__ void xload_b16(XRegB16<BMT>& R, const bf16_t* const (&rowp)[(BMT + 127) / 128], int k0, int tid) {
#pragma unroll
  for (int r = 0; r < (BMT + 127) / 128; ++r) if (BMT >= 128 || tid < BMT * 4) R.r[r] = *(const u32x4*)(rowp[r] + k0 + (tid & 3) * 8);
}
template <int BMT> __device__ __forceinline__ void xstore_b16(const XRegB16<BMT>& R, lptr img, int tid) {
#pragma unroll
  for (int r = 0; r < (BMT + 127) / 128; ++r) if (BMT >= 128 || tid < BMT * 4) *(LAS u32x4*)(img + kmin_off((tid >> 2) + 128 * r, tid & 3)) = R.r[r];
}

template <int BNT> struct WLb16 {
  typedef WRegB16<BNT> Regs; const bf16_t* src; int ld;
  __device__ __forceinline__ void load(Regs& R, int k0, int tid) const { wload_b16<BNT>(R, src + (size_t)k0 * ld, ld, tid); }
  __device__ __forceinline__ void store(const Regs& R, lptr img, int rs, int tid) const { wstore_b16<BNT>(R, img, rs, tid); }
};
struct WLgu {
  typedef WRegB16<512> Regs; const bf16_t *g, *u;
  __device__ __forceinline__ void load(Regs& R, int k0, int tid) const {
    const int c8 = tid & 63, kr = tid >> 6, col = c8 * 8, grp = col >> 6, w = col & 63;
    const unsigned long long ga = (unsigned long long)g, ua = (unsigned long long)u;
    const bf16_t* s = (const bf16_t*)(w < 32 ? ga : ua) + grp * 32 + (w & 31);
#pragma unroll
    for (int r = 0; r < 4; ++r) R.r[r] = *(const u32x4*)(s + (size_t)(k0 + kr + r * 8) * 256);
  }
  __device__ __forceinline__ void store(const Regs& R, lptr img, int rs, int tid) const { wstore_b16<512>(R, img, rs, tid); }
};
struct WReg32x8 { f32x4 r[8]; };
__device__ __forceinline__ void wstore_f32_512(const WReg32x8& R, lptr img, int rs, int tid) {
  const int c4 = tid & 127, kr = tid >> 7;
#pragma unroll
  for (int r = 0; r < 8; ++r) { u32x2 o; o.x = pk2(R.r[r].x, R.r[r].y); o.y = pk2(R.r[r].z, R.r[r].w); *(LAS u32x2*)(img + (kr + 4 * r) * rs + c4 * 8) = o; }
}
struct WLf32 {
  typedef WReg32x8 Regs; const float* src; int ld;
  __device__ __forceinline__ void load(Regs& R, int k0, int tid) const {
    const float* s = src + (size_t)(k0 + (tid >> 7)) * ld + (tid & 127) * 4;
#pragma unroll
    for (int r = 0; r < 8; ++r) R.r[r] = *(const f32x4*)(s + (size_t)(4 * r) * ld);
  }
  __device__ __forceinline__ void store(const Regs& R, lptr img, int rs, int tid) const { wstore_f32_512(R, img, rs, tid); }
};
struct WLf32gu {
  typedef WReg32x8 Regs; const float *g, *u;
  __device__ __forceinline__ void load(Regs& R, int k0, int tid) const {
    const int col = (tid & 127) * 4, grp = col >> 7, w = col & 127;
    const unsigned long long ga = (unsigned long long)g, ua = (unsigned long long)u;
    const float* s = (const float*)(w < 64 ? ga : ua) + (size_t)(k0 + (tid >> 7)) * 256 + grp * 64 + (w & 63);
#pragma unroll
    for (int r = 0; r < 8; ++r) R.r[r] = *(const f32x4*)(s + (size_t)(4 * r) * 256);
  }
  __device__ __forceinline__ void store(const Regs& R, lptr img, int rs, int tid) const { wstore_f32_512(R, img, rs, tid); }
};
template <int BMT> struct XLrows {
  typedef XRegB16<BMT> Regs; const bf16_t* rowp[(BMT + 127) / 128]; lptr ximg;
  __device__ __forceinline__ void load(Regs& R, int k0, int tid) const { xload_b16<BMT>(R, rowp, k0, tid); }
  __device__ __forceinline__ void store(const Regs& R, int tid) const { xstore_b16<BMT>(R, ximg, tid); }
  __device__ __forceinline__ lptr img(int) const { return ximg; }
};
struct XLres {
  struct Regs {}; lptr base; int bytes;
  __device__ __forceinline__ void load(Regs&, int, int) const {}
  __device__ __forceinline__ void store(const Regs&, int) const {}
  __device__ __forceinline__ lptr img(int k0) const { return base + (k0 >> 5) * bytes; }
};
template <int TM, int TN, class WL, class XL>
__device__ __forceinline__ void gemm_loop(f32x16 (&acc)[TM][TN], int K, const WL& wl, const XL& xl, lptr wimg, int wrs, int wn0, int xt0, int tid, int lane) {
  asm volatile("" : "+v"(tid), "+v"(lane));
  typename WL::Regs wr; typename XL::Regs xr;
  wl.load(wr, 0, tid); xl.load(xr, 0, tid);
  for (int k0 = 0; k0 < K; k0 += 32) {
    wl.store(wr, wimg, wrs, tid); xl.store(xr, tid);
    __syncthreads();
    if (k0 + 32 < K) { wl.load(wr, k0 + 32, tid); xl.load(xr, k0 + 32, tid); }
    mma_step<TM, TN, true, false>(acc, wimg, wrs, wn0, xl.img(k0), 0, xt0, lane);
    __syncthreads();
  }
}
template <int TM, int TN> __device__ __forceinline__ void acc_zero(f32x16 (&acc)[TM][TN]) {
#pragma unroll
  for (int a = 0; a < TM; ++a)
#pragma unroll
    for (int b = 0; b < TN; ++b)
#pragma unroll
      for (int r = 0; r < 16; ++r) acc[a][b][r] = 0.f;
}

constexpr int LDS_INV64 = 150 * 1024, LDS_INV128 = LDS_INV64 + 128, LDS_XB = LDS_INV128 + 256, LDS_BYTES = 152 * 1024;

__device__ __forceinline__ void cvt_items(const float* src, bf16_t* dst, size_t n8, int gtid, int gthreads) {
  for (size_t i = gtid; i < n8; i += gthreads) {
    const f32x4 a = *(const f32x4*)(src + i * 8), b = *(const f32x4*)(src + i * 8 + 4);
    u32x4 o; o.x = pk2(a.x, a.y); o.y = pk2(a.z, a.w); o.z = pk2(b.x, b.y); o.w = pk2(b.z, b.w);
    *(u32x4*)(dst + i * 8) = o;
  }
}
__device__ __forceinline__ void phase0a(const P& p, lptr lds, int vcu, int G) {
  const int tid = threadIdx.x, wid = tid >> 6, lane = tid & 63;
  if (vcu < 96) {
    const int j = vcu * 64 + lane;
    float a0 = 0.f, a1 = 0.f, a2 = 0.f, a3 = 0.f;
    for (int k = wid * 128; k < wid * 128 + 128; ++k) {
      const float w = p.w_ada[(size_t)k * 6144 + j];
      a0 += silu(p.c[k]) * w; a1 += silu(p.c[D + k]) * w; a2 += silu(p.c[2 * D + k]) * w; a3 += silu(p.c[3 * D + k]) * w;
    }
    LAS float* part = (LAS float*)lds;
    part[(wid * 4 + 0) * 64 + lane] = a0; part[(wid * 4 + 1) * 64 + lane] = a1; part[(wid * 4 + 2) * 64 + lane] = a2; part[(wid * 4 + 3) * 64 + lane] = a3;
    __syncthreads();
    if (wid < 4) { float s = p.b_ada[j];
#pragma unroll
      for (int w = 0; w < 8; ++w) s += part[(w * 4 + wid) * 64 + lane];
      p.mod[wid * 6144 + j] = s; }
    __syncthreads();
  }
  const int gtid = vcu * 512 + tid, gth = G * 512;
  cvt_items(p.w_in, p.winb, (size_t)D * INW / 8, gtid, gth);
  cvt_items(p.w_out, p.woutb, (size_t)D * D / 8, gtid, gth);
  cvt_items(p.w_router, p.wrb, (size_t)D * NE / 8, gtid, gth);
  cvt_items(p.wg_s, p.wgsb, (size_t)D * 256 / 8, gtid, gth);
  cvt_items(p.wu_s, p.wusb, (size_t)D * 256 / 8, gtid, gth);
  cvt_items(p.wd_s, p.wdsb, (size_t)256 * D / 8, gtid, gth);
  cvt_items(p.cw1k, p.cw1kb, (size_t)2048 * 128 / 8, gtid, gth);
  cvt_items(p.cw1v, p.cw1vb, (size_t)2048 * 128 / 8, gtid, gth);
  cvt_items(p.cw2k, p.cw2kb, (size_t)128 * 64 / 8, gtid, gth);
  cvt_items(p.cw2v, p.cw2vb, (size_t)128 * 64 / 8, gtid, gth);
}

__device__ __forceinline__ void phase0b(const P& p, lptr lds, int vcu, int G) {
  const int tid = threadIdx.x, wid = tid >> 6, lane = tid & 63;
  LAS float* wg = (LAS float*)lds;
  for (int i = tid; i < D * 24; i += 512) wg[i] = p.w_in[(size_t)(i / 24) * INW + C_GN + (i % 24)];
  __syncthreads();
  for (int row = vcu * 8 + wid; row < T; row += G * 8) {
    const int b = row / SEQ;
    f32x4 v[4]; float s = 0.f;
#pragma unroll
    for (int j = 0; j < 4; ++j) { v[j] = *(const f32x4*)(p.x + (size_t)row * D + j * 256 + lane * 4); s += v[j].x * v[j].x + v[j].y * v[j].y + v[j].z * v[j].z + v[j].w * v[j].w; }
    s = wave_sum(s);
    const float r = rsqrtf(s * (1.f / D) + EPS);
    f32x4 y[4];
#pragma unroll
    for (int j = 0; j < 4; ++j) {
      const int k = j * 256 + lane * 4;
      const f32x4 g = *(const f32x4*)(p.g_mix + k), sc = *(const f32x4*)(p.mod + b * 6144 + 1024 + k), sh = *(const f32x4*)(p.mod + b * 6144 + k);
      y[j].x = v[j].x * r * g.x * (1.f + sc.x) + sh.x; y[j].y = v[j].y * r * g.y * (1.f + sc.y) + sh.y;
      y[j].z = v[j].z * r * g.z * (1.f + sc.z) + sh.z; y[j].w = v[j].w * r * g.w * (1.f + sc.w) + sh.w;
      u32x2 o; o.x = pk2(y[j].x, y[j].y); o.y = pk2(y[j].z, y[j].w);
      *(u32x2*)(p.hb + (size_t)row * D + k) = o;
    }
#pragma unroll
    for (int half = 0; half < 2; ++half) {
      float ga[12];
#pragma unroll
      for (int q = 0; q < 12; ++q) ga[q] = 0.f;
#pragma unroll
      for (int j = 0; j < 4; ++j) {
        const float yy[4] = {y[j].x, y[j].y, y[j].z, y[j].w};
#pragma unroll
        for (int e = 0; e < 4; ++e) {
          const LAS f32x4* wr = (const LAS f32x4*)(wg + (j * 256 + lane * 4 + e) * 24 + half * 12);
#pragma unroll
          for (int q4 = 0; q4 < 3; ++q4) { const f32x4 w = wr[q4]; ga[q4 * 4] += yy[e] * w.x; ga[q4 * 4 + 1] += yy[e] * w.y; ga[q4 * 4 + 2] += yy[e] * w.z; ga[q4 * 4 + 3] += yy[e] * w.w; }
          __builtin_amdgcn_sched_barrier(0);
        }
      }
#pragma unroll
      for (int q = 0; q < 12; ++q) { const float t = wave_sum(ga[q]); if (lane == q) p.gates[(size_t)row * 24 + half * 12 + q] = sigm(t); __builtin_amdgcn_sched_barrier(0); }
    }
  }
  __syncthreads();
}

#define ROPE_PAIR(X1, X2, posf, invrev, sc) do { float pf_ = (posf); asm volatile("" : "+v"(pf_)); const float fr_ = __builtin_amdgcn_fractf(pf_ * (invrev)); \
    const float sn_ = __builtin_amdgcn_sinf(fr_), cs_ = __builtin_amdgcn_cosf(fr_); const float a_ = (X1), b_ = (X2); \
    float o1_ = (a_ * cs_ - b_ * sn_) * (sc), o2_ = (a_ * sn_ + b_ * cs_) * (sc); asm volatile("" : "+v"(o1_), "+v"(o2_)); (X1) = o1_; (X2) = o2_; } while (0)
__device__ __forceinline__ void phase1(const P& p, lptr lds, int vcu, int G) {
  const int tid = threadIdx.x, wid = __builtin_amdgcn_readfirstlane(tid >> 6), lane = tid & 63, wn = wid >> 2, wt = wid & 3, h = lane >> 5;
  constexpr int WRS = 256 * 2 + 64;
  lptr wimg = lds, ximg = lds + 32 * WRS;
  const LAS float* inv64 = (const LAS float*)(lds + LDS_INV64);
  const LAS float* inv128 = (const LAS float*)(lds + LDS_INV128);
  for (int u = vcu; u < 13 * 64; u += G) {
    const int j = u % 13, mt = u / 13, t0 = mt * 256;
    const int wcol = j < 5 ? j * 256 : C_QR + (j - 5) * 256;
    const bf16_t* wsrc = p.winb + wcol;
    const bf16_t* rowp[2] = {p.hb + (size_t)(t0 + (tid >> 2)) * D, p.hb + (size_t)(t0 + 128 + (tid >> 2)) * D};
    f32x16 acc[4][2];
#pragma unroll
    for (int a = 0; a < 4; ++a)
#pragma unroll
      for (int b = 0; b < 2; ++b)
#pragma unroll
        for (int r = 0; r < 16; ++r) acc[a][b][r] = 0.f;
    WRegB16<256> wr; XRegB16<256> xr;
    wload_b16<256>(wr, wsrc, INW, tid); xload_b16<256>(xr, rowp, 0, tid);
    for (int k0 = 0; k0 < D; k0 += 32) {
      wstore_b16<256>(wr, wimg, WRS, tid); xstore_b16<256>(xr, ximg, tid);
      __syncthreads();
      if (k0 + 32 < D) { wload_b16<256>(wr, wsrc + (size_t)(k0 + 32) * INW, INW, tid); xload_b16<256>(xr, rowp, k0 + 32, tid); }
      mma_step<4, 2, true, false>(acc, wimg, WRS, wn * 128, ximg, 0, wt * 64, lane);
      __syncthreads();
    }
    const int kind = (j < 2) ? 0 : (j == 2) ? 3 : (j < 5) ? (wn == 0 ? 1 : 3) : (j < 7) ? 2 : (j < 9) ? 4 : (j < 11) ? 3 : 5;
#pragma unroll
    for (int tn = 0; tn < 2; ++tn) {
      const int tok = t0 + wt * 64 + tn * 32 + (lane & 31);
      const float posf = (float)p.pos[tok];
      if (kind == 0 || kind == 1) {
        const float sc = kind == 0 ? 0.125f : 1.f;
#pragma unroll
        for (int r = 0; r < 16; ++r) { const float iv = inv64[(r & 3) + 8 * (r >> 2) + 4 * h];
          ROPE_PAIR(acc[0][tn][r], acc[1][tn][r], posf, iv, sc); ROPE_PAIR(acc[2][tn][r], acc[3][tn][r], posf, iv, sc); if ((r & 3) == 3) __builtin_amdgcn_sched_barrier(0); }
      } else if (kind == 2 || kind == 4) {
        const float sc = kind == 4 ? 0.08838834764831845f : 1.f;
#pragma unroll
        for (int r = 0; r < 16; ++r) { const int i = (r & 3) + 8 * (r >> 2) + 4 * h;
          ROPE_PAIR(acc[0][tn][r], acc[2][tn][r], posf, inv128[i], sc); ROPE_PAIR(acc[1][tn][r], acc[3][tn][r], posf, inv128[32 + i], sc); if ((r & 3) == 3) __builtin_amdgcn_sched_barrier(0); }
      } else if (kind == 5) {
#pragma unroll
        for (int tm = 0; tm < 4; ++tm)
#pragma unroll
          for (int r = 0; r < 16; ++r) { float v = acc[tm][tn][r]; asm volatile("" : "+v"(v)); float o = v * __builtin_amdgcn_rcpf(1.f + __builtin_amdgcn_exp2f(-1.4426950408889634f * v)); asm volatile("" : "+v"(o)); acc[tm][tn][r] = o; }
      }
      bf16_t* orow = p.projb + (size_t)tok * PJW + j * 256 + wn * 128 + 4 * h;
#pragma unroll
      for (int tm = 0; tm < 4; ++tm)
#pragma unroll
        for (int a = 0; a < 4; ++a) { u32x2 o; o.x = pk2(acc[tm][tn][4 * a], acc[tm][tn][4 * a + 1]); o.y = pk2(acc[tm][tn][4 * a + 2], acc[tm][tn][4 * a + 3]);
          *(u32x2*)(orow + tm * 32 + a * 8) = o; __builtin_amdgcn_sched_barrier(0); }
    }
  }
}

__device__ __forceinline__ void phase5(const P& p, lptr lds, int vcu, int G) {
  const int tid = threadIdx.x, wid = __builtin_amdgcn_readfirstlane(tid >> 6), lane = tid & 63, h = lane >> 5, l31 = lane & 31;
  constexpr int WRS1 = 1024 * 2 + 64;
  lptr wimg = lds, ximg = lds + 32 * WRS1;
  lptr lgb = lds + 72 * 1024;
  LAS float* part = (LAS float*)(lds + 138 * 1024);
  LAS float* rstd = part + 512;
  for (int u = vcu; u < T / 64; u += G) {
    const int t0 = u * 64, b = t0 / SEQ;
    f32x16 acc[4][2];
    acc_zero<4, 2>(acc);
    { WLb16<1024> wl; wl.src = p.woutb; wl.ld = D;
      XLrows<64> xl; xl.rowp[0] = p.mixb + (size_t)(t0 + ((tid >> 2) & 63)) * D; xl.ximg = ximg;
      gemm_loop<4, 2>(acc, D, wl, xl, wimg, WRS1, wid * 128, 0, tid, lane); }
    int nb = wid * 128 + 4 * h, tb = t0 + l31;
    asm volatile("" : "+v"(nb), "+v"(tb));
#pragma unroll
    for (int tn = 0; tn < 2; ++tn) {
      const int tok = tb + tn * 32; float ss = 0.f;
#pragma unroll
      for (int tm = 0; tm < 4; ++tm)
#pragma unroll
        for (int a = 0; a < 4; ++a) {
          const int n = nb + tm * 32 + a * 8;
          const f32x4 xv = *(const f32x4*)(p.x + (size_t)tok * D + n), gt = *(const f32x4*)(p.mod + b * 6144 + 2048 + n);
          f32x4 v; v.x = xv.x + gt.x * acc[tm][tn][4 * a]; v.y = xv.y + gt.y * acc[tm][tn][4 * a + 1]; v.z = xv.z + gt.z * acc[tm][tn][4 * a + 2]; v.w = xv.w + gt.w * acc[tm][tn][4 * a + 3];
          acc[tm][tn][4 * a] = v.x; acc[tm][tn][4 * a + 1] = v.y; acc[tm][tn][4 * a + 2] = v.z; acc[tm][tn][4 * a + 3] = v.w;
          *(f32x4*)(p.x1 + (size_t)tok * D + n) = v;
          ss += v.x * v.x + v.y * v.y + v.z * v.z + v.w * v.w;
          if (a == 3) __builtin_amdgcn_sched_barrier(0);
        }
      ss += __shfl_xor(ss, 32);
      if (h == 0) part[wid * 64 + tn * 32 + l31] = ss;
    }
    __syncthreads();
    if (tid < 64) { float q = 0.f;
#pragma unroll
      for (int w = 0; w < 8; ++w) q += part[w * 64 + tid];
      rstd[tid] = rsqrtf(q * (1.f / D) + EPS); }
    __syncthreads();
    asm volatile("" : "+v"(nb), "+v"(tb));
#pragma unroll
    for (int tn = 0; tn < 2; ++tn) {
      const int tok = tb + tn * 32; const float r = rstd[tn * 32 + l31];
#pragma unroll
      for (int tm = 0; tm < 4; ++tm)
#pragma unroll
        for (int a = 0; a < 4; ++a) {
          const int n = nb + tm * 32 + a * 8;
          const f32x4 g = *(const f32x4*)(p.g_ffn + n), sc = *(const f32x4*)(p.mod + b * 6144 + 4096 + n), sh = *(const f32x4*)(p.mod + b * 6144 + 3072 + n);
          u32x2 o;
          o.x = pk2(acc[tm][tn][4 * a] * r * g.x * (1.f + sc.x) + sh.x, acc[tm][tn][4 * a + 1] * r * g.y * (1.f + sc.y) + sh.y);
          o.y = pk2(acc[tm][tn][4 * a + 2] * r * g.z * (1.f + sc.z) + sh.z, acc[tm][tn][4 * a + 3] * r * g.w * (1.f + sc.w) + sh.w);
          *(u32x2*)(p.h2b + (size_t)tok * D + n) = o;
          if (a == 3) __builtin_amdgcn_sched_barrier(0);
        }
    }
    asm volatile("s_waitcnt vmcnt(0)" ::: "memory");
    __syncthreads();
    { f32x16 a2[1][2]; acc_zero<1, 2>(a2);
      WLb16<256> wl; wl.src = p.wrb; wl.ld = NE;
      XLrows<64> xl; xl.rowp[0] = p.h2b + (size_t)(t0 + ((tid >> 2) & 63)) * D; xl.ximg = ximg;
      gemm_loop<1, 2>(a2, D, wl, xl, wimg, 256 * 2 + 64, wid * 32, 0, tid, lane);
      int lo = ((l31 * 256 + wid * 32 + 4 * h) * 4);
      asm volatile("" : "+v"(lo));
#pragma unroll
      for (int tn = 0; tn < 2; ++tn)
#pragma unroll
        for (int a = 0; a < 4; ++a) { f32x4 v = {a2[0][tn][4 * a], a2[0][tn][4 * a + 1], a2[0][tn][4 * a + 2], a2[0][tn][4 * a + 3]};
          *(LAS f32x4*)(lgb + lo + (tn * 32 * 256 + a * 8) * 4) = v; } }
    __syncthreads();
    { int lane_ = lane; asm volatile("" : "+v"(lane_));
      const int lane = lane_;
      const f32x4 rb = *(const f32x4*)(p.rbias + lane * 4);
      for (int i = 0; i < 8; ++i) {
        const int tl = wid * 8 + i, tok = t0 + tl;
        const f32x4 lv = *(const LAS f32x4*)(lgb + (tl * 256 + lane * 4) * 4);
        const float s0 = sigm(lv.x), s1 = sigm(lv.y), s2 = sigm(lv.z), s3 = sigm(lv.w);
        float c0 = s0 + rb.x, c1 = s1 + rb.y, c2 = s2 + rb.z, c3 = s3 + rb.w;
        float m1, m2;
        { const float h1 = fmaxf(c0, c1), l1 = fminf(c0, c1), h2 = fmaxf(c2, c3), l2 = fminf(c2, c3); m1 = fmaxf(h1, h2); m2 = fmaxf(fminf(h1, h2), fmaxf(l1, l2)); }
#pragma unroll
        for (int o = 1; o < 8; o <<= 1) { const float o1 = __shfl_xor(m1, o), o2 = __shfl_xor(m2, o); const float n1 = fmaxf(m1, o1), n2 = fmaxf(fminf(m1, o1), fmaxf(m2, o2)); m1 = n1; m2 = n2; }
        const float gs = m1 + m2; const int myg = lane >> 3; int rank = 0;
#pragma unroll
        for (int g2 = 0; g2 < 8; ++g2) { const float og = __shfl(gs, g2 * 8); rank += (og > gs || (og == gs && g2 < myg)) ? 1 : 0; }
        if (rank >= 4) { c0 = -INFINITY; c1 = -INFINITY; c2 = -INFINITY; c3 = -INFINITY; }
        int my_e = 0; float my_s = 0.f;
#pragma unroll
        for (int k = 0; k < 8; ++k) {
          float bv = c0; int li = lane * 4;
          if (c1 > bv) { bv = c1; li = lane * 4 + 1; }
          if (c2 > bv) { bv = c2; li = lane * 4 + 2; }
          if (c3 > bv) { bv = c3; li = lane * 4 + 3; }
#pragma unroll
          for (int o = 1; o < 64; o <<= 1) { const float ov = __shfl_xor(bv, o); const int oi = __shfl_xor(li, o); if (ov > bv || (ov == bv && oi < li)) { bv = ov; li = oi; } }
          const int j = li & 3; const float sj = j == 0 ? s0 : j == 1 ? s1 : j == 2 ? s2 : s3;
          const float sv = __shfl(sj, li >> 2);
          if (lane * 4 == li) c0 = -INFINITY;
          if (lane * 4 + 1 == li) c1 = -INFINITY;
          if (lane * 4 + 2 == li) c2 = -INFINITY;
          if (lane * 4 + 3 == li) c3 = -INFINITY;
          if (lane == k) { my_e = li; my_s = sv; }
        }
        const float wsum = wave_sum(lane < 8 ? my_s : 0.f);
        if (lane < 8) { const int pos = atomicAdd(&p.cnt[my_e], 1); p.list[my_e * ECAP + pos] = tok * 8 + lane; p.wts[tok * 8 + lane] = my_s / wsum * 2.5f; }
      } }
    __syncthreads();
    { f32x16 a3[2][2]; acc_zero<2, 2>(a3);
      WLgu wl; wl.g = p.wgsb; wl.u = p.wusb;
      XLrows<64> xl; xl.rowp[0] = p.h2b + (size_t)(t0 + ((tid >> 2) & 63)) * D; xl.ximg = ximg;
      gemm_loop<2, 2>(a3, D, wl, xl, wimg, 512 * 2 + 64, wid * 64, 0, tid, lane);
      int l31_ = l31, h_ = h; asm volatile("" : "+v"(l31_), "+v"(h_));
#pragma unroll
      for (int tn = 0; tn < 2; ++tn)
#pragma unroll
        for (int a = 0; a < 4; ++a) {
          float o[4];
#pragma unroll
          for (int e = 0; e < 4; ++e) { const float gv = a3[0][tn][4 * a + e], uv = a3[1][tn][4 * a + e]; o[e] = gv * __builtin_amdgcn_rcpf(1.f + __builtin_amdgcn_exp2f(-1.4426950408889634f * gv)) * uv; }
          const int col = wid * 32 + a * 8 + 4 * h_;
          u32x2 w2; w2.x = pk2(o[0], o[1]); w2.y = pk2(o[2], o[3]);
          *(LAS u32x2*)(lgb + (col >> 5) * 4096 + kmin_off(tn * 32 + l31_, (col & 31) >> 3) + (col & 7) * 2) = w2;
        } }
    __syncthreads();
    acc_zero<4, 2>(acc);
    { WLb16<1024> wl; wl.src = p.wdsb; wl.ld = D;
      XLres xl; xl.base = lgb; xl.bytes = 4096;
      gemm_loop<4, 2>(acc, 256, wl, xl, wimg, WRS1, wid * 128, 0, tid, lane); }
    asm volatile("" : "+v"(nb), "+v"(tb));
#pragma unroll
    for (int tn = 0; tn < 2; ++tn) {
      const int tok = tb + tn * 32;
#pragma unroll
      for (int tm = 0; tm < 4; ++tm)
#pragma unroll
        for (int a = 0; a < 4; ++a) {
          const int n = nb + tm * 32 + a * 8;
          f32x4 v = *(const f32x4*)(p.x1 + (size_t)tok * D + n); const f32x4 gt = *(const f32x4*)(p.mod + b * 6144 + 5120 + n);
          v.x += gt.x * acc[tm][tn][4 * a]; v.y += gt.y * acc[tm][tn][4 * a + 1]; v.z += gt.z * acc[tm][tn][4 * a + 2]; v.w += gt.w * acc[tm][tn][4 * a + 3];
          *(f32x4*)(p.x1 + (size_t)tok * D + n) = v;
          if (a == 3) __builtin_amdgcn_sched_barrier(0);
        }
    }
    __syncthreads();
  }
}

__device__ __forceinline__ void phase6(const P& p, lptr lds, int vcu, int G) {
  const int tid = threadIdx.x, wid = __builtin_amdgcn_readfirstlane(tid >> 6), lane = tid & 63, h = lane >> 5, l31 = lane & 31, wn = wid >> 1, wt = wid & 1;
  constexpr int WRS = 512 * 2 + 64;
  lptr wimg = lds, ximg = lds + 32 * WRS;
  lptr actb = lds + 44 * 1024;
  LAS int* pre = (LAS int*)(lds + 110 * 1024);
  LAS int* sidl = pre + 320;
  if (tid < NE) pre[tid + 1] = (p.cnt[tid] + 127) >> 7;
  if (tid == 0) pre[0] = 0;
  __syncthreads();
  if (tid == 0) { int a = 0; for (int e = 1; e <= NE; ++e) { a += pre[e]; pre[e] = a; } }
  __syncthreads();
  const int nunits = pre[NE];
  for (int u = vcu; u < nunits; u += G) {
    int lo = 0, hi = NE;
    while (hi - lo > 1) { const int mid = (lo + hi) >> 1; if (pre[mid] <= u) lo = mid; else hi = mid; }
    const int e = lo, off = (u - pre[e]) * 128, cnt = p.cnt[e];
    if (tid < 128) sidl[tid] = off + tid < cnt ? p.list[e * ECAP + off + tid] : -1;
    __syncthreads();
    f32x16 acc[4][2];
    acc_zero<4, 2>(acc);
    { WLf32gu wl; wl.g = p.wg_e + (size_t)e * D * 256; wl.u = p.wu_e + (size_t)e * D * 256;
      XLrows<128> xl; { const int sd = sidl[(tid >> 2) & 127]; xl.rowp[0] = p.h2b + (size_t)(sd < 0 ? 0 : sd >> 3) * D; } xl.ximg = ximg;
      gemm_loop<4, 2>(acc, D, wl, xl, wimg, WRS, wn * 128, wt * 64, tid, lane); }
    { int l31_ = l31, h_ = h; asm volatile("" : "+v"(l31_), "+v"(h_));
#pragma unroll
      for (int tn = 0; tn < 2; ++tn)
#pragma unroll
        for (int tm = 0; tm < 2; ++tm)
#pragma unroll
          for (int a = 0; a < 4; ++a) {
            float o[4];
#pragma unroll
            for (int q = 0; q < 4; ++q) { const float gv = acc[tm][tn][4 * a + q], uv = acc[tm + 2][tn][4 * a + q]; o[q] = gv * __builtin_amdgcn_rcpf(1.f + __builtin_amdgcn_exp2f(-1.4426950408889634f * gv)) * uv; }
            const int col = wn * 64 + tm * 32 + a * 8 + 4 * h_;
            u32x2 w2; w2.x = pk2(o[0], o[1]); w2.y = pk2(o[2], o[3]);
            *(LAS u32x2*)(actb + (col >> 5) * 8192 + kmin_off(wt * 64 + tn * 32 + l31_, (col & 31) >> 3) + (col & 7) * 2) = w2;
          } }
    __syncthreads();
#pragma unroll 1
    for (int pass = 0; pass < 2; ++pass) {
      acc_zero<4, 2>(acc);
      { WLf32 wl; wl.src = p.wd_e + (size_t)e * 256 * D + pass * 512; wl.ld = D;
        XLres xl; xl.base = actb; xl.bytes = 8192;
        gemm_loop<4, 2>(acc, 256, wl, xl, wimg, WRS, wn * 128, wt * 64, tid, lane); }
      int nb = pass * 512 + wn * 128 + 4 * h, sl = wt * 64 + l31;
      asm volatile("" : "+v"(nb), "+v"(sl));
#pragma unroll
      for (int tn = 0; tn < 2; ++tn) {
        const int sd = sidl[sl + tn * 32];
        if (sd >= 0) {
          const float wgt = p.wts[sd];
          bf16_t* orow = p.slab + (size_t)sd * D + nb;
#pragma unroll
          for (int tm = 0; tm < 4; ++tm)
#pragma unroll
            for (int a = 0; a < 4; ++a) { u32x2 o; o.x = pk2(acc[tm][tn][4 * a] * wgt, acc[tm][tn][4 * a + 1] * wgt); o.y = pk2(acc[tm][tn][4 * a + 2] * wgt, acc[tm][tn][4 * a + 3] * wgt);
              *(u32x2*)(orow + tm * 32 + a * 8) = o; }
        }
      }
    }
    __syncthreads();
  }
}

__device__ __forceinline__ void phase7(const P& p, lptr lds, int vcu, int G) {
  const int tid = threadIdx.x, wid = tid >> 6, lane = tid & 63;
  for (int tok = vcu * 8 + wid; tok < T; tok += G * 8) {
    const int b = tok / SEQ;
    float v[16]; float ss = 0.f;
#pragma unroll
    for (int j = 0; j < 2; ++j) {
      const int n = j * 512 + lane * 8;
      float a[8];
#pragma unroll
      for (int q = 0; q < 8; ++q) a[q] = 0.f;
#pragma unroll
      for (int k = 0; k < 8; ++k) { const u32x4 w = *(const u32x4*)(p.slab + ((size_t)tok * 8 + k) * D + n);
        a[0] += bflo(w.x); a[1] += bfhi(w.x); a[2] += bflo(w.y); a[3] += bfhi(w.y); a[4] += bflo(w.z); a[5] += bfhi(w.z); a[6] += bflo(w.w); a[7] += bfhi(w.w); }
#pragma unroll
      for (int q4 = 0; q4 < 2; ++q4) {
        const f32x4 xv = *(const f32x4*)(p.x1 + (size_t)tok * D + n + q4 * 4), gt = *(const f32x4*)(p.mod + b * 6144 + 5120 + n + q4 * 4);
        const float y0 = xv.x + gt.x * a[q4 * 4], y1 = xv.y + gt.y * a[q4 * 4 + 1], y2 = xv.z + gt.z * a[q4 * 4 + 2], y3 = xv.w + gt.w * a[q4 * 4 + 3];
        v[j * 8 + q4 * 4] = y0; v[j * 8 + q4 * 4 + 1] = y1; v[j * 8 + q4 * 4 + 2] = y2; v[j * 8 + q4 * 4 + 3] = y3;
        ss += y0 * y0 + y1 * y1 + y2 * y2 + y3 * y3;
      }
    }
    ss = wave_sum(ss);
    const float r = rsqrtf(ss * (1.f / D) + EPS);
#pragma unroll
    for (int j = 0; j < 2; ++j)
#pragma unroll
      for (int q4 = 0; q4 < 2; ++q4) {
        const int n = j * 512 + lane * 8 + q4 * 4;
        const f32x4 g = *(const f32x4*)(p.g_final + n);
        f32x4 o; o.x = v[j * 8 + q4 * 4] * r * g.x; o.y = v[j * 8 + q4 * 4 + 1] * r * g.y; o.z = v[j * 8 + q4 * 4 + 2] * r * g.z; o.w = v[j * 8 + q4 * 4 + 3] * r * g.w;
        *(f32x4*)(p.out + (size_t)tok * D + n) = o;
      }
  }
}

constexpr int NSA_KB = 8192, NSA_VRS = 192, NSA_SLOT = NSA_KB + 64 * NSA_VRS, NSA_IMP = 2 * NSA_SLOT;
__device__ __forceinline__ void nsa_qk(f32x16 (&s)[2], lptr kimg, const bf16x8 (&qf)[4], int l31, int h) {
#pragma unroll
  for (int kt = 0; kt < 2; ++kt) {
#pragma unroll
    for (int r = 0; r < 16; ++r) s[kt][r] = 0.f;
    const int key = kt * 32 + l31;
#pragma unroll
    for (int ds = 0; ds < 4; ++ds) {
      const bf16x8 a = *(LAS bf16x8*)(kimg + key * 128 + (((2 * ds + h) ^ ((key >> 1) & 7)) << 4));
      s[kt] = __builtin_amdgcn_mfma_f32_32x32x16_bf16(a, qf[ds], s[kt], 0, 0, 0);
    }
  }
}
__device__ __forceinline__ void nsa_pv(f32x16 (&o)[2], lptr vimg, const f32x16 (&pr)[2], int lane) {
  const int h = lane >> 5, blk = (lane >> 4) & 1, q = (lane & 15) >> 2, pp = lane & 3;
  bf16x8 pb[4];
#pragma unroll
  for (int ks = 0; ks < 4; ++ks) {
    const int kt = ks >> 1, rb = 8 * (ks & 1);
    u32x4 w; w.x = pk2(pr[kt][rb], pr[kt][rb + 1]); w.y = pk2(pr[kt][rb + 2], pr[kt][rb + 3]); w.z = pk2(pr[kt][rb + 4], pr[kt][rb + 5]); w.w = pk2(pr[kt][rb + 6], pr[kt][rb + 7]);
    pb[ks] = __builtin_bit_cast(bf16x8, w);
  }
#pragma unroll
  for (int dt = 0; dt < 2; ++dt)
#pragma unroll
    for (int ks = 0; ks < 4; ++ks) {
      lptr a = vimg + (16 * ks + 4 * h + q) * NSA_VRS + (dt * 32 + 16 * blk + 4 * pp) * 2;
      const v4i16_t lo = __builtin_amdgcn_ds_read_tr16_b64_v4i16((LAS v4i16_t*)a);
      const v4i16_t hi = __builtin_amdgcn_ds_read_tr16_b64_v4i16((LAS v4i16_t*)(a + 8 * NSA_VRS));
      const bf16x8 vf = {lo[0], lo[1], lo[2], lo[3], hi[0], hi[1], hi[2], hi[3]};
      o[dt] = __builtin_amdgcn_mfma_f32_32x32x16_bf16(vf, pb[ks], o[dt], 0, 0, 0);
    }
}
__device__ __forceinline__ float fexp(float x) { return __builtin_amdgcn_exp2f(x * 1.4426950408889634f); }
__device__ __forceinline__ void phase_nsa(const P& p, lptr lds, int vcu, int G) {
  const int tid = threadIdx.x, wid = __builtin_amdgcn_readfirstlane(tid >> 6), lane0 = tid & 63;
  LAS float* imp = (LAS float*)(lds + NSA_IMP);
  LAS float* obuf = (LAS float*)(lds + NSA_IMP + 16384) + wid * 2048 + lane0;
  const int srow = tid >> 3, sch = tid & 7;
  for (int u = vcu; u < 512; u += G) {
    const int bg = u & 7, j0 = u < 256 ? 63 - (u >> 3) : ((u - 256) >> 3), b = bg >> 1, g = bg & 1, t0 = j0 * 64;
    const int t = t0 + wid * 8 + ((lane0 & 31) >> 2), hg = g * 4 + (lane0 & 3);
    const size_t trow = (size_t)(b * SEQ + t);
    bf16x8 qf[4];
#pragma unroll
    for (int ds = 0; ds < 4; ++ds) qf[ds] = *(const bf16x8*)(p.projb + trow * PJW + J_QN + hg * 64 + 16 * ds + 8 * (lane0 >> 5));
#pragma unroll
    for (int i = 0; i < 8; ++i) imp[(wid * 8 + i) * 64 + lane0] = 0.f;
    const int nct = (((t0 + 32) >> 4) >> 6) + 1, jw0 = j0 > 8 ? j0 - 8 : 0;
    const int itC = 2 * nct, itD = itC + j0 + 1, NI = itD + (j0 - jw0 + 1);
    const int cmaxt = t >= 31 ? (t - 31) >> 4 : -1;
    u32x4 kreg, vreg;
    const char* pbt = (const char*)(p.projb + (size_t)(b * SEQ) * PJW + g * 64) + (size_t)srow * (PJW * 2) + sch * 16;
    const char* kct = (const char*)(p.kcmpb + (size_t)bg * NC * 64) + srow * 128 + sch * 16;
    const char* vct = (const char*)(p.vcmpb + (size_t)bg * NC * 64) + srow * 128 + sch * 16;
#define NSA_LOAD(IT) do { const int it_ = (IT); \
      if (it_ < itC) { const unsigned o_ = (unsigned)(it_ < nct ? it_ : it_ - nct) * 8192u; kreg = *(const u32x4*)(kct + o_); vreg = *(const u32x4*)(vct + o_); } \
      else { const bool sel_ = it_ < itD; const unsigned o_ = (unsigned)(sel_ ? it_ - itC : jw0 + it_ - itD) * (unsigned)(64 * PJW * 2); \
             kreg = *(const u32x4*)(pbt + o_ + (sel_ ? J_KS * 2 : J_KW * 2)); vreg = *(const u32x4*)(pbt + o_ + (sel_ ? J_VS * 2 : J_VW * 2)); } } while (0)
#define NSA_STEP() lptr slot = lds + (it & 1) * NSA_SLOT; \
      *(LAS u32x4*)(slot + srow * 128 + ((sch ^ ((srow >> 1) & 7)) << 4)) = kreg; \
      *(LAS u32x4*)(slot + NSA_KB + srow * NSA_VRS + sch * 16) = vreg; \
      __syncthreads(); \
      if (it + 1 < NI) NSA_LOAD(it + 1); \
      int lane = lane0; asm volatile("" : "+v"(lane)); const int h = lane >> 5, l31 = lane & 31; (void)l31
    NSA_LOAD(0);
    int it = 0;
    float m1 = -1e30f, l1 = 0.f;
    for (; it < nct; ++it) {
      NSA_STEP();
      f32x16 s[2]; nsa_qk(s, slot, qf, l31, h);
      float mx = -1e30f;
#pragma unroll
      for (int r = 0; r < 16; ++r) { const int c = 64 * it + (r & 3) + 8 * (r >> 2) + 4 * h; if (c <= cmaxt) mx = fmaxf(mx, s[0][r]); if (c + 32 <= cmaxt) mx = fmaxf(mx, s[1][r]); }
      mx = fmaxf(mx, __shfl_xor(mx, 32));
      const float mn = fmaxf(m1, mx); float rs = 0.f;
#pragma unroll
      for (int r = 0; r < 16; ++r) { const int c = 64 * it + (r & 3) + 8 * (r >> 2) + 4 * h; rs += (c <= cmaxt ? fexp(s[0][r] - mn) : 0.f) + (c + 32 <= cmaxt ? fexp(s[1][r] - mn) : 0.f); }
      rs += __shfl_xor(rs, 32);
      l1 = l1 * fexp(m1 - mn) + rs; m1 = mn;
    }
    f32x16 o[2];
#pragma unroll
    for (int r = 0; r < 16; ++r) { o[0][r] = 0.f; o[1][r] = 0.f; }
    { const float il = 1.f / fmaxf(l1, 1e-20f);
      for (; it < itC; ++it) {
        NSA_STEP();
        const int i = it - nct, tl = l31 >> 2, r4 = l31 & 3;
        f32x16 s[2]; nsa_qk(s, slot, qf, l31, h);
#pragma unroll
        for (int r = 0; r < 16; ++r) { const int c = 64 * i + (r & 3) + 8 * (r >> 2) + 4 * h; s[0][r] = c <= cmaxt ? fexp(s[0][r] - m1) * il : 0.f; s[1][r] = c + 32 <= cmaxt ? fexp(s[1][r] - m1) * il : 0.f; }
#pragma unroll
        for (int kt = 0; kt < 2; ++kt)
#pragma unroll
          for (int a = 0; a < 4; ++a) {
            float v4 = (s[kt][4 * a] + s[kt][4 * a + 1]) + (s[kt][4 * a + 2] + s[kt][4 * a + 3]), cy = s[kt][4 * a + 3];
            v4 += __shfl_xor(v4, 1); v4 += __shfl_xor(v4, 2); cy += __shfl_xor(cy, 1); cy += __shfl_xor(cy, 2);
            const int jj = 16 * i + 8 * kt + 2 * a + h;
            if (r4 == 0) { LAS float* ip = imp + (wid * 8 + tl) * 64 + jj; ip[0] += v4; }
            if (r4 == 0 && jj < 63) { LAS float* ip = imp + (wid * 8 + tl) * 64 + jj + 1; ip[0] += cy; }
          }
        nsa_pv(o, slot + NSA_KB, s, lane);
      } }
    { const float g0 = p.gates[trow * 24 + hg * 3];
#pragma unroll
      for (int r = 0; r < 16; ++r) { obuf[r * 64] = g0 * o[0][r]; obuf[(16 + r) * 64] = g0 * o[1][r]; o[0][r] = 0.f; o[1][r] = 0.f; } }
    unsigned long long U = 0ull, mym = 0ull;
    __builtin_amdgcn_s_waitcnt(0xc07f);
    for (int i2 = 0; i2 < 8; ++i2) {
      float v = imp[(wid * 8 + i2) * 64 + lane0];
      const bool forced = lane0 == 0 || lane0 == j0 || lane0 == j0 - 1;
      v = lane0 <= j0 ? (forced ? v + 1e4f : v) : -1.f;
      unsigned long long msk = 0ull;
      for (int k = 0; k < 8; ++k) {
        float bv = v; int bi = lane0;
#pragma unroll
        for (int of = 1; of < 64; of <<= 1) { const float ov = __shfl_xor(bv, of); const int oi = __shfl_xor(bi, of); if (ov > bv || (ov == bv && oi < bi)) { bv = ov; bi = oi; } }
        msk |= 1ull << bi; if (lane0 == bi) v = -INFINITY;
      }
      U |= msk; if (((lane0 & 31) >> 2) == i2) mym = msk;
    }
    float m = -1e30f, l = 0.f;
#define NSA_ONLINE(MINE, LOWPOS, JB) do { \
      f32x16 s[2]; nsa_qk(s, slot, qf, l31, h); \
      unsigned ok0 = 0u, ok1 = 0u; \
      _Pragma("unroll") for (int r = 0; r < 16; ++r) { const int pos = 64 * (JB) + (r & 3) + 8 * (r >> 2) + 4 * h; if ((MINE) && pos <= t && pos > (LOWPOS)) ok0 |= 1u << r; if ((MINE) && pos + 32 <= t && pos + 32 > (LOWPOS)) ok1 |= 1u << r; } \
      float mx = -1e30f; \
      _Pragma("unroll") for (int r = 0; r < 16; ++r) { if ((ok0 >> r) & 1u) mx = fmaxf(mx, s[0][r]); if ((ok1 >> r) & 1u) mx = fmaxf(mx, s[1][r]); } \
      mx = fmaxf(mx, __shfl_xor(mx, 32)); \
      const float mn = fmaxf(m, mx), alpha = fexp(m - mn); float rs = 0.f; \
      _Pragma("unroll") for (int r = 0; r < 16; ++r) { const float p0 = ((ok0 >> r) & 1u) ? fexp(s[0][r] - mn) : 0.f, p1 = ((ok1 >> r) & 1u) ? fexp(s[1][r] - mn) : 0.f; s[0][r] = p0; s[1][r] = p1; rs += p0 + p1; } \
      rs += __shfl_xor(rs, 32); \
      l = l * alpha + rs; m = mn; \
      _Pragma("unroll") for (int r = 0; r < 16; ++r) { o[0][r] *= alpha; o[1][r] *= alpha; } \
      nsa_pv(o, slot + NSA_KB, s, lane); } while (0)
    for (; it < itD; ++it) {
      NSA_STEP();
      const int j = it - itC;
      if ((U >> j) & 1ull) { const bool mine = (mym >> j) & 1ull; NSA_ONLINE(mine, -1, j); }
    }
    { const float f = p.gates[trow * 24 + hg * 3 + 1] / fmaxf(l, 1e-20f);
#pragma unroll
      for (int r = 0; r < 16; ++r) { obuf[r * 64] += f * o[0][r]; obuf[(16 + r) * 64] += f * o[1][r]; o[0][r] = 0.f; o[1][r] = 0.f; }
      m = -1e30f; l = 0.f; }
    for (; it < NI; ++it) {
      NSA_STEP();
      const int j = jw0 + it - itD;
      NSA_ONLINE(true, t - 512, j);
    }
#undef NSA_ONLINE
#undef NSA_STEP
#undef NSA_LOAD
    { const float f = p.gates[trow * 24 + hg * 3 + 2] / fmaxf(l, 1e-20f);
      bf16_t* orow = p.onsab + trow * 512 + hg * 64 + 4 * (lane0 >> 5);
#pragma unroll
      for (int dt = 0; dt < 2; ++dt)
#pragma unroll
        for (int a = 0; a < 4; ++a) { u32x2 w; const int r = 4 * a;
          w.x = pk2(obuf[(16 * dt + r) * 64] + f * o[dt][r], obuf[(16 * dt + r + 1) * 64] + f * o[dt][r + 1]); w.y = pk2(obuf[(16 * dt + r + 2) * 64] + f * o[dt][r + 2], obuf[(16 * dt + r + 3) * 64] + f * o[dt][r + 3]);
          *(u32x2*)(orow + dt * 32 + a * 8) = w; } }
    __syncthreads();
  }
}

template <class F>
__device__ __forceinline__ void d_gemm(const F& f, int bx, int by, char* smem, int tid) {
  float (*As)[68] = (float (*)[68])smem;
  float (*Bs)[68] = (float (*)[68])(smem + 16 * 68 * 4);
  int* rid = (int*)(smem + 2 * 16 * 68 * 4);
  const int mt = by, n0 = bx * 64;
  typename F::Tile ti;
  f.tile(mt, ti);
  if (tid < 64) rid[tid] = f.row(ti, tid);
  __syncthreads();
  float acc[4][4];
#pragma unroll
  for (int i = 0; i < 4; ++i)
#pragma unroll
    for (int j = 0; j < 4; ++j) acc[i][j] = 0.f;
  const int ty = tid >> 4, tx = tid & 15;
  const int ar = tid >> 2, ak = (tid & 3) * 4, bk = tid >> 4, bn = (tid & 15) * 4;
  const int arid = rid[ar];
  for (int k0 = 0; k0 < f.K; k0 += 16) {
#pragma unroll
    for (int i = 0; i < 4; ++i) As[ak + i][ar] = arid >= 0 ? f.a(ti, arid, k0 + ak + i) : 0.f;
#pragma unroll
    for (int j = 0; j < 4; ++j) { const int n = n0 + bn + j; Bs[bk][bn + j] = n < f.N ? f.b(ti, k0 + bk, n) : 0.f; }
    __syncthreads();
#pragma unroll
    for (int kk = 0; kk < 16; ++kk) {
      const float4 a = *(const float4*)&As[kk][ty * 4];
      const float4 b = *(const float4*)&Bs[kk][tx * 4];
      const float av[4] = {a.x, a.y, a.z, a.w}, bv[4] = {b.x, b.y, b.z, b.w};
#pragma unroll
      for (int i = 0; i < 4; ++i)
#pragma unroll
        for (int j = 0; j < 4; ++j) acc[i][j] += av[i] * bv[j];
    }
    __syncthreads();
  }
#pragma unroll
  for (int i = 0; i < 4; ++i) {
    const int r = rid[ty * 4 + i];
    if (r < 0) continue;
#pragma unroll
    for (int j = 0; j < 4; ++j) { const int n = n0 + tx * 4 + j; if (n < f.N) f.epi(ti, r, n, acc[i][j]); }
  }
}

struct DenseTile { int m0; };
struct FCmp1 {
  typedef DenseTile Tile; P p; int N, K; int col, pad; const float *pe, *w1; float* hid;
  __device__ bool tile(int mt, Tile& t) const { t.m0 = mt * 64; return true; }
  __device__ int row(const Tile& t, int i) const { const int r = t.m0 + i; return r < NCR ? r : -1; }
  __device__ float a(const Tile&, int r, int k) const {
    const int b = r / (2 * NC), g = (r / NC) & 1, c = r % NC, l = k >> 6, d = k & 63;
    return bf2f(p.projb[(size_t)(b * SEQ + 16 * c + l) * PJW + col + g * 64 + d]) + pe[k];
  }
  __device__ float b(const Tile&, int k, int n) const { return w1[k * 128 + n]; }
  __device__ void epi(const Tile&, int r, int n, float v) const { hid[r * 128 + n] = gelu_tanh(v); }
};
struct FCmp2 {
  typedef DenseTile Tile; P p; int N, K; const float *hid, *w2; float* outp;
  __device__ bool tile(int mt, Tile& t) const { t.m0 = mt * 64; return true; }
  __device__ int row(const Tile& t, int i) const { const int r = t.m0 + i; return r < NCR ? r : -1; }
  __device__ float a(const Tile&, int r, int k) const { return hid[r * 128 + k]; }
  __device__ float b(const Tile&, int k, int n) const { return w2[k * 64 + n]; }
  __device__ void epi(const Tile&, int r, int n, float v) const { outp[r * 64 + n] = v; }
};
__device__ __forceinline__ float ret_logg(int h) { return logf(1.f - exp2f(-5.f - (float)h)); }
struct RetTile { int chunk, i0, b, h, s0; };
__device__ __forceinline__ void ret_tile(int mt, RetTile& t) { t.chunk = mt >> 1; t.i0 = (mt & 1) * 64; const int bh = t.chunk >> 5; t.b = bh >> 2; t.h = bh & 3; t.s0 = (t.chunk & 31) * 128; }
struct FRet1 {
  typedef RetTile Tile; P p; int N, K;
  __device__ bool tile(int mt, Tile& t) const { ret_tile(mt, t); return true; }
  __device__ int row(const Tile& t, int i) const { return t.i0 + i; }
  __device__ float a(const Tile& t, int r, int k) const { return bf2f(p.projb[(size_t)(t.b * SEQ + t.s0 + r) * PJW + J_QR + t.h * 128 + k]); }
  __device__ float b(const Tile& t, int k, int n) const { return bf2f(p.projb[(size_t)(t.b * SEQ + t.s0 + n) * PJW + J_KR + t.h * 128 + k]); }
  __device__ void epi(const Tile& t, int r, int n, float v) const { p.Sc[((size_t)t.chunk * 128 + r) * 128 + n] = r >= n ? v * expf(ret_logg(t.h) * (float)(r - n)) : 0.f; }
};
struct FRet2 {
  typedef RetTile Tile; P p; int N, K;
  __device__ bool tile(int mt, Tile& t) const { ret_tile(mt, t); return true; }
  __device__ int row(const Tile& t, int i) const { return t.i0 + i; }
  __device__ float a(const Tile& t, int r, int k) const { return bf2f(p.projb[(size_t)(t.b * SEQ + t.s0 + k) * PJW + J_KR + t.h * 128 + r]) * expf(ret_logg(t.h) * (float)(127 - k)); }
  __device__ float b(const Tile& t, int k, int n) const { return bf2f(p.projb[(size_t)(t.b * SEQ + t.s0 + k) * PJW + J_VR + t.h * 128 + n]); }
  __device__ void epi(const Tile& t, int r, int n, float v) const { p.kv[((size_t)t.chunk * 128 + r) * 128 + n] = v; }
};
struct FRet3 {
  typedef RetTile Tile; P p; int N, K;
  __device__ bool tile(int mt, Tile& t) const { ret_tile(mt, t); return true; }
  __device__ int row(const Tile& t, int i) const { return t.i0 + i; }
  __device__ float a(const Tile& t, int r, int k) const {
    if (k < 128) return p.Sc[((size_t)t.chunk * 128 + r) * 128 + k];
    return bf2f(p.projb[(size_t)(t.b * SEQ + t.s0 + r) * PJW + J_QR + t.h * 128 + (k - 128)]) * expf(ret_logg(t.h) * (float)(r + 1));
  }
  __device__ float b(const Tile& t, int k, int n) const {
    if (k < 128) return bf2f(p.projb[(size_t)(t.b * SEQ + t.s0 + k) * PJW + J_VR + t.h * 128 + n]);
    return p.kv[((size_t)t.chunk * 128 + (k - 128)) * 128 + n];
  }
  __device__ void epi(const Tile& t, int r, int n, float v) const { p.retout[(size_t)(t.b * SEQ + t.s0 + r) * 512 + t.h * 128 + n] = v; }
};
__device__ __forceinline__ void d_rope_cmp(const P& p, int bx, int tid) {
  const int id = bx * 256 + tid;
  if (id >= NCR * 32) return;
  const int r = id >> 5, i = id & 31, b = r / (2 * NC), c = r % NC;
  const float inv = powf(10000.f, -(float)(2 * i) / 64.f);
  const float ang = (float)p.pos[b * SEQ + 16 * c + 31] * inv;
  float sn, cs; sincosf(ang, &sn, &cs);
  float* q = p.kcmp + r * 64;
  const float x1 = q[i], x2 = q[i + 32];
  const float y1 = x1 * cs - x2 * sn, y2 = x1 * sn + x2 * cs;
  q[i] = y1; q[i + 32] = y2;
  p.kcmpb[r * 64 + i] = (bf16_t)(pk2(y1, 0.f) & 0xffffu); p.kcmpb[r * 64 + i + 32] = (bf16_t)(pk2(y2, 0.f) & 0xffffu);
  p.vcmpb[r * 64 + i] = (bf16_t)(pk2(p.vcmp[r * 64 + i], 0.f) & 0xffffu); p.vcmpb[r * 64 + i + 32] = (bf16_t)(pk2(p.vcmp[r * 64 + i + 32], 0.f) & 0xffffu);
}

__device__ __forceinline__ void d_nsa(const P& p, int bx, int by, char* smem, int tid) {
  const int bt = bx, g = by, b = bt / SEQ, t = bt % SEQ;
  const int r = tid >> 6, lane = tid & 63, h = g * 4 + r;
  float (*qs)[64] = (float (*)[64])smem;
  float (*pc)[256] = (float (*)[256])(smem + 1024);
  float (*ps)[512] = (float (*)[512])(smem + 1024 + 4096);
  float* impv = (float*)(smem + 1024 + 4096 + 8192);
  int* sel = (int*)(smem + 1024 + 4096 + 8192 + 256);
  qs[r][lane] = bf2f(p.projb[(size_t)bt * PJW + J_QN + h * 64 + lane]);
  __syncthreads();
  float sc[4], mx = -1e30f;
#pragma unroll
  for (int i = 0; i < 4; ++i) {
    const int c = i * 64 + lane; float s = -1e30f;
    if (c < NC && 16 * c + 31 <= t) { const float* kr = p.kcmp + ((size_t)(b * 2 + g) * NC + c) * 64; float a = 0.f; for (int d = 0; d < 64; ++d) a += qs[r][d] * kr[d]; s = a; }
    sc[i] = s; mx = fmaxf(mx, s);
  }
  mx = wave_max(mx);
  float sum = 0.f;
#pragma unroll
  for (int i = 0; i < 4; ++i) { const int c = i * 64 + lane; const bool v = c < NC && 16 * c + 31 <= t; const float e = v ? expf(sc[i] - mx) : 0.f; sc[i] = e; sum += e; }
  sum = wave_sum(sum);
  float inv = 1.f / fmaxf(sum, 1e-20f);
#pragma unroll
  for (int i = 0; i < 4; ++i) pc[r][i * 64 + lane] = sc[i] * inv;
  __syncthreads();
  float oc = 0.f;
  { const int nv = t >= 31 ? min(NC, (t - 31) / 16 + 1) : 0;
    for (int c = 0; c < nv; ++c) oc += pc[r][c] * p.vcmp[((size_t)(b * 2 + g) * NC + c) * 64 + lane]; }
  if (tid < 64) {
    const int j = tid; float im = 0.f;
    const int c0 = max(0, 4 * j - 1), c1 = min(NC - 1, 4 * j + 3);
    for (int rr = 0; rr < 4; ++rr) for (int c = c0; c <= c1; ++c) im += pc[rr][c];
    const int cur = t >> 6; const bool valid = j * 64 <= t, forced = (j == 0) || (j == cur) || (j == cur - 1);
    impv[j] = valid ? im + (forced ? 1e4f : 0.f) : -1.f;
  }
  __syncthreads();
  if (tid == 0) {
    for (int k = 0; k < 8; ++k) { int best = 0; float bv = impv[0]; for (int j = 1; j < 64; ++j) if (impv[j] > bv) { bv = impv[j]; best = j; } sel[k] = best; impv[best] = -INFINITY; }
  }
  __syncthreads();
  float ss[8]; mx = -1e30f;
#pragma unroll
  for (int i = 0; i < 8; ++i) {
    const int q = sel[i] * 64 + lane; float s = -1e30f;
    if (q <= t) { const bf16_t* kr = p.projb + (size_t)(b * SEQ + q) * PJW + J_KS + g * 64; float a = 0.f; for (int d = 0; d < 64; ++d) a += qs[r][d] * bf2f(kr[d]); s = a; }
    ss[i] = s; mx = fmaxf(mx, s);
  }
  mx = wave_max(mx); sum = 0.f;
#pragma unroll
  for (int i = 0; i < 8; ++i) { const int q = sel[i] * 64 + lane; const float e = q <= t ? expf(ss[i] - mx) : 0.f; ss[i] = e; sum += e; }
  sum = wave_sum(sum); inv = 1.f / fmaxf(sum, 1e-20f);
#pragma unroll
  for (int i = 0; i < 8; ++i) ps[r][i * 64 + lane] = ss[i] * inv;
  __syncthreads();
  float os = 0.f;
  for (int i = 0; i < 8; ++i) { const int q0 = sel[i] * 64;
    for (int l = 0; l < 64; ++l) { const int q = q0 + l; if (q <= t) os += ps[r][i * 64 + l] * bf2f(p.projb[(size_t)(b * SEQ + q) * PJW + J_VS + g * 64 + lane]); } }
  __syncthreads();
  mx = -1e30f;
#pragma unroll
  for (int i = 0; i < 8; ++i) {
    const int q = t - 511 + i * 64 + lane; float s = -1e30f;
    if (q >= 0) { const bf16_t* kr = p.projb + (size_t)(b * SEQ + q) * PJW + J_KW + g * 64; float a = 0.f; for (int d = 0; d < 64; ++d) a += qs[r][d] * bf2f(kr[d]); s = a; }
    ss[i] = s; mx = fmaxf(mx, s);
  }
  mx = wave_max(mx); sum = 0.f;
#pragma unroll
  for (int i = 0; i < 8; ++i) { const int q = t - 511 + i * 64 + lane; const float e = q >= 0 ? expf(ss[i] - mx) : 0.f; ss[i] = e; sum += e; }
  sum = wave_sum(sum); inv = 1.f / fmaxf(sum, 1e-20f);
#pragma unroll
  for (int i = 0; i < 8; ++i) ps[r][i * 64 + lane] = ss[i] * inv;
  __syncthreads();
  float ow = 0.f;
  for (int i = 0; i < 512; ++i) { const int q = t - 511 + i; if (q >= 0) ow += ps[r][i] * bf2f(p.projb[(size_t)(b * SEQ + q) * PJW + J_VW + g * 64 + lane]); }
  const float* gp = p.gates + (size_t)bt * 24 + h * 3;
  p.onsa[(size_t)bt * 512 + h * 64 + lane] = gp[0] * oc + gp[1] * os + gp[2] * ow;
}

__device__ __forceinline__ void d_mixin(const P& p, int bx, int tid) {
  const int tok = bx * 4 + (tid >> 6), lane = tid & 63;
  float v[8], s = 0.f;
#pragma unroll
  for (int i = 0; i < 8; ++i) { v[i] = bf2f(p.onsab[(size_t)tok * 512 + i * 64 + lane]); s += v[i] * v[i]; }
  s = wave_sum(s);
  float r = rsqrtf(s * (1.f / 512.f) + EPS);
#pragma unroll
  for (int i = 0; i < 8; ++i) p.mixb[(size_t)tok * D + i * 64 + lane] = (bf16_t)(pk2(v[i] * r * p.g_nsa[i * 64 + lane], 0.f) & 0xffffu);
#pragma unroll
  for (int hh = 0; hh < 4; ++hh) {
    const float a = p.retout[(size_t)tok * 512 + hh * 128 + lane], b = p.retout[(size_t)tok * 512 + hh * 128 + 64 + lane];
    const float q = wave_sum(a * a + b * b);
    r = rsqrtf(q * (1.f / 128.f) + EPS);
    const bf16_t* gr = p.projb + (size_t)tok * PJW + J_GR + hh * 128;
    p.mixb[(size_t)tok * D + 512 + hh * 128 + lane] = (bf16_t)(pk2(bf2f(gr[lane]) * a * r * p.g_ret[hh * 128 + lane], 0.f) & 0xffffu);
    p.mixb[(size_t)tok * D + 512 + hh * 128 + 64 + lane] = (bf16_t)(pk2(bf2f(gr[64 + lane]) * b * r * p.g_ret[hh * 128 + 64 + lane], 0.f) & 0xffffu);
  }
}

__device__ __forceinline__ void d_ret_scan(const P& p, int bx, int tid) {
  const int id = bx * 256 + tid;
  const int bh = id >> 14, de = id & 16383, h = bh & 3;
  const float gc = expf(ret_logg(h) * 128.f);
  float st = 0.f;
  for (int n = 0; n < 32; ++n) { float* q = p.kv + ((size_t)(bh * 32 + n) * 16384 + de); const float kvn = *q; *q = st; st = st * gc + kvn; }
}

constexpr int NPHASE = 11;
#define FOR_VP(n) for (int vp = vcu; vp < ((n) + 1) / 2; vp += G)
#define VBI(n) (vp * 2 + hb < (n) ? vp * 2 + hb : (n) - 1)
#define NGEMM(FT, INIT, nx, ny) do { const FT f INIT; FOR_VP((nx) * (ny)) { const int vb = VBI((nx) * (ny)); d_gemm(f, vb % (nx), vb / (nx), smem, t256); __syncthreads(); } } while (0)
__global__ void __launch_bounds__(512) mega(P p, int lo, int hi) {
  extern __shared__ __attribute__((aligned(16))) char lds_raw[];
  lptr lds = (lptr)lds_raw;
  const int tid = threadIdx.x, G = gridDim.x, hb = tid >> 8, t256 = tid & 255;
  char* smem = lds_raw + hb * 16384;
  const int vcu = (G % 8 == 0) ? ((int)blockIdx.x % 8) * (G / 8) + (int)blockIdx.x / 8 : (int)blockIdx.x;
  if (tid < 32) ((LAS float*)(lds + LDS_INV64))[tid] = exp2f(-(float)(2 * tid) / 64.f * 13.287712379549449f) * 0.15915494309189535f;
  if (tid < 64) ((LAS float*)(lds + LDS_INV128))[tid] = exp2f(-(float)(2 * tid) / 128.f * 13.287712379549449f) * 0.15915494309189535f;
  if (tid < 4) ((LAS unsigned*)(lds + LDS_XB))[tid] = 0u;
  __syncthreads();
  XcdBarrier xb; xb.bar = p.bar; xb.x = 0; xb.st = (volatile LAS unsigned*)(lds + LDS_XB);
  if (hi - lo > 1) xb = xcd_barrier_post(p.bar, (volatile LAS unsigned*)(lds + LDS_XB));
#define PH(k, call) if (lo <= (k) && (k) < hi) { call; if ((k) + 1 < hi) xcd_barrier(xb); }
  PH(0, phase0a(p, lds, vcu, G));
  PH(1, phase0b(p, lds, vcu, G));
  PH(2, phase1(p, lds, vcu, G));
  PH(3, { NGEMM(FCmp1, ({p, 128, 2048, J_KC, 0, p.cpk, p.cw1k, p.hidk}), 2, 32); NGEMM(FCmp1, ({p, 128, 2048, J_VC, 0, p.cpv, p.cw1v, p.hidv}), 2, 32);
          NGEMM(FRet1, ({p, 128, 128}), 2, 1024); NGEMM(FRet2, ({p, 128, 128}), 2, 1024); });
  PH(4, { NGEMM(FCmp2, ({p, 64, 128, p.hidk, p.cw2k, p.kcmp}), 1, 32); NGEMM(FCmp2, ({p, 64, 128, p.hidv, p.cw2v, p.vcmp}), 1, 32);
          FOR_VP(16 * 16384 / 256) d_ret_scan(p, VBI(16 * 16384 / 256), t256); });
  PH(5, { FOR_VP((NCR * 32 + 255) / 256) d_rope_cmp(p, VBI((NCR * 32 + 255) / 256), t256); NGEMM(FRet3, ({p, 128, 256}), 2, 1024); });
  PH(6, phase_nsa(p, lds, vcu, G));
  PH(7, { FOR_VP(T / 4) d_mixin(p, VBI(T / 4), t256); });
  PH(8, phase5(p, lds, vcu, G));
  PH(9, phase6(p, lds, vcu, G));
  PH(10, phase7(p, lds, vcu, G));
#undef PH
}
}

extern "C" void kernel_launch(void* const* d_in, const int* in_sizes, int n_in, void* d_out, int out_size, void* d_ws, size_t ws_size, hipStream_t stream) {
  P p{};
  p.x = (const float*)d_in[0]; p.c = (const float*)d_in[1]; p.pos = (const int*)d_in[2];
  p.w_ada = (const float*)d_in[3]; p.b_ada = (const float*)d_in[4]; p.g_mix = (const float*)d_in[5]; p.w_in = (const float*)d_in[6];
  p.cpk = (const float*)d_in[7]; p.cw1k = (const float*)d_in[8]; p.cw2k = (const float*)d_in[9];
  p.cpv = (const float*)d_in[10]; p.cw1v = (const float*)d_in[11]; p.cw2v = (const float*)d_in[12];
  p.g_nsa = (const float*)d_in[13]; p.g_ret = (const float*)d_in[14]; p.w_out = (const float*)d_in[15]; p.g_ffn = (const float*)d_in[16];
  p.w_router = (const float*)d_in[17]; p.rbias = (const float*)d_in[18]; p.wg_e = (const float*)d_in[19]; p.wu_e = (const float*)d_in[20];
  p.wd_e = (const float*)d_in[21]; p.wg_s = (const float*)d_in[22]; p.wu_s = (const float*)d_in[23]; p.wd_s = (const float*)d_in[24];
  p.g_final = (const float*)d_in[25];
  p.out = (float*)d_out;
  char* w = (char*)d_ws; size_t off = 0;
  auto take = [&](size_t bytes) { char* r = w + off; off += (bytes + 255) & ~(size_t)255; return r; };
  p.bar = (unsigned*)take(XCD_BAR_WORDS * 4);
  p.cnt = (int*)take(NE * 4);
  const size_t zero_bytes = off;
  p.mod = (float*)take(BATCH * 6144 * 4);
  p.hidk = (float*)take(2048 * 128 * 4); p.hidv = (float*)take(2048 * 128 * 4);
  p.kcmp = (float*)take(2048 * 64 * 4); p.vcmp = (float*)take(2048 * 64 * 4);
  p.onsa = (float*)take((size_t)T * 512 * 4);
  p.Sc = (float*)take((size_t)512 * 16384 * 4); p.kv = (float*)take((size_t)512 * 16384 * 4);
  p.retout = (float*)take((size_t)T * 512 * 4);
  p.x1 = (float*)take((size_t)T * D * 4);
  p.wts = (float*)take((size_t)T * 8 * 4);
  p.list = (int*)take((size_t)NE * ECAP * 4);
  p.gates = (float*)take((size_t)T * 24 * 4);
  p.winb = (bf16_t*)take((size_t)D * INW * 2); p.woutb = (bf16_t*)take((size_t)D * D * 2); p.wrb = (bf16_t*)take((size_t)D * NE * 2);
  p.wgsb = (bf16_t*)take((size_t)D * 256 * 2); p.wusb = (bf16_t*)take((size_t)D * 256 * 2); p.wdsb = (bf16_t*)take((size_t)256 * D * 2);
  p.cw1kb = (bf16_t*)take(2048 * 128 * 2); p.cw1vb = (bf16_t*)take(2048 * 128 * 2); p.cw2kb = (bf16_t*)take(128 * 64 * 2); p.cw2vb = (bf16_t*)take(128 * 64 * 2);
  p.hb = (bf16_t*)take((size_t)T * D * 2);
  p.projb = (bf16_t*)take((size_t)T * PJW * 2);
  p.mixb = (bf16_t*)take((size_t)T * D * 2); p.h2b = (bf16_t*)take((size_t)T * D * 2);
  p.slab = (bf16_t*)take((size_t)T * 8 * D * 2);
  p.kcmpb = (bf16_t*)take((2048 + 64) * 64 * 2); p.vcmpb = (bf16_t*)take((2048 + 64) * 64 * 2);
  p.onsab = (bf16_t*)take((size_t)T * 512 * 2);
  if (off > ws_size) { fprintf(stderr, "kernel_launch: workspace too small: need %zu have %zu\n", off, ws_size); return; }
  static int grid = 0;
  if (!grid) {
    int dev = 0, cus = 0, per_cu = 0;
    (void)hipGetDevice(&dev);
    (void)hipDeviceGetAttribute(&cus, hipDeviceAttributeMultiprocessorCount, dev);
    (void)hipFuncSetAttribute((const void*)mega, hipFuncAttributeMaxDynamicSharedMemorySize, LDS_BYTES);
    (void)hipOccupancyMaxActiveBlocksPerMultiprocessor(&per_cu, (const void*)mega, 512, LDS_BYTES);
    if (per_cu < 1) fprintf(stderr, "kernel_launch: occupancy query says %d blocks per CU\n", per_cu);
    grid = cus;
  }
  (void)hipMemsetAsync(d_ws, 0, zero_bytes, stream);
  hipLaunchKernelGGL(mega, dim3(grid), dim3(512), LDS_BYTES, stream, p, 0, NPHASE);
}
```

```cpp
#include <hip/hip_runtime.h>
#include <cstdint>
#include <cstdio>

namespace {
constexpr int D = 1024, BATCH = 4, SEQ = 4096, T = BATCH * SEQ;
constexpr int INW = 3352;
constexpr int C_QN = 0, C_KC = 512, C_VC = 640, C_KS = 768, C_VS = 896, C_KW = 1024, C_VW = 1152, C_GN = 1280,
              C_QR = 1304, C_KR = 1816, C_VR = 2328, C_GR = 2840;
constexpr int PJW = 3328, J_QN = 0, J_KC = 512, J_VC = 640, J_KS = 768, J_VS = 896, J_KW = 1024, J_VW = 1152, J_QR = 1280, J_KR = 1792, J_VR = 2304, J_GR = 2816;
constexpr int NC = 255, NCR = BATCH * 2 * NC;
constexpr int NE = 256, ECAP = 16384;
constexpr float EPS = 1e-6f;
typedef unsigned short bf16_t;

struct P {
  const float *x, *c; const int* pos;
  const float *w_ada, *b_ada, *g_mix, *w_in, *cpk, *cw1k, *cw2k, *cpv, *cw1v, *cw2v, *g_nsa, *g_ret, *w_out, *g_ffn,
      *w_router, *rbias, *wg_e, *wu_e, *wd_e, *wg_s, *wu_s, *wd_s, *g_final;
  float* out;
  float *mod, *h, *proj, *hidk, *hidv, *kcmp, *vcmp, *onsa, *Sc, *kv, *retout, *mixin, *x1, *logits, *wts, *Gs, *acts,
      *G, *act, *yacc, *gates;
  int *cnt, *list, *tile_e, *tile_off, *ntiles;
  bf16_t *winb, *woutb, *wrb, *wgsb, *wusb, *wdsb, *cw1kb, *cw1vb, *cw2kb, *cw2vb, *hb, *projb, *mixb, *h2b, *slab, *kcmpb, *vcmpb, *onsab, *stateb;
  float *hidp;
  unsigned* bar;
};

#define LAS __attribute__((address_space(3)))
typedef LAS char* lptr;
typedef short bf16x8 __attribute__((ext_vector_type(8)));
typedef short v4i16_t __attribute__((ext_vector_type(4)));
typedef float f32x16 __attribute__((ext_vector_type(16)));
typedef float f32x4 __attribute__((ext_vector_type(4)));
typedef float f32x2_t __attribute__((ext_vector_type(2)));
typedef __bf16 bf16x2_t __attribute__((ext_vector_type(2)));
typedef unsigned u32x4 __attribute__((ext_vector_type(4)));
typedef unsigned u32x2 __attribute__((ext_vector_type(2)));

__device__ __forceinline__ float wave_sum(float v) {
#pragma unroll
  for (int o = 1; o < 64; o <<= 1) v += __shfl_xor(v, o);
  return v;
}
__device__ __forceinline__ float wave_max(float v) {
#pragma unroll
  for (int o = 1; o < 64; o <<= 1) v = fmaxf(v, __shfl_xor(v, o));
  return v;
}
__device__ __forceinline__ float silu(float v) { return v / (1.f + expf(-v)); }
__device__ __forceinline__ float sigm(float v) { return 1.f / (1.f + expf(-v)); }
__device__ __forceinline__ float gelu_tanh(float v) { return 0.5f * v * (1.f + tanhf(0.7978845608028654f * (v + 0.044715f * v * v * v))); }
__device__ __forceinline__ unsigned pk2(float lo, float hi) { f32x2_t v = {lo, hi}; bf16x2_t b = __builtin_convertvector(v, bf16x2_t); return __builtin_bit_cast(unsigned, b); }
__device__ __forceinline__ float bf2f(bf16_t u) { return __uint_as_float((unsigned)u << 16); }
__device__ __forceinline__ float bflo(unsigned u) { return __uint_as_float(u << 16); }
__device__ __forceinline__ float bfhi(unsigned u) { return __uint_as_float(u & 0xffff0000u); }

#define XB_TMO      128
#define XB_XCNT(j)  (256  + 64 * (j))
#define XB_XSUB(j)  (1280 + 64 * (j))
#define XB_XGEN(j)  (2304 + 64 * (j))
#define XB_TOP      3328
#define XB_TOPGEN   3392
#define XCD_BAR_WORDS 3456
#define XB_SPIN_CAP (1u << 18)
__device__ __forceinline__ unsigned xb_ld(unsigned* p)              { return __hip_atomic_load(p, __ATOMIC_RELAXED, __HIP_MEMORY_SCOPE_AGENT); }
__device__ __forceinline__ unsigned xb_add(unsigned* p, unsigned v) { return __hip_atomic_fetch_add(p, v, __ATOMIC_RELAXED, __HIP_MEMORY_SCOPE_AGENT); }
__device__ __forceinline__ unsigned xb_xcc_id() { return (unsigned)__builtin_amdgcn_s_getreg((3 << 11) | 20) & 0xFu; }
#define XB_SPIN(cond, bar) do { unsigned _sp = 0; while (cond) { __builtin_amdgcn_s_sleep(1); \
    if ((++_sp & 255u) == 0u) { if (xb_ld(&(bar)[XB_TMO])) break; if (_sp > XB_SPIN_CAP) { atomicAdd(&(bar)[XB_TMO], 1u); break; } } } } while (0)
struct XcdBarrier { unsigned* bar; unsigned x; volatile LAS unsigned* st; };
__device__ __forceinline__ XcdBarrier xcd_barrier_post(unsigned* bar, volatile LAS unsigned* st) {
    XcdBarrier b; b.bar = bar; b.x = xb_xcc_id(); b.st = st;
    if (threadIdx.x == 0) (void)xb_add(&bar[XB_XCNT(b.x)], 1u);
    return b;
}
__device__ __forceinline__ void xcd_barrier_complete(unsigned* bar, unsigned x, unsigned& nloc, unsigned& nx) {
    const unsigned G = gridDim.x * gridDim.y * gridDim.z;
    unsigned sum, cnt, mine, sp = 0u;
    for (;;) {
        sum = 0u; cnt = 0u; mine = 0u;
#pragma unroll
        for (unsigned j = 0; j < 16; ++j) { const unsigned c = xb_ld(&bar[XB_XCNT(j)]); sum += c; cnt += (c > 0u) ? 1u : 0u; mine = (j == x) ? c : mine; }
        if (sum == G) break;
        __builtin_amdgcn_s_sleep(1);
        if ((++sp & 255u) == 0u) { if (xb_ld(&bar[XB_TMO])) break; if (sp > XB_SPIN_CAP) { atomicAdd(&bar[XB_TMO], 1u); break; } }
    }
    nloc = mine > 0u ? mine : 1u; nx = cnt > 0u ? cnt : 1u;
}
__device__ __forceinline__ void xcd_barrier(const XcdBarrier& b) {
    asm volatile("s_waitcnt vmcnt(0)" ::: "memory");
    __syncthreads();
    if (threadIdx.x == 0) {
        unsigned* bar = b.bar;
        __builtin_amdgcn_s_waitcnt(0);
        unsigned nloc = b.st[0], nx = b.st[1];
        if (nloc == 0u) { xcd_barrier_complete(bar, b.x, nloc, nx); b.st[0] = nloc; b.st[1] = nx; }
        const unsigned old = xb_add(&bar[XB_XSUB(b.x)], 1u);
        const unsigned gen = old / nloc;
        if (old + 1u == (gen + 1u) * nloc) {
            __builtin_amdgcn_fence(__ATOMIC_RELEASE, "agent");
            asm volatile("s_waitcnt vmcnt(0)" ::: "memory");
            const unsigned og = xb_add(&bar[XB_TOP], 1u);
            const unsigned tg = og / nx;
            if (og + 1u == (tg + 1u) * nx) xb_add(&bar[XB_TOPGEN], 1u);
            else XB_SPIN(xb_ld(&bar[XB_TOPGEN]) == tg, bar);
            __builtin_amdgcn_fence(__ATOMIC_ACQUIRE, "agent");
            xb_add(&bar[XB_XGEN(b.x)], 1u);
            asm volatile("s_waitcnt vmcnt(0)" ::: "memory");
        } else {
            XB_SPIN(xb_ld(&bar[XB_XGEN(b.x)]) == gen, bar);
            __builtin_amdgcn_fence(__ATOMIC_ACQUIRE, "agent");
            asm volatile("s_waitcnt vmcnt(0)" ::: "memory");
        }
    }
    __syncthreads();
}

__device__ __forceinline__ bf16x8 frag_kmaj(lptr img, int rs, int o, int s, int lane) {
  const int h = lane >> 5, blk = (lane >> 4) & 1, q = (lane & 15) >> 2, pp = lane & 3;
  lptr a = img + (16 * s + 8 * h + q) * rs + (o + 16 * blk + 4 * pp) * 2;
  const v4i16_t lo = __builtin_amdgcn_ds_read_tr16_b64_v4i16((LAS v4i16_t*)a);
  const v4i16_t hi = __builtin_amdgcn_ds_read_tr16_b64_v4i16((LAS v4i16_t*)(a + 4 * rs));
  return (bf16x8){lo[0], lo[1], lo[2], lo[3], hi[0], hi[1], hi[2], hi[3]};
}
__device__ __forceinline__ bf16x8 frag_kmin(lptr img, int o, int s, int lane) {
  const int row = o + (lane & 31), c = 2 * s + (lane >> 5);
  return *(LAS bf16x8*)(img + row * 64 + ((c ^ ((row >> 2) & 3)) << 4));
}
__device__ __forceinline__ int kmin_off(int row, int c) { return row * 64 + ((c ^ ((row >> 2) & 3)) << 4); }

template <int TM, int TN, bool WKMAJ, bool XKMAJ>
__device__ __forceinline__ void mma_step(f32x16 (&acc)[TM][TN], lptr wimg, int wrs, int wn0, lptr ximg, int xrs, int xt0, int lane) {
#pragma unroll
  for (int s = 0; s < 2; ++s) {
    bf16x8 wf[TM], xf[TN];
#pragma unroll
    for (int tm = 0; tm < TM; ++tm) wf[tm] = WKMAJ ? frag_kmaj(wimg, wrs, wn0 + 32 * tm, s, lane) : frag_kmin(wimg, wn0 + 32 * tm, s, lane);
#pragma unroll
    for (int tn = 0; tn < TN; ++tn) xf[tn] = XKMAJ ? frag_kmaj(ximg, xrs, xt0 + 32 * tn, s, lane) : frag_kmin(ximg, xt0 + 32 * tn, s, lane);
#pragma unroll
    for (int tm = 0; tm < TM; ++tm)
#pragma unroll
      for (int tn = 0; tn < TN; ++tn) acc[tm][tn] = __builtin_amdgcn_mfma_f32_32x32x16_bf16(wf[tm], xf[tn], acc[tm][tn], 0, 0, 0);
    if (s == 0) __builtin_amdgcn_sched_barrier(0);
  }
}

template <int BNT> struct WRegB16 { u32x4 r[BNT / 128]; };
template <int BNT> __device__ __forceinline__ void wload_b16(WRegB16<BNT>& R, const bf16_t* src  , int ld, int tid) {
  constexpr int C8 = BNT / 8, KPR = 512 / C8;
  const int c8 = tid % C8, kr = tid / C8;
#pragma unroll
  for (int r = 0; r < BNT / 128; ++r) R.r[r] = *(const u32x4*)(src + (size_t)(kr + r * KPR) * ld + c8 * 8);
}
template <int BNT> __device__ __forceinline__ void wstore_b16(const WRegB16<BNT>& R, lptr img, int rs, int tid) {
  constexpr int C8 = BNT / 8, KPR = 512 / C8;
  const int c8 = tid % C8, kr = tid / C8;
#pragma unroll
  for (int r = 0; r < BNT / 128; ++r) *(LAS u32x4*)(img + (kr + r * KPR) * rs + c8 * 16) = R.r[r];
}
template <int BMT> struct XRegB16 { u32x4 r[(BMT + 127) / 128]; };
template <int BMT> __device__ __forceinline__ void xload_b16(XRegB16<BMT>& R, const bf16_t* const (&rowp)[(BMT + 127) / 128], int k0, int tid) {
#pragma unroll
  for (int r = 0; r < (BMT + 127) / 128; ++r) if (BMT >= 128 || tid < BMT * 4) R.r[r] = *(const u32x4*)(rowp[r] + k0 + (tid & 3) * 8);
}
template <int BMT> __device__ __forceinline__ void xstore_b16(const XRegB16<BMT>& R, lptr img, int tid) {
#pragma unroll
  for (int r = 0; r < (BMT + 127) / 128; ++r) if (BMT >= 128 || tid < BMT * 4) *(LAS u32x4*)(img + kmin_off((tid >> 2) + 128 * r, tid & 3)) = R.r[r];
}

template <int BNT> struct WLb16 {
  typedef WRegB16<BNT> Regs; const bf16_t* src; int ld;
  __device__ __forceinline__ void load(Regs& R, int k0, int tid) const { wload_b16<BNT>(R, src + (size_t)k0 * ld, ld, tid); }
  __device__ __forceinline__ void store(const Regs& R, lptr img, int rs, int tid) const { wstore_b16<BNT>(R, img, rs, tid); }
};
struct WLgu {
  typedef WRegB16<512> Regs; const bf16_t *g, *u;
  __device__ __forceinline__ void load(Regs& R, int k0, int tid) const {
    const int c8 = tid & 63, kr = tid >> 6, col = c8 * 8, grp = col >> 6, w = col & 63;
    const unsigned long long ga = (unsigned long long)g, ua = (unsigned long long)u;
    const bf16_t* s = (const bf16_t*)(w < 32 ? ga : ua) + grp * 32 + (w & 31);
#pragma unroll
    for (int r = 0; r < 4; ++r) R.r[r] = *(const u32x4*)(s + (size_t)(k0 + kr + r * 8) * 256);
  }
  __device__ __forceinline__ void store(const Regs& R, lptr img, int rs, int tid) const { wstore_b16<512>(R, img, rs, tid); }
};
struct WReg32x8 { f32x4 r[8]; };
__device__ __forceinline__ void wstore_f32_512(const WReg32x8& R, lptr img, int rs, int tid) {
  const int c4 = tid & 127, kr = tid >> 7;
#pragma unroll
  for (int r = 0; r < 8; ++r) { u32x2 o; o.x = pk2(R.r[r].x, R.r[r].y); o.y = pk2(R.r[r].z, R.r[r].w); *(LAS u32x2*)(img + (kr + 4 * r) * rs + c4 * 8) = o; }
}
struct WLf32 {
  typedef WReg32x8 Regs; const float* src; int ld;
  __device__ __forceinline__ void load(Regs& R, int k0, int tid) const {
    const float* s = src + (size_t)(k0 + (tid >> 7)) * ld + (tid & 127) * 4;
#pragma unroll
    for (int r = 0; r < 8; ++r) R.r[r] = *(const f32x4*)(s + (size_t)(4 * r) * ld);
  }
  __device__ __forceinline__ void store(const Regs& R, lptr img, int rs, int tid) const { wstore_f32_512(R, img, rs, tid); }
};
struct WLf32gu {
  typedef WReg32x8 Regs; const float *g, *u;
  __device__ __forceinline__ void load(Regs& R, int k0, int tid) const {
    const int col = (tid & 127) * 4, grp = col >> 7, w = col & 127;
    const unsigned long long ga = (unsigned long long)g, ua = (unsigned long long)u;
    const float* s = (const float*)(w < 64 ? ga : ua) + (size_t)(k0 + (tid >> 7)) * 256 + grp * 64 + (w & 63);
#pragma unroll
    for (int r = 0; r < 8; ++r) R.r[r] = *(const f32x4*)(s + (size_t)(4 * r) * 256);
  }
  __device__ __forceinline__ void store(const Regs& R, lptr img, int rs, int tid) const { wstore_f32_512(R, img, rs, tid); }
};
template <int BMT> struct XLrows {
  typedef XRegB16<BMT> Regs; const bf16_t* rowp[(BMT + 127) / 128]; lptr ximg;
  __device__ __forceinline__ void load(Regs& R, int k0, int tid) const { xload_b16<BMT>(R, rowp, k0, tid); }
  __device__ __forceinline__ void store(const Regs& R, int tid) const { xstore_b16<BMT>(R, ximg, tid); }
  __device__ __forceinline__ lptr img(int) const { return ximg; }
};
struct XLres {
  struct Regs {}; lptr base; int bytes;
  __device__ __forceinline__ void load(Regs&, int, int) const {}
  __device__ __forceinline__ void store(const Regs&, int) const {}
  __device__ __forceinline__ lptr img(int k0) const { return base + (k0 >> 5) * bytes; }
};
template <int TM, int TN, class WL, class XL, bool WK = true, bool XK = false>
__device__ __forceinline__ void gemm_loop(f32x16 (&acc)[TM][TN], int K, const WL& wl, const XL& xl, lptr wimg, int wrs, int wn0, int xt0, int tid, int lane, int xrs = 0) {
  asm volatile("" : "+v"(tid), "+v"(lane));
  typename WL::Regs wr; typename XL::Regs xr;
  wl.load(wr, 0, tid); xl.load(xr, 0, tid);
  for (int k0 = 0; k0 < K; k0 += 32) {
    wl.store(wr, wimg, wrs, tid); xl.store(xr, tid);
    __syncthreads();
    if (k0 + 32 < K) { wl.load(wr, k0 + 32, tid); xl.load(xr, k0 + 32, tid); }
    mma_step<TM, TN, WK, XK>(acc, wimg, wrs, wn0, xl.img(k0), xrs, xt0, lane);
    __syncthreads();
  }
}
template <int TM, int TN> __device__ __forceinline__ void acc_zero(f32x16 (&acc)[TM][TN]) {
#pragma unroll
  for (int a = 0; a < TM; ++a)
#pragma unroll
    for (int b = 0; b < TN; ++b)
#pragma unroll
      for (int r = 0; r < 16; ++r) acc[a][b][r] = 0.f;
}

constexpr int LDS_INV64 = 150 * 1024, LDS_INV128 = LDS_INV64 + 128, LDS_XB = LDS_INV128 + 256, LDS_BYTES = 152 * 1024;

__device__ __forceinline__ void cvt_items(const float* src, bf16_t* dst, size_t n8, int gtid, int gthreads) {
  for (size_t i = gtid; i < n8; i += gthreads) {
    const f32x4 a = *(const f32x4*)(src + i * 8), b = *(const f32x4*)(src + i * 8 + 4);
    u32x4 o; o.x = pk2(a.x, a.y); o.y = pk2(a.z, a.w); o.z = pk2(b.x, b.y); o.w = pk2(b.z, b.w);
    *(u32x4*)(dst + i * 8) = o;
  }
}
__device__ __forceinline__ void phase0a(const P& p, lptr lds, int vcu, int G) {
  const int tid = threadIdx.x, wid = tid >> 6, lane = tid & 63;
  if (vcu < 96) {
    const int j = vcu * 64 + lane;
    float a0 = 0.f, a1 = 0.f, a2 = 0.f, a3 = 0.f;
    for (int k = wid * 128; k < wid * 128 + 128; ++k) {
      const float w = p.w_ada[(size_t)k * 6144 + j];
      a0 += silu(p.c[k]) * w; a1 += silu(p.c[D + k]) * w; a2 += silu(p.c[2 * D + k]) * w; a3 += silu(p.c[3 * D + k]) * w;
    }
    LAS float* part = (LAS float*)lds;
    part[(wid * 4 + 0) * 64 + lane] = a0; part[(wid * 4 + 1) * 64 + lane] = a1; part[(wid * 4 + 2) * 64 + lane] = a2; part[(wid * 4 + 3) * 64 + lane] = a3;
    __syncthreads();
    if (wid < 4) { float s = p.b_ada[j];
#pragma unroll
      for (int w = 0; w < 8; ++w) s += part[(w * 4 + wid) * 64 + lane];
      p.mod[wid * 6144 + j] = s; }
    __syncthreads();
  }
  const int gtid = vcu * 512 + tid, gth = G * 512;
  cvt_items(p.w_in, p.winb, (size_t)D * INW / 8, gtid, gth);
  cvt_items(p.w_out, p.woutb, (size_t)D * D / 8, gtid, gth);
  cvt_items(p.w_router, p.wrb, (size_t)D * NE / 8, gtid, gth);
  cvt_items(p.wg_s, p.wgsb, (size_t)D * 256 / 8, gtid, gth);
  cvt_items(p.wu_s, p.wusb, (size_t)D * 256 / 8, gtid, gth);
  cvt_items(p.wd_s, p.wdsb, (size_t)256 * D / 8, gtid, gth);
  cvt_items(p.cw1k, p.cw1kb, (size_t)2048 * 128 / 8, gtid, gth);
  cvt_items(p.cw1v, p.cw1vb, (size_t)2048 * 128 / 8, gtid, gth);
  cvt_items(p.cw2k, p.cw2kb, (size_t)128 * 64 / 8, gtid, gth);
  cvt_items(p.cw2v, p.cw2vb, (size_t)128 * 64 / 8, gtid, gth);
}

__device__ __forceinline__ void phase0b(const P& p, lptr lds, int vcu, int G) {
  const int tid = threadIdx.x, wid = tid >> 6, lane = tid & 63;
  LAS float* wg = (LAS float*)lds;
  for (int i = tid; i < D * 24; i += 512) wg[i] = p.w_in[(size_t)(i / 24) * INW + C_GN + (i % 24)];
  __syncthreads();
  for (int row = vcu * 8 + wid; row < T; row += G * 8) {
    const int b = row / SEQ;
    f32x4 v[4]; float s = 0.f;
#pragma unroll
    for (int j = 0; j < 4; ++j) { v[j] = *(const f32x4*)(p.x + (size_t)row * D + j * 256 + lane * 4); s += v[j].x * v[j].x + v[j].y * v[j].y + v[j].z * v[j].z + v[j].w * v[j].w; }
    s = wave_sum(s);
    const float r = rsqrtf(s * (1.f / D) + EPS);
    f32x4 y[4];
#pragma unroll
    for (int j = 0; j < 4; ++j) {
      const int k = j * 256 + lane * 4;
      const f32x4 g = *(const f32x4*)(p.g_mix + k), sc = *(const f32x4*)(p.mod + b * 6144 + 1024 + k), sh = *(const f32x4*)(p.mod + b * 6144 + k);
      y[j].x = v[j].x * r * g.x * (1.f + sc.x) + sh.x; y[j].y = v[j].y * r * g.y * (1.f + sc.y) + sh.y;
      y[j].z = v[j].z * r * g.z * (1.f + sc.z) + sh.z; y[j].w = v[j].w * r * g.w * (1.f + sc.w) + sh.w;
      u32x2 o; o.x = pk2(y[j].x, y[j].y); o.y = pk2(y[j].z, y[j].w);
      *(u32x2*)(p.hb + (size_t)row * D + k) = o;
    }
#pragma unroll
    for (int half = 0; half < 2; ++half) {
      float ga[12];
#pragma unroll
      for (int q = 0; q < 12; ++q) ga[q] = 0.f;
#pragma unroll
      for (int j = 0; j < 4; ++j) {
        const float yy[4] = {y[j].x, y[j].y, y[j].z, y[j].w};
#pragma unroll
        for (int e = 0; e < 4; ++e) {
          const LAS f32x4* wr = (const LAS f32x4*)(wg + (j * 256 + lane * 4 + e) * 24 + half * 12);
#pragma unroll
          for (int q4 = 0; q4 < 3; ++q4) { const f32x4 w = wr[q4]; ga[q4 * 4] += yy[e] * w.x; ga[q4 * 4 + 1] += yy[e] * w.y; ga[q4 * 4 + 2] += yy[e] * w.z; ga[q4 * 4 + 3] += yy[e] * w.w; }
          __builtin_amdgcn_sched_barrier(0);
        }
      }
#pragma unroll
      for (int q = 0; q < 12; ++q) { const float t = wave_sum(ga[q]); if (lane == q) p.gates[(size_t)row * 24 + half * 12 + q] = sigm(t); __builtin_amdgcn_sched_barrier(0); }
    }
  }
  __syncthreads();
}

#define ROPE_PAIR(X1, X2, posf, invrev, sc) do { float pf_ = (posf); asm volatile("" : "+v"(pf_)); const float fr_ = __builtin_amdgcn_fractf(pf_ * (invrev)); \
    const float sn_ = __builtin_amdgcn_sinf(fr_), cs_ = __builtin_amdgcn_cosf(fr_); const float a_ = (X1), b_ = (X2); \
    float o1_ = (a_ * cs_ - b_ * sn_) * (sc), o2_ = (a_ * sn_ + b_ * cs_) * (sc); asm volatile("" : "+v"(o1_), "+v"(o2_)); (X1) = o1_; (X2) = o2_; } while (0)
__device__ __forceinline__ void phase1(const P& p, lptr lds, int vcu, int G) {
  const int tid = threadIdx.x, wid = __builtin_amdgcn_readfirstlane(tid >> 6), lane = tid & 63, wn = wid >> 2, wt = wid & 3, h = lane >> 5;
  constexpr int WRS = 256 * 2 + 64;
  lptr wimg = lds, ximg = lds + 32 * WRS;
  const LAS float* inv64 = (const LAS float*)(lds + LDS_INV64);
  const LAS float* inv128 = (const LAS float*)(lds + LDS_INV128);
  for (int u = vcu; u < 13 * 64; u += G) {
    const int j = u % 13, mt = u / 13, t0 = mt * 256;
    const int wcol = j < 5 ? j * 256 : C_QR + (j - 5) * 256;
    const bf16_t* wsrc = p.winb + wcol;
    const bf16_t* rowp[2] = {p.hb + (size_t)(t0 + (tid >> 2)) * D, p.hb + (size_t)(t0 + 128 + (tid >> 2)) * D};
    f32x16 acc[4][2];
#pragma unroll
    for (int a = 0; a < 4; ++a)
#pragma unroll
      for (int b = 0; b < 2; ++b)
#pragma unroll
        for (int r = 0; r < 16; ++r) acc[a][b][r] = 0.f;
    WRegB16<256> wr; XRegB16<256> xr;
    wload_b16<256>(wr, wsrc, INW, tid); xload_b16<256>(xr, rowp, 0, tid);
    for (int k0 = 0; k0 < D; k0 += 32) {
      wstore_b16<256>(wr, wimg, WRS, tid); xstore_b16<256>(xr, ximg, tid);
      __syncthreads();
      if (k0 + 32 < D) { wload_b16<256>(wr, wsrc + (size_t)(k0 + 32) * INW, INW, tid); xload_b16<256>(xr, rowp, k0 + 32, tid); }
      mma_step<4, 2, true, false>(acc, wimg, WRS, wn * 128, ximg, 0, wt * 64, lane);
      __syncthreads();
    }
    const int kind = (j < 2) ? 0 : (j == 2) ? 3 : (j < 5) ? (wn == 0 ? 1 : 3) : (j < 7) ? 2 : (j < 9) ? 4 : (j < 11) ? 3 : 5;
#pragma unroll
    for (int tn = 0; tn < 2; ++tn) {
      const int tok = t0 + wt * 64 + tn * 32 + (lane & 31);
      const float posf = (float)p.pos[tok];
      if (kind == 0 || kind == 1) {
        const float sc = kind == 0 ? 0.125f : 1.f;
#pragma unroll
        for (int r = 0; r < 16; ++r) { const float iv = inv64[(r & 3) + 8 * (r >> 2) + 4 * h];
          ROPE_PAIR(acc[0][tn][r], acc[1][tn][r], posf, iv, sc); ROPE_PAIR(acc[2][tn][r], acc[3][tn][r], posf, iv, sc); if ((r & 3) == 3) __builtin_amdgcn_sched_barrier(0); }
      } else if (kind == 2 || kind == 4) {
        const float sc = kind == 4 ? 0.08838834764831845f : 1.f;
#pragma unroll
        for (int r = 0; r < 16; ++r) { const int i = (r & 3) + 8 * (r >> 2) + 4 * h;
          ROPE_PAIR(acc[0][tn][r], acc[2][tn][r], posf, inv128[i], sc); ROPE_PAIR(acc[1][tn][r], acc[3][tn][r], posf, inv128[32 + i], sc); if ((r & 3) == 3) __builtin_amdgcn_sched_barrier(0); }
      } else if (kind == 5) {
#pragma unroll
        for (int tm = 0; tm < 4; ++tm)
#pragma unroll
          for (int r = 0; r < 16; ++r) { float v = acc[tm][tn][r]; asm volatile("" : "+v"(v)); float o = v * __builtin_amdgcn_rcpf(1.f + __builtin_amdgcn_exp2f(-1.4426950408889634f * v)); asm volatile("" : "+v"(o)); acc[tm][tn][r] = o; }
      }
      bf16_t* orow = p.projb + (size_t)tok * PJW + j * 256 + wn * 128 + 4 * h;
#pragma unroll
      for (int tm = 0; tm < 4; ++tm)
#pragma unroll
        for (int a = 0; a < 4; ++a) { u32x2 o; o.x = pk2(acc[tm][tn][4 * a], acc[tm][tn][4 * a + 1]); o.y = pk2(acc[tm][tn][4 * a + 2], acc[tm][tn][4 * a + 3]);
          *(u32x2*)(orow + tm * 32 + a * 8) = o; __builtin_amdgcn_sched_barrier(0); }
    }
  }
}

__device__ __forceinline__ void phase5(const P& p, lptr lds, int vcu, int G) {
  const int tid = threadIdx.x, wid = __builtin_amdgcn_readfirstlane(tid >> 6), lane = tid & 63, h = lane >> 5, l31 = lane & 31;
  constexpr int WRS1 = 1024 * 2 + 64;
  lptr wimg = lds, ximg = lds + 32 * WRS1;
  lptr lgb = lds + 72 * 1024;
  LAS float* part = (LAS float*)(lds + 138 * 1024);
  LAS float* rstd = part + 512;
  for (int u = vcu; u < T / 64; u += G) {
    const int t0 = u * 64, b = t0 / SEQ;
    f32x16 acc[4][2];
    acc_zero<4, 2>(acc);
    { WLb16<1024> wl; wl.src = p.woutb; wl.ld = D;
      XLrows<64> xl; xl.rowp[0] = p.mixb + (size_t)(t0 + ((tid >> 2) & 63)) * D; xl.ximg = ximg;
      gemm_loop<4, 2>(acc, D, wl, xl, wimg, WRS1, wid * 128, 0, tid, lane); }
    int nb = wid * 128 + 4 * h, tb = t0 + l31;
    asm volatile("" : "+v"(nb), "+v"(tb));
#pragma unroll
    for (int tn = 0; tn < 2; ++tn) {
      const int tok = tb + tn * 32; float ss = 0.f;
#pragma unroll
      for (int tm = 0; tm < 4; ++tm)
#pragma unroll
        for (int a = 0; a < 4; ++a) {
          const int n = nb + tm * 32 + a * 8;
          const f32x4 xv = *(const f32x4*)(p.x + (size_t)tok * D + n), gt = *(const f32x4*)(p.mod + b * 6144 + 2048 + n);
          f32x4 v; v.x = xv.x + gt.x * acc[tm][tn][4 * a]; v.y = xv.y + gt.y * acc[tm][tn][4 * a + 1]; v.z = xv.z + gt.z * acc[tm][tn][4 * a + 2]; v.w = xv.w + gt.w * acc[tm][tn][4 * a + 3];
          acc[tm][tn][4 * a] = v.x; acc[tm][tn][4 * a + 1] = v.y; acc[tm][tn][4 * a + 2] = v.z; acc[tm][tn][4 * a + 3] = v.w;
          *(f32x4*)(p.x1 + (size_t)tok * D + n) = v;
          ss += v.x * v.x + v.y * v.y + v.z * v.z + v.w * v.w;
          if (a == 3) __builtin_amdgcn_sched_barrier(0);
        }
      ss += __shfl_xor(ss, 32);
      if (h == 0) part[wid * 64 + tn * 32 + l31] = ss;
    }
    __syncthreads();
    if (tid < 64) { float q = 0.f;
#pragma unroll
      for (int w = 0; w < 8; ++w) q += part[w * 64 + tid];
      rstd[tid] = rsqrtf(q * (1.f / D) + EPS); }
    __syncthreads();
    asm volatile("" : "+v"(nb), "+v"(tb));
#pragma unroll
    for (int tn = 0; tn < 2; ++tn) {
      const int tok = tb + tn * 32; const float r = rstd[tn * 32 + l31];
#pragma unroll
      for (int tm = 0; tm < 4; ++tm)
#pragma unroll
        for (int a = 0; a < 4; ++a) {
          const int n = nb + tm * 32 + a * 8;
          const f32x4 g = *(const f32x4*)(p.g_ffn + n), sc = *(const f32x4*)(p.mod + b * 6144 + 4096 + n), sh = *(const f32x4*)(p.mod + b * 6144 + 3072 + n);
          u32x2 o;
          o.x = pk2(acc[tm][tn][4 * a] * r * g.x * (1.f + sc.x) + sh.x, acc[tm][tn][4 * a + 1] * r * g.y * (1.f + sc.y) + sh.y);
          o.y = pk2(acc[tm][tn][4 * a + 2] * r * g.z * (1.f + sc.z) + sh.z, acc[tm][tn][4 * a + 3] * r * g.w * (1.f + sc.w) + sh.w);
          *(u32x2*)(p.h2b + (size_t)tok * D + n) = o;
          if (a == 3) __builtin_amdgcn_sched_barrier(0);
        }
    }
    asm volatile("s_waitcnt vmcnt(0)" ::: "memory");
    __syncthreads();
    { f32x16 a2[1][2]; acc_zero<1, 2>(a2);
      WLb16<256> wl; wl.src = p.wrb; wl.ld = NE;
      XLrows<64> xl; xl.rowp[0] = p.h2b + (size_t)(t0 + ((tid >> 2) & 63)) * D; xl.ximg = ximg;
      gemm_loop<1, 2>(a2, D, wl, xl, wimg, 256 * 2 + 64, wid * 32, 0, tid, lane);
      int lo = ((l31 * 256 + wid * 32 + 4 * h) * 4);
      asm volatile("" : "+v"(lo));
#pragma unroll
      for (int tn = 0; tn < 2; ++tn)
#pragma unroll
        for (int a = 0; a < 4; ++a) { f32x4 v = {a2[0][tn][4 * a], a2[0][tn][4 * a + 1], a2[0][tn][4 * a + 2], a2[0][tn][4 * a + 3]};
          *(LAS f32x4*)(lgb + lo + (tn * 32 * 256 + a * 8) * 4) = v; } }
    __syncthreads();
    { int lane_ = lane; asm volatile("" : "+v"(lane_));
      const int lane = lane_;
      const f32x4 rb = *(const f32x4*)(p.rbias + lane * 4);
      for (int i = 0; i < 8; ++i) {
        const int tl = wid * 8 + i, tok = t0 + tl;
        const f32x4 lv = *(const LAS f32x4*)(lgb + (tl * 256 + lane * 4) * 4);
        const float s0 = sigm(lv.x), s1 = sigm(lv.y), s2 = sigm(lv.z), s3 = sigm(lv.w);
        float c0 = s0 + rb.x, c1 = s1 + rb.y, c2 = s2 + rb.z, c3 = s3 + rb.w;
        float m1, m2;
        { const float h1 = fmaxf(c0, c1), l1 = fminf(c0, c1), h2 = fmaxf(c2, c3), l2 = fminf(c2, c3); m1 = fmaxf(h1, h2); m2 = fmaxf(fminf(h1, h2), fmaxf(l1, l2)); }
#pragma unroll
        for (int o = 1; o < 8; o <<= 1) { const float o1 = __shfl_xor(m1, o), o2 = __shfl_xor(m2, o); const float n1 = fmaxf(m1, o1), n2 = fmaxf(fminf(m1, o1), fmaxf(m2, o2)); m1 = n1; m2 = n2; }
        const float gs = m1 + m2; const int myg = lane >> 3; int rank = 0;
#pragma unroll
        for (int g2 = 0; g2 < 8; ++g2) { const float og = __shfl(gs, g2 * 8); rank += (og > gs || (og == gs && g2 < myg)) ? 1 : 0; }
        if (rank >= 4) { c0 = -INFINITY; c1 = -INFINITY; c2 = -INFINITY; c3 = -INFINITY; }
        int my_e = 0; float my_s = 0.f;
#pragma unroll
        for (int k = 0; k < 8; ++k) {
          float bv = c0; int li = lane * 4;
          if (c1 > bv) { bv = c1; li = lane * 4 + 1; }
          if (c2 > bv) { bv = c2; li = lane * 4 + 2; }
          if (c3 > bv) { bv = c3; li = lane * 4 + 3; }
#pragma unroll
          for (int o = 1; o < 64; o <<= 1) { const float ov = __shfl_xor(bv, o); const int oi = __shfl_xor(li, o); if (ov > bv || (ov == bv && oi < li)) { bv = ov; li = oi; } }
          const int j = li & 3; const float sj = j == 0 ? s0 : j == 1 ? s1 : j == 2 ? s2 : s3;
          const float sv = __shfl(sj, li >> 2);
          if (lane * 4 == li) c0 = -INFINITY;
          if (lane * 4 + 1 == li) c1 = -INFINITY;
          if (lane * 4 + 2 == li) c2 = -INFINITY;
          if (lane * 4 + 3 == li) c3 = -INFINITY;
          if (lane == k) { my_e = li; my_s = sv; }
        }
        const float wsum = wave_sum(lane < 8 ? my_s : 0.f);
        if (lane < 8) { const int pos = atomicAdd(&p.cnt[my_e], 1); p.list[my_e * ECAP + pos] = tok * 8 + lane; p.wts[tok * 8 + lane] = my_s / wsum * 2.5f; }
      } }
    __syncthreads();
    { f32x16 a3[2][2]; acc_zero<2, 2>(a3);
      WLgu wl; wl.g = p.wgsb; wl.u = p.wusb;
      XLrows<64> xl; xl.rowp[0] = p.h2b + (size_t)(t0 + ((tid >> 2) & 63)) * D; xl.ximg = ximg;
      gemm_loop<2, 2>(a3, D, wl, xl, wimg, 512 * 2 + 64, wid * 64, 0, tid, lane);
      int l31_ = l31, h_ = h; asm volatile("" : "+v"(l31_), "+v"(h_));
#pragma unroll
      for (int tn = 0; tn < 2; ++tn)
#pragma unroll
        for (int a = 0; a < 4; ++a) {
          float o[4];
#pragma unroll
          for (int e = 0; e < 4; ++e) { const float gv = a3[0][tn][4 * a + e], uv = a3[1][tn][4 * a + e]; o[e] = gv * __builtin_amdgcn_rcpf(1.f + __builtin_amdgcn_exp2f(-1.4426950408889634f * gv)) * uv; }
          const int col = wid * 32 + a * 8 + 4 * h_;
          u32x2 w2; w2.x = pk2(o[0], o[1]); w2.y = pk2(o[2], o[3]);
          *(LAS u32x2*)(lgb + (col >> 5) * 4096 + kmin_off(tn * 32 + l31_, (col & 31) >> 3) + (col & 7) * 2) = w2;
        } }
    __syncthreads();
    acc_zero<4, 2>(acc);
    { WLb16<1024> wl; wl.src = p.wdsb; wl.ld = D;
      XLres xl; xl.base = lgb; xl.bytes = 4096;
      gemm_loop<4, 2>(acc, 256, wl, xl, wimg, WRS1, wid * 128, 0, tid, lane); }
    asm volatile("" : "+v"(nb), "+v"(tb));
#pragma unroll
    for (int tn = 0; tn < 2; ++tn) {
      const int tok = tb + tn * 32;
#pragma unroll
      for (int tm = 0; tm < 4; ++tm)
#pragma unroll
        for (int a = 0; a < 4; ++a) {
          const int n = nb + tm * 32 + a * 8;
          f32x4 v = *(const f32x4*)(p.x1 + (size_t)tok * D + n); const f32x4 gt = *(const f32x4*)(p.mod + b * 6144 + 5120 + n);
          v.x += gt.x * acc[tm][tn][4 * a]; v.y += gt.y * acc[tm][tn][4 * a + 1]; v.z += gt.z * acc[tm][tn][4 * a + 2]; v.w += gt.w * acc[tm][tn][4 * a + 3];
          *(f32x4*)(p.x1 + (size_t)tok * D + n) = v;
          if (a == 3) __builtin_amdgcn_sched_barrier(0);
        }
    }
    __syncthreads();
  }
}

__device__ __forceinline__ void phase6(const P& p, lptr lds, int vcu, int G) {
  const int tid = threadIdx.x, wid = __builtin_amdgcn_readfirstlane(tid >> 6), lane = tid & 63, h = lane >> 5, l31 = lane & 31, wn = wid >> 1, wt = wid & 1;
  constexpr int WRS = 512 * 2 + 64;
  lptr wimg = lds, ximg = lds + 32 * WRS;
  lptr actb = lds + 44 * 1024;
  LAS int* pre = (LAS int*)(lds + 110 * 1024);
  LAS int* sidl = pre + 320;
  if (tid < NE) pre[tid + 1] = (p.cnt[tid] + 127) >> 7;
  if (tid == 0) pre[0] = 0;
  __syncthreads();
  if (tid == 0) { int a = 0; for (int e = 1; e <= NE; ++e) { a += pre[e]; pre[e] = a; } }
  __syncthreads();
  const int nunits = pre[NE];
  for (int u = vcu; u < nunits; u += G) {
    int lo = 0, hi = NE;
    while (hi - lo > 1) { const int mid = (lo + hi) >> 1; if (pre[mid] <= u) lo = mid; else hi = mid; }
    const int e = lo, off = (u - pre[e]) * 128, cnt = p.cnt[e];
    if (tid < 128) sidl[tid] = off + tid < cnt ? p.list[e * ECAP + off + tid] : -1;
    __syncthreads();
    f32x16 acc[4][2];
    acc_zero<4, 2>(acc);
    { WLf32gu wl; wl.g = p.wg_e + (size_t)e * D * 256; wl.u = p.wu_e + (size_t)e * D * 256;
      XLrows<128> xl; { const int sd = sidl[(tid >> 2) & 127]; xl.rowp[0] = p.h2b + (size_t)(sd < 0 ? 0 : sd >> 3) * D; } xl.ximg = ximg;
      gemm_loop<4, 2>(acc, D, wl, xl, wimg, WRS, wn * 128, wt * 64, tid, lane); }
    { int l31_ = l31, h_ = h; asm volatile("" : "+v"(l31_), "+v"(h_));
#pragma unroll
      for (int tn = 0; tn < 2; ++tn)
#pragma unroll
        for (int tm = 0; tm < 2; ++tm)
#pragma unroll
          for (int a = 0; a < 4; ++a) {
            float o[4];
#pragma unroll
            for (int q = 0; q < 4; ++q) { const float gv = acc[tm][tn][4 * a + q], uv = acc[tm + 2][tn][4 * a + q]; o[q] = gv * __builtin_amdgcn_rcpf(1.f + __builtin_amdgcn_exp2f(-1.4426950408889634f * gv)) * uv; }
            const int col = wn * 64 + tm * 32 + a * 8 + 4 * h_;
            u32x2 w2; w2.x = pk2(o[0], o[1]); w2.y = pk2(o[2], o[3]);
            *(LAS u32x2*)(actb + (col >> 5) * 8192 + kmin_off(wt * 64 + tn * 32 + l31_, (col & 31) >> 3) + (col & 7) * 2) = w2;
          } }
    __syncthreads();
#pragma unroll 1
    for (int pass = 0; pass < 2; ++pass) {
      acc_zero<4, 2>(acc);
      { WLf32 wl; wl.src = p.wd_e + (size_t)e * 256 * D + pass * 512; wl.ld = D;
        XLres xl; xl.base = actb; xl.bytes = 8192;
        gemm_loop<4, 2>(acc, 256, wl, xl, wimg, WRS, wn * 128, wt * 64, tid, lane); }
      int nb = pass * 512 + wn * 128 + 4 * h, sl = wt * 64 + l31;
      asm volatile("" : "+v"(nb), "+v"(sl));
#pragma unroll
      for (int tn = 0; tn < 2; ++tn) {
        const int sd = sidl[sl + tn * 32];
        if (sd >= 0) {
          const float wgt = p.wts[sd];
          bf16_t* orow = p.slab + (size_t)sd * D + nb;
#pragma unroll
          for (int tm = 0; tm < 4; ++tm)
#pragma unroll
            for (int a = 0; a < 4; ++a) { u32x2 o; o.x = pk2(acc[tm][tn][4 * a] * wgt, acc[tm][tn][4 * a + 1] * wgt); o.y = pk2(acc[tm][tn][4 * a + 2] * wgt, acc[tm][tn][4 * a + 3] * wgt);
              *(u32x2*)(orow + tm * 32 + a * 8) = o; }
        }
      }
    }
    __syncthreads();
  }
}

__device__ __forceinline__ void phase7(const P& p, lptr lds, int vcu, int G) {
  const int tid = threadIdx.x, wid = tid >> 6, lane = tid & 63;
  for (int tok = vcu * 8 + wid; tok < T; tok += G * 8) {
    const int b = tok / SEQ;
    float v[16]; float ss = 0.f;
#pragma unroll
    for (int j = 0; j < 2; ++j) {
      const int n = j * 512 + lane * 8;
      float a[8];
#pragma unroll
      for (int q = 0; q < 8; ++q) a[q] = 0.f;
#pragma unroll
      for (int k = 0; k < 8; ++k) { const u32x4 w = *(const u32x4*)(p.slab + ((size_t)tok * 8 + k) * D + n);
        a[0] += bflo(w.x); a[1] += bfhi(w.x); a[2] += bflo(w.y); a[3] += bfhi(w.y); a[4] += bflo(w.z); a[5] += bfhi(w.z); a[6] += bflo(w.w); a[7] += bfhi(w.w); }
#pragma unroll
      for (int q4 = 0; q4 < 2; ++q4) {
        const f32x4 xv = *(const f32x4*)(p.x1 + (size_t)tok * D + n + q4 * 4), gt = *(const f32x4*)(p.mod + b * 6144 + 5120 + n + q4 * 4);
        const float y0 = xv.x + gt.x * a[q4 * 4], y1 = xv.y + gt.y * a[q4 * 4 + 1], y2 = xv.z + gt.z * a[q4 * 4 + 2], y3 = xv.w + gt.w * a[q4 * 4 + 3];
        v[j * 8 + q4 * 4] = y0; v[j * 8 + q4 * 4 + 1] = y1; v[j * 8 + q4 * 4 + 2] = y2; v[j * 8 + q4 * 4 + 3] = y3;
        ss += y0 * y0 + y1 * y1 + y2 * y2 + y3 * y3;
      }
    }
    ss = wave_sum(ss);
    const float r = rsqrtf(ss * (1.f / D) + EPS);
#pragma unroll
    for (int j = 0; j < 2; ++j)
#pragma unroll
      for (int q4 = 0; q4 < 2; ++q4) {
        const int n = j * 512 + lane * 8 + q4 * 4;
        const f32x4 g = *(const f32x4*)(p.g_final + n);
        f32x4 o; o.x = v[j * 8 + q4 * 4] * r * g.x; o.y = v[j * 8 + q4 * 4 + 1] * r * g.y; o.z = v[j * 8 + q4 * 4 + 2] * r * g.z; o.w = v[j * 8 + q4 * 4 + 3] * r * g.w;
        *(f32x4*)(p.out + (size_t)tok * D + n) = o;
      }
  }
}

constexpr int NSA_KB = 8192, NSA_VRS = 192, NSA_SLOT = NSA_KB + 64 * NSA_VRS, NSA_IMP = 2 * NSA_SLOT;
__device__ __forceinline__ void nsa_qk(f32x16 (&s)[2], lptr kimg, const bf16x8 (&qf)[4], int l31, int h) {
#pragma unroll
  for (int kt = 0; kt < 2; ++kt) {
#pragma unroll
    for (int r = 0; r < 16; ++r) s[kt][r] = 0.f;
    const int key = kt * 32 + l31;
#pragma unroll
    for (int ds = 0; ds < 4; ++ds) {
      const bf16x8 a = *(LAS bf16x8*)(kimg + key * 128 + (((2 * ds + h) ^ ((key >> 1) & 7)) << 4));
      s[kt] = __builtin_amdgcn_mfma_f32_32x32x16_bf16(a, qf[ds], s[kt], 0, 0, 0);
    }
  }
}
__device__ __forceinline__ void nsa_pv(f32x16 (&o)[2], lptr vimg, const f32x16 (&pr)[2], int lane) {
  const int h = lane >> 5, blk = (lane >> 4) & 1, q = (lane & 15) >> 2, pp = lane & 3;
  bf16x8 pb[4];
#pragma unroll
  for (int ks = 0; ks < 4; ++ks) {
    const int kt = ks >> 1, rb = 8 * (ks & 1);
    u32x4 w; w.x = pk2(pr[kt][rb], pr[kt][rb + 1]); w.y = pk2(pr[kt][rb + 2], pr[kt][rb + 3]); w.z = pk2(pr[kt][rb + 4], pr[kt][rb + 5]); w.w = pk2(pr[kt][rb + 6], pr[kt][rb + 7]);
    pb[ks] = __builtin_bit_cast(bf16x8, w);
  }
#pragma unroll
  for (int dt = 0; dt < 2; ++dt)
#pragma unroll
    for (int ks = 0; ks < 4; ++ks) {
      lptr a = vimg + (16 * ks + 4 * h + q) * NSA_VRS + (dt * 32 + 16 * blk + 4 * pp) * 2;
      const v4i16_t lo = __builtin_amdgcn_ds_read_tr16_b64_v4i16((LAS v4i16_t*)a);
      const v4i16_t hi = __builtin_amdgcn_ds_read_tr16_b64_v4i16((LAS v4i16_t*)(a + 8 * NSA_VRS));
      const bf16x8 vf = {lo[0], lo[1], lo[2], lo[3], hi[0], hi[1], hi[2], hi[3]};
      o[dt] = __builtin_amdgcn_mfma_f32_32x32x16_bf16(vf, pb[ks], o[dt], 0, 0, 0);
    }
}
__device__ __forceinline__ float fexp(float x) { return __builtin_amdgcn_exp2f(x * 1.4426950408889634f); }
__device__ __forceinline__ void phase_nsa(const P& p, lptr lds, int vcu, int G) {
  const int tid = threadIdx.x, wid = __builtin_amdgcn_readfirstlane(tid >> 6), lane0 = tid & 63;
  LAS float* imp = (LAS float*)(lds + NSA_IMP);
  LAS float* obuf = (LAS float*)(lds + NSA_IMP + 16384) + wid * 2048 + lane0;
  const int srow = tid >> 3, sch = tid & 7;
  for (int u = vcu; u < 512; u += G) {
    const int bg = u & 7, j0 = u < 256 ? 63 - (u >> 3) : ((u - 256) >> 3), b = bg >> 1, g = bg & 1, t0 = j0 * 64;
    const int t = t0 + wid * 8 + ((lane0 & 31) >> 2), hg = g * 4 + (lane0 & 3);
    const size_t trow = (size_t)(b * SEQ + t);
    bf16x8 qf[4];
#pragma unroll
    for (int ds = 0; ds < 4; ++ds) qf[ds] = *(const bf16x8*)(p.projb + trow * PJW + J_QN + hg * 64 + 16 * ds + 8 * (lane0 >> 5));
#pragma unroll
    for (int i = 0; i < 8; ++i) imp[(wid * 8 + i) * 64 + lane0] = 0.f;
    const int nct = (((t0 + 32) >> 4) >> 6) + 1, jw0 = j0 > 8 ? j0 - 8 : 0;
    const int itC = 2 * nct, itD = itC + j0 + 1, NI = itD + (j0 - jw0 + 1);
    const int cmaxt = t >= 31 ? (t - 31) >> 4 : -1;
    u32x4 kreg, vreg;
    const char* pbt = (const char*)(p.projb + (size_t)(b * SEQ) * PJW + g * 64) + (size_t)srow * (PJW * 2) + sch * 16;
    const char* kct = (const char*)(p.kcmpb + (size_t)bg * NC * 64) + srow * 128 + sch * 16;
    const char* vct = (const char*)(p.vcmpb + (size_t)bg * NC * 64) + srow * 128 + sch * 16;
#define NSA_LOAD(IT) do { const int it_ = (IT); \
      if (it_ < itC) { const unsigned o_ = (unsigned)(it_ < nct ? it_ : it_ - nct) * 8192u; kreg = *(const u32x4*)(kct + o_); vreg = *(const u32x4*)(vct + o_); } \
      else { const bool sel_ = it_ < itD; const unsigned o_ = (unsigned)(sel_ ? it_ - itC : jw0 + it_ - itD) * (unsigned)(64 * PJW * 2); \
             kreg = *(const u32x4*)(pbt + o_ + (sel_ ? J_KS * 2 : J_KW * 2)); vreg = *(const u32x4*)(pbt + o_ + (sel_ ? J_VS * 2 : J_VW * 2)); } } while (0)
#define NSA_STEP() lptr slot = lds + (it & 1) * NSA_SLOT; \
      *(LAS u32x4*)(slot + srow * 128 + ((sch ^ ((srow >> 1) & 7)) << 4)) = kreg; \
      *(LAS u32x4*)(slot + NSA_KB + srow * NSA_VRS + sch * 16) = vreg; \
      __syncthreads(); \
      if (it + 1 < NI) NSA_LOAD(it + 1); \
      int lane = lane0; asm volatile("" : "+v"(lane)); const int h = lane >> 5, l31 = lane & 31; (void)l31
    NSA_LOAD(0);
    int it = 0;
    float m1 = -1e30f, l1 = 0.f;
    for (; it < nct; ++it) {
      NSA_STEP();
      f32x16 s[2]; nsa_qk(s, slot, qf, l31, h);
      float mx = -1e30f;
#pragma unroll
      for (int r = 0; r < 16; ++r) { const int c = 64 * it + (r & 3) + 8 * (r >> 2) + 4 * h; if (c <= cmaxt) mx = fmaxf(mx, s[0][r]); if (c + 32 <= cmaxt) mx = fmaxf(mx, s[1][r]); }
      mx = fmaxf(mx, __shfl_xor(mx, 32));
      const float mn = fmaxf(m1, mx); float rs = 0.f;
#pragma unroll
      for (int r = 0; r < 16; ++r) { const int c = 64 * it + (r & 3) + 8 * (r >> 2) + 4 * h; rs += (c <= cmaxt ? fexp(s[0][r] - mn) : 0.f) + (c + 32 <= cmaxt ? fexp(s[1][r] - mn) : 0.f); }
      rs += __shfl_xor(rs, 32);
      l1 = l1 * fexp(m1 - mn) + rs; m1 = mn;
    }
    f32x16 o[2];
#pragma unroll
    for (int r = 0; r < 16; ++r) { o[0][r] = 0.f; o[1][r] = 0.f; }
    { const float il = 1.f / fmaxf(l1, 1e-20f);
      for (; it < itC; ++it) {
        NSA_STEP();
        const int i = it - nct, tl = l31 >> 2, r4 = l31 & 3;
        f32x16 s[2]; nsa_qk(s, slot, qf, l31, h);
#pragma unroll
        for (int r = 0; r < 16; ++r) { const int c = 64 * i + (r & 3) + 8 * (r >> 2) + 4 * h; s[0][r] = c <= cmaxt ? fexp(s[0][r] - m1) * il : 0.f; s[1][r] = c + 32 <= cmaxt ? fexp(s[1][r] - m1) * il : 0.f; }
#pragma unroll
        for (int kt = 0; kt < 2; ++kt)
#pragma unroll
          for (int a = 0; a < 4; ++a) {
            float v4 = (s[kt][4 * a] + s[kt][4 * a + 1]) + (s[kt][4 * a + 2] + s[kt][4 * a + 3]), cy = s[kt][4 * a + 3];
            v4 += __shfl_xor(v4, 1); v4 += __shfl_xor(v4, 2); cy += __shfl_xor(cy, 1); cy += __shfl_xor(cy, 2);
            const int jj = 16 * i + 8 * kt + 2 * a + h;
            if (r4 == 0) { LAS float* ip = imp + (wid * 8 + tl) * 64 + jj; ip[0] += v4; }
            if (r4 == 0 && jj < 63) { LAS float* ip = imp + (wid * 8 + tl) * 64 + jj + 1; ip[0] += cy; }
          }
        nsa_pv(o, slot + NSA_KB, s, lane);
      } }
    { const float g0 = p.gates[trow * 24 + hg * 3];
#pragma unroll
      for (int r = 0; r < 16; ++r) { obuf[r * 64] = g0 * o[0][r]; obuf[(16 + r) * 64] = g0 * o[1][r]; o[0][r] = 0.f; o[1][r] = 0.f; } }
    unsigned long long U = 0ull, mym = 0ull;
    __builtin_amdgcn_s_waitcnt(0xc07f);
    for (int i2 = 0; i2 < 8; ++i2) {
      float v = imp[(wid * 8 + i2) * 64 + lane0];
      const bool forced = lane0 == 0 || lane0 == j0 || lane0 == j0 - 1;
      v = lane0 <= j0 ? (forced ? v + 1e4f : v) : -1.f;
      unsigned long long msk = 0ull;
      for (int k = 0; k < 8; ++k) {
        float bv = v; int bi = lane0;
#pragma unroll
        for (int of = 1; of < 64; of <<= 1) { const float ov = __shfl_xor(bv, of); const int oi = __shfl_xor(bi, of); if (ov > bv || (ov == bv && oi < bi)) { bv = ov; bi = oi; } }
        msk |= 1ull << bi; if (lane0 == bi) v = -INFINITY;
      }
      U |= msk; if (((lane0 & 31) >> 2) == i2) mym = msk;
    }
    float m = -1e30f, l = 0.f;
#define NSA_ONLINE(MINE, LOWPOS, JB) do { \
      f32x16 s[2]; nsa_qk(s, slot, qf, l31, h); \
      unsigned ok0 = 0u, ok1 = 0u; \
      _Pragma("unroll") for (int r = 0; r < 16; ++r) { const int pos = 64 * (JB) + (r & 3) + 8 * (r >> 2) + 4 * h; if ((MINE) && pos <= t && pos > (LOWPOS)) ok0 |= 1u << r; if ((MINE) && pos + 32 <= t && pos + 32 > (LOWPOS)) ok1 |= 1u << r; } \
      float mx = -1e30f; \
      _Pragma("unroll") for (int r = 0; r < 16; ++r) { if ((ok0 >> r) & 1u) mx = fmaxf(mx, s[0][r]); if ((ok1 >> r) & 1u) mx = fmaxf(mx, s[1][r]); } \
      mx = fmaxf(mx, __shfl_xor(mx, 32)); \
      const float mn = fmaxf(m, mx), alpha = fexp(m - mn); float rs = 0.f; \
      _Pragma("unroll") for (int r = 0; r < 16; ++r) { const float p0 = ((ok0 >> r) & 1u) ? fexp(s[0][r] - mn) : 0.f, p1 = ((ok1 >> r) & 1u) ? fexp(s[1][r] - mn) : 0.f; s[0][r] = p0; s[1][r] = p1; rs += p0 + p1; } \
      rs += __shfl_xor(rs, 32); \
      l = l * alpha + rs; m = mn; \
      _Pragma("unroll") for (int r = 0; r < 16; ++r) { o[0][r] *= alpha; o[1][r] *= alpha; } \
      nsa_pv(o, slot + NSA_KB, s, lane); } while (0)
    for (; it < itD; ++it) {
      NSA_STEP();
      const int j = it - itC;
      if ((U >> j) & 1ull) { const bool mine = (mym >> j) & 1ull; NSA_ONLINE(mine, -1, j); }
    }
    { const float f = p.gates[trow * 24 + hg * 3 + 1] / fmaxf(l, 1e-20f);
#pragma unroll
      for (int r = 0; r < 16; ++r) { obuf[r * 64] += f * o[0][r]; obuf[(16 + r) * 64] += f * o[1][r]; o[0][r] = 0.f; o[1][r] = 0.f; }
      m = -1e30f; l = 0.f; }
    for (; it < NI; ++it) {
      NSA_STEP();
      const int j = jw0 + it - itD;
      NSA_ONLINE(true, t - 512, j);
    }
#undef NSA_ONLINE
#undef NSA_STEP
#undef NSA_LOAD
    { const float f = p.gates[trow * 24 + hg * 3 + 2] / fmaxf(l, 1e-20f);
      bf16_t* orow = p.onsab + trow * 512 + hg * 64 + 4 * (lane0 >> 5);
#pragma unroll
      for (int dt = 0; dt < 2; ++dt)
#pragma unroll
        for (int a = 0; a < 4; ++a) { u32x2 w; const int r = 4 * a;
          w.x = pk2(obuf[(16 * dt + r) * 64] + f * o[dt][r], obuf[(16 * dt + r + 1) * 64] + f * o[dt][r + 1]); w.y = pk2(obuf[(16 * dt + r + 2) * 64] + f * o[dt][r + 2], obuf[(16 * dt + r + 3) * 64] + f * o[dt][r + 3]);
          *(u32x2*)(orow + dt * 32 + a * 8) = w; } }
    __syncthreads();
  }
}

__device__ __forceinline__ float ret_logg2(int h) { return logf(1.f - exp2f(-5.f - (float)h)); }
struct WLkminRows {
  typedef XRegB16<128> Regs; const bf16_t* rowp[1];
  __device__ __forceinline__ void load(Regs& R, int k0, int tid) const { xload_b16<128>(R, rowp, k0, tid); }
  __device__ __forceinline__ void store(const Regs& R, lptr img, int, int tid) const { xstore_b16<128>(R, img, tid); }
};
struct XLcmp {
  struct Regs { u32x4 r; }; const bf16_t* src; const float* pe; lptr ximg;
  __device__ __forceinline__ void load(Regs& R, int k0, int tid) const {
    if (tid < 256) { const int l = k0 >> 6, d0 = (k0 & 63) + (tid & 3) * 8;
      const u32x4 v = *(const u32x4*)(src + (size_t)l * PJW + (k0 & 63));
      const f32x4 p0 = *(const f32x4*)(pe + l * 64 + d0), p1 = *(const f32x4*)(pe + l * 64 + d0 + 4);
      R.r.x = pk2(bflo(v.x) + p0.x, bfhi(v.x) + p0.y); R.r.y = pk2(bflo(v.y) + p0.z, bfhi(v.y) + p0.w);
      R.r.z = pk2(bflo(v.z) + p1.x, bfhi(v.z) + p1.y); R.r.w = pk2(bflo(v.w) + p1.z, bfhi(v.w) + p1.w); }
  }
  __device__ __forceinline__ void store(const Regs& R, int tid) const { if (tid < 256) *(LAS u32x4*)(ximg + kmin_off(tid >> 2, tid & 3)) = R.r; }
  __device__ __forceinline__ lptr img(int) const { return ximg; }
};
struct XLretk {
  struct Regs { u32x4 r; }; const bf16_t* src; float lg; lptr ximg;
  __device__ __forceinline__ void load(Regs& R, int k0, int tid) const {
    const u32x4 v = *(const u32x4*)(src + (size_t)k0 * PJW);
    const float z = __expf(lg * (float)(127 - k0 - (tid >> 4)));
    R.r.x = pk2(bflo(v.x) * z, bfhi(v.x) * z); R.r.y = pk2(bflo(v.y) * z, bfhi(v.y) * z); R.r.z = pk2(bflo(v.z) * z, bfhi(v.z) * z); R.r.w = pk2(bflo(v.w) * z, bfhi(v.w) * z);
  }
  __device__ __forceinline__ void store(const Regs& R, int tid) const { *(LAS u32x4*)(ximg + (tid >> 4) * 320 + (tid & 15) * 16) = R.r; }
  __device__ __forceinline__ lptr img(int) const { return ximg; }
};
__device__ __forceinline__ void phase_r1(const P& p, lptr lds, int vcu, int G) {
  const int tid = threadIdx.x, wid = __builtin_amdgcn_readfirstlane(tid >> 6), lane = tid & 63, h = lane >> 5, l31 = lane & 31;
  lptr wimg = lds, ximg = lds + 16 * 1024;
  for (int u = vcu; u < 256 + 512; u += G) {
    if (u < 256) {
      const int isv = u >> 7, rt = (u >> 2) & 31, kq = u & 3, wn = wid >> 1, wt = wid & 1;
      f32x16 acc[1][1]; acc_zero<1, 1>(acc);
      WLb16<128> wl; wl.src = (isv ? p.cw1vb : p.cw1kb) + (size_t)kq * 512 * 128; wl.ld = 128;
      XLcmp xl; { int r = rt * 64 + ((tid >> 2) & 63); r = r < NCR ? r : NCR - 1; const int b = r / (2 * NC), g = (r / NC) & 1, c = r % NC;
        xl.src = p.projb + (size_t)(b * SEQ + 16 * c + kq * 8) * PJW + (isv ? J_VC : J_KC) + g * 64 + (tid & 3) * 8; xl.pe = (isv ? p.cpv : p.cpk) + kq * 512; xl.ximg = ximg; }
      gemm_loop<1, 1>(acc, 512, wl, xl, wimg, 128 * 2 + 64, wn * 32, wt * 32, tid, lane);
      int row = rt * 64 + wt * 32 + l31, nb = wn * 32 + 4 * h; asm volatile("" : "+v"(row), "+v"(nb));
      if (row < NCR) { float* o = p.hidp + (((size_t)(isv * 4 + kq) * 2048 + row) * 128) + nb;
#pragma unroll
        for (int a = 0; a < 4; ++a) { f32x4 v = {acc[0][0][4 * a], acc[0][0][4 * a + 1], acc[0][0][4 * a + 2], acc[0][0][4 * a + 3]}; *(f32x4*)(o + a * 8) = v; } }
    } else {
      const int chunk = u - 256, bh = chunk >> 5, b = bh >> 2, hh = bh & 3, s0 = (chunk & 31) * 128, wn = wid >> 1, wt = wid & 1;
      f32x16 acc[1][2]; acc_zero<1, 2>(acc);
      const bf16_t* base = p.projb + (size_t)(b * SEQ + s0) * PJW + hh * 128;
      WLb16<128> wl; wl.src = base + J_VR; wl.ld = PJW;
      XLretk xl; xl.src = base + J_KR + (size_t)(tid >> 4) * PJW + (tid & 15) * 8; xl.lg = ret_logg2(hh); xl.ximg = ximg;
      gemm_loop<1, 2, WLb16<128>, XLretk, true, true>(acc, 128, wl, xl, wimg, 128 * 2 + 64, wn * 32, wt * 64, tid, lane, 320);
      int dcol = wt * 64 + l31, nb = wn * 32 + 4 * h; asm volatile("" : "+v"(dcol), "+v"(nb));
#pragma unroll
      for (int tn = 0; tn < 2; ++tn) { float* o = p.kv + ((size_t)chunk * 128 + dcol + tn * 32) * 128 + nb;
#pragma unroll
        for (int a = 0; a < 4; ++a) { f32x4 v = {acc[0][tn][4 * a], acc[0][tn][4 * a + 1], acc[0][tn][4 * a + 2], acc[0][tn][4 * a + 3]}; *(f32x4*)(o + a * 8) = v; } }
    }
  }
}
__device__ __forceinline__ void phase_r2(const P& p, lptr lds, int vcu, int G) {
  const int tid = threadIdx.x;
  LAS float* hs = (LAS float*)lds;
  LAS float* os = hs + 1024;
  const LAS float* inv64 = (const LAS float*)(lds + LDS_INV64);
  for (int u = vcu; u < 2 * 255; u += G) {
    const int isv = u >= 255, r0 = (isv ? u - 255 : u) * 8;
    { const int i = tid, row = r0 + (i >> 7), k = i & 127;
#pragma unroll
      for (int q = 0; q < 2; ++q) { const int rr = row + 4 * q; float a = 0.f;
#pragma unroll
        for (int kq = 0; kq < 4; ++kq) a += p.hidp[((size_t)(isv * 4 + kq) * 2048 + rr) * 128 + k];
        hs[(rr - r0) * 128 + k] = gelu_tanh(a); } }
    __syncthreads();
    { const int rl = tid >> 6, n = tid & 63; const float* w2 = isv ? p.cw2v : p.cw2k; float a = 0.f;
#pragma unroll 8
      for (int k = 0; k < 128; ++k) a += hs[rl * 128 + k] * w2[k * 64 + n];
      os[rl * 64 + n] = a; }
    __syncthreads();
    { const int rl = tid >> 6, n = tid & 63, row = r0 + rl; float y = os[rl * 64 + n];
      if (!isv) { const int b = row / (2 * NC), c = row % NC, i = n & 31;
        const float fr = __builtin_amdgcn_fractf((float)p.pos[b * SEQ + 16 * c + 31] * inv64[i]);
        const float sn = __builtin_amdgcn_sinf(fr), cs = __builtin_amdgcn_cosf(fr), x1 = os[rl * 64 + i], x2 = os[rl * 64 + i + 32];
        y = n < 32 ? x1 * cs - x2 * sn : x1 * sn + x2 * cs; }
      (isv ? p.vcmpb : p.kcmpb)[(size_t)row * 64 + n] = (bf16_t)(pk2(y, 0.f) & 0xffffu); }
    __syncthreads();
  }
  for (int id = vcu * 512 + tid; id < 16 * 16384; id += G * 512) {
    const int bh = id >> 14, de = id & 16383; const float gc = __expf(ret_logg2(bh & 3) * 128.f);
    float v[32];
#pragma unroll
    for (int n = 0; n < 32; ++n) v[n] = p.kv[(size_t)(bh * 32 + n) * 16384 + de];
    float st = 0.f;
#pragma unroll
    for (int n = 0; n < 32; ++n) { p.stateb[(size_t)(bh * 32 + n) * 16384 + de] = (bf16_t)(pk2(st, 0.f) & 0xffffu); st = st * gc + v[n]; }
  }
}
__device__ __forceinline__ void phase_r3(const P& p, lptr lds, int vcu, int G) {
  const int tid = threadIdx.x, wid = __builtin_amdgcn_readfirstlane(tid >> 6), lane = tid & 63, h = lane >> 5, l31 = lane & 31, wn = wid >> 2, wt = wid & 3;
  lptr wimg = lds, ximg = lds + 12 * 1024, scb = lds + 20 * 1024;
  LAS float* part = (LAS float*)(lds + 52 * 1024);
  for (int chunk = vcu; chunk < 512; chunk += G) {
    const int bh = chunk >> 5, b = bh >> 2, hh = bh & 3, s0 = (chunk & 31) * 128; const float lg = ret_logg2(hh);
    const bf16_t* base = p.projb + (size_t)(b * SEQ + s0) * PJW + hh * 128;
    f32x16 acc[2][1];
    acc_zero<2, 1>(acc);
    { WLkminRows wl; wl.rowp[0] = base + J_KR + (size_t)((tid >> 2) & 127) * PJW;
      XLrows<128> xl; xl.rowp[0] = base + J_QR + (size_t)((tid >> 2) & 127) * PJW; xl.ximg = ximg;
      gemm_loop<2, 1, WLkminRows, XLrows<128>, false, false>(acc, 128, wl, xl, wimg, 0, wn * 64, wt * 32, tid, lane); }
    { int i = wt * 32 + l31, jb = wn * 64 + 4 * h; asm volatile("" : "+v"(i), "+v"(jb));
#pragma unroll
      for (int tm = 0; tm < 2; ++tm)
#pragma unroll
        for (int a = 0; a < 4; ++a) { const int j = jb + tm * 32 + a * 8; float o[4];
#pragma unroll
          for (int q = 0; q < 4; ++q) o[q] = i >= j + q ? acc[tm][0][4 * a + q] * __expf(lg * (float)(i - j - q)) : 0.f;
          u32x2 w; w.x = pk2(o[0], o[1]); w.y = pk2(o[2], o[3]);
          *(LAS u32x2*)(scb + (j >> 5) * 8192 + kmin_off(i, (j & 31) >> 3) + (j & 7) * 2) = w; } }
    __syncthreads();
    acc_zero<2, 1>(acc);
    { WLb16<128> wl; wl.src = p.stateb + (size_t)chunk * 16384; wl.ld = 128;
      XLrows<128> xl; xl.rowp[0] = base + J_QR + (size_t)((tid >> 2) & 127) * PJW; xl.ximg = ximg;
      gemm_loop<2, 1>(acc, 128, wl, xl, wimg, 128 * 2 + 64, wn * 64, wt * 32, tid, lane); }
    { const float xi = __expf(lg * (float)(wt * 32 + l31 + 1));
#pragma unroll
      for (int tm = 0; tm < 2; ++tm)
#pragma unroll
        for (int r = 0; r < 16; ++r) acc[tm][0][r] *= xi; }
    { WLb16<128> wl; wl.src = base + J_VR; wl.ld = PJW;
      XLres xl; xl.base = scb; xl.bytes = 8192;
      gemm_loop<2, 1>(acc, 128, wl, xl, wimg, 128 * 2 + 64, wn * 64, wt * 32, tid, lane); }
    { float ss = 0.f;
#pragma unroll
      for (int tm = 0; tm < 2; ++tm)
#pragma unroll
        for (int r = 0; r < 16; ++r) ss += acc[tm][0][r] * acc[tm][0][r];
      ss += __shfl_xor(ss, 32);
      if (h == 0) part[wn * 128 + wt * 32 + l31] = ss; }
    __syncthreads();
    { int i = wt * 32 + l31, eb = wn * 64 + 4 * h; asm volatile("" : "+v"(i), "+v"(eb));
      const float rs = rsqrtf((part[i] + part[128 + i]) * (1.f / 128.f) + EPS);
      const size_t trow = (size_t)(b * SEQ + s0 + i);
#pragma unroll
      for (int tm = 0; tm < 2; ++tm)
#pragma unroll
        for (int a = 0; a < 4; ++a) { const int e = eb + tm * 32 + a * 8;
          const f32x4 gr = *(const f32x4*)(p.g_ret + hh * 128 + e); const u32x2 gt = *(const u32x2*)(p.projb + trow * PJW + J_GR + hh * 128 + e);
          u32x2 w; w.x = pk2(acc[tm][0][4 * a] * rs * gr.x * bflo(gt.x), acc[tm][0][4 * a + 1] * rs * gr.y * bfhi(gt.x));
          w.y = pk2(acc[tm][0][4 * a + 2] * rs * gr.z * bflo(gt.y), acc[tm][0][4 * a + 3] * rs * gr.w * bfhi(gt.y));
          *(u32x2*)(p.mixb + trow * D + 512 + hh * 128 + e) = w; } }
    __syncthreads();
  }
  for (int tok = vcu * 8 + wid; tok < T; tok += G * 8) {
    const u32x4 v = *(const u32x4*)(p.onsab + (size_t)tok * 512 + lane * 8);
    float x[8] = {bflo(v.x), bfhi(v.x), bflo(v.y), bfhi(v.y), bflo(v.z), bfhi(v.z), bflo(v.w), bfhi(v.w)};
    float ss = 0.f;
#pragma unroll
    for (int q = 0; q < 8; ++q) ss += x[q] * x[q];
    ss = wave_sum(ss);
    const float rs = rsqrtf(ss * (1.f / 512.f) + EPS);
    const f32x4 g0 = *(const f32x4*)(p.g_nsa + lane * 8), g1 = *(const f32x4*)(p.g_nsa + lane * 8 + 4);
    u32x4 w; w.x = pk2(x[0] * rs * g0.x, x[1] * rs * g0.y); w.y = pk2(x[2] * rs * g0.z, x[3] * rs * g0.w); w.z = pk2(x[4] * rs * g1.x, x[5] * rs * g1.y); w.w = pk2(x[6] * rs * g1.z, x[7] * rs * g1.w);
    *(u32x4*)(p.mixb + (size_t)tok * D + lane * 8) = w;
  }
}

constexpr int NPHASE = 10;
__global__ void __launch_bounds__(512) mega(P p, int lo, int hi) {
  extern __shared__ __attribute__((aligned(16))) char lds_raw[];
  lptr lds = (lptr)lds_raw;
  const int tid = threadIdx.x, G = gridDim.x;
  const int vcu = (G % 8 == 0) ? ((int)blockIdx.x % 8) * (G / 8) + (int)blockIdx.x / 8 : (int)blockIdx.x;
  if (tid < 32) ((LAS float*)(lds + LDS_INV64))[tid] = exp2f(-(float)(2 * tid) / 64.f * 13.287712379549449f) * 0.15915494309189535f;
  if (tid < 64) ((LAS float*)(lds + LDS_INV128))[tid] = exp2f(-(float)(2 * tid) / 128.f * 13.287712379549449f) * 0.15915494309189535f;
  if (tid < 4) ((LAS unsigned*)(lds + LDS_XB))[tid] = 0u;
  __syncthreads();
  XcdBarrier xb; xb.bar = p.bar; xb.x = 0; xb.st = (volatile LAS unsigned*)(lds + LDS_XB);
  if (hi - lo > 1) xb = xcd_barrier_post(p.bar, (volatile LAS unsigned*)(lds + LDS_XB));
#define PH(k, call) if (lo <= (k) && (k) < hi) { call; if ((k) + 1 < hi) xcd_barrier(xb); }
  PH(0, phase0a(p, lds, vcu, G));
  PH(1, phase0b(p, lds, vcu, G));
  PH(2, phase1(p, lds, vcu, G));
  PH(3, phase_r1(p, lds, vcu, G));
  PH(4, phase_r2(p, lds, vcu, G));
  PH(5, phase_nsa(p, lds, vcu, G));
  PH(6, phase_r3(p, lds, vcu, G));
  PH(7, phase5(p, lds, vcu, G));
  PH(8, phase6(p, lds, vcu, G));
  PH(9, phase7(p, lds, vcu, G));
#undef PH
}
}

extern "C" void kernel_launch(void* const* d_in, const int* in_sizes, int n_in, void* d_out, int out_size, void* d_ws, size_t ws_size, hipStream_t stream) {
  P p{};
  p.x = (const float*)d_in[0]; p.c = (const float*)d_in[1]; p.pos = (const int*)d_in[2];
  p.w_ada = (const float*)d_in[3]; p.b_ada = (const float*)d_in[4]; p.g_mix = (const float*)d_in[5]; p.w_in = (const float*)d_in[6];
  p.cpk = (const float*)d_in[7]; p.cw1k = (const float*)d_in[8]; p.cw2k = (const float*)d_in[9];
  p.cpv = (const float*)d_in[10]; p.cw1v = (const float*)d_in[11]; p.cw2v = (const float*)d_in[12];
  p.g_nsa = (const float*)d_in[13]; p.g_ret = (const float*)d_in[14]; p.w_out = (const float*)d_in[15]; p.g_ffn = (const float*)d_in[16];
  p.w_router = (const float*)d_in[17]; p.rbias = (const float*)d_in[18]; p.wg_e = (const float*)d_in[19]; p.wu_e = (const float*)d_in[20];
  p.wd_e = (const float*)d_in[21]; p.wg_s = (const float*)d_in[22]; p.wu_s = (const float*)d_in[23]; p.wd_s = (const float*)d_in[24];
  p.g_final = (const float*)d_in[25];
  p.out = (float*)d_out;
  char* w = (char*)d_ws; size_t off = 0;
  auto take = [&](size_t bytes) { char* r = w + off; off += (bytes + 255) & ~(size_t)255; return r; };
  p.bar = (unsigned*)take(XCD_BAR_WORDS * 4);
  p.cnt = (int*)take(NE * 4);
  const size_t zero_bytes = off;
  p.mod = (float*)take(BATCH * 6144 * 4);
  p.hidp = (float*)take((size_t)8 * 2048 * 128 * 4);
  p.kv = (float*)take((size_t)512 * 16384 * 4);
  p.stateb = (bf16_t*)take((size_t)512 * 16384 * 2);
  p.x1 = (float*)take((size_t)T * D * 4);
  p.wts = (float*)take((size_t)T * 8 * 4);
  p.list = (int*)take((size_t)NE * ECAP * 4);
  p.gates = (float*)take((size_t)T * 24 * 4);
  p.winb = (bf16_t*)take((size_t)D * INW * 2); p.woutb = (bf16_t*)take((size_t)D * D * 2); p.wrb = (bf16_t*)take((size_t)D * NE * 2);
  p.wgsb = (bf16_t*)take((size_t)D * 256 * 2); p.wusb = (bf16_t*)take((size_t)D * 256 * 2); p.wdsb = (bf16_t*)take((size_t)256 * D * 2);
  p.cw1kb = (bf16_t*)take(2048 * 128 * 2); p.cw1vb = (bf16_t*)take(2048 * 128 * 2); p.cw2kb = (bf16_t*)take(128 * 64 * 2); p.cw2vb = (bf16_t*)take(128 * 64 * 2);
  p.hb = (bf16_t*)take((size_t)T * D * 2);
  p.projb = (bf16_t*)take((size_t)T * PJW * 2);
  p.mixb = (bf16_t*)take((size_t)T * D * 2); p.h2b = (bf16_t*)take((size_t)T * D * 2);
  p.slab = (bf16_t*)take((size_t)T * 8 * D * 2);
  p.kcmpb = (bf16_t*)take((2048 + 64) * 64 * 2); p.vcmpb = (bf16_t*)take((2048 + 64) * 64 * 2);
  p.onsab = (bf16_t*)take((size_t)T * 512 * 2);
  if (off > ws_size) { fprintf(stderr, "kernel_launch: workspace too small: need %zu have %zu\n", off, ws_size); return; }
  static int grid = 0;
  if (!grid) {
    int dev = 0, cus = 0, per_cu = 0;
    (void)hipGetDevice(&dev);
    (void)hipDeviceGetAttribute(&cus, hipDeviceAttributeMultiprocessorCount, dev);
    (void)hipFuncSetAttribute((const void*)mega, hipFuncAttributeMaxDynamicSharedMemorySize, LDS_BYTES);
    (void)hipOccupancyMaxActiveBlocksPerMultiprocessor(&per_cu, (const void*)mega, 512, LDS_BYTES);
    if (per_cu < 1) fprintf(stderr, "kernel_launch: occupancy query says %d blocks per CU\n", per_cu);
    grid = cus;
  }
  (void)hipMemsetAsync(d_ws, 0, zero_bytes, stream);
  hipLaunchKernelGGL(mega, dim3(grid), dim3(512), LDS_BYTES, stream, p, 0, NPHASE);
}
```

```cpp
#include <hip/hip_runtime.h>
#include <cstdint>
#include <cstdio>

namespace {
constexpr int D = 1024, BATCH = 4, SEQ = 4096, T = BATCH * SEQ;
constexpr int INW = 3352;
constexpr int C_QN = 0, C_KC = 512, C_VC = 640, C_KS = 768, C_VS = 896, C_KW = 1024, C_VW = 1152, C_GN = 1280,
              C_QR = 1304, C_KR = 1816, C_VR = 2328, C_GR = 2840;
constexpr int PJW = 3328, J_QN = 0, J_KC = 512, J_VC = 640, J_KS = 768, J_VS = 896, J_KW = 1024, J_VW = 1152, J_QR = 1280, J_KR = 1792, J_VR = 2304, J_GR = 2816;
constexpr int NC = 255, NCR = BATCH * 2 * NC;
constexpr int NE = 256, ECAP = 16384;
constexpr float EPS = 1e-6f;
typedef unsigned short bf16_t;

struct P {
  const float *x, *c; const int* pos;
  const float *w_ada, *b_ada, *g_mix, *w_in, *cpk, *cw1k, *cw2k, *cpv, *cw1v, *cw2v, *g_nsa, *g_ret, *w_out, *g_ffn,
      *w_router, *rbias, *wg_e, *wu_e, *wd_e, *wg_s, *wu_s, *wd_s, *g_final;
  float* out;
  float *mod, *h, *proj, *hidk, *hidv, *kcmp, *vcmp, *onsa, *Sc, *kv, *retout, *mixin, *x1, *logits, *wts, *Gs, *acts,
      *G, *act, *yacc, *gates;
  int *cnt, *list, *tile_e, *tile_off, *ntiles;
  bf16_t *winb, *woutb, *wrb, *wgsb, *wusb, *wdsb, *cw1kb, *cw1vb, *cw2kb, *cw2vb, *hb, *projb, *mixb, *h2b, *slab, *kcmpb, *vcmpb, *onsab, *stateb, *actsb;
  float *hidp;
  unsigned* bar;
};

#define LAS __attribute__((address_space(3)))
typedef LAS char* lptr;
typedef short bf16x8 __attribute__((ext_vector_type(8)));
typedef short v4i16_t __attribute__((ext_vector_type(4)));
typedef float f32x16 __attribute__((ext_vector_type(16)));
typedef float f32x4 __attribute__((ext_vector_type(4)));
typedef float f32x2_t __attribute__((ext_vector_type(2)));
typedef __bf16 bf16x2_t __attribute__((ext_vector_type(2)));
typedef unsigned u32x4 __attribute__((ext_vector_type(4)));
typedef unsigned u32x2 __attribute__((ext_vector_type(2)));

__device__ __forceinline__ float wave_sum(float v) {
#pragma unroll
  for (int o = 1; o < 64; o <<= 1) v += __shfl_xor(v, o);
  return v;
}
__device__ __forceinline__ float wave_max(float v) {
#pragma unroll
  for (int o = 1; o < 64; o <<= 1) v = fmaxf(v, __shfl_xor(v, o));
  return v;
}
__device__ __forceinline__ float silu(float v) { return v / (1.f + expf(-v)); }
__device__ __forceinline__ float sigm(float v) { return 1.f / (1.f + expf(-v)); }
__device__ __forceinline__ float gelu_tanh(float v) { return 0.5f * v * (1.f + tanhf(0.7978845608028654f * (v + 0.044715f * v * v * v))); }
__device__ __forceinline__ unsigned pk2(float lo, float hi) { f32x2_t v = {lo, hi}; bf16x2_t b = __builtin_convertvector(v, bf16x2_t); return __builtin_bit_cast(unsigned, b); }
__device__ __forceinline__ float bf2f(bf16_t u) { return __uint_as_float((unsigned)u << 16); }
__device__ __forceinline__ float bflo(unsigned u) { return __uint_as_float(u << 16); }
__device__ __forceinline__ float bfhi(unsigned u) { return __uint_as_float(u & 0xffff0000u); }

#define XB_TMO      128
#define XB_XCNT(j)  (256  + 64 * (j))
#define XB_XSUB(j)  (1280 + 64 * (j))
#define XB_XGEN(j)  (2304 + 64 * (j))
#define XB_TOP      3328
#define XB_TOPGEN   3392
#define XCD_BAR_WORDS 3456
#define XB_SPIN_CAP (1u << 18)
__device__ __forceinline__ unsigned xb_ld(unsigned* p)              { return __hip_atomic_load(p, __ATOMIC_RELAXED, __HIP_MEMORY_SCOPE_AGENT); }
__device__ __forceinline__ unsigned xb_add(unsigned* p, unsigned v) { return __hip_atomic_fetch_add(p, v, __ATOMIC_RELAXED, __HIP_MEMORY_SCOPE_AGENT); }
__device__ __forceinline__ unsigned xb_xcc_id() { return (unsigned)__builtin_amdgcn_s_getreg((3 << 11) | 20) & 0xFu; }
#define XB_SPIN(cond, bar) do { unsigned _sp = 0; while (cond) { __builtin_amdgcn_s_sleep(1); \
    if ((++_sp & 255u) == 0u) { if (xb_ld(&(bar)[XB_TMO])) break; if (_sp > XB_SPIN_CAP) { atomicAdd(&(bar)[XB_TMO], 1u); break; } } } } while (0)
struct XcdBarrier { unsigned* bar; unsigned x; volatile LAS unsigned* st; };
__device__ __forceinline__ XcdBarrier xcd_barrier_post(unsigned* bar, volatile LAS unsigned* st) {
    XcdBarrier b; b.bar = bar; b.x = xb_xcc_id(); b.st = st;
    if (threadIdx.x == 0) (void)xb_add(&bar[XB_XCNT(b.x)], 1u);
    return b;
}
__device__ __forceinline__ void xcd_barrier_complete(unsigned* bar, unsigned x, unsigned& nloc, unsigned& nx) {
    const unsigned G = gridDim.x * gridDim.y * gridDim.z;
    unsigned sum, cnt, mine, sp = 0u;
    for (;;) {
        sum = 0u; cnt = 0u; mine = 0u;
#pragma unroll
        for (unsigned j = 0; j < 16; ++j) { const unsigned c = xb_ld(&bar[XB_XCNT(j)]); sum += c; cnt += (c > 0u) ? 1u : 0u; mine = (j == x) ? c : mine; }
        if (sum == G) break;
        __builtin_amdgcn_s_sleep(1);
        if ((++sp & 255u) == 0u) { if (xb_ld(&bar[XB_TMO])) break; if (sp > XB_SPIN_CAP) { atomicAdd(&bar[XB_TMO], 1u); break; } }
    }
    nloc = mine > 0u ? mine : 1u; nx = cnt > 0u ? cnt : 1u;
}
__device__ __forceinline__ void xcd_barrier(const XcdBarrier& b) {
    asm volatile("s_waitcnt vmcnt(0)" ::: "memory");
    __syncthreads();
    if (threadIdx.x == 0) {
        unsigned* bar = b.bar;
        __builtin_amdgcn_s_waitcnt(0);
        unsigned nloc = b.st[0], nx = b.st[1];
        if (nloc == 0u) { xcd_barrier_complete(bar, b.x, nloc, nx); b.st[0] = nloc; b.st[1] = nx; }
        const unsigned old = xb_add(&bar[XB_XSUB(b.x)], 1u);
        const unsigned gen = old / nloc;
        if (old + 1u == (gen + 1u) * nloc) {
            __builtin_amdgcn_fence(__ATOMIC_RELEASE, "agent");
            asm volatile("s_waitcnt vmcnt(0)" ::: "memory");
            const unsigned og = xb_add(&bar[XB_TOP], 1u);
            const unsigned tg = og / nx;
            if (og + 1u == (tg + 1u) * nx) xb_add(&bar[XB_TOPGEN], 1u);
            else XB_SPIN(xb_ld(&bar[XB_TOPGEN]) == tg, bar);
            __builtin_amdgcn_fence(__ATOMIC_ACQUIRE, "agent");
            xb_add(&bar[XB_XGEN(b.x)], 1u);
            asm volatile("s_waitcnt vmcnt(0)" ::: "memory");
        } else {
            XB_SPIN(xb_ld(&bar[XB_XGEN(b.x)]) == gen, bar);
            __builtin_amdgcn_fence(__ATOMIC_ACQUIRE, "agent");
            asm volatile("s_waitcnt vmcnt(0)" ::: "memory");
        }
    }
    __syncthreads();
}

__device__ __forceinline__ bf16x8 frag_kmaj(lptr img, int rs, int o, int s, int lane) {
  const int h = lane >> 5, blk = (lane >> 4) & 1, q = (lane & 15) >> 2, pp = lane & 3;
  lptr a = img + (16 * s + 8 * h + q) * rs + (o + 16 * blk + 4 * pp) * 2;
  const v4i16_t lo = __builtin_amdgcn_ds_read_tr16_b64_v4i16((LAS v4i16_t*)a);
  const v4i16_t hi = __builtin_amdgcn_ds_read_tr16_b64_v4i16((LAS v4i16_t*)(a + 4 * rs));
  return (bf16x8){lo[0], lo[1], lo[2], lo[3], hi[0], hi[1], hi[2], hi[3]};
}
__device__ __forceinline__ bf16x8 frag_kmin(lptr img, int o, int s, int lane) {
  const int row = o + (lane & 31), c = 2 * s + (lane >> 5);
  return *(LAS bf16x8*)(img + row * 64 + ((c ^ ((row >> 2) & 3)) << 4));
}
__device__ __forceinline__ int kmin_off(int row, int c) { return row * 64 + ((c ^ ((row >> 2) & 3)) << 4); }

template <int TM, int TN, bool WKMAJ, bool XKMAJ>
__device__ __forceinline__ void mma_step(f32x16 (&acc)[TM][TN], lptr wimg, int wrs, int wn0, lptr ximg, int xrs, int xt0, int lane) {
#pragma unroll
  for (int s = 0; s < 2; ++s) {
    bf16x8 wf[TM], xf[TN];
#pragma unroll
    for (int tm = 0; tm < TM; ++tm) wf[tm] = WKMAJ ? frag_kmaj(wimg, wrs, wn0 + 32 * tm, s, lane) : frag_kmin(wimg, wn0 + 32 * tm, s, lane);
#pragma unroll
    for (int tn = 0; tn < TN; ++tn) xf[tn] = XKMAJ ? frag_kmaj(ximg, xrs, xt0 + 32 * tn, s, lane) : frag_kmin(ximg, xt0 + 32 * tn, s, lane);
#pragma unroll
    for (int tm = 0; tm < TM; ++tm)
#pragma unroll
      for (int tn = 0; tn < TN; ++tn) acc[tm][tn] = __builtin_amdgcn_mfma_f32_32x32x16_bf16(wf[tm], xf[tn], acc[tm][tn], 0, 0, 0);
    if (s == 0) __builtin_amdgcn_sched_barrier(0);
  }
}

template <int BNT> struct WRegB16 { u32x4 r[BNT / 128]; };
template <int BNT> __device__ __forceinline__ void wload_b16(WRegB16<BNT>& R, const bf16_t* src  , int ld, int tid) {
  constexpr int C8 = BNT / 8, KPR = 512 / C8;
  const int c8 = tid % C8, kr = tid / C8;
#pragma unroll
  for (int r = 0; r < BNT / 128; ++r) R.r[r] = *(const u32x4*)(src + (size_t)(kr + r * KPR) * ld + c8 * 8);
}
template <int BNT> __device__ __forceinline__ void wstore_b16(const WRegB16<BNT>& R, lptr img, int rs, int tid) {
  constexpr int C8 = BNT / 8, KPR = 512 / C8;
  const int c8 = tid % C8, kr = tid / C8;
#pragma unroll
  for (int r = 0; r < BNT / 128; ++r) *(LAS u32x4*)(img + (kr + r * KPR) * rs + c8 * 16) = R.r[r];
}
template <int BMT> struct XRegB16 { u32x4 r[(BMT + 127) / 128]; };
template <int BMT> __device__ __forceinline__ void xload_b16(XRegB16<BMT>& R, const bf16_t* const (&rowp)[(BMT + 127) / 128], int k0, int tid) {
#pragma unroll
  for (int r = 0; r < (BMT + 127) / 128; ++r) if (BMT >= 128 || tid < BMT * 4) R.r[r] = *(const u32x4*)(rowp[r] + k0 + (tid & 3) * 8);
}
template <int BMT> __device__ __forceinline__ void xstore_b16(const XRegB16<BMT>& R, lptr img, int tid) {
#pragma unroll
  for (int r = 0; r < (BMT + 127) / 128; ++r) if (BMT >= 128 || tid < BMT * 4) *(LAS u32x4*)(img + kmin_off((tid >> 2) + 128 * r, tid & 3)) = R.r[r];
}

template <int BNT> struct WLb16 {
  typedef WRegB16<BNT> Regs; const bf16_t* src; int ld;
  __device__ __forceinline__ void load(Regs& R, int k0, int tid) const { wload_b16<BNT>(R, src + (size_t)k0 * ld, ld, tid); }
  __device__ __forceinline__ void store(const Regs& R, lptr img, int rs, int tid) const { wstore_b16<BNT>(R, img, rs, tid); }
};
struct WLgu {
  typedef WRegB16<512> Regs; const bf16_t *g, *u;
  __device__ __forceinline__ void load(Regs& R, int k0, int tid) const {
    const int c8 = tid & 63, kr = tid >> 6, col = c8 * 8, grp = col >> 6, w = col & 63;
    const unsigned long long ga = (unsigned long long)g, ua = (unsigned long long)u;
    const bf16_t* s = (const bf16_t*)(w < 32 ? ga : ua) + grp * 32 + (w & 31);
#pragma unroll
    for (int r = 0; r < 4; ++r) R.r[r] = *(const u32x4*)(s + (size_t)(k0 + kr + r * 8) * 256);
  }
  __device__ __forceinline__ void store(const Regs& R, lptr img, int rs, int tid) const { wstore_b16<512>(R, img, rs, tid); }
};
struct WReg32x8 { f32x4 r[8]; };
__device__ __forceinline__ void wstore_f32_512(const WReg32x8& R, lptr img, int rs, int tid) {
  const int c4 = tid & 127, kr = tid >> 7;
#pragma unroll
  for (int r = 0; r < 8; ++r) { u32x2 o; o.x = pk2(R.r[r].x, R.r[r].y); o.y = pk2(R.r[r].z, R.r[r].w); *(LAS u32x2*)(img + (kr + 4 * r) * rs + c4 * 8) = o; }
}
struct WLf32 {
  typedef WReg32x8 Regs; const float* src; int ld;
  __device__ __forceinline__ void load(Regs& R, int k0, int tid) const {
    const float* s = src + (size_t)(k0 + (tid >> 7)) * ld + (tid & 127) * 4;
#pragma unroll
    for (int r = 0; r < 8; ++r) R.r[r] = *(const f32x4*)(s + (size_t)(4 * r) * ld);
  }
  __device__ __forceinline__ void store(const Regs& R, lptr img, int rs, int tid) const { wstore_f32_512(R, img, rs, tid); }
};
struct WLf32gu {
  typedef WReg32x8 Regs; const float *g, *u;
  __device__ __forceinline__ void load(Regs& R, int k0, int tid) const {
    const int col = (tid & 127) * 4, grp = col >> 7, w = col & 127;
    const unsigned long long ga = (unsigned long long)g, ua = (unsigned long long)u;
    const float* s = (const float*)(w < 64 ? ga : ua) + (size_t)(k0 + (tid >> 7)) * 256 + grp * 64 + (w & 63);
#pragma unroll
    for (int r = 0; r < 8; ++r) R.r[r] = *(const f32x4*)(s + (size_t)(4 * r) * 256);
  }
  __device__ __forceinline__ void store(const Regs& R, lptr img, int rs, int tid) const { wstore_f32_512(R, img, rs, tid); }
};
template <int BMT> struct XLrows {
  typedef XRegB16<BMT> Regs; const bf16_t* rowp[(BMT + 127) / 128]; lptr ximg;
  __device__ __forceinline__ void load(Regs& R, int k0, int tid) const { xload_b16<BMT>(R, rowp, k0, tid); }
  __device__ __forceinline__ void store(const Regs& R, int tid) const { xstore_b16<BMT>(R, ximg, tid); }
  __device__ __forceinline__ lptr img(int) const { return ximg; }
};
struct XLres {
  struct Regs {}; lptr base; int bytes;
  __device__ __forceinline__ void load(Regs&, int, int) const {}
  __device__ __forceinline__ void store(const Regs&, int) const {}
  __device__ __forceinline__ lptr img(int k0) const { return base + (k0 >> 5) * bytes; }
};
template <int TM, int TN, class WL, class XL, bool WK = true, bool XK = false>
__device__ __forceinline__ void gemm_loop(f32x16 (&acc)[TM][TN], int K, const WL& wl, const XL& xl, lptr wimg, int wrs, int wn0, int xt0, int tid, int lane, int xrs = 0) {
  asm volatile("" : "+v"(tid), "+v"(lane));
  typename WL::Regs wr; typename XL::Regs xr;
  wl.load(wr, 0, tid); xl.load(xr, 0, tid);
  for (int k0 = 0; k0 < K; k0 += 32) {
    wl.store(wr, wimg, wrs, tid); xl.store(xr, tid);
    __syncthreads();
    if (k0 + 32 < K) { wl.load(wr, k0 + 32, tid); xl.load(xr, k0 + 32, tid); }
    mma_step<TM, TN, WK, XK>(acc, wimg, wrs, wn0, xl.img(k0), xrs, xt0, lane);
    __syncthreads();
  }
}
template <int TM, int TN, class WL, class XL, bool WK = true, bool XK = false>
__device__ __forceinline__ void gemm_loop2(f32x16 (&acc)[TM][TN], int K, const WL& wl, const XL& xl, lptr wimg, int wrs, int wn0, int xt0, int tid, int lane, int xrs = 0) {
  asm volatile("" : "+v"(tid), "+v"(lane));
  typename WL::Regs wa, wb; typename XL::Regs xa, xb;
  wl.load(wa, 0, tid); xl.load(xa, 0, tid); wl.load(wb, 32, tid); xl.load(xb, 32, tid);
  for (int k0 = 0; k0 < K; k0 += 64) {
    wl.store(wa, wimg, wrs, tid); xl.store(xa, tid);
    __syncthreads();
    if (k0 + 64 < K) { wl.load(wa, k0 + 64, tid); xl.load(xa, k0 + 64, tid); }
    mma_step<TM, TN, WK, XK>(acc, wimg, wrs, wn0, xl.img(k0), xrs, xt0, lane);
    __syncthreads();
    wl.store(wb, wimg, wrs, tid); xl.store(xb, tid);
    __syncthreads();
    if (k0 + 96 < K) { wl.load(wb, k0 + 96, tid); xl.load(xb, k0 + 96, tid); }
    mma_step<TM, TN, WK, XK>(acc, wimg, wrs, wn0, xl.img(k0 + 32), xrs, xt0, lane);
    __syncthreads();
  }
}
template <int TM, int TN> __device__ __forceinline__ void acc_zero(f32x16 (&acc)[TM][TN]) {
#pragma unroll
  for (int a = 0; a < TM; ++a)
#pragma unroll
    for (int b = 0; b < TN; ++b)
#pragma unroll
      for (int r = 0; r < 16; ++r) acc[a][b][r] = 0.f;
}

struct WLgu256 {
  typedef WRegB16<256> Regs; const bf16_t *g, *u; int abase;
  __device__ __forceinline__ void load(Regs& R, int k0, int tid) const {
    const int col = (tid & 31) * 8, grp = col >> 7, w = col & 127;
    const unsigned long long ga = (unsigned long long)g, ua = (unsigned long long)u;
    const bf16_t* s = (const bf16_t*)(w < 64 ? ga : ua) + abase + grp * 64 + (w & 63) + (size_t)(k0 + (tid >> 5)) * 256;
#pragma unroll
    for (int r = 0; r < 2; ++r) R.r[r] = *(const u32x4*)(s + (size_t)(r * 16) * 256);
  }
  __device__ __forceinline__ void store(const Regs& R, lptr img, int rs, int tid) const { wstore_b16<256>(R, img, rs, tid); }
};
template <class WL>
__device__ __forceinline__ void gemm256(f32x16 (&acc)[4][2], const WL& wl, const bf16_t* xbase, int ldx, int t0, int K, lptr lds, int wn, int wt, int tid, int lane) {
  constexpr int WRS = 256 * 2 + 64;
  XLrows<256> xl; xl.rowp[0] = xbase + (size_t)(t0 + (tid >> 2)) * ldx; xl.rowp[1] = xl.rowp[0] + (size_t)128 * ldx; xl.ximg = lds + 32 * WRS;
  acc_zero<4, 2>(acc);
  gemm_loop2<4, 2>(acc, K, wl, xl, lds, WRS, wn * 128, wt * 64, tid, lane);
}
constexpr int LDS_INV64 = 150 * 1024, LDS_INV128 = LDS_INV64 + 128, LDS_XB = LDS_INV128 + 256, LDS_BYTES = 152 * 1024;

__device__ __forceinline__ void cvt_items(const float* src, bf16_t* dst, size_t n8, int gtid, int gthreads) {
  for (size_t i = gtid; i < n8; i += gthreads) {
    const f32x4 a = *(const f32x4*)(src + i * 8), b = *(const f32x4*)(src + i * 8 + 4);
    u32x4 o; o.x = pk2(a.x, a.y); o.y = pk2(a.z, a.w); o.z = pk2(b.x, b.y); o.w = pk2(b.z, b.w);
    *(u32x4*)(dst + i * 8) = o;
  }
}
__device__ __forceinline__ void phase0a(const P& p, lptr lds, int vcu, int G) {
  const int tid = threadIdx.x, wid = tid >> 6, lane = tid & 63;
  if (vcu < 96) {
    const int j = vcu * 64 + lane;
    float a0 = 0.f, a1 = 0.f, a2 = 0.f, a3 = 0.f;
    for (int k = wid * 128; k < wid * 128 + 128; k += 8) {
      float w[8];
#pragma unroll
      for (int q = 0; q < 8; ++q) w[q] = p.w_ada[(size_t)(k + q) * 6144 + j];
#pragma unroll
      for (int q = 0; q < 8; ++q) { a0 += silu(p.c[k + q]) * w[q]; a1 += silu(p.c[D + k + q]) * w[q]; a2 += silu(p.c[2 * D + k + q]) * w[q]; a3 += silu(p.c[3 * D + k + q]) * w[q]; }
    }
    LAS float* part = (LAS float*)lds;
    part[(wid * 4 + 0) * 64 + lane] = a0; part[(wid * 4 + 1) * 64 + lane] = a1; part[(wid * 4 + 2) * 64 + lane] = a2; part[(wid * 4 + 3) * 64 + lane] = a3;
    __syncthreads();
    if (wid < 4) { float s = p.b_ada[j];
#pragma unroll
      for (int w = 0; w < 8; ++w) s += part[(w * 4 + wid) * 64 + lane];
      p.mod[wid * 6144 + j] = s; }
    __syncthreads();
  }
  const int gtid = vcu * 512 + tid, gth = G * 512;
  cvt_items(p.w_in, p.winb, (size_t)D * INW / 8, gtid, gth);
  cvt_items(p.w_out, p.woutb, (size_t)D * D / 8, gtid, gth);
  cvt_items(p.w_router, p.wrb, (size_t)D * NE / 8, gtid, gth);
  cvt_items(p.wg_s, p.wgsb, (size_t)D * 256 / 8, gtid, gth);
  cvt_items(p.wu_s, p.wusb, (size_t)D * 256 / 8, gtid, gth);
  cvt_items(p.wd_s, p.wdsb, (size_t)256 * D / 8, gtid, gth);
  cvt_items(p.cw1k, p.cw1kb, (size_t)2048 * 128 / 8, gtid, gth);
  cvt_items(p.cw1v, p.cw1vb, (size_t)2048 * 128 / 8, gtid, gth);
  cvt_items(p.cw2k, p.cw2kb, (size_t)128 * 64 / 8, gtid, gth);
  cvt_items(p.cw2v, p.cw2vb, (size_t)128 * 64 / 8, gtid, gth);
}

__device__ __forceinline__ void phase0b(const P& p, lptr lds, int vcu, int G) {
  const int tid = threadIdx.x, wid = tid >> 6, lane = tid & 63;
  LAS float* wg = (LAS float*)lds;
  for (int i = tid; i < D * 24; i += 512) wg[(i % 24) * D + (i / 24)] = p.w_in[(size_t)(i / 24) * INW + C_GN + (i % 24)];
  __syncthreads();
  for (int row = vcu * 8 + wid; row < T; row += G * 8) {
    const int b = row / SEQ;
    f32x4 v[4]; float s = 0.f;
#pragma unroll
    for (int j = 0; j < 4; ++j) { v[j] = *(const f32x4*)(p.x + (size_t)row * D + j * 256 + lane * 4); s += v[j].x * v[j].x + v[j].y * v[j].y + v[j].z * v[j].z + v[j].w * v[j].w; }
    s = wave_sum(s);
    const float r = rsqrtf(s * (1.f / D) + EPS);
    f32x4 y[4];
#pragma unroll
    for (int j = 0; j < 4; ++j) {
      const int k = j * 256 + lane * 4;
      const f32x4 g = *(const f32x4*)(p.g_mix + k), sc = *(const f32x4*)(p.mod + b * 6144 + 1024 + k), sh = *(const f32x4*)(p.mod + b * 6144 + k);
      y[j].x = v[j].x * r * g.x * (1.f + sc.x) + sh.x; y[j].y = v[j].y * r * g.y * (1.f + sc.y) + sh.y;
      y[j].z = v[j].z * r * g.z * (1.f + sc.z) + sh.z; y[j].w = v[j].w * r * g.w * (1.f + sc.w) + sh.w;
      u32x2 o; o.x = pk2(y[j].x, y[j].y); o.y = pk2(y[j].z, y[j].w);
      *(u32x2*)(p.hb + (size_t)row * D + k) = o;
    }
#pragma unroll
    for (int half = 0; half < 2; ++half) {
      float ga[12];
#pragma unroll
      for (int q = 0; q < 12; ++q) {
        float a = 0.f;
#pragma unroll
        for (int j = 0; j < 4; ++j) { const f32x4 w = *(const LAS f32x4*)(wg + (half * 12 + q) * D + j * 256 + lane * 4); a += y[j].x * w.x + y[j].y * w.y + y[j].z * w.z + y[j].w * w.w; }
        ga[q] = a;
        if ((q & 3) == 3) __builtin_amdgcn_sched_barrier(0);
      }
#pragma unroll
      for (int q = 0; q < 12; ++q) { const float t = wave_sum(ga[q]); if (lane == q) p.gates[(size_t)row * 24 + half * 12 + q] = sigm(t); __builtin_amdgcn_sched_barrier(0); }
    }
  }
  __syncthreads();
}

#define ROPE_PAIR(X1, X2, posf, invrev, sc) do { float pf_ = (posf); asm volatile("" : "+v"(pf_)); const float fr_ = __builtin_amdgcn_fractf(pf_ * (invrev)); \
    const float sn_ = __builtin_amdgcn_sinf(fr_), cs_ = __builtin_amdgcn_cosf(fr_); const float a_ = (X1), b_ = (X2); \
    float o1_ = (a_ * cs_ - b_ * sn_) * (sc), o2_ = (a_ * sn_ + b_ * cs_) * (sc); asm volatile("" : "+v"(o1_), "+v"(o2_)); (X1) = o1_; (X2) = o2_; } while (0)
__device__ __forceinline__ void phase1(const P& p, lptr lds, int vcu, int G) {
  const int tid = threadIdx.x, wid = __builtin_amdgcn_readfirstlane(tid >> 6), lane = tid & 63, wn = wid >> 2, wt = wid & 3, h = lane >> 5;
  const LAS float* inv64 = (const LAS float*)(lds + LDS_INV64);
  const LAS float* inv128 = (const LAS float*)(lds + LDS_INV128);
  for (int u = vcu; u < 13 * 64; u += G) {
    const int j = u % 13, mt = u / 13, t0 = mt * 256;
    const int wcol = j < 5 ? j * 256 : C_QR + (j - 5) * 256;
    f32x16 acc[4][2];
    { WLb16<256> wl; wl.src = p.winb + wcol; wl.ld = INW; gemm256(acc, wl, p.hb, D, t0, D, lds, wn, wt, tid, lane); }
    const int kind = (j < 2) ? 0 : (j == 2) ? 3 : (j < 5) ? (wn == 0 ? 1 : 3) : (j < 7) ? 2 : (j < 9) ? 4 : (j < 11) ? 3 : 5;
#pragma unroll
    for (int tn = 0; tn < 2; ++tn) {
      const int tok = t0 + wt * 64 + tn * 32 + (lane & 31);
      const float posf = (float)p.pos[tok];
      if (kind == 0 || kind == 1) {
        const float sc = kind == 0 ? 0.125f : 1.f;
#pragma unroll
        for (int r = 0; r < 16; ++r) { const float iv = inv64[(r & 3) + 8 * (r >> 2) + 4 * h];
          ROPE_PAIR(acc[0][tn][r], acc[1][tn][r], posf, iv, sc); ROPE_PAIR(acc[2][tn][r], acc[3][tn][r], posf, iv, sc); if ((r & 3) == 3) __builtin_amdgcn_sched_barrier(0); }
      } else if (kind == 2 || kind == 4) {
        const float sc = kind == 4 ? 0.08838834764831845f : 1.f;
#pragma unroll
        for (int r = 0; r < 16; ++r) { const int i = (r & 3) + 8 * (r >> 2) + 4 * h;
          ROPE_PAIR(acc[0][tn][r], acc[2][tn][r], posf, inv128[i], sc); ROPE_PAIR(acc[1][tn][r], acc[3][tn][r], posf, inv128[32 + i], sc); if ((r & 3) == 3) __builtin_amdgcn_sched_barrier(0); }
      } else if (kind == 5) {
#pragma unroll
        for (int tm = 0; tm < 4; ++tm)
#pragma unroll
          for (int r = 0; r < 16; ++r) { float v = acc[tm][tn][r]; asm volatile("" : "+v"(v)); float o = v * __builtin_amdgcn_rcpf(1.f + __builtin_amdgcn_exp2f(-1.4426950408889634f * v)); asm volatile("" : "+v"(o)); acc[tm][tn][r] = o; }
      }
      bf16_t* orow = p.projb + (size_t)tok * PJW + j * 256 + wn * 128 + 4 * h;
#pragma unroll
      for (int tm = 0; tm < 4; ++tm)
#pragma unroll
        for (int a = 0; a < 4; ++a) { u32x2 o; o.x = pk2(acc[tm][tn][4 * a], acc[tm][tn][4 * a + 1]); o.y = pk2(acc[tm][tn][4 * a + 2], acc[tm][tn][4 * a + 3]);
          *(u32x2*)(orow + tm * 32 + a * 8) = o; __builtin_amdgcn_sched_barrier(0); }
    }
  }
}

__device__ __forceinline__ void phase5(const P& p, lptr lds, int vcu, int G) {
  const int tid = threadIdx.x, wid = __builtin_amdgcn_readfirstlane(tid >> 6), lane = tid & 63, h = lane >> 5, l31 = lane & 31;
  constexpr int WRS1 = 1024 * 2 + 64;
  lptr wimg = lds, ximg = lds + 32 * WRS1;
  lptr lgb = lds + 72 * 1024;
  LAS float* part = (LAS float*)(lds + 138 * 1024);
  LAS float* rstd = part + 512;
  for (int u = vcu; u < T / 64; u += G) {
    const int t0 = u * 64, b = t0 / SEQ;
    f32x16 acc[4][2];
    acc_zero<4, 2>(acc);
    { WLb16<1024> wl; wl.src = p.woutb; wl.ld = D;
      XLrows<64> xl; xl.rowp[0] = p.mixb + (size_t)(t0 + ((tid >> 2) & 63)) * D; xl.ximg = ximg;
      gemm_loop<4, 2>(acc, D, wl, xl, wimg, WRS1, wid * 128, 0, tid, lane); }
    int nb = wid * 128 + 4 * h, tb = t0 + l31;
    asm volatile("" : "+v"(nb), "+v"(tb));
#pragma unroll
    for (int tn = 0; tn < 2; ++tn) {
      const int tok = tb + tn * 32; float ss = 0.f;
#pragma unroll
      for (int tm = 0; tm < 4; ++tm)
#pragma unroll
        for (int a = 0; a < 4; ++a) {
          const int n = nb + tm * 32 + a * 8;
          const f32x4 xv = *(const f32x4*)(p.x + (size_t)tok * D + n), gt = *(const f32x4*)(p.mod + b * 6144 + 2048 + n);
          f32x4 v; v.x = xv.x + gt.x * acc[tm][tn][4 * a]; v.y = xv.y + gt.y * acc[tm][tn][4 * a + 1]; v.z = xv.z + gt.z * acc[tm][tn][4 * a + 2]; v.w = xv.w + gt.w * acc[tm][tn][4 * a + 3];
          acc[tm][tn][4 * a] = v.x; acc[tm][tn][4 * a + 1] = v.y; acc[tm][tn][4 * a + 2] = v.z; acc[tm][tn][4 * a + 3] = v.w;
          *(f32x4*)(p.x1 + (size_t)tok * D + n) = v;
          ss += v.x * v.x + v.y * v.y + v.z * v.z + v.w * v.w;
          if (a == 3) __builtin_amdgcn_sched_barrier(0);
        }
      ss += __shfl_xor(ss, 32);
      if (h == 0) part[wid * 64 + tn * 32 + l31] = ss;
    }
    __syncthreads();
    if (tid < 64) { float q = 0.f;
#pragma unroll
      for (int w = 0; w < 8; ++w) q += part[w * 64 + tid];
      rstd[tid] = rsqrtf(q * (1.f / D) + EPS); }
    __syncthreads();
    asm volatile("" : "+v"(nb), "+v"(tb));
#pragma unroll
    for (int tn = 0; tn < 2; ++tn) {
      const int tok = tb + tn * 32; const float r = rstd[tn * 32 + l31];
#pragma unroll
      for (int tm = 0; tm < 4; ++tm)
#pragma unroll
        for (int a = 0; a < 4; ++a) {
          const int n = nb + tm * 32 + a * 8;
          const f32x4 g = *(const f32x4*)(p.g_ffn + n), sc = *(const f32x4*)(p.mod + b * 6144 + 4096 + n), sh = *(const f32x4*)(p.mod + b * 6144 + 3072 + n);
          u32x2 o;
          o.x = pk2(acc[tm][tn][4 * a] * r * g.x * (1.f + sc.x) + sh.x, acc[tm][tn][4 * a + 1] * r * g.y * (1.f + sc.y) + sh.y);
          o.y = pk2(acc[tm][tn][4 * a + 2] * r * g.z * (1.f + sc.z) + sh.z, acc[tm][tn][4 * a + 3] * r * g.w * (1.f + sc.w) + sh.w);
          *(u32x2*)(p.h2b + (size_t)tok * D + n) = o;
          if (a == 3) __builtin_amdgcn_sched_barrier(0);
        }
    }
    asm volatile("s_waitcnt vmcnt(0)" ::: "memory");
    __syncthreads();
    { f32x16 a2[1][2]; acc_zero<1, 2>(a2);
      WLb16<256> wl; wl.src = p.wrb; wl.ld = NE;
      XLrows<64> xl; xl.rowp[0] = p.h2b + (size_t)(t0 + ((tid >> 2) & 63)) * D; xl.ximg = ximg;
      gemm_loop<1, 2>(a2, D, wl, xl, wimg, 256 * 2 + 64, wid * 32, 0, tid, lane);
      int lo = ((l31 * 256 + wid * 32 + 4 * h) * 4);
      asm volatile("" : "+v"(lo));
#pragma unroll
      for (int tn = 0; tn < 2; ++tn)
#pragma unroll
        for (int a = 0; a < 4; ++a) { f32x4 v = {a2[0][tn][4 * a], a2[0][tn][4 * a + 1], a2[0][tn][4 * a + 2], a2[0][tn][4 * a + 3]};
          *(LAS f32x4*)(lgb + lo + (tn * 32 * 256 + a * 8) * 4) = v; } }
    __syncthreads();
    { int lane_ = lane; asm volatile("" : "+v"(lane_));
      const int lane = lane_;
      const f32x4 rb = *(const f32x4*)(p.rbias + lane * 4);
      for (int i = 0; i < 8; ++i) {
        const int tl = wid * 8 + i, tok = t0 + tl;
        const f32x4 lv = *(const LAS f32x4*)(lgb + (tl * 256 + lane * 4) * 4);
        const float s0 = sigm(lv.x), s1 = sigm(lv.y), s2 = sigm(lv.z), s3 = sigm(lv.w);
        float c0 = s0 + rb.x, c1 = s1 + rb.y, c2 = s2 + rb.z, c3 = s3 + rb.w;
        float m1, m2;
        { const float h1 = fmaxf(c0, c1), l1 = fminf(c0, c1), h2 = fmaxf(c2, c3), l2 = fminf(c2, c3); m1 = fmaxf(h1, h2); m2 = fmaxf(fminf(h1, h2), fmaxf(l1, l2)); }
#pragma unroll
        for (int o = 1; o < 8; o <<= 1) { const float o1 = __shfl_xor(m1, o), o2 = __shfl_xor(m2, o); const float n1 = fmaxf(m1, o1), n2 = fmaxf(fminf(m1, o1), fmaxf(m2, o2)); m1 = n1; m2 = n2; }
        const float gs = m1 + m2; const int myg = lane >> 3; int rank = 0;
#pragma unroll
        for (int g2 = 0; g2 < 8; ++g2) { const float og = __shfl(gs, g2 * 8); rank += (og > gs || (og == gs && g2 < myg)) ? 1 : 0; }
        if (rank >= 4) { c0 = -INFINITY; c1 = -INFINITY; c2 = -INFINITY; c3 = -INFINITY; }
        int my_e = 0; float my_s = 0.f;
#pragma unroll
        for (int k = 0; k < 8; ++k) {
          float bv = c0; int li = lane * 4;
          if (c1 > bv) { bv = c1; li = lane * 4 + 1; }
          if (c2 > bv) { bv = c2; li = lane * 4 + 2; }
          if (c3 > bv) { bv = c3; li = lane * 4 + 3; }
#pragma unroll
          for (int o = 1; o < 64; o <<= 1) { const float ov = __shfl_xor(bv, o); const int oi = __shfl_xor(li, o); if (ov > bv || (ov == bv && oi < li)) { bv = ov; li = oi; } }
          const int j = li & 3; const float sj = j == 0 ? s0 : j == 1 ? s1 : j == 2 ? s2 : s3;
          const float sv = __shfl(sj, li >> 2);
          if (lane * 4 == li) c0 = -INFINITY;
          if (lane * 4 + 1 == li) c1 = -INFINITY;
          if (lane * 4 + 2 == li) c2 = -INFINITY;
          if (lane * 4 + 3 == li) c3 = -INFINITY;
          if (lane == k) { my_e = li; my_s = sv; }
        }
        const float wsum = wave_sum(lane < 8 ? my_s : 0.f);
        if (lane < 8) { const int pos = atomicAdd(&p.cnt[my_e], 1); p.list[my_e * ECAP + pos] = tok * 8 + lane; p.wts[tok * 8 + lane] = my_s / wsum * 2.5f; }
      } }
    __syncthreads();
    { f32x16 a3[2][2]; acc_zero<2, 2>(a3);
      WLgu wl; wl.g = p.wgsb; wl.u = p.wusb;
      XLrows<64> xl; xl.rowp[0] = p.h2b + (size_t)(t0 + ((tid >> 2) & 63)) * D; xl.ximg = ximg;
      gemm_loop<2, 2>(a3, D, wl, xl, wimg, 512 * 2 + 64, wid * 64, 0, tid, lane);
      int l31_ = l31, h_ = h; asm volatile("" : "+v"(l31_), "+v"(h_));
#pragma unroll
      for (int tn = 0; tn < 2; ++tn)
#pragma unroll
        for (int a = 0; a < 4; ++a) {
          float o[4];
#pragma unroll
          for (int e = 0; e < 4; ++e) { const float gv = a3[0][tn][4 * a + e], uv = a3[1][tn][4 * a + e]; o[e] = gv * __builtin_amdgcn_rcpf(1.f + __builtin_amdgcn_exp2f(-1.4426950408889634f * gv)) * uv; }
          const int col = wid * 32 + a * 8 + 4 * h_;
          u32x2 w2; w2.x = pk2(o[0], o[1]); w2.y = pk2(o[2], o[3]);
          *(LAS u32x2*)(lgb + (col >> 5) * 4096 + kmin_off(tn * 32 + l31_, (col & 31) >> 3) + (col & 7) * 2) = w2;
        } }
    __syncthreads();
    acc_zero<4, 2>(acc);
    { WLb16<1024> wl; wl.src = p.wdsb; wl.ld = D;
      XLres xl; xl.base = lgb; xl.bytes = 4096;
      gemm_loop<4, 2>(acc, 256, wl, xl, wimg, WRS1, wid * 128, 0, tid, lane); }
    asm volatile("" : "+v"(nb), "+v"(tb));
#pragma unroll
    for (int tn = 0; tn < 2; ++tn) {
      const int tok = tb + tn * 32;
#pragma unroll
      for (int tm = 0; tm < 4; ++tm)
#pragma unroll
        for (int a = 0; a < 4; ++a) {
          const int n = nb + tm * 32 + a * 8;
          f32x4 v = *(const f32x4*)(p.x1 + (size_t)tok * D + n); const f32x4 gt = *(const f32x4*)(p.mod + b * 6144 + 5120 + n);
          v.x += gt.x * acc[tm][tn][4 * a]; v.y += gt.y * acc[tm][tn][4 * a + 1]; v.z += gt.z * acc[tm][tn][4 * a + 2]; v.w += gt.w * acc[tm][tn][4 * a + 3];
          *(f32x4*)(p.x1 + (size_t)tok * D + n) = v;
          if (a == 3) __builtin_amdgcn_sched_barrier(0);
        }
    }
    __syncthreads();
  }
}

__device__ __forceinline__ void phase6(const P& p, lptr lds, int vcu, int G) {
  const int tid = threadIdx.x, wid = __builtin_amdgcn_readfirstlane(tid >> 6), lane = tid & 63, h = lane >> 5, l31 = lane & 31, wn = wid >> 1, wt = wid & 1;
  constexpr int WRS = 512 * 2 + 64;
  lptr wimg = lds, ximg = lds + 32 * WRS;
  lptr actb = lds + 44 * 1024;
  LAS int* pre = (LAS int*)(lds + 110 * 1024);
  LAS int* sidl = pre + 320;
  if (tid < NE) pre[tid + 1] = (p.cnt[tid] + 127) >> 7;
  if (tid == 0) pre[0] = 0;
  __syncthreads();
  if (tid == 0) { int a = 0; for (int e = 1; e <= NE; ++e) { a += pre[e]; pre[e] = a; } }
  __syncthreads();
  const int nunits = pre[NE];
  for (int u = vcu; u < nunits; u += G) {
    int lo = 0, hi = NE;
    while (hi - lo > 1) { const int mid = (lo + hi) >> 1; if (pre[mid] <= u) lo = mid; else hi = mid; }
    const int e = lo, off = (u - pre[e]) * 128, cnt = p.cnt[e];
    if (tid < 128) sidl[tid] = off + tid < cnt ? p.list[e * ECAP + off + tid] : -1;
    __syncthreads();
    f32x16 acc[4][2];
    acc_zero<4, 2>(acc);
    { WLf32gu wl; wl.g = p.wg_e + (size_t)e * D * 256; wl.u = p.wu_e + (size_t)e * D * 256;
      XLrows<128> xl; { const int sd = sidl[(tid >> 2) & 127]; xl.rowp[0] = p.h2b + (size_t)(sd < 0 ? 0 : sd >> 3) * D; } xl.ximg = ximg;
      gemm_loop2<4, 2>(acc, D, wl, xl, wimg, WRS, wn * 128, wt * 64, tid, lane); }
    { int l31_ = l31, h_ = h; asm volatile("" : "+v"(l31_), "+v"(h_));
#pragma unroll
      for (int tn = 0; tn < 2; ++tn)
#pragma unroll
        for (int tm = 0; tm < 2; ++tm)
#pragma unroll
          for (int a = 0; a < 4; ++a) {
            float o[4];
#pragma unroll
            for (int q = 0; q < 4; ++q) { const float gv = acc[tm][tn][4 * a + q], uv = acc[tm + 2][tn][4 * a + q]; o[q] = gv * __builtin_amdgcn_rcpf(1.f + __builtin_amdgcn_exp2f(-1.4426950408889634f * gv)) * uv; }
            const int col = wn * 64 + tm * 32 + a * 8 + 4 * h_;
            u32x2 w2; w2.x = pk2(o[0], o[1]); w2.y = pk2(o[2], o[3]);
            *(LAS u32x2*)(actb + (col >> 5) * 8192 + kmin_off(wt * 64 + tn * 32 + l31_, (col & 31) >> 3) + (col & 7) * 2) = w2;
          } }
    __syncthreads();
#pragma unroll 1
    for (int pass = 0; pass < 2; ++pass) {
      acc_zero<4, 2>(acc);
      { WLf32 wl; wl.src = p.wd_e + (size_t)e * 256 * D + pass * 512; wl.ld = D;
        XLres xl; xl.base = actb; xl.bytes = 8192;
        gemm_loop2<4, 2>(acc, 256, wl, xl, wimg, WRS, wn * 128, wt * 64, tid, lane); }
      int nb = pass * 512 + wn * 128 + 4 * h, sl = wt * 64 + l31;
      asm volatile("" : "+v"(nb), "+v"(sl));
#pragma unroll
      for (int tn = 0; tn < 2; ++tn) {
        const int sd = sidl[sl + tn * 32];
        if (sd >= 0) {
          const float wgt = p.wts[sd];
          bf16_t* orow = p.slab + (size_t)sd * D + nb;
#pragma unroll
          for (int tm = 0; tm < 4; ++tm)
#pragma unroll
            for (int a = 0; a < 4; ++a) { u32x2 o; o.x = pk2(acc[tm][tn][4 * a] * wgt, acc[tm][tn][4 * a + 1] * wgt); o.y = pk2(acc[tm][tn][4 * a + 2] * wgt, acc[tm][tn][4 * a + 3] * wgt);
              *(u32x2*)(orow + tm * 32 + a * 8) = o; }
        }
      }
    }
    __syncthreads();
  }
}

__device__ __forceinline__ void phase7(const P& p, lptr lds, int vcu, int G) {
  const int tid = threadIdx.x, wid = tid >> 6, lane = tid & 63;
  for (int tok = vcu * 8 + wid; tok < T; tok += G * 8) {
    const int b = tok / SEQ;
    float v[16]; float ss = 0.f;
#pragma unroll
    for (int j = 0; j < 2; ++j) {
      const int n = j * 512 + lane * 8;
      float a[8];
#pragma unroll
      for (int q = 0; q < 8; ++q) a[q] = 0.f;
#pragma unroll
      for (int k = 0; k < 8; ++k) { const u32x4 w = *(const u32x4*)(p.slab + ((size_t)tok * 8 + k) * D + n);
        a[0] += bflo(w.x); a[1] += bfhi(w.x); a[2] += bflo(w.y); a[3] += bfhi(w.y); a[4] += bflo(w.z); a[5] += bfhi(w.z); a[6] += bflo(w.w); a[7] += bfhi(w.w); }
#pragma unroll
      for (int q4 = 0; q4 < 2; ++q4) {
        const f32x4 xv = *(const f32x4*)(p.x1 + (size_t)tok * D + n + q4 * 4), gt = *(const f32x4*)(p.mod + b * 6144 + 5120 + n + q4 * 4);
        const float y0 = xv.x + gt.x * a[q4 * 4], y1 = xv.y + gt.y * a[q4 * 4 + 1], y2 = xv.z + gt.z * a[q4 * 4 + 2], y3 = xv.w + gt.w * a[q4 * 4 + 3];
        v[j * 8 + q4 * 4] = y0; v[j * 8 + q4 * 4 + 1] = y1; v[j * 8 + q4 * 4 + 2] = y2; v[j * 8 + q4 * 4 + 3] = y3;
        ss += y0 * y0 + y1 * y1 + y2 * y2 + y3 * y3;
      }
    }
    ss = wave_sum(ss);
    const float r = rsqrtf(ss * (1.f / D) + EPS);
#pragma unroll
    for (int j = 0; j < 2; ++j)
#pragma unroll
      for (int q4 = 0; q4 < 2; ++q4) {
        const int n = j * 512 + lane * 8 + q4 * 4;
        const f32x4 g = *(const f32x4*)(p.g_final + n);
        f32x4 o; o.x = v[j * 8 + q4 * 4] * r * g.x; o.y = v[j * 8 + q4 * 4 + 1] * r * g.y; o.z = v[j * 8 + q4 * 4 + 2] * r * g.z; o.w = v[j * 8 + q4 * 4 + 3] * r * g.w;
        *(f32x4*)(p.out + (size_t)tok * D + n) = o;
      }
  }
}

constexpr int NSA_KB = 8192, NSA_VRS = 192, NSA_SLOT = NSA_KB + 64 * NSA_VRS, NSA_IMP = 2 * NSA_SLOT;
__device__ __forceinline__ void nsa_qk(f32x16 (&s)[2], lptr kimg, const bf16x8 (&qf)[4], int l31, int h) {
#pragma unroll
  for (int kt = 0; kt < 2; ++kt) {
#pragma unroll
    for (int r = 0; r < 16; ++r) s[kt][r] = 0.f;
    const int key = kt * 32 + l31;
#pragma unroll
    for (int ds = 0; ds < 4; ++ds) {
      const bf16x8 a = *(LAS bf16x8*)(kimg + key * 128 + (((2 * ds + h) ^ ((key >> 1) & 7)) << 4));
      s[kt] = __builtin_amdgcn_mfma_f32_32x32x16_bf16(a, qf[ds], s[kt], 0, 0, 0);
    }
  }
}
__device__ __forceinline__ void nsa_pv(f32x16 (&o)[2], lptr vimg, const f32x16 (&pr)[2], int lane) {
  const int h = lane >> 5, blk = (lane >> 4) & 1, q = (lane & 15) >> 2, pp = lane & 3;
  bf16x8 pb[4];
#pragma unroll
  for (int ks = 0; ks < 4; ++ks) {
    const int kt = ks >> 1, rb = 8 * (ks & 1);
    u32x4 w; w.x = pk2(pr[kt][rb], pr[kt][rb + 1]); w.y = pk2(pr[kt][rb + 2], pr[kt][rb + 3]); w.z = pk2(pr[kt][rb + 4], pr[kt][rb + 5]); w.w = pk2(pr[kt][rb + 6], pr[kt][rb + 7]);
    pb[ks] = __builtin_bit_cast(bf16x8, w);
  }
#pragma unroll
  for (int dt = 0; dt < 2; ++dt)
#pragma unroll
    for (int ks = 0; ks < 4; ++ks) {
      lptr a = vimg + (16 * ks + 4 * h + q) * NSA_VRS + (dt * 32 + 16 * blk + 4 * pp) * 2;
      const v4i16_t lo = __builtin_amdgcn_ds_read_tr16_b64_v4i16((LAS v4i16_t*)a);
      const v4i16_t hi = __builtin_amdgcn_ds_read_tr16_b64_v4i16((LAS v4i16_t*)(a + 8 * NSA_VRS));
      const bf16x8 vf = {lo[0], lo[1], lo[2], lo[3], hi[0], hi[1], hi[2], hi[3]};
      o[dt] = __builtin_amdgcn_mfma_f32_32x32x16_bf16(vf, pb[ks], o[dt], 0, 0, 0);
    }
}
__device__ __forceinline__ float fexp(float x) { return __builtin_amdgcn_exp2f(x * 1.4426950408889634f); }
__device__ __forceinline__ void phase_nsa(const P& p, lptr lds, int vcu, int G) {
  const int tid = threadIdx.x, wid = __builtin_amdgcn_readfirstlane(tid >> 6), lane0 = tid & 63;
  LAS float* imp = (LAS float*)(lds + NSA_IMP);
  LAS float* obuf = (LAS float*)(lds + NSA_IMP + 16384) + wid * 2048 + lane0;
  const int srow = tid >> 3, sch = tid & 7;
  for (int u = vcu; u < 512; u += G) {
    const int bg = u & 7, j0 = u < 256 ? 63 - (u >> 3) : ((u - 256) >> 3), b = bg >> 1, g = bg & 1, t0 = j0 * 64;
    const int t = t0 + wid * 8 + ((lane0 & 31) >> 2), hg = g * 4 + (lane0 & 3);
    const size_t trow = (size_t)(b * SEQ + t);
    bf16x8 qf[4];
#pragma unroll
    for (int ds = 0; ds < 4; ++ds) qf[ds] = *(const bf16x8*)(p.projb + trow * PJW + J_QN + hg * 64 + 16 * ds + 8 * (lane0 >> 5));
#pragma unroll
    for (int i = 0; i < 8; ++i) imp[(wid * 8 + i) * 64 + lane0] = 0.f;
    const int nct = (((t0 + 32) >> 4) >> 6) + 1, jw0 = j0 > 8 ? j0 - 8 : 0;
    const int itC = 2 * nct, itD = itC + j0 + 1, NI = itD + (j0 - jw0 + 1);
    const int cmaxt = t >= 31 ? (t - 31) >> 4 : -1;
    u32x4 kreg, vreg;
    const char* pbt = (const char*)(p.projb + (size_t)(b * SEQ) * PJW + g * 64) + (size_t)srow * (PJW * 2) + sch * 16;
    const char* kct = (const char*)(p.kcmpb + (size_t)bg * NC * 64) + srow * 128 + sch * 16;
    const char* vct = (const char*)(p.vcmpb + (size_t)bg * NC * 64) + srow * 128 + sch * 16;
#define NSA_LOAD(IT) do { const int it_ = (IT); \
      if (it_ < itC) { const unsigned o_ = (unsigned)(it_ < nct ? it_ : it_ - nct) * 8192u; kreg = *(const u32x4*)(kct + o_); vreg = *(const u32x4*)(vct + o_); } \
      else { const bool sel_ = it_ < itD; const unsigned o_ = (unsigned)(sel_ ? it_ - itC : jw0 + it_ - itD) * (unsigned)(64 * PJW * 2); \
             kreg = *(const u32x4*)(pbt + o_ + (sel_ ? J_KS * 2 : J_KW * 2)); vreg = *(const u32x4*)(pbt + o_ + (sel_ ? J_VS * 2 : J_VW * 2)); } } while (0)
#define NSA_STEP() lptr slot = lds + (it & 1) * NSA_SLOT; \
      *(LAS u32x4*)(slot + srow * 128 + ((sch ^ ((srow >> 1) & 7)) << 4)) = kreg; \
      *(LAS u32x4*)(slot + NSA_KB + srow * NSA_VRS + sch * 16) = vreg; \
      __syncthreads(); \
      if (it + 1 < NI) NSA_LOAD(it + 1); \
      int lane = lane0; asm volatile("" : "+v"(lane)); const int h = lane >> 5, l31 = lane & 31; (void)l31
    NSA_LOAD(0);
    int it = 0;
    float m1 = -1e30f, l1 = 0.f;
    for (; it < nct; ++it) {
      NSA_STEP();
      f32x16 s[2]; nsa_qk(s, slot, qf, l31, h);
      float mx = -1e30f;
#pragma unroll
      for (int r = 0; r < 16; ++r) { const int c = 64 * it + (r & 3) + 8 * (r >> 2) + 4 * h; if (c <= cmaxt) mx = fmaxf(mx, s[0][r]); if (c + 32 <= cmaxt) mx = fmaxf(mx, s[1][r]); }
      mx = fmaxf(mx, __shfl_xor(mx, 32));
      const float mn = fmaxf(m1, mx); float rs = 0.f;
#pragma unroll
      for (int r = 0; r < 16; ++r) { const int c = 64 * it + (r & 3) + 8 * (r >> 2) + 4 * h; rs += (c <= cmaxt ? fexp(s[0][r] - mn) : 0.f) + (c + 32 <= cmaxt ? fexp(s[1][r] - mn) : 0.f); }
      rs += __shfl_xor(rs, 32);
      l1 = l1 * fexp(m1 - mn) + rs; m1 = mn;
    }
    f32x16 o[2];
#pragma unroll
    for (int r = 0; r < 16; ++r) { o[0][r] = 0.f; o[1][r] = 0.f; }
    { const float il = 1.f / fmaxf(l1, 1e-20f);
      for (; it < itC; ++it) {
        NSA_STEP();
        const int i = it - nct, tl = l31 >> 2, r4 = l31 & 3;
        f32x16 s[2]; nsa_qk(s, slot, qf, l31, h);
#pragma unroll
        for (int r = 0; r < 16; ++r) { const int c = 64 * i + (r & 3) + 8 * (r >> 2) + 4 * h; s[0][r] = c <= cmaxt ? fexp(s[0][r] - m1) * il : 0.f; s[1][r] = c + 32 <= cmaxt ? fexp(s[1][r] - m1) * il : 0.f; }
#pragma unroll
        for (int kt = 0; kt < 2; ++kt)
#pragma unroll
          for (int a = 0; a < 4; ++a) {
            float v4 = (s[kt][4 * a] + s[kt][4 * a + 1]) + (s[kt][4 * a + 2] + s[kt][4 * a + 3]), cy = s[kt][4 * a + 3];
            v4 += __shfl_xor(v4, 1); v4 += __shfl_xor(v4, 2); cy += __shfl_xor(cy, 1); cy += __shfl_xor(cy, 2);
            const int jj = 16 * i + 8 * kt + 2 * a + h;
            if (r4 == 0) { LAS float* ip = imp + (wid * 8 + tl) * 64 + jj; ip[0] += v4; }
            if (r4 == 0 && jj < 63) { LAS float* ip = imp + (wid * 8 + tl) * 64 + jj + 1; ip[0] += cy; }
          }
        nsa_pv(o, slot + NSA_KB, s, lane);
      } }
    { const float g0 = p.gates[trow * 24 + hg * 3];
#pragma unroll
      for (int r = 0; r < 16; ++r) { obuf[r * 64] = g0 * o[0][r]; obuf[(16 + r) * 64] = g0 * o[1][r]; o[0][r] = 0.f; o[1][r] = 0.f; } }
    unsigned long long U = 0ull, mym = 0ull;
    __builtin_amdgcn_s_waitcnt(0xc07f);
    for (int i2 = 0; i2 < 8; ++i2) {
      float v = imp[(wid * 8 + i2) * 64 + lane0];
      const bool forced = lane0 == 0 || lane0 == j0 || lane0 == j0 - 1;
      v = lane0 <= j0 ? (forced ? v + 1e4f : v) : -1.f;
      unsigned long long msk = 0ull;
      for (int k = 0; k < 8; ++k) {
        float bv = v; int bi = lane0;
#pragma unroll
        for (int of = 1; of < 64; of <<= 1) { const float ov = __shfl_xor(bv, of); const int oi = __shfl_xor(bi, of); if (ov > bv || (ov == bv && oi < bi)) { bv = ov; bi = oi; } }
        msk |= 1ull << bi; if (lane0 == bi) v = -INFINITY;
      }
      U |= msk; if (((lane0 & 31) >> 2) == i2) mym = msk;
    }
    float m = -1e30f, l = 0.f;
#define NSA_ONLINE(MINE, LOWPOS, JB) do { \
      f32x16 s[2]; nsa_qk(s, slot, qf, l31, h); \
      const int tmin_ = t0 + wid * 8, tmax_ = tmin_ + 7; \
      const bool interior_ = (64 * (JB) + 63 <= tmin_) && (64 * (JB) > tmax_ - 512 || (LOWPOS) < 0);     \
      float mx = -1e30f, rs = 0.f, mn, alpha; \
      if (interior_) { \
        _Pragma("unroll") for (int r = 0; r < 16; ++r) mx = fmaxf(mx, fmaxf(s[0][r], s[1][r])); \
        mx = fmaxf(mx, __shfl_xor(mx, 32)); \
        mn = (MINE) ? fmaxf(m, mx) : m; alpha = fexp(m - mn); \
        const float me_ = (MINE) ? mn : 1e30f;                        \
        _Pragma("unroll") for (int r = 0; r < 16; ++r) { const float p0 = fexp(s[0][r] - me_), p1 = fexp(s[1][r] - me_); s[0][r] = p0; s[1][r] = p1; rs += p0 + p1; } \
      } else { \
        unsigned ok0 = 0u, ok1 = 0u; \
        _Pragma("unroll") for (int r = 0; r < 16; ++r) { const int pos = 64 * (JB) + (r & 3) + 8 * (r >> 2) + 4 * h; if ((MINE) && pos <= t && pos > (LOWPOS)) ok0 |= 1u << r; if ((MINE) && pos + 32 <= t && pos + 32 > (LOWPOS)) ok1 |= 1u << r; } \
        _Pragma("unroll") for (int r = 0; r < 16; ++r) { if ((ok0 >> r) & 1u) mx = fmaxf(mx, s[0][r]); if ((ok1 >> r) & 1u) mx = fmaxf(mx, s[1][r]); } \
        mx = fmaxf(mx, __shfl_xor(mx, 32)); \
        mn = fmaxf(m, mx); alpha = fexp(m - mn); \
        _Pragma("unroll") for (int r = 0; r < 16; ++r) { const float p0 = ((ok0 >> r) & 1u) ? fexp(s[0][r] - mn) : 0.f, p1 = ((ok1 >> r) & 1u) ? fexp(s[1][r] - mn) : 0.f; s[0][r] = p0; s[1][r] = p1; rs += p0 + p1; } \
      } \
      rs += __shfl_xor(rs, 32); \
      l = l * alpha + rs; m = mn; \
      _Pragma("unroll") for (int r = 0; r < 16; ++r) { o[0][r] *= alpha; o[1][r] *= alpha; } \
      nsa_pv(o, slot + NSA_KB, s, lane); } while (0)
    for (; it < itD; ++it) {
      NSA_STEP();
      const int j = it - itC;
      if ((U >> j) & 1ull) { const bool mine = (mym >> j) & 1ull; NSA_ONLINE(mine, -1, j); }
    }
    { const float f = p.gates[trow * 24 + hg * 3 + 1] / fmaxf(l, 1e-20f);
#pragma unroll
      for (int r = 0; r < 16; ++r) { obuf[r * 64] += f * o[0][r]; obuf[(16 + r) * 64] += f * o[1][r]; o[0][r] = 0.f; o[1][r] = 0.f; }
      m = -1e30f; l = 0.f; }
    for (; it < NI; ++it) {
      NSA_STEP();
      const int j = jw0 + it - itD;
      NSA_ONLINE(true, t - 512, j);
    }
#undef NSA_ONLINE
#undef NSA_STEP
#undef NSA_LOAD
    { const float f = p.gates[trow * 24 + hg * 3 + 2] / fmaxf(l, 1e-20f);
      bf16_t* orow = p.onsab + trow * 512 + hg * 64 + 4 * (lane0 >> 5);
#pragma unroll
      for (int dt = 0; dt < 2; ++dt)
#pragma unroll
        for (int a = 0; a < 4; ++a) { u32x2 w; const int r = 4 * a;
          w.x = pk2(obuf[(16 * dt + r) * 64] + f * o[dt][r], obuf[(16 * dt + r + 1) * 64] + f * o[dt][r + 1]); w.y = pk2(obuf[(16 * dt + r + 2) * 64] + f * o[dt][r + 2], obuf[(16 * dt + r + 3) * 64] + f * o[dt][r + 3]);
          *(u32x2*)(orow + dt * 32 + a * 8) = w; } }
    __syncthreads();
  }
}

__device__ __forceinline__ float ret_logg2(int h) { return logf(1.f - exp2f(-5.f - (float)h)); }
struct WLkminRows {
  typedef XRegB16<128> Regs; const bf16_t* rowp[1];
  __device__ __forceinline__ void load(Regs& R, int k0, int tid) const { xload_b16<128>(R, rowp, k0, tid); }
  __device__ __forceinline__ void store(const Regs& R, lptr img, int, int tid) const { xstore_b16<128>(R, img, tid); }
};
struct XLcmp {
  struct Regs { u32x4 r; }; const bf16_t* src; const float* pe; lptr ximg;
  __device__ __forceinline__ void load(Regs& R, int k0, int tid) const {
    if (tid < 256) { const int l = k0 >> 6, d0 = (k0 & 63) + (tid & 3) * 8;
      const u32x4 v = *(const u32x4*)(src + (size_t)l * PJW + (k0 & 63));
      const f32x4 p0 = *(const f32x4*)(pe + l * 64 + d0), p1 = *(const f32x4*)(pe + l * 64 + d0 + 4);
      R.r.x = pk2(bflo(v.x) + p0.x, bfhi(v.x) + p0.y); R.r.y = pk2(bflo(v.y) + p0.z, bfhi(v.y) + p0.w);
      R.r.z = pk2(bflo(v.z) + p1.x, bfhi(v.z) + p1.y); R.r.w = pk2(bflo(v.w) + p1.z, bfhi(v.w) + p1.w); }
  }
  __device__ __forceinline__ void store(const Regs& R, int tid) const { if (tid < 256) *(LAS u32x4*)(ximg + kmin_off(tid >> 2, tid & 3)) = R.r; }
  __device__ __forceinline__ lptr img(int) const { return ximg; }
};
struct XLretk {
  struct Regs { u32x4 r; }; const bf16_t* src; float lg; lptr ximg;
  __device__ __forceinline__ void load(Regs& R, int k0, int tid) const {
    const u32x4 v = *(const u32x4*)(src + (size_t)k0 * PJW);
    const float z = __expf(lg * (float)(127 - k0 - (tid >> 4)));
    R.r.x = pk2(bflo(v.x) * z, bfhi(v.x) * z); R.r.y = pk2(bflo(v.y) * z, bfhi(v.y) * z); R.r.z = pk2(bflo(v.z) * z, bfhi(v.z) * z); R.r.w = pk2(bflo(v.w) * z, bfhi(v.w) * z);
  }
  __device__ __forceinline__ void store(const Regs& R, int tid) const { *(LAS u32x4*)(ximg + (tid >> 4) * 320 + (tid & 15) * 16) = R.r; }
  __device__ __forceinline__ lptr img(int) const { return ximg; }
};
__device__ __forceinline__ void phase_r1(const P& p, lptr lds, int vcu, int G) {
  const int tid = threadIdx.x, wid = __builtin_amdgcn_readfirstlane(tid >> 6), lane = tid & 63, h = lane >> 5, l31 = lane & 31;
  lptr wimg = lds, ximg = lds + 16 * 1024;
  for (int u = vcu; u < 256 + 512; u += G) {
    if (u < 256) {
      const int isv = u >> 7, rt = (u >> 2) & 31, kq = u & 3, wn = wid >> 1, wt = wid & 1;
      f32x16 acc[1][1]; acc_zero<1, 1>(acc);
      WLb16<128> wl; wl.src = (isv ? p.cw1vb : p.cw1kb) + (size_t)kq * 512 * 128; wl.ld = 128;
      XLcmp xl; { int r = rt * 64 + ((tid >> 2) & 63); r = r < NCR ? r : NCR - 1; const int b = r / (2 * NC), g = (r / NC) & 1, c = r % NC;
        xl.src = p.projb + (size_t)(b * SEQ + 16 * c + kq * 8) * PJW + (isv ? J_VC : J_KC) + g * 64 + (tid & 3) * 8; xl.pe = (isv ? p.cpv : p.cpk) + kq * 512; xl.ximg = ximg; }
      gemm_loop<1, 1>(acc, 512, wl, xl, wimg, 128 * 2 + 64, wn * 32, wt * 32, tid, lane);
      int row = rt * 64 + wt * 32 + l31, nb = wn * 32 + 4 * h; asm volatile("" : "+v"(row), "+v"(nb));
      if (row < NCR) { float* o = p.hidp + (((size_t)(isv * 4 + kq) * 2048 + row) * 128) + nb;
#pragma unroll
        for (int a = 0; a < 4; ++a) { f32x4 v = {acc[0][0][4 * a], acc[0][0][4 * a + 1], acc[0][0][4 * a + 2], acc[0][0][4 * a + 3]}; *(f32x4*)(o + a * 8) = v; } }
    } else {
      const int chunk = u - 256, bh = chunk >> 5, b = bh >> 2, hh = bh & 3, s0 = (chunk & 31) * 128, wn = wid >> 1, wt = wid & 1;
      f32x16 acc[1][2]; acc_zero<1, 2>(acc);
      const bf16_t* base = p.projb + (size_t)(b * SEQ + s0) * PJW + hh * 128;
      WLb16<128> wl; wl.src = base + J_VR; wl.ld = PJW;
      XLretk xl; xl.src = base + J_KR + (size_t)(tid >> 4) * PJW + (tid & 15) * 8; xl.lg = ret_logg2(hh); xl.ximg = ximg;
      gemm_loop<1, 2, WLb16<128>, XLretk, true, true>(acc, 128, wl, xl, wimg, 128 * 2 + 64, wn * 32, wt * 64, tid, lane, 320);
      int dcol = wt * 64 + l31, nb = wn * 32 + 4 * h; asm volatile("" : "+v"(dcol), "+v"(nb));
#pragma unroll
      for (int tn = 0; tn < 2; ++tn) { float* o = p.kv + ((size_t)chunk * 128 + dcol + tn * 32) * 128 + nb;
#pragma unroll
        for (int a = 0; a < 4; ++a) { f32x4 v = {acc[0][tn][4 * a], acc[0][tn][4 * a + 1], acc[0][tn][4 * a + 2], acc[0][tn][4 * a + 3]}; *(f32x4*)(o + a * 8) = v; } }
    }
  }
}
__device__ __forceinline__ void phase_r2(const P& p, lptr lds, int vcu, int G) {
  const int tid = threadIdx.x;
  LAS float* hs = (LAS float*)lds;
  LAS float* os = hs + 1024;
  const LAS float* inv64 = (const LAS float*)(lds + LDS_INV64);
  for (int u = vcu; u < 2 * 255; u += G) {
    const int isv = u >= 255, r0 = (isv ? u - 255 : u) * 8;
    { const int i = tid, row = r0 + (i >> 7), k = i & 127;
#pragma unroll
      for (int q = 0; q < 2; ++q) { const int rr = row + 4 * q; float a = 0.f;
#pragma unroll
        for (int kq = 0; kq < 4; ++kq) a += p.hidp[((size_t)(isv * 4 + kq) * 2048 + rr) * 128 + k];
        hs[(rr - r0) * 128 + k] = gelu_tanh(a); } }
    __syncthreads();
    { const int rl = tid >> 6, n = tid & 63; const float* w2 = isv ? p.cw2v : p.cw2k; float a = 0.f;
#pragma unroll 8
      for (int k = 0; k < 128; ++k) a += hs[rl * 128 + k] * w2[k * 64 + n];
      os[rl * 64 + n] = a; }
    __syncthreads();
    { const int rl = tid >> 6, n = tid & 63, row = r0 + rl; float y = os[rl * 64 + n];
      if (!isv) { const int b = row / (2 * NC), c = row % NC, i = n & 31;
        const float fr = __builtin_amdgcn_fractf((float)p.pos[b * SEQ + 16 * c + 31] * inv64[i]);
        const float sn = __builtin_amdgcn_sinf(fr), cs = __builtin_amdgcn_cosf(fr), x1 = os[rl * 64 + i], x2 = os[rl * 64 + i + 32];
        y = n < 32 ? x1 * cs - x2 * sn : x1 * sn + x2 * cs; }
      (isv ? p.vcmpb : p.kcmpb)[(size_t)row * 64 + n] = (bf16_t)(pk2(y, 0.f) & 0xffffu); }
    __syncthreads();
  }
  for (int id = vcu * 512 + tid; id < 16 * 16384; id += G * 512) {
    const int bh = id >> 14, de = id & 16383; const float gc = __expf(ret_logg2(bh & 3) * 128.f);
    float v[32];
#pragma unroll
    for (int n = 0; n < 32; ++n) v[n] = p.kv[(size_t)(bh * 32 + n) * 16384 + de];
    float st = 0.f;
#pragma unroll
    for (int n = 0; n < 32; ++n) { p.stateb[(size_t)(bh * 32 + n) * 16384 + de] = (bf16_t)(pk2(st, 0.f) & 0xffffu); st = st * gc + v[n]; }
  }
}
__device__ __forceinline__ void phase_r3(const P& p, lptr lds, int vcu, int G) {
  const int tid = threadIdx.x, wid = __builtin_amdgcn_readfirstlane(tid >> 6), lane = tid & 63, h = lane >> 5, l31 = lane & 31, wn = wid >> 2, wt = wid & 3;
  lptr wimg = lds, ximg = lds + 12 * 1024, scb = lds + 20 * 1024;
  LAS float* part = (LAS float*)(lds + 52 * 1024);
  for (int chunk = vcu; chunk < 512; chunk += G) {
    const int bh = chunk >> 5, b = bh >> 2, hh = bh & 3, s0 = (chunk & 31) * 128; const float lg = ret_logg2(hh);
    const bf16_t* base = p.projb + (size_t)(b * SEQ + s0) * PJW + hh * 128;
    f32x16 acc[2][1];
    acc_zero<2, 1>(acc);
    { WLkminRows wl; wl.rowp[0] = base + J_KR + (size_t)((tid >> 2) & 127) * PJW;
      XLrows<128> xl; xl.rowp[0] = base + J_QR + (size_t)((tid >> 2) & 127) * PJW; xl.ximg = ximg;
      gemm_loop<2, 1, WLkminRows, XLrows<128>, false, false>(acc, 128, wl, xl, wimg, 0, wn * 64, wt * 32, tid, lane); }
    { int i = wt * 32 + l31, jb = wn * 64 + 4 * h; asm volatile("" : "+v"(i), "+v"(jb));
#pragma unroll
      for (int tm = 0; tm < 2; ++tm)
#pragma unroll
        for (int a = 0; a < 4; ++a) { const int j = jb + tm * 32 + a * 8; float o[4];
#pragma unroll
          for (int q = 0; q < 4; ++q) o[q] = i >= j + q ? acc[tm][0][4 * a + q] * __expf(lg * (float)(i - j - q)) : 0.f;
          u32x2 w; w.x = pk2(o[0], o[1]); w.y = pk2(o[2], o[3]);
          *(LAS u32x2*)(scb + (j >> 5) * 8192 + kmin_off(i, (j & 31) >> 3) + (j & 7) * 2) = w; } }
    __syncthreads();
    acc_zero<2, 1>(acc);
    { WLb16<128> wl; wl.src = p.stateb + (size_t)chunk * 16384; wl.ld = 128;
      XLrows<128> xl; xl.rowp[0] = base + J_QR + (size_t)((tid >> 2) & 127) * PJW; xl.ximg = ximg;
      gemm_loop<2, 1>(acc, 128, wl, xl, wimg, 128 * 2 + 64, wn * 64, wt * 32, tid, lane); }
    { const float xi = __expf(lg * (float)(wt * 32 + l31 + 1));
#pragma unroll
      for (int tm = 0; tm < 2; ++tm)
#pragma unroll
        for (int r = 0; r < 16; ++r) acc[tm][0][r] *= xi; }
    { WLb16<128> wl; wl.src = base + J_VR; wl.ld = PJW;
      XLres xl; xl.base = scb; xl.bytes = 8192;
      gemm_loop<2, 1>(acc, 128, wl, xl, wimg, 128 * 2 + 64, wn * 64, wt * 32, tid, lane); }
    { float ss = 0.f;
#pragma unroll
      for (int tm = 0; tm < 2; ++tm)
#pragma unroll
        for (int r = 0; r < 16; ++r) ss += acc[tm][0][r] * acc[tm][0][r];
      ss += __shfl_xor(ss, 32);
      if (h == 0) part[wn * 128 + wt * 32 + l31] = ss; }
    __syncthreads();
    { int i = wt * 32 + l31, eb = wn * 64 + 4 * h; asm volatile("" : "+v"(i), "+v"(eb));
      const float rs = rsqrtf((part[i] + part[128 + i]) * (1.f / 128.f) + EPS);
      const size_t trow = (size_t)(b * SEQ + s0 + i);
#pragma unroll
      for (int tm = 0; tm < 2; ++tm)
#pragma unroll
        for (int a = 0; a < 4; ++a) { const int e = eb + tm * 32 + a * 8;
          const f32x4 gr = *(const f32x4*)(p.g_ret + hh * 128 + e); const u32x2 gt = *(const u32x2*)(p.projb + trow * PJW + J_GR + hh * 128 + e);
          u32x2 w; w.x = pk2(acc[tm][0][4 * a] * rs * gr.x * bflo(gt.x), acc[tm][0][4 * a + 1] * rs * gr.y * bfhi(gt.x));
          w.y = pk2(acc[tm][0][4 * a + 2] * rs * gr.z * bflo(gt.y), acc[tm][0][4 * a + 3] * rs * gr.w * bfhi(gt.y));
          *(u32x2*)(p.mixb + trow * D + 512 + hh * 128 + e) = w; } }
    __syncthreads();
  }
  for (int tok = vcu * 8 + wid; tok < T; tok += G * 8) {
    const u32x4 v = *(const u32x4*)(p.onsab + (size_t)tok * 512 + lane * 8);
    float x[8] = {bflo(v.x), bfhi(v.x), bflo(v.y), bfhi(v.y), bflo(v.z), bfhi(v.z), bflo(v.w), bfhi(v.w)};
    float ss = 0.f;
#pragma unroll
    for (int q = 0; q < 8; ++q) ss += x[q] * x[q];
    ss = wave_sum(ss);
    const float rs = rsqrtf(ss * (1.f / 512.f) + EPS);
    const f32x4 g0 = *(const f32x4*)(p.g_nsa + lane * 8), g1 = *(const f32x4*)(p.g_nsa + lane * 8 + 4);
    u32x4 w; w.x = pk2(x[0] * rs * g0.x, x[1] * rs * g0.y); w.y = pk2(x[2] * rs * g0.z, x[3] * rs * g0.w); w.z = pk2(x[4] * rs * g1.x, x[5] * rs * g1.y); w.w = pk2(x[6] * rs * g1.z, x[7] * rs * g1.w);
    *(u32x4*)(p.mixb + (size_t)tok * D + lane * 8) = w;
  }
}

__device__ __forceinline__ void phase5a(const P& p, lptr lds, int vcu, int G) {
  const int tid = threadIdx.x, wid = __builtin_amdgcn_readfirstlane(tid >> 6), lane = tid & 63, wn = wid >> 2, wt = wid & 3;
  for (int u = vcu; u < 4 * 64; u += G) {
    const int j = u & 3, t0 = (u >> 2) * 256, b = t0 / SEQ;
    f32x16 acc[4][2];
    WLb16<256> wl; wl.src = p.woutb + j * 256; wl.ld = D;
    gemm256(acc, wl, p.mixb, D, t0, D, lds, wn, wt, tid, lane);
    int nb = j * 256 + wn * 128 + 4 * (lane >> 5), tb = t0 + wt * 64 + (lane & 31); asm volatile("" : "+v"(nb), "+v"(tb));
#pragma unroll
    for (int tn = 0; tn < 2; ++tn)
#pragma unroll
      for (int tm = 0; tm < 4; ++tm) {
#pragma unroll
        for (int a = 0; a < 4; ++a) { const int n = nb + tm * 32 + a * 8; const size_t o = (size_t)(tb + tn * 32) * D + n;
          const f32x4 xv = *(const f32x4*)(p.x + o), gt = *(const f32x4*)(p.mod + b * 6144 + 2048 + n);
          f32x4 v; v.x = xv.x + gt.x * acc[tm][tn][4 * a]; v.y = xv.y + gt.y * acc[tm][tn][4 * a + 1]; v.z = xv.z + gt.z * acc[tm][tn][4 * a + 2]; v.w = xv.w + gt.w * acc[tm][tn][4 * a + 3];
          *(f32x4*)(p.x1 + o) = v; }
        __builtin_amdgcn_sched_barrier(0);
      }
  }
}
__device__ __forceinline__ void phase5b(const P& p, lptr lds, int vcu, int G) {
  const int tid = threadIdx.x, wid = tid >> 6, lane = tid & 63;
  for (int row = vcu * 8 + wid; row < T; row += G * 8) {
    const int b = row / SEQ;
    f32x4 v[4]; float s = 0.f;
#pragma unroll
    for (int j = 0; j < 4; ++j) { v[j] = *(const f32x4*)(p.x1 + (size_t)row * D + j * 256 + lane * 4); s += v[j].x * v[j].x + v[j].y * v[j].y + v[j].z * v[j].z + v[j].w * v[j].w; }
    s = wave_sum(s);
    const float r = rsqrtf(s * (1.f / D) + EPS);
#pragma unroll
    for (int j = 0; j < 4; ++j) {
      const int k = j * 256 + lane * 4;
      const f32x4 g = *(const f32x4*)(p.g_ffn + k), sc = *(const f32x4*)(p.mod + b * 6144 + 4096 + k), sh = *(const f32x4*)(p.mod + b * 6144 + 3072 + k);
      u32x2 o; o.x = pk2(v[j].x * r * g.x * (1.f + sc.x) + sh.x, v[j].y * r * g.y * (1.f + sc.y) + sh.y); o.y = pk2(v[j].z * r * g.z * (1.f + sc.z) + sh.z, v[j].w * r * g.w * (1.f + sc.w) + sh.w);
      *(u32x2*)(p.h2b + (size_t)row * D + k) = o;
    }
  }
}
__device__ __forceinline__ void phase5c(const P& p, lptr lds, int vcu, int G) {
  const int tid = threadIdx.x, wid = __builtin_amdgcn_readfirstlane(tid >> 6), lane = tid & 63, wn = wid >> 2, wt = wid & 3;
  for (int u = vcu; u < 3 * 64; u += G) {
    const int j = u % 3, t0 = (u / 3) * 256;
    f32x16 acc[4][2];
    if (j == 0) { WLb16<256> wl; wl.src = p.wrb; wl.ld = NE; gemm256(acc, wl, p.h2b, D, t0, D, lds, wn, wt, tid, lane); }
    else { WLgu256 wl; wl.g = p.wgsb; wl.u = p.wusb; wl.abase = (j - 1) * 128; gemm256(acc, wl, p.h2b, D, t0, D, lds, wn, wt, tid, lane); }
    int h4 = 4 * (lane >> 5), tb = t0 + wt * 64 + (lane & 31); asm volatile("" : "+v"(h4), "+v"(tb));
    if (j == 0) {
#pragma unroll
      for (int tn = 0; tn < 2; ++tn)
#pragma unroll
        for (int tm = 0; tm < 4; ++tm)
#pragma unroll
          for (int a = 0; a < 4; ++a) { f32x4 v = {acc[tm][tn][4 * a], acc[tm][tn][4 * a + 1], acc[tm][tn][4 * a + 2], acc[tm][tn][4 * a + 3]};
            *(f32x4*)(p.logits + (size_t)(tb + tn * 32) * NE + wn * 128 + tm * 32 + a * 8 + h4) = v; }
    } else {
#pragma unroll
      for (int tn = 0; tn < 2; ++tn)
#pragma unroll
        for (int tm = 0; tm < 2; ++tm)
#pragma unroll
          for (int a = 0; a < 4; ++a) { float o[4];
#pragma unroll
            for (int q = 0; q < 4; ++q) { const float gv = acc[tm][tn][4 * a + q], uv = acc[tm + 2][tn][4 * a + q]; o[q] = gv * __builtin_amdgcn_rcpf(1.f + __builtin_amdgcn_exp2f(-1.4426950408889634f * gv)) * uv; }
            u32x2 w; w.x = pk2(o[0], o[1]); w.y = pk2(o[2], o[3]);
            *(u32x2*)(p.actsb + (size_t)(tb + tn * 32) * 256 + (j - 1) * 128 + wn * 64 + tm * 32 + a * 8 + h4) = w; }
    }
  }
}
__device__ __forceinline__ void phase5d(const P& p, lptr lds, int vcu, int G) {
  const int tid = threadIdx.x, wid = __builtin_amdgcn_readfirstlane(tid >> 6), lane = tid & 63, wn = wid >> 2, wt = wid & 3;
  { const f32x4 rb = *(const f32x4*)(p.rbias + lane * 4);
    for (int tok = vcu * 8 + wid; tok < T; tok += G * 8) {
      const f32x4 lv = *(const f32x4*)(p.logits + (size_t)tok * NE + lane * 4);
      const float s0 = sigm(lv.x), s1 = sigm(lv.y), s2 = sigm(lv.z), s3 = sigm(lv.w);
      float c0 = s0 + rb.x, c1 = s1 + rb.y, c2 = s2 + rb.z, c3 = s3 + rb.w;
      float m1, m2;
      { const float h1 = fmaxf(c0, c1), l1 = fminf(c0, c1), h2 = fmaxf(c2, c3), l2 = fminf(c2, c3); m1 = fmaxf(h1, h2); m2 = fmaxf(fminf(h1, h2), fmaxf(l1, l2)); }
#pragma unroll
      for (int o = 1; o < 8; o <<= 1) { const float o1 = __shfl_xor(m1, o), o2 = __shfl_xor(m2, o); const float n1 = fmaxf(m1, o1), n2 = fmaxf(fminf(m1, o1), fmaxf(m2, o2)); m1 = n1; m2 = n2; }
      const float gs = m1 + m2; const int myg = lane >> 3; int rank = 0;
#pragma unroll
      for (int g2 = 0; g2 < 8; ++g2) { const float og = __shfl(gs, g2 * 8); rank += (og > gs || (og == gs && g2 < myg)) ? 1 : 0; }
      if (rank >= 4) { c0 = -INFINITY; c1 = -INFINITY; c2 = -INFINITY; c3 = -INFINITY; }
      int my_e = 0; float my_s = 0.f;
#pragma unroll
      for (int k = 0; k < 8; ++k) {
        float bv = c0; int li = lane * 4;
        if (c1 > bv) { bv = c1; li = lane * 4 + 1; }
        if (c2 > bv) { bv = c2; li = lane * 4 + 2; }
        if (c3 > bv) { bv = c3; li = lane * 4 + 3; }
#pragma unroll
        for (int o = 1; o < 64; o <<= 1) { const float ov = __shfl_xor(bv, o); const int oi = __shfl_xor(li, o); if (ov > bv || (ov == bv && oi < li)) { bv = ov; li = oi; } }
        const int jx = li & 3; const float sj = jx == 0 ? s0 : jx == 1 ? s1 : jx == 2 ? s2 : s3;
        const float sv = __shfl(sj, li >> 2);
        if (lane * 4 == li) c0 = -INFINITY;
        if (lane * 4 + 1 == li) c1 = -INFINITY;
        if (lane * 4 + 2 == li) c2 = -INFINITY;
        if (lane * 4 + 3 == li) c3 = -INFINITY;
        if (lane == k) { my_e = li; my_s = sv; }
      }
      const float wsum = wave_sum(lane < 8 ? my_s : 0.f);
      if (lane < 8) { const int pos = atomicAdd(&p.cnt[my_e], 1); p.list[my_e * ECAP + pos] = tok * 8 + lane; p.wts[tok * 8 + lane] = my_s / wsum * 2.5f; }
    } }
  __syncthreads();
  for (int u = vcu; u < 4 * 64; u += G) {
    const int j = u & 3, t0 = (u >> 2) * 256, b = t0 / SEQ;
    f32x16 acc[4][2];
    WLb16<256> wl; wl.src = p.wdsb + j * 256; wl.ld = D;
    gemm256(acc, wl, p.actsb, 256, t0, 256, lds, wn, wt, tid, lane);
    int nb = j * 256 + wn * 128 + 4 * (lane >> 5), tb = t0 + wt * 64 + (lane & 31); asm volatile("" : "+v"(nb), "+v"(tb));
#pragma unroll
    for (int tn = 0; tn < 2; ++tn)
#pragma unroll
      for (int tm = 0; tm < 4; ++tm) {
#pragma unroll
        for (int a = 0; a < 4; ++a) { const int n = nb + tm * 32 + a * 8; const size_t o = (size_t)(tb + tn * 32) * D + n;
          f32x4 v = *(const f32x4*)(p.x1 + o); const f32x4 gt = *(const f32x4*)(p.mod + b * 6144 + 5120 + n);
          v.x += gt.x * acc[tm][tn][4 * a]; v.y += gt.y * acc[tm][tn][4 * a + 1]; v.z += gt.z * acc[tm][tn][4 * a + 2]; v.w += gt.w * acc[tm][tn][4 * a + 3];
          *(f32x4*)(p.x1 + o) = v; }
        __builtin_amdgcn_sched_barrier(0);
      }
  }
}

constexpr int NPHASE = 13;
__global__ void __launch_bounds__(512) mega(P p, int lo, int hi) {
  extern __shared__ __attribute__((aligned(16))) char lds_raw[];
  lptr lds = (lptr)lds_raw;
  const int tid = threadIdx.x, G = gridDim.x;
  const int vcu = (G % 8 == 0) ? ((int)blockIdx.x % 8) * (G / 8) + (int)blockIdx.x / 8 : (int)blockIdx.x;
  if (tid < 32) ((LAS float*)(lds + LDS_INV64))[tid] = exp2f(-(float)(2 * tid) / 64.f * 13.287712379549449f) * 0.15915494309189535f;
  if (tid < 64) ((LAS float*)(lds + LDS_INV128))[tid] = exp2f(-(float)(2 * tid) / 128.f * 13.287712379549449f) * 0.15915494309189535f;
  if (tid < 4) ((LAS unsigned*)(lds + LDS_XB))[tid] = 0u;
  __syncthreads();
  XcdBarrier xb; xb.bar = p.bar; xb.x = 0; xb.st = (volatile LAS unsigned*)(lds + LDS_XB);
  if (hi - lo > 1) xb = xcd_barrier_post(p.bar, (volatile LAS unsigned*)(lds + LDS_XB));
#define PH(k, call) if (lo <= (k) && (k) < hi) { call; if ((k) + 1 < hi) xcd_barrier(xb); }
  PH(0, phase0a(p, lds, vcu, G));
  PH(1, phase0b(p, lds, vcu, G));
  PH(2, phase1(p, lds, vcu, G));
  PH(3, phase_r1(p, lds, vcu, G));
  PH(4, phase_r2(p, lds, vcu, G));
  PH(5, phase_nsa(p, lds, vcu, G));
  PH(6, phase_r3(p, lds, vcu, G));
  PH(7, phase5a(p, lds, vcu, G));
  PH(8, phase5b(p, lds, vcu, G));
  PH(9, phase5c(p, lds, vcu, G));
  PH(10, phase5d(p, lds, vcu, G));
  PH(11, phase6(p, lds, vcu, G));
  PH(12, phase7(p, lds, vcu, G));
#undef PH
}
}

extern "C" void kernel_launch(void* const* d_in, const int* in_sizes, int n_in, void* d_out, int out_size, void* d_ws, size_t ws_size, hipStream_t stream) {
  P p{};
  p.x = (const float*)d_in[0]; p.c = (const float*)d_in[1]; p.pos = (const int*)d_in[2];
  p.w_ada = (const float*)d_in[3]; p.b_ada = (const float*)d_in[4]; p.g_mix = (const float*)d_in[5]; p.w_in = (const float*)d_in[6];
  p.cpk = (const float*)d_in[7]; p.cw1k = (const float*)d_in[8]; p.cw2k = (const float*)d_in[9];
  p.cpv = (const float*)d_in[10]; p.cw1v = (const float*)d_in[11]; p.cw2v = (const float*)d_in[12];
  p.g_nsa = (const float*)d_in[13]; p.g_ret = (const float*)d_in[14]; p.w_out = (const float*)d_in[15]; p.g_ffn = (const float*)d_in[16];
  p.w_router = (const float*)d_in[17]; p.rbias = (const float*)d_in[18]; p.wg_e = (const float*)d_in[19]; p.wu_e = (const float*)d_in[20];
  p.wd_e = (const float*)d_in[21]; p.wg_s = (const float*)d_in[22]; p.wu_s = (const float*)d_in[23]; p.wd_s = (const float*)d_in[24];
  p.g_final = (const float*)d_in[25];
  p.out = (float*)d_out;
  char* w = (char*)d_ws; size_t off = 0;
  auto take = [&](size_t bytes) { char* r = w + off; off += (bytes + 255) & ~(size_t)255; return r; };
  p.bar = (unsigned*)take(XCD_BAR_WORDS * 4);
  p.cnt = (int*)take(NE * 4);
  const size_t zero_bytes = off;
  p.mod = (float*)take(BATCH * 6144 * 4);
  p.hidp = (float*)take((size_t)8 * 2048 * 128 * 4);
  p.kv = (float*)take((size_t)512 * 16384 * 4);
  p.stateb = (bf16_t*)take((size_t)512 * 16384 * 2);
  p.logits = (float*)take((size_t)T * NE * 4); p.actsb = (bf16_t*)take((size_t)T * 256 * 2);
  p.x1 = (float*)take((size_t)T * D * 4);
  p.wts = (float*)take((size_t)T * 8 * 4);
  p.list = (int*)take((size_t)NE * ECAP * 4);
  p.gates = (float*)take((size_t)T * 24 * 4);
  p.winb = (bf16_t*)take((size_t)D * INW * 2); p.woutb = (bf16_t*)take((size_t)D * D * 2); p.wrb = (bf16_t*)take((size_t)D * NE * 2);
  p.wgsb = (bf16_t*)take((size_t)D * 256 * 2); p.wusb = (bf16_t*)take((size_t)D * 256 * 2); p.wdsb = (bf16_t*)take((size_t)256 * D * 2);
  p.cw1kb = (bf16_t*)take(2048 * 128 * 2); p.cw1vb = (bf16_t*)take(2048 * 128 * 2); p.cw2kb = (bf16_t*)take(128 * 64 * 2); p.cw2vb = (bf16_t*)take(128 * 64 * 2);
  p.hb = (bf16_t*)take((size_t)T * D * 2);
  p.projb = (bf16_t*)take((size_t)T * PJW * 2);
  p.mixb = (bf16_t*)take((size_t)T * D * 2); p.h2b = (bf16_t*)take((size_t)T * D * 2);
  p.slab = (bf16_t*)take((size_t)T * 8 * D * 2);
  p.kcmpb = (bf16_t*)take((2048 + 64) * 64 * 2); p.vcmpb = (bf16_t*)take((2048 + 64) * 64 * 2);
  p.onsab = (bf16_t*)take((size_t)T * 512 * 2);
  if (off > ws_size) { fprintf(stderr, "kernel_launch: workspace too small: need %zu have %zu\n", off, ws_size); return; }
  static int grid = 0;
  if (!grid) {
    int dev = 0, cus = 0, per_cu = 0;
    (void)hipGetDevice(&dev);
    (void)hipDeviceGetAttribute(&cus, hipDeviceAttributeMultiprocessorCount, dev);
    (void)hipFuncSetAttribute((const void*)mega, hipFuncAttributeMaxDynamicSharedMemorySize, LDS_BYTES);
    (void)hipOccupancyMaxActiveBlocksPerMultiprocessor(&per_cu, (const void*)mega, 512, LDS_BYTES);
    if (per_cu < 1) fprintf(stderr, "kernel_launch: occupancy query says %d blocks per CU\n", per_cu);
    grid = cus;
  }
  (void)hipMemsetAsync(d_ws, 0, zero_bytes, stream);
  hipLaunchKernelGGL(mega, dim3(grid), dim3(512), LDS_BYTES, stream, p, 0, NPHASE);
}
```

```cpp
#include <hip/hip_runtime.h>
#include <cstdint>
#include <cstdio>

namespace {
constexpr int D = 1024, BATCH = 4, SEQ = 4096, T = BATCH * SEQ;
constexpr int INW = 3352;
constexpr int C_QN = 0, C_KC = 512, C_VC = 640, C_KS = 768, C_VS = 896, C_KW = 1024, C_VW = 1152, C_GN = 1280,
              C_QR = 1304, C_KR = 1816, C_VR = 2328, C_GR = 2840;
constexpr int PJW = 3328, J_QN = 0, J_KC = 512, J_VC = 640, J_KS = 768, J_VS = 896, J_KW = 1024, J_VW = 1152, J_QR = 1280, J_KR = 1792, J_VR = 2304, J_GR = 2816;
constexpr int NC = 255, NCR = BATCH * 2 * NC;
constexpr int NE = 256, ECAP = 16384;
constexpr float EPS = 1e-6f;
typedef unsigned short bf16_t;

struct P {
  const float *x, *c; const int* pos;
  const float *w_ada, *b_ada, *g_mix, *w_in, *cpk, *cw1k, *cw2k, *cpv, *cw1v, *cw2v, *g_nsa, *g_ret, *w_out, *g_ffn,
      *w_router, *rbias, *wg_e, *wu_e, *wd_e, *wg_s, *wu_s, *wd_s, *g_final;
  float* out;
  float *mod, *h, *proj, *hidk, *hidv, *kcmp, *vcmp, *onsa, *Sc, *kv, *retout, *mixin, *x1, *logits, *wts, *Gs, *acts,
      *G, *act, *yacc, *gates;
  int *cnt, *list, *tile_e, *tile_off, *ntiles;
  bf16_t *winb, *woutb, *wrb, *wgsb, *wusb, *wdsb, *cw1kb, *cw1vb, *cw2kb, *cw2vb, *hb, *projb, *mixb, *h2b, *slab, *kcmpb, *vcmpb, *onsab, *stateb, *actsb;
  float *hidp;
  unsigned* bar;
};

#define LAS __attribute__((address_space(3)))
typedef LAS char* lptr;
typedef short bf16x8 __attribute__((ext_vector_type(8)));
typedef short v4i16_t __attribute__((ext_vector_type(4)));
typedef float f32x16 __attribute__((ext_vector_type(16)));
typedef float f32x4 __attribute__((ext_vector_type(4)));
typedef float f32x2_t __attribute__((ext_vector_type(2)));
typedef __bf16 bf16x2_t __attribute__((ext_vector_type(2)));
typedef unsigned u32x4 __attribute__((ext_vector_type(4)));
typedef unsigned u32x2 __attribute__((ext_vector_type(2)));

__device__ __forceinline__ float wave_sum(float v) {
#pragma unroll
  for (int o = 1; o < 64; o <<= 1) v += __shfl_xor(v, o);
  return v;
}
__device__ __forceinline__ float wave_max(float v) {
#pragma unroll
  for (int o = 1; o < 64; o <<= 1) v = fmaxf(v, __shfl_xor(v, o));
  return v;
}
__device__ __forceinline__ float silu(float v) { return v / (1.f + expf(-v)); }
__device__ __forceinline__ float sigm(float v) { return 1.f / (1.f + expf(-v)); }
__device__ __forceinline__ float gelu_tanh(float v) { return 0.5f * v * (1.f + tanhf(0.7978845608028654f * (v + 0.044715f * v * v * v))); }
__device__ __forceinline__ unsigned pk2(float lo, float hi) { f32x2_t v = {lo, hi}; bf16x2_t b = __builtin_convertvector(v, bf16x2_t); return __builtin_bit_cast(unsigned, b); }
__device__ __forceinline__ float bf2f(bf16_t u) { return __uint_as_float((unsigned)u << 16); }
__device__ __forceinline__ float bflo(unsigned u) { return __uint_as_float(u << 16); }
__device__ __forceinline__ float bfhi(unsigned u) { return __uint_as_float(u & 0xffff0000u); }

#define XB_TMO      128
#define XB_XCNT(j)  (256  + 64 * (j))
#define XB_XSUB(j)  (1280 + 64 * (j))
#define XB_XGEN(j)  (2304 + 64 * (j))
#define XB_TOP      3328
#define XB_TOPGEN   3392
#define XCD_BAR_WORDS 3456
#define XB_SPIN_CAP (1u << 18)
__device__ __forceinline__ unsigned xb_ld(unsigned* p)              { return __hip_atomic_load(p, __ATOMIC_RELAXED, __HIP_MEMORY_SCOPE_AGENT); }
__device__ __forceinline__ unsigned xb_add(unsigned* p, unsigned v) { return __hip_atomic_fetch_add(p, v, __ATOMIC_RELAXED, __HIP_MEMORY_SCOPE_AGENT); }
__device__ __forceinline__ unsigned xb_xcc_id() { return (unsigned)__builtin_amdgcn_s_getreg((3 << 11) | 20) & 0xFu; }
#define XB_SPIN(cond, bar) do { unsigned _sp = 0; while (cond) { __builtin_amdgcn_s_sleep(1); \
    if ((++_sp & 255u) == 0u) { if (xb_ld(&(bar)[XB_TMO])) break; if (_sp > XB_SPIN_CAP) { atomicAdd(&(bar)[XB_TMO], 1u); break; } } } } while (0)
struct XcdBarrier { unsigned* bar; unsigned x; volatile LAS unsigned* st; };
__device__ __forceinline__ XcdBarrier xcd_barrier_post(unsigned* bar, volatile LAS unsigned* st) {
    XcdBarrier b; b.bar = bar; b.x = xb_xcc_id(); b.st = st;
    if (threadIdx.x == 0) (void)xb_add(&bar[XB_XCNT(b.x)], 1u);
    return b;
}
__device__ __forceinline__ void xcd_barrier_complete(unsigned* bar, unsigned x, unsigned& nloc, unsigned& nx) {
    const unsigned G = gridDim.x * gridDim.y * gridDim.z;
    unsigned sum, cnt, mine, sp = 0u;
    for (;;) {
        sum = 0u; cnt = 0u; mine = 0u;
#pragma unroll
        for (unsigned j = 0; j < 16; ++j) { const unsigned c = xb_ld(&bar[XB_XCNT(j)]); sum += c; cnt += (c > 0u) ? 1u : 0u; mine = (j == x) ? c : mine; }
        if (sum == G) break;
        __builtin_amdgcn_s_sleep(1);
        if ((++sp & 255u) == 0u) { if (xb_ld(&bar[XB_TMO])) break; if (sp > XB_SPIN_CAP) { atomicAdd(&bar[XB_TMO], 1u); break; } }
    }
    nloc = mine > 0u ? mine : 1u; nx = cnt > 0u ? cnt : 1u;
}
__device__ __forceinline__ void xcd_barrier(const XcdBarrier& b) {
    asm volatile("s_waitcnt vmcnt(0)" ::: "memory");
    __syncthreads();
    if (threadIdx.x == 0) {
        unsigned* bar = b.bar;
        __builtin_amdgcn_s_waitcnt(0);
        unsigned nloc = b.st[0], nx = b.st[1];
        if (nloc == 0u) { xcd_barrier_complete(bar, b.x, nloc, nx); b.st[0] = nloc; b.st[1] = nx; }
        const unsigned old = xb_add(&bar[XB_XSUB(b.x)], 1u);
        const unsigned gen = old / nloc;
        if (old + 1u == (gen + 1u) * nloc) {
            __builtin_amdgcn_fence(__ATOMIC_RELEASE, "agent");
            asm volatile("s_waitcnt vmcnt(0)" ::: "memory");
            const unsigned og = xb_add(&bar[XB_TOP], 1u);
            const unsigned tg = og / nx;
            if (og + 1u == (tg + 1u) * nx) xb_add(&bar[XB_TOPGEN], 1u);
            else XB_SPIN(xb_ld(&bar[XB_TOPGEN]) == tg, bar);
            __builtin_amdgcn_fence(__ATOMIC_ACQUIRE, "agent");
            xb_add(&bar[XB_XGEN(b.x)], 1u);
            asm volatile("s_waitcnt vmcnt(0)" ::: "memory");
        } else {
            XB_SPIN(xb_ld(&bar[XB_XGEN(b.x)]) == gen, bar);
            __builtin_amdgcn_fence(__ATOMIC_ACQUIRE, "agent");
            asm volatile("s_waitcnt vmcnt(0)" ::: "memory");
        }
    }
    __syncthreads();
}

__device__ __forceinline__ bf16x8 frag_kmaj(lptr img, int rs, int o, int s, int lane) {
  const int h = lane >> 5, blk = (lane >> 4) & 1, q = (lane & 15) >> 2, pp = lane & 3;
  lptr a = img + (16 * s + 8 * h + q) * rs + (o + 16 * blk + 4 * pp) * 2;
  const v4i16_t lo = __builtin_amdgcn_ds_read_tr16_b64_v4i16((LAS v4i16_t*)a);
  const v4i16_t hi = __builtin_amdgcn_ds_read_tr16_b64_v4i16((LAS v4i16_t*)(a + 4 * rs));
  return (bf16x8){lo[0], lo[1], lo[2], lo[3], hi[0], hi[1], hi[2], hi[3]};
}
__device__ __forceinline__ bf16x8 frag_kmin(lptr img, int o, int s, int lane) {
  const int row = o + (lane & 31), c = 2 * s + (lane >> 5);
  return *(LAS bf16x8*)(img + row * 64 + ((c ^ ((row >> 2) & 3)) << 4));
}
__device__ __forceinline__ int kmin_off(int row, int c) { return row * 64 + ((c ^ ((row >> 2) & 3)) << 4); }

template <int TM, int TN, bool WKMAJ, bool XKMAJ>
__device__ __forceinline__ void mma_step(f32x16 (&acc)[TM][TN], lptr wimg, int wrs, int wn0, lptr ximg, int xrs, int xt0, int lane) {
#pragma unroll
  for (int s = 0; s < 2; ++s) {
    bf16x8 wf[TM], xf[TN];
#pragma unroll
    for (int tm = 0; tm < TM; ++tm) wf[tm] = WKMAJ ? frag_kmaj(wimg, wrs, wn0 + 32 * tm, s, lane) : frag_kmin(wimg, wn0 + 32 * tm, s, lane);
#pragma unroll
    for (int tn = 0; tn < TN; ++tn) xf[tn] = XKMAJ ? frag_kmaj(ximg, xrs, xt0 + 32 * tn, s, lane) : frag_kmin(ximg, xt0 + 32 * tn, s, lane);
#pragma unroll
    for (int tm = 0; tm < TM; ++tm)
#pragma unroll
      for (int tn = 0; tn < TN; ++tn) acc[tm][tn] = __builtin_amdgcn_mfma_f32_32x32x16_bf16(wf[tm], xf[tn], acc[tm][tn], 0, 0, 0);
    if (s == 0) __builtin_amdgcn_sched_barrier(0);
  }
}

template <int BNT> struct WRegB16 { u32x4 r[BNT / 128]; };
template <int BNT> __device__ __forceinline__ void wload_b16(WRegB16<BNT>& R, const bf16_t* src  , int ld, int tid) {
  constexpr int C8 = BNT / 8, KPR = 512 / C8;
  const int c8 = tid % C8, kr = tid / C8;
#pragma unroll
  for (int r = 0; r < BNT / 128; ++r) R.r[r] = *(const u32x4*)(src + (size_t)(kr + r * KPR) * ld + c8 * 8);
}
template <int BNT> __device__ __forceinline__ void wstore_b16(const WRegB16<BNT>& R, lptr img, int rs, int tid) {
  constexpr int C8 = BNT / 8, KPR = 512 / C8;
  const int c8 = tid % C8, kr = tid / C8;
#pragma unroll
  for (int r = 0; r < BNT / 128; ++r) *(LAS u32x4*)(img + (kr + r * KPR) * rs + c8 * 16) = R.r[r];
}
template <int BMT> struct XRegB16 { u32x4 r[(BMT + 127) / 128]; };
template <int BMT> __device__ __forceinline__ void xload_b16(XRegB16<BMT>& R, const bf16_t* const (&rowp)[(BMT + 127) / 128], int k0, int tid) {
#pragma unroll
  for (int r = 0; r < (BMT + 127) / 128; ++r) if (BMT >= 128 || tid < BMT * 4) R.r[r] = *(const u32x4*)(rowp[r] + k0 + (tid & 3) * 8);
}
template <int BMT> __device__ __forceinline__ void xstore_b16(const XRegB16<BMT>& R, lptr img, int tid) {
#pragma unroll
  for (int r = 0; r < (BMT + 127) / 128; ++r) if (BMT >= 128 || tid < BMT * 4) *(LAS u32x4*)(img + kmin_off((tid >> 2) + 128 * r, tid & 3)) = R.r[r];
}

template <int BNT> struct WLb16 {
  typedef WRegB16<BNT> Regs; const bf16_t* src; int ld;
  __device__ __forceinline__ void load(Regs& R, int k0, int tid) const { wload_b16<BNT>(R, src + (size_t)k0 * ld, ld, tid); }
  __device__ __forceinline__ void store(const Regs& R, lptr img, int rs, int tid) const { wstore_b16<BNT>(R, img, rs, tid); }
};
struct WLgu {
  typedef WRegB16<512> Regs; const bf16_t *g, *u;
  __device__ __forceinline__ void load(Regs& R, int k0, int tid) const {
    const int c8 = tid & 63, kr = tid >> 6, col = c8 * 8, grp = col >> 6, w = col & 63;
    const unsigned long long ga = (unsigned long long)g, ua = (unsigned long long)u;
    const bf16_t* s = (const bf16_t*)(w < 32 ? ga : ua) + grp * 32 + (w & 31);
#pragma unroll
    for (int r = 0; r < 4; ++r) R.r[r] = *(const u32x4*)(s + (size_t)(k0 + kr + r * 8) * 256);
  }
  __device__ __forceinline__ void store(const Regs& R, lptr img, int rs, int tid) const { wstore_b16<512>(R, img, rs, tid); }
};
struct WReg32x8 { f32x4 r[8]; };
__device__ __forceinline__ void wstore_f32_512(const WReg32x8& R, lptr img, int rs, int tid) {
  const int c4 = tid & 127, kr = tid >> 7;
#pragma unroll
  for (int r = 0; r < 8; ++r) { u32x2 o; o.x = pk2(R.r[r].x, R.r[r].y); o.y = pk2(R.r[r].z, R.r[r].w); *(LAS u32x2*)(img + (kr + 4 * r) * rs + c4 * 8) = o; }
}
struct WLf32 {
  typedef WReg32x8 Regs; const float* src; int ld;
  __device__ __forceinline__ void load(Regs& R, int k0, int tid) const {
    const float* s = src + (size_t)(k0 + (tid >> 7)) * ld + (tid & 127) * 4;
#pragma unroll
    for (int r = 0; r < 8; ++r) R.r[r] = *(const f32x4*)(s + (size_t)(4 * r) * ld);
  }
  __device__ __forceinline__ void store(const Regs& R, lptr img, int rs, int tid) const { wstore_f32_512(R, img, rs, tid); }
};
struct WLf32gu {
  typedef WReg32x8 Regs; const float *g, *u;
  __device__ __forceinline__ void load(Regs& R, int k0, int tid) const {
    const int col = (tid & 127) * 4, grp = col >> 7, w = col & 127;
    const unsigned long long ga = (unsigned long long)g, ua = (unsigned long long)u;
    const float* s = (const float*)(w < 64 ? ga : ua) + (size_t)(k0 + (tid >> 7)) * 256 + grp * 64 + (w & 63);
#pragma unroll
    for (int r = 0; r < 8; ++r) R.r[r] = *(const f32x4*)(s + (size_t)(4 * r) * 256);
  }
  __device__ __forceinline__ void store(const Regs& R, lptr img, int rs, int tid) const { wstore_f32_512(R, img, rs, tid); }
};
template <int BMT> struct XLrows {
  typedef XRegB16<BMT> Regs; const bf16_t* rowp[(BMT + 127) / 128]; lptr ximg;
  __device__ __forceinline__ void load(Regs& R, int k0, int tid) const { xload_b16<BMT>(R, rowp, k0, tid); }
  __device__ __forceinline__ void store(const Regs& R, int tid) const { xstore_b16<BMT>(R, ximg, tid); }
  __device__ __forceinline__ void store(const Regs& R, int off, int tid) const { xstore_b16<BMT>(R, ximg + off, tid); }
  __device__ __forceinline__ lptr img(int) const { return ximg; }
  __device__ __forceinline__ int staged() const { return 1; }
};
struct XLres {
  struct Regs {}; lptr base; int bytes;
  __device__ __forceinline__ void load(Regs&, int, int) const {}
  __device__ __forceinline__ void store(const Regs&, int) const {}
  __device__ __forceinline__ void store(const Regs&, int, int) const {}
  __device__ __forceinline__ lptr img(int k0) const { return base + (k0 >> 5) * bytes; }
  __device__ __forceinline__ int staged() const { return 0; }
};
template <int TM, int TN, class WL, class XL, bool WK = true, bool XK = false>
__device__ __forceinline__ void gemm_loop(f32x16 (&acc)[TM][TN], int K, const WL& wl, const XL& xl, lptr wimg, int wrs, int wn0, int xt0, int tid, int lane, int xrs = 0) {
  asm volatile("" : "+v"(tid), "+v"(lane));
  typename WL::Regs wr; typename XL::Regs xr;
  wl.load(wr, 0, tid); xl.load(xr, 0, tid);
  for (int k0 = 0; k0 < K; k0 += 32) {
    wl.store(wr, wimg, wrs, tid); xl.store(xr, tid);
    __syncthreads();
    if (k0 + 32 < K) { wl.load(wr, k0 + 32, tid); xl.load(xr, k0 + 32, tid); }
    mma_step<TM, TN, WK, XK>(acc, wimg, wrs, wn0, xl.img(k0), xrs, xt0, lane);
    __syncthreads();
  }
}
template <int TM, int TN, class WL, class XL, bool WK = true, bool XK = false>
__device__ __forceinline__ void gemm_loop2(f32x16 (&acc)[TM][TN], int K, const WL& wl, const XL& xl, lptr wimg, int wrs, int wn0, int xt0, int tid, int lane, int xrs = 0) {
  asm volatile("" : "+v"(tid), "+v"(lane));
  typename WL::Regs wa, wb; typename XL::Regs xa, xb;
  wl.load(wa, 0, tid); xl.load(xa, 0, tid); wl.load(wb, 32, tid); xl.load(xb, 32, tid);
  for (int k0 = 0; k0 < K; k0 += 64) {
    wl.store(wa, wimg, wrs, tid); xl.store(xa, tid);
    __syncthreads();
    if (k0 + 64 < K) { wl.load(wa, k0 + 64, tid); xl.load(xa, k0 + 64, tid); }
    mma_step<TM, TN, WK, XK>(acc, wimg, wrs, wn0, xl.img(k0), xrs, xt0, lane);
    __syncthreads();
    wl.store(wb, wimg, wrs, tid); xl.store(xb, tid);
    __syncthreads();
    if (k0 + 96 < K) { wl.load(wb, k0 + 96, tid); xl.load(xb, k0 + 96, tid); }
    mma_step<TM, TN, WK, XK>(acc, wimg, wrs, wn0, xl.img(k0 + 32), xrs, xt0, lane);
    __syncthreads();
  }
}
template <int TM, int TN, class WL, class XL>
__device__ __forceinline__ void gemm_loop64(f32x16 (&acc)[TM][TN], int K, const WL& wl, const XL& xl, lptr wimg, int wrs, int wn0, int xt0, int xhalf, int tid, int lane) {
  asm volatile("" : "+v"(tid), "+v"(lane));
  typename WL::Regs wa, wb; typename XL::Regs xa, xb;
  wl.load(wa, 0, tid); xl.load(xa, 0, tid); wl.load(wb, 32, tid); xl.load(xb, 32, tid);
  for (int k0 = 0; k0 < K; k0 += 64) {
    wl.store(wa, wimg, wrs, tid); xl.store(xa, 0, tid);
    wl.store(wb, wimg + 32 * wrs, wrs, tid); xl.store(xb, xhalf, tid);
    __syncthreads();
    if (k0 + 64 < K) { wl.load(wa, k0 + 64, tid); xl.load(xa, k0 + 64, tid); wl.load(wb, k0 + 96, tid); xl.load(xb, k0 + 96, tid); }
    mma_step<TM, TN, true, false>(acc, wimg, wrs, wn0, xl.img(k0), 0, xt0, lane);
    mma_step<TM, TN, true, false>(acc, wimg + 32 * wrs, wrs, wn0, xl.img(k0 + 32) + xhalf * xl.staged(), 0, xt0, lane);
    __syncthreads();
  }
}
template <int TM, int TN, class WL, class XL>
__device__ __forceinline__ void gemm_loop_db(f32x16 (&acc)[TM][TN], int K, const WL& wl, const XL& xl, lptr wimg, int wrs, int wn0, int xt0, int xhalf, int tid, int lane) {
  asm volatile("" : "+v"(tid), "+v"(lane));
  const bool early = __builtin_amdgcn_readfirstlane(tid) < 256;
  typename WL::Regs wa, wb; typename XL::Regs xa, xb;
  wl.load(wa, 0, tid); xl.load(xa, 0, tid); wl.load(wb, 32, tid); xl.load(xb, 32, tid);
  wl.store(wa, wimg, wrs, tid); xl.store(xa, 0, tid);
  __syncthreads();
  if (64 < K) { wl.load(wa, 64, tid); xl.load(xa, 64, tid); }
  for (int k0 = 0; k0 < K; k0 += 64) {
    if (early) { wl.store(wb, wimg + 32 * wrs, wrs, tid); xl.store(xb, xhalf, tid); if (k0 + 96 < K) { wl.load(wb, k0 + 96, tid); xl.load(xb, k0 + 96, tid); } }
    mma_step<TM, TN, true, false>(acc, wimg, wrs, wn0, xl.img(k0), 0, xt0, lane);
    if (!early) { wl.store(wb, wimg + 32 * wrs, wrs, tid); xl.store(xb, xhalf, tid); if (k0 + 96 < K) { wl.load(wb, k0 + 96, tid); xl.load(xb, k0 + 96, tid); } }
    __syncthreads();
    if (early && k0 + 64 < K) { wl.store(wa, wimg, wrs, tid); xl.store(xa, 0, tid); if (k0 + 128 < K) { wl.load(wa, k0 + 128, tid); xl.load(xa, k0 + 128, tid); } }
    mma_step<TM, TN, true, false>(acc, wimg + 32 * wrs, wrs, wn0, xl.img(k0 + 32) + xhalf * xl.staged(), 0, xt0, lane);
    if (!early && k0 + 64 < K) { wl.store(wa, wimg, wrs, tid); xl.store(xa, 0, tid); if (k0 + 128 < K) { wl.load(wa, k0 + 128, tid); xl.load(xa, k0 + 128, tid); } }
    __syncthreads();
  }
}
template <int TM, int TN> __device__ __forceinline__ void acc_zero(f32x16 (&acc)[TM][TN]) {
#pragma unroll
  for (int a = 0; a < TM; ++a)
#pragma unroll
    for (int b = 0; b < TN; ++b)
#pragma unroll
      for (int r = 0; r < 16; ++r) acc[a][b][r] = 0.f;
}

struct WLgu256 {
  typedef WRegB16<256> Regs; const bf16_t *g, *u; int abase;
  __device__ __forceinline__ void load(Regs& R, int k0, int tid) const {
    const int col = (tid & 31) * 8, grp = col >> 7, w = col & 127;
    const unsigned long long ga = (unsigned long long)g, ua = (unsigned long long)u;
    const bf16_t* s = (const bf16_t*)(w < 64 ? ga : ua) + abase + grp * 64 + (w & 63) + (size_t)(k0 + (tid >> 5)) * 256;
#pragma unroll
    for (int r = 0; r < 2; ++r) R.r[r] = *(const u32x4*)(s + (size_t)(r * 16) * 256);
  }
  __device__ __forceinline__ void store(const Regs& R, lptr img, int rs, int tid) const { wstore_b16<256>(R, img, rs, tid); }
};
template <class WL>
__device__ __forceinline__ void gemm256(f32x16 (&acc)[4][2], const WL& wl, const bf16_t* xbase, int ldx, int t0, int K, lptr lds, int wn, int wt, int tid, int lane) {
  constexpr int WRS = 256 * 2 + 64;
  XLrows<256> xl; xl.rowp[0] = xbase + (size_t)(t0 + (tid >> 2)) * ldx; xl.rowp[1] = xl.rowp[0] + (size_t)128 * ldx; xl.ximg = lds + 64 * WRS;
  acc_zero<4, 2>(acc);
  gemm_loop_db<4, 2>(acc, K, wl, xl, lds, WRS, wn * 128, wt * 64, 256 * 64, tid, lane);
}
constexpr int LDS_INV64 = 150 * 1024, LDS_INV128 = LDS_INV64 + 128, LDS_XB = LDS_INV128 + 256, LDS_BYTES = 152 * 1024;

__device__ __forceinline__ void cvt_items(const float* src, bf16_t* dst, size_t n8, int gtid, int gthreads) {
  for (size_t i = gtid; i < n8; i += gthreads) {
    const f32x4 a = *(const f32x4*)(src + i * 8), b = *(const f32x4*)(src + i * 8 + 4);
    u32x4 o; o.x = pk2(a.x, a.y); o.y = pk2(a.z, a.w); o.z = pk2(b.x, b.y); o.w = pk2(b.z, b.w);
    *(u32x4*)(dst + i * 8) = o;
  }
}
__device__ __forceinline__ void phase0a(const P& p, lptr lds, int vcu, int G) {
  const int tid = threadIdx.x, wid = tid >> 6, lane = tid & 63;
  if (vcu < 96) {
    const int j = vcu * 64 + lane;
    float a0 = 0.f, a1 = 0.f, a2 = 0.f, a3 = 0.f;
    for (int k = wid * 128; k < wid * 128 + 128; k += 32) {
      float w[32];
#pragma unroll
      for (int q = 0; q < 32; ++q) w[q] = p.w_ada[(size_t)(k + q) * 6144 + j];
#pragma unroll
      for (int q = 0; q < 32; ++q) { a0 += silu(p.c[k + q]) * w[q]; a1 += silu(p.c[D + k + q]) * w[q]; a2 += silu(p.c[2 * D + k + q]) * w[q]; a3 += silu(p.c[3 * D + k + q]) * w[q]; }
    }
    LAS float* part = (LAS float*)lds;
    part[(wid * 4 + 0) * 64 + lane] = a0; part[(wid * 4 + 1) * 64 + lane] = a1; part[(wid * 4 + 2) * 64 + lane] = a2; part[(wid * 4 + 3) * 64 + lane] = a3;
    __syncthreads();
    if (wid < 4) { float s = p.b_ada[j];
#pragma unroll
      for (int w = 0; w < 8; ++w) s += part[(w * 4 + wid) * 64 + lane];
      p.mod[wid * 6144 + j] = s; }
    __syncthreads();
  }
  if (vcu < 96 && G > 96) return;
  const int gtid = (G > 96 ? vcu - 96 : vcu) * 512 + tid, gth = (G > 96 ? G - 96 : G) * 512;
  cvt_items(p.w_in, p.winb, (size_t)D * INW / 8, gtid, gth);
  cvt_items(p.w_out, p.woutb, (size_t)D * D / 8, gtid, gth);
  cvt_items(p.w_router, p.wrb, (size_t)D * NE / 8, gtid, gth);
  cvt_items(p.wg_s, p.wgsb, (size_t)D * 256 / 8, gtid, gth);
  cvt_items(p.wu_s, p.wusb, (size_t)D * 256 / 8, gtid, gth);
  cvt_items(p.wd_s, p.wdsb, (size_t)256 * D / 8, gtid, gth);
  cvt_items(p.cw1k, p.cw1kb, (size_t)2048 * 128 / 8, gtid, gth);
  cvt_items(p.cw1v, p.cw1vb, (size_t)2048 * 128 / 8, gtid, gth);
  cvt_items(p.cw2k, p.cw2kb, (size_t)128 * 64 / 8, gtid, gth);
  cvt_items(p.cw2v, p.cw2vb, (size_t)128 * 64 / 8, gtid, gth);
}

__device__ __forceinline__ void phase0b(const P& p, lptr lds, int vcu, int G) {
  const int tid = threadIdx.x, wid = tid >> 6, lane = tid & 63;
  for (int row = vcu * 8 + wid; row < T; row += G * 8) {
    const int b = row / SEQ;
    f32x4 v[4]; float s = 0.f;
#pragma unroll
    for (int j = 0; j < 4; ++j) { v[j] = *(const f32x4*)(p.x + (size_t)row * D + j * 256 + lane * 4); s += v[j].x * v[j].x + v[j].y * v[j].y + v[j].z * v[j].z + v[j].w * v[j].w; }
    s = wave_sum(s);
    const float r = rsqrtf(s * (1.f / D) + EPS);
#pragma unroll
    for (int j = 0; j < 4; ++j) {
      const int k = j * 256 + lane * 4;
      const f32x4 g = *(const f32x4*)(p.g_mix + k), sc = *(const f32x4*)(p.mod + b * 6144 + 1024 + k), sh = *(const f32x4*)(p.mod + b * 6144 + k);
      u32x2 o; o.x = pk2(v[j].x * r * g.x * (1.f + sc.x) + sh.x, v[j].y * r * g.y * (1.f + sc.y) + sh.y); o.y = pk2(v[j].z * r * g.z * (1.f + sc.z) + sh.z, v[j].w * r * g.w * (1.f + sc.w) + sh.w);
      *(u32x2*)(p.hb + (size_t)row * D + k) = o;
    }
  }
}

#define ROPE_PAIR(X1, X2, posf, invrev, sc) do { float pf_ = (posf); asm volatile("" : "+v"(pf_)); const float fr_ = __builtin_amdgcn_fractf(pf_ * (invrev)); \
    const float sn_ = __builtin_amdgcn_sinf(fr_), cs_ = __builtin_amdgcn_cosf(fr_); const float a_ = (X1), b_ = (X2); \
    float o1_ = (a_ * cs_ - b_ * sn_) * (sc), o2_ = (a_ * sn_ + b_ * cs_) * (sc); asm volatile("" : "+v"(o1_), "+v"(o2_)); (X1) = o1_; (X2) = o2_; } while (0)
__device__ __forceinline__ void phase1(const P& p, lptr lds, int vcu, int G) {
  const int tid = threadIdx.x, wid = __builtin_amdgcn_readfirstlane(tid >> 6), lane = tid & 63, wn = wid >> 2, wt = wid & 3, h = lane >> 5;
  const LAS float* inv64 = (const LAS float*)(lds + LDS_INV64);
  const LAS float* inv128 = (const LAS float*)(lds + LDS_INV128);
  for (int u = vcu; u < 14 * 64; u += G) {
    const int j = u % 14, mt = u / 14, t0 = mt * 256;
    if (j == 13) {
      f32x16 ag[1][1]; acc_zero<1, 1>(ag);
      WLb16<128> wl; wl.src = p.winb + C_GN; wl.ld = INW;
      XLrows<256> xl; xl.rowp[0] = p.hb + (size_t)(t0 + (tid >> 2)) * D; xl.rowp[1] = xl.rowp[0] + (size_t)128 * D; xl.ximg = lds + 32 * 320;
      gemm_loop2<1, 1>(ag, D, wl, xl, lds, 320, 0, wid * 32, tid, lane);
      int tok = t0 + wid * 32 + (lane & 31), nb = 4 * h; asm volatile("" : "+v"(tok), "+v"(nb));
#pragma unroll
      for (int a = 0; a < 3; ++a) { f32x4 v; v.x = sigm(ag[0][0][4 * a]); v.y = sigm(ag[0][0][4 * a + 1]); v.z = sigm(ag[0][0][4 * a + 2]); v.w = sigm(ag[0][0][4 * a + 3]);
        *(f32x4*)(p.gates + (size_t)tok * 24 + nb + a * 8) = v; }
      continue;
    }
    const int wcol = j < 5 ? j * 256 : C_QR + (j - 5) * 256;
    f32x16 acc[4][2];
    { WLb16<256> wl; wl.src = p.winb + wcol; wl.ld = INW; gemm256(acc, wl, p.hb, D, t0, D, lds, wn, wt, tid, lane); }
    const int kind = (j < 2) ? 0 : (j == 2) ? 3 : (j < 5) ? (wn == 0 ? 1 : 3) : (j < 7) ? 2 : (j < 9) ? 4 : (j < 11) ? 3 : 5;
#pragma unroll
    for (int tn = 0; tn < 2; ++tn) {
      const int tok = t0 + wt * 64 + tn * 32 + (lane & 31);
      const float posf = (float)p.pos[tok];
      if (kind == 0 || kind == 1) {
        const float sc = kind == 0 ? 0.125f : 1.f;
#pragma unroll
        for (int r = 0; r < 16; ++r) { const float iv = inv64[(r & 3) + 8 * (r >> 2) + 4 * h];
          ROPE_PAIR(acc[0][tn][r], acc[1][tn][r], posf, iv, sc); ROPE_PAIR(acc[2][tn][r], acc[3][tn][r], posf, iv, sc); if ((r & 3) == 3) __builtin_amdgcn_sched_barrier(0); }
      } else if (kind == 2 || kind == 4) {
        const float sc = kind == 4 ? 0.08838834764831845f : 1.f;
#pragma unroll
        for (int r = 0; r < 16; ++r) { const int i = (r & 3) + 8 * (r >> 2) + 4 * h;
          ROPE_PAIR(acc[0][tn][r], acc[2][tn][r], posf, inv128[i], sc); ROPE_PAIR(acc[1][tn][r], acc[3][tn][r], posf, inv128[32 + i], sc); if ((r & 3) == 3) __builtin_amdgcn_sched_barrier(0); }
      } else if (kind == 5) {
#pragma unroll
        for (int tm = 0; tm < 4; ++tm)
#pragma unroll
          for (int r = 0; r < 16; ++r) { float v = acc[tm][tn][r]; asm volatile("" : "+v"(v)); float o = v * __builtin_amdgcn_rcpf(1.f + __builtin_amdgcn_exp2f(-1.4426950408889634f * v)); asm volatile("" : "+v"(o)); acc[tm][tn][r] = o; }
      }
      bf16_t* orow = p.projb + (size_t)tok * PJW + j * 256 + wn * 128 + 4 * h;
#pragma unroll
      for (int tm = 0; tm < 4; ++tm)
#pragma unroll
        for (int a = 0; a < 4; ++a) { u32x2 o; o.x = pk2(acc[tm][tn][4 * a], acc[tm][tn][4 * a + 1]); o.y = pk2(acc[tm][tn][4 * a + 2], acc[tm][tn][4 * a + 3]);
          *(u32x2*)(orow + tm * 32 + a * 8) = o; __builtin_amdgcn_sched_barrier(0); }
    }
  }
}

__device__ __forceinline__ void phase5(const P& p, lptr lds, int vcu, int G) {
  const int tid = threadIdx.x, wid = __builtin_amdgcn_readfirstlane(tid >> 6), lane = tid & 63, h = lane >> 5, l31 = lane & 31;
  constexpr int WRS1 = 1024 * 2 + 64;
  lptr wimg = lds, ximg = lds + 32 * WRS1;
  lptr lgb = lds + 72 * 1024;
  LAS float* part = (LAS float*)(lds + 138 * 1024);
  LAS float* rstd = part + 512;
  for (int u = vcu; u < T / 64; u += G) {
    const int t0 = u * 64, b = t0 / SEQ;
    f32x16 acc[4][2];
    acc_zero<4, 2>(acc);
    { WLb16<1024> wl; wl.src = p.woutb; wl.ld = D;
      XLrows<64> xl; xl.rowp[0] = p.mixb + (size_t)(t0 + ((tid >> 2) & 63)) * D; xl.ximg = ximg;
      gemm_loop<4, 2>(acc, D, wl, xl, wimg, WRS1, wid * 128, 0, tid, lane); }
    int nb = wid * 128 + 4 * h, tb = t0 + l31;
    asm volatile("" : "+v"(nb), "+v"(tb));
#pragma unroll
    for (int tn = 0; tn < 2; ++tn) {
      const int tok = tb + tn * 32; float ss = 0.f;
#pragma unroll
      for (int tm = 0; tm < 4; ++tm)
#pragma unroll
        for (int a = 0; a < 4; ++a) {
          const int n = nb + tm * 32 + a * 8;
          const f32x4 xv = *(const f32x4*)(p.x + (size_t)tok * D + n), gt = *(const f32x4*)(p.mod + b * 6144 + 2048 + n);
          f32x4 v; v.x = xv.x + gt.x * acc[tm][tn][4 * a]; v.y = xv.y + gt.y * acc[tm][tn][4 * a + 1]; v.z = xv.z + gt.z * acc[tm][tn][4 * a + 2]; v.w = xv.w + gt.w * acc[tm][tn][4 * a + 3];
          acc[tm][tn][4 * a] = v.x; acc[tm][tn][4 * a + 1] = v.y; acc[tm][tn][4 * a + 2] = v.z; acc[tm][tn][4 * a + 3] = v.w;
          *(f32x4*)(p.x1 + (size_t)tok * D + n) = v;
          ss += v.x * v.x + v.y * v.y + v.z * v.z + v.w * v.w;
          if (a == 3) __builtin_amdgcn_sched_barrier(0);
        }
      ss += __shfl_xor(ss, 32);
      if (h == 0) part[wid * 64 + tn * 32 + l31] = ss;
    }
    __syncthreads();
    if (tid < 64) { float q = 0.f;
#pragma unroll
      for (int w = 0; w < 8; ++w) q += part[w * 64 + tid];
      rstd[tid] = rsqrtf(q * (1.f / D) + EPS); }
    __syncthreads();
    asm volatile("" : "+v"(nb), "+v"(tb));
#pragma unroll
    for (int tn = 0; tn < 2; ++tn) {
      const int tok = tb + tn * 32; const float r = rstd[tn * 32 + l31];
#pragma unroll
      for (int tm = 0; tm < 4; ++tm)
#pragma unroll
        for (int a = 0; a < 4; ++a) {
          const int n = nb + tm * 32 + a * 8;
          const f32x4 g = *(const f32x4*)(p.g_ffn + n), sc = *(const f32x4*)(p.mod + b * 6144 + 4096 + n), sh = *(const f32x4*)(p.mod + b * 6144 + 3072 + n);
          u32x2 o;
          o.x = pk2(acc[tm][tn][4 * a] * r * g.x * (1.f + sc.x) + sh.x, acc[tm][tn][4 * a + 1] * r * g.y * (1.f + sc.y) + sh.y);
          o.y = pk2(acc[tm][tn][4 * a + 2] * r * g.z * (1.f + sc.z) + sh.z, acc[tm][tn][4 * a + 3] * r * g.w * (1.f + sc.w) + sh.w);
          *(u32x2*)(p.h2b + (size_t)tok * D + n) = o;
          if (a == 3) __builtin_amdgcn_sched_barrier(0);
        }
    }
    asm volatile("s_waitcnt vmcnt(0)" ::: "memory");
    __syncthreads();
    { f32x16 a2[1][2]; acc_zero<1, 2>(a2);
      WLb16<256> wl; wl.src = p.wrb; wl.ld = NE;
      XLrows<64> xl; xl.rowp[0] = p.h2b + (size_t)(t0 + ((tid >> 2) & 63)) * D; xl.ximg = ximg;
      gemm_loop<1, 2>(a2, D, wl, xl, wimg, 256 * 2 + 64, wid * 32, 0, tid, lane);
      int lo = ((l31 * 256 + wid * 32 + 4 * h) * 4);
      asm volatile("" : "+v"(lo));
#pragma unroll
      for (int tn = 0; tn < 2; ++tn)
#pragma unroll
        for (int a = 0; a < 4; ++a) { f32x4 v = {a2[0][tn][4 * a], a2[0][tn][4 * a + 1], a2[0][tn][4 * a + 2], a2[0][tn][4 * a + 3]};
          *(LAS f32x4*)(lgb + lo + (tn * 32 * 256 + a * 8) * 4) = v; } }
    __syncthreads();
    { int lane_ = lane; asm volatile("" : "+v"(lane_));
      const int lane = lane_;
      const f32x4 rb = *(const f32x4*)(p.rbias + lane * 4);
      for (int i = 0; i < 8; ++i) {
        const int tl = wid * 8 + i, tok = t0 + tl;
        const f32x4 lv = *(const LAS f32x4*)(lgb + (tl * 256 + lane * 4) * 4);
        const float s0 = sigm(lv.x), s1 = sigm(lv.y), s2 = sigm(lv.z), s3 = sigm(lv.w);
        float c0 = s0 + rb.x, c1 = s1 + rb.y, c2 = s2 + rb.z, c3 = s3 + rb.w;
        float m1, m2;
        { const float h1 = fmaxf(c0, c1), l1 = fminf(c0, c1), h2 = fmaxf(c2, c3), l2 = fminf(c2, c3); m1 = fmaxf(h1, h2); m2 = fmaxf(fminf(h1, h2), fmaxf(l1, l2)); }
#pragma unroll
        for (int o = 1; o < 8; o <<= 1) { const float o1 = __shfl_xor(m1, o), o2 = __shfl_xor(m2, o); const float n1 = fmaxf(m1, o1), n2 = fmaxf(fminf(m1, o1), fmaxf(m2, o2)); m1 = n1; m2 = n2; }
        const float gs = m1 + m2; const int myg = lane >> 3; int rank = 0;
#pragma unroll
        for (int g2 = 0; g2 < 8; ++g2) { const float og = __shfl(gs, g2 * 8); rank += (og > gs || (og == gs && g2 < myg)) ? 1 : 0; }
        if (rank >= 4) { c0 = -INFINITY; c1 = -INFINITY; c2 = -INFINITY; c3 = -INFINITY; }
        int my_e = 0; float my_s = 0.f;
#pragma unroll
        for (int k = 0; k < 8; ++k) {
          float bv = c0; int li = lane * 4;
          if (c1 > bv) { bv = c1; li = lane * 4 + 1; }
          if (c2 > bv) { bv = c2; li = lane * 4 + 2; }
          if (c3 > bv) { bv = c3; li = lane * 4 + 3; }
#pragma unroll
          for (int o = 1; o < 64; o <<= 1) { const float ov = __shfl_xor(bv, o); const int oi = __shfl_xor(li, o); if (ov > bv || (ov == bv && oi < li)) { bv = ov; li = oi; } }
          const int j = li & 3; const float sj = j == 0 ? s0 : j == 1 ? s1 : j == 2 ? s2 : s3;
          const float sv = __shfl(sj, li >> 2);
          if (lane * 4 == li) c0 = -INFINITY;
          if (lane * 4 + 1 == li) c1 = -INFINITY;
          if (lane * 4 + 2 == li) c2 = -INFINITY;
          if (lane * 4 + 3 == li) c3 = -INFINITY;
          if (lane == k) { my_e = li; my_s = sv; }
        }
        const float wsum = wave_sum(lane < 8 ? my_s : 0.f);
        if (lane < 8) { const int pos = atomicAdd(&p.cnt[my_e], 1); p.list[my_e * ECAP + pos] = tok * 8 + lane; p.wts[tok * 8 + lane] = my_s / wsum * 2.5f; }
      } }
    __syncthreads();
    { f32x16 a3[2][2]; acc_zero<2, 2>(a3);
      WLgu wl; wl.g = p.wgsb; wl.u = p.wusb;
      XLrows<64> xl; xl.rowp[0] = p.h2b + (size_t)(t0 + ((tid >> 2) & 63)) * D; xl.ximg = ximg;
      gemm_loop<2, 2>(a3, D, wl, xl, wimg, 512 * 2 + 64, wid * 64, 0, tid, lane);
      int l31_ = l31, h_ = h; asm volatile("" : "+v"(l31_), "+v"(h_));
#pragma unroll
      for (int tn = 0; tn < 2; ++tn)
#pragma unroll
        for (int a = 0; a < 4; ++a) {
          float o[4];
#pragma unroll
          for (int e = 0; e < 4; ++e) { const float gv = a3[0][tn][4 * a + e], uv = a3[1][tn][4 * a + e]; o[e] = gv * __builtin_amdgcn_rcpf(1.f + __builtin_amdgcn_exp2f(-1.4426950408889634f * gv)) * uv; }
          const int col = wid * 32 + a * 8 + 4 * h_;
          u32x2 w2; w2.x = pk2(o[0], o[1]); w2.y = pk2(o[2], o[3]);
          *(LAS u32x2*)(lgb + (col >> 5) * 4096 + kmin_off(tn * 32 + l31_, (col & 31) >> 3) + (col & 7) * 2) = w2;
        } }
    __syncthreads();
    acc_zero<4, 2>(acc);
    { WLb16<1024> wl; wl.src = p.wdsb; wl.ld = D;
      XLres xl; xl.base = lgb; xl.bytes = 4096;
      gemm_loop<4, 2>(acc, 256, wl, xl, wimg, WRS1, wid * 128, 0, tid, lane); }
    asm volatile("" : "+v"(nb), "+v"(tb));
#pragma unroll
    for (int tn = 0; tn < 2; ++tn) {
      const int tok = tb + tn * 32;
#pragma unroll
      for (int tm = 0; tm < 4; ++tm)
#pragma unroll
        for (int a = 0; a < 4; ++a) {
          const int n = nb + tm * 32 + a * 8;
          f32x4 v = *(const f32x4*)(p.x1 + (size_t)tok * D + n); const f32x4 gt = *(const f32x4*)(p.mod + b * 6144 + 5120 + n);
          v.x += gt.x * acc[tm][tn][4 * a]; v.y += gt.y * acc[tm][tn][4 * a + 1]; v.z += gt.z * acc[tm][tn][4 * a + 2]; v.w += gt.w * acc[tm][tn][4 * a + 3];
          *(f32x4*)(p.x1 + (size_t)tok * D + n) = v;
          if (a == 3) __builtin_amdgcn_sched_barrier(0);
        }
    }
    __syncthreads();
  }
}

__device__ __forceinline__ void phase6(const P& p, lptr lds, int vcu, int G) {
  const int tid = threadIdx.x, wid = __builtin_amdgcn_readfirstlane(tid >> 6), lane = tid & 63, h = lane >> 5, l31 = lane & 31, wn = wid >> 1, wt = wid & 1;
  constexpr int WRS = 512 * 2 + 64;
  lptr wimg = lds, ximg = lds + 68 * 1024;
  lptr actb = lds + 84 * 1024;
  LAS int* pre = (LAS int*)(lds + 148 * 1024);
  LAS int* sidl = pre + 320;
  if (tid < NE) pre[tid + 1] = (p.cnt[tid] + 127) >> 7;
  if (tid == 0) pre[0] = 0;
  __syncthreads();
  if (tid == 0) { int a = 0; for (int e = 1; e <= NE; ++e) { a += pre[e]; pre[e] = a; } }
  __syncthreads();
  const int nunits = pre[NE];
  for (int u = vcu; u < nunits; u += G) {
    int lo = 0, hi = NE;
    while (hi - lo > 1) { const int mid = (lo + hi) >> 1; if (pre[mid] <= u) lo = mid; else hi = mid; }
    const int e = lo, off = (u - pre[e]) * 128, cnt = p.cnt[e];
    if (tid < 128) sidl[tid] = off + tid < cnt ? p.list[e * ECAP + off + tid] : -1;
    __syncthreads();
    f32x16 acc[4][2];
    acc_zero<4, 2>(acc);
    { WLf32gu wl; wl.g = p.wg_e + (size_t)e * D * 256; wl.u = p.wu_e + (size_t)e * D * 256;
      XLrows<128> xl; { const int sd = sidl[(tid >> 2) & 127]; xl.rowp[0] = p.h2b + (size_t)(sd < 0 ? 0 : sd >> 3) * D; } xl.ximg = ximg;
      gemm_loop_db<4, 2>(acc, D, wl, xl, wimg, WRS, wn * 128, wt * 64, 128 * 64, tid, lane); }
    { int l31_ = l31, h_ = h; asm volatile("" : "+v"(l31_), "+v"(h_));
#pragma unroll
      for (int tn = 0; tn < 2; ++tn)
#pragma unroll
        for (int tm = 0; tm < 2; ++tm)
#pragma unroll
          for (int a = 0; a < 4; ++a) {
            float o[4];
#pragma unroll
            for (int q = 0; q < 4; ++q) { const float gv = acc[tm][tn][4 * a + q], uv = acc[tm + 2][tn][4 * a + q]; o[q] = gv * __builtin_amdgcn_rcpf(1.f + __builtin_amdgcn_exp2f(-1.4426950408889634f * gv)) * uv; }
            const int col = wn * 64 + tm * 32 + a * 8 + 4 * h_;
            u32x2 w2; w2.x = pk2(o[0], o[1]); w2.y = pk2(o[2], o[3]);
            *(LAS u32x2*)(actb + (col >> 5) * 8192 + kmin_off(wt * 64 + tn * 32 + l31_, (col & 31) >> 3) + (col & 7) * 2) = w2;
          } }
    __syncthreads();
#pragma unroll 1
    for (int pass = 0; pass < 2; ++pass) {
      acc_zero<4, 2>(acc);
      { WLf32 wl; wl.src = p.wd_e + (size_t)e * 256 * D + pass * 512; wl.ld = D;
        XLres xl; xl.base = actb; xl.bytes = 8192;
        gemm_loop_db<4, 2>(acc, 256, wl, xl, wimg, WRS, wn * 128, wt * 64, 0, tid, lane); }
      int nb = pass * 512 + wn * 128 + 4 * h, sl = wt * 64 + l31;
      asm volatile("" : "+v"(nb), "+v"(sl));
#pragma unroll
      for (int tn = 0; tn < 2; ++tn) {
        const int sd = sidl[sl + tn * 32];
        if (sd >= 0) {
          const float wgt = p.wts[sd];
          bf16_t* orow = p.slab + (size_t)sd * D + nb;
#pragma unroll
          for (int tm = 0; tm < 4; ++tm)
#pragma unroll
            for (int a = 0; a < 4; ++a) { u32x2 o; o.x = pk2(acc[tm][tn][4 * a] * wgt, acc[tm][tn][4 * a + 1] * wgt); o.y = pk2(acc[tm][tn][4 * a + 2] * wgt, acc[tm][tn][4 * a + 3] * wgt);
              *(u32x2*)(orow + tm * 32 + a * 8) = o; }
        }
      }
    }
    __syncthreads();
  }
}

__device__ __forceinline__ void phase7(const P& p, lptr lds, int vcu, int G) {
  const int tid = threadIdx.x, wid = tid >> 6, lane = tid & 63;
  for (int tok = vcu * 8 + wid; tok < T; tok += G * 8) {
    const int b = tok / SEQ;
    float v[16]; float ss = 0.f;
#pragma unroll
    for (int j = 0; j < 2; ++j) {
      const int n = j * 512 + lane * 8;
      float a[8];
#pragma unroll
      for (int q = 0; q < 8; ++q) a[q] = 0.f;
#pragma unroll
      for (int k = 0; k < 8; ++k) { const u32x4 w = *(const u32x4*)(p.slab + ((size_t)tok * 8 + k) * D + n);
        a[0] += bflo(w.x); a[1] += bfhi(w.x); a[2] += bflo(w.y); a[3] += bfhi(w.y); a[4] += bflo(w.z); a[5] += bfhi(w.z); a[6] += bflo(w.w); a[7] += bfhi(w.w); }
#pragma unroll
      for (int q4 = 0; q4 < 2; ++q4) {
        const f32x4 xv = *(const f32x4*)(p.x1 + (size_t)tok * D + n + q4 * 4), gt = *(const f32x4*)(p.mod + b * 6144 + 5120 + n + q4 * 4);
        const float y0 = xv.x + gt.x * a[q4 * 4], y1 = xv.y + gt.y * a[q4 * 4 + 1], y2 = xv.z + gt.z * a[q4 * 4 + 2], y3 = xv.w + gt.w * a[q4 * 4 + 3];
        v[j * 8 + q4 * 4] = y0; v[j * 8 + q4 * 4 + 1] = y1; v[j * 8 + q4 * 4 + 2] = y2; v[j * 8 + q4 * 4 + 3] = y3;
        ss += y0 * y0 + y1 * y1 + y2 * y2 + y3 * y3;
      }
    }
    ss = wave_sum(ss);
    const float r = rsqrtf(ss * (1.f / D) + EPS);
#pragma unroll
    for (int j = 0; j < 2; ++j)
#pragma unroll
      for (int q4 = 0; q4 < 2; ++q4) {
        const int n = j * 512 + lane * 8 + q4 * 4;
        const f32x4 g = *(const f32x4*)(p.g_final + n);
        f32x4 o; o.x = v[j * 8 + q4 * 4] * r * g.x; o.y = v[j * 8 + q4 * 4 + 1] * r * g.y; o.z = v[j * 8 + q4 * 4 + 2] * r * g.z; o.w = v[j * 8 + q4 * 4 + 3] * r * g.w;
        *(f32x4*)(p.out + (size_t)tok * D + n) = o;
      }
  }
}

constexpr int NSA_KB = 8192, NSA_VRS = 128, NSA_SLOT = NSA_KB + 64 * NSA_VRS, NSA_NSLOT = 4, NSA_IMP = NSA_NSLOT * NSA_SLOT;
__device__ __forceinline__ void glds16(const void* gsrc, unsigned lds_dst) { unsigned keep;
  asm volatile("s_mov_b32 %0, m0\n\ts_mov_b32 m0, %2\n\ts_nop 0\n\tglobal_load_lds_dwordx4 %1, off\n\ts_mov_b32 m0, %0" : "=&s"(keep) : "v"(gsrc), "s"(lds_dst) : "memory"); }
__device__ __forceinline__ void nsa_qk(f32x16 (&s)[2], lptr kimg, const bf16x8 (&qf)[4], int l31, int h) {
#pragma unroll
  for (int kt = 0; kt < 2; ++kt) {
#pragma unroll
    for (int r = 0; r < 16; ++r) s[kt][r] = 0.f;
    const int key = kt * 32 + l31;
#pragma unroll
    for (int ds = 0; ds < 4; ++ds) {
      const bf16x8 a = *(LAS bf16x8*)(kimg + key * 128 + (((2 * ds + h) ^ ((key >> 1) & 7)) << 4));
      s[kt] = __builtin_amdgcn_mfma_f32_32x32x16_bf16(a, qf[ds], s[kt], 0, 0, 0);
    }
  }
}
__device__ __forceinline__ void nsa_pv(f32x16 (&o)[2], lptr vimg, const f32x16 (&pr)[2], int lane) {
  const int h = lane >> 5, blk = (lane >> 4) & 1, q = (lane & 15) >> 2, pp = lane & 3;
  bf16x8 pb[4];
#pragma unroll
  for (int ks = 0; ks < 4; ++ks) {
    const int kt = ks >> 1, rb = 8 * (ks & 1);
    u32x4 w; w.x = pk2(pr[kt][rb], pr[kt][rb + 1]); w.y = pk2(pr[kt][rb + 2], pr[kt][rb + 3]); w.z = pk2(pr[kt][rb + 4], pr[kt][rb + 5]); w.w = pk2(pr[kt][rb + 6], pr[kt][rb + 7]);
    pb[ks] = __builtin_bit_cast(bf16x8, w);
  }
#pragma unroll
  for (int dt = 0; dt < 2; ++dt)
#pragma unroll
    for (int ks = 0; ks < 4; ++ks) {
      lptr a = vimg + (16 * ks + 4 * h + q) * NSA_VRS + (((dt * 4 + 2 * blk + (pp >> 1)) ^ ((q >> 1) << 2)) << 4) + (pp & 1) * 8;
      const v4i16_t lo = __builtin_amdgcn_ds_read_tr16_b64_v4i16((LAS v4i16_t*)a);
      const v4i16_t hi = __builtin_amdgcn_ds_read_tr16_b64_v4i16((LAS v4i16_t*)(a + 8 * NSA_VRS));
      const bf16x8 vf = {lo[0], lo[1], lo[2], lo[3], hi[0], hi[1], hi[2], hi[3]};
      o[dt] = __builtin_amdgcn_mfma_f32_32x32x16_bf16(vf, pb[ks], o[dt], 0, 0, 0);
    }
}
__device__ __forceinline__ float fexp(float x) { return __builtin_amdgcn_exp2f(x * 1.4426950408889634f); }
__device__ __forceinline__ float xmax32(float x) { const auto rr = __builtin_amdgcn_permlane32_swap(__float_as_uint(x), __float_as_uint(x), false, false); return fmaxf(__uint_as_float(rr[0]), __uint_as_float(rr[1])); }
__device__ __forceinline__ float xsum32(float x) { const auto rr = __builtin_amdgcn_permlane32_swap(__float_as_uint(x), __float_as_uint(x), false, false); return __uint_as_float(rr[0]) + __uint_as_float(rr[1]); }
__device__ __forceinline__ void phase_nsa(const P& p, lptr lds, int vcu, int G) {
  const int tid = threadIdx.x, wid = __builtin_amdgcn_readfirstlane(tid >> 6), lane0 = tid & 63;
  LAS float* imp = (LAS float*)(lds + NSA_IMP);
  LAS float* obuf = (LAS float*)(lds + NSA_IMP + 16384) + wid * 2048 + lane0;
  for (int u = vcu; u < 512; u += G) {
    const int bg = u & 7, j0 = u < 256 ? 63 - (u >> 3) : ((u - 256) >> 3), b = bg >> 1, g = bg & 1, t0 = j0 * 64;
    const int t = t0 + wid * 8 + ((lane0 & 31) >> 2), hg = g * 4 + (lane0 & 3);
    const size_t trow = (size_t)(b * SEQ + t);
    bf16x8 qf[4];
#pragma unroll
    for (int ds = 0; ds < 4; ++ds) qf[ds] = *(const bf16x8*)(p.projb + trow * PJW + J_QN + hg * 64 + 16 * ds + 8 * (lane0 >> 5));
#pragma unroll
    for (int i = 0; i < 8; ++i) imp[(wid * 8 + i) * 64 + lane0] = 0.f;
    const int nct = (((t0 + 32) >> 4) >> 6) + 1, jw0 = j0 > 8 ? j0 - 8 : 0;
    const int itC = 2 * nct, itD = itC + j0 + 1, NI = itD + (j0 - jw0 + 1);
    const int cmaxt = t >= 31 ? (t - 31) >> 4 : -1;
    const int drow = wid * 8 + (lane0 >> 3), dch = lane0 & 7;
    const char* pbt = (const char*)(p.projb + (size_t)(b * SEQ) * PJW + g * 64) + (size_t)drow * (PJW * 2);
    const char* kct = (const char*)(p.kcmpb + (size_t)bg * NC * 64) + drow * 128;
    const char* vct = (const char*)(p.vcmpb + (size_t)bg * NC * 64) + drow * 128;
    const unsigned kx = (unsigned)((dch ^ ((drow >> 1) & 7)) * 16), vx = (unsigned)((dch ^ (((drow >> 1) & 1) << 2)) * 16);
    const unsigned ring0 = (unsigned)(uintptr_t)lds + (unsigned)wid * 1024u;
#define NSA_ISSUE(IT) do { const int it_ = (IT) < NI ? (IT) : NI - 1; const unsigned sl_ = (unsigned)__builtin_amdgcn_readfirstlane((int)(ring0 + (unsigned)((IT) & (NSA_NSLOT - 1)) * NSA_SLOT)); \
      if (it_ < itC) { const unsigned o_ = (unsigned)(it_ < nct ? it_ : it_ - nct) * 8192u; glds16(kct + o_ + kx, sl_); glds16(vct + o_ + vx, sl_ + NSA_KB); } \
      else { const bool sel_ = it_ < itD; const unsigned o_ = (unsigned)(sel_ ? it_ - itC : jw0 + it_ - itD) * (unsigned)(64 * PJW * 2); \
             glds16(pbt + o_ + (sel_ ? J_KS * 2 : J_KW * 2) + kx, sl_); glds16(pbt + o_ + (sel_ ? J_VS * 2 : J_VW * 2) + vx, sl_ + NSA_KB); } } while (0)
#define NSA_STEP() lptr slot = lds + (it & (NSA_NSLOT - 1)) * NSA_SLOT; \
      asm volatile("s_waitcnt vmcnt(4)\n\ts_barrier" ::: "memory"); \
      NSA_ISSUE(it + 3); \
      int lane = lane0; asm volatile("" : "+v"(lane)); const int h = lane >> 5, l31 = lane & 31; (void)l31
    NSA_ISSUE(0); NSA_ISSUE(1); NSA_ISSUE(2);
    int it = 0;
    float m1 = -1e30f, l1 = 0.f;
    for (; it < nct; ++it) {
      NSA_STEP();
      f32x16 s[2]; nsa_qk(s, slot, qf, l31, h);
      float mx = -1e30f;
#pragma unroll
      for (int r = 0; r < 16; ++r) { const int c = 64 * it + (r & 3) + 8 * (r >> 2) + 4 * h; if (c <= cmaxt) mx = fmaxf(mx, s[0][r]); if (c + 32 <= cmaxt) mx = fmaxf(mx, s[1][r]); }
      mx = xmax32(mx);
      const float mn = fmaxf(m1, mx); float rs = 0.f;
#pragma unroll
      for (int r = 0; r < 16; ++r) { const int c = 64 * it + (r & 3) + 8 * (r >> 2) + 4 * h; rs += (c <= cmaxt ? fexp(s[0][r] - mn) : 0.f) + (c + 32 <= cmaxt ? fexp(s[1][r] - mn) : 0.f); }
      rs = xsum32(rs);
      l1 = l1 * fexp(m1 - mn) + rs; m1 = mn;
    }
    f32x16 o[2];
#pragma unroll
    for (int r = 0; r < 16; ++r) { o[0][r] = 0.f; o[1][r] = 0.f; }
    { const float il = 1.f / fmaxf(l1, 1e-20f);
      for (; it < itC; ++it) {
        NSA_STEP();
        const int i = it - nct, tl = l31 >> 2, r4 = l31 & 3;
        f32x16 s[2]; nsa_qk(s, slot, qf, l31, h);
#pragma unroll
        for (int r = 0; r < 16; ++r) { const int c = 64 * i + (r & 3) + 8 * (r >> 2) + 4 * h; s[0][r] = c <= cmaxt ? fexp(s[0][r] - m1) * il : 0.f; s[1][r] = c + 32 <= cmaxt ? fexp(s[1][r] - m1) * il : 0.f; }
#pragma unroll
        for (int kt = 0; kt < 2; ++kt)
#pragma unroll
          for (int a = 0; a < 4; ++a) {
            float v4 = (s[kt][4 * a] + s[kt][4 * a + 1]) + (s[kt][4 * a + 2] + s[kt][4 * a + 3]), cy = s[kt][4 * a + 3];
            v4 += __shfl_xor(v4, 1); v4 += __shfl_xor(v4, 2); cy += __shfl_xor(cy, 1); cy += __shfl_xor(cy, 2);
            const int jj = 16 * i + 8 * kt + 2 * a + h;
            if (r4 == 0) { LAS float* ip = imp + (wid * 8 + tl) * 64 + jj; ip[0] += v4; }
            if (r4 == 0 && jj < 63) { LAS float* ip = imp + (wid * 8 + tl) * 64 + jj + 1; ip[0] += cy; }
          }
        nsa_pv(o, slot + NSA_KB, s, lane);
      } }
    { const float g0 = p.gates[trow * 24 + hg * 3];
#pragma unroll
      for (int r = 0; r < 16; ++r) { obuf[r * 64] = g0 * o[0][r]; obuf[(16 + r) * 64] = g0 * o[1][r]; o[0][r] = 0.f; o[1][r] = 0.f; } }
    unsigned long long U = 0ull, mym = 0ull;
    __builtin_amdgcn_s_waitcnt(0xc07f);
    {
      const bool forced = lane0 == 0 || lane0 == j0 || lane0 == j0 - 1;
#pragma unroll
      for (int i2 = 0; i2 < 8; ++i2) { const float v = imp[(wid * 8 + i2) * 64 + lane0]; imp[(wid * 8 + i2) * 64 + lane0] = lane0 <= j0 ? (forced ? v + 1e4f : v) : -1.f; }
      __builtin_amdgcn_s_waitcnt(0xc07f);
      const int lane0_ = lane0;
#pragma unroll 1
      for (int i2 = 0; i2 < 8; ++i2) {
        const LAS float* row = imp + (wid * 8 + i2) * 64;
        int lane0 = lane0_; asm volatile("" : "+v"(lane0));
        const float mv = row[lane0]; int rank = 0;
#pragma unroll
        for (int j4 = 0; j4 < 16; ++j4) { const f32x4 v = *(const LAS f32x4*)(row + 4 * j4);
          rank += (v.x > mv || (v.x == mv && 4 * j4 < lane0)) ? 1 : 0; rank += (v.y > mv || (v.y == mv && 4 * j4 + 1 < lane0)) ? 1 : 0;
          rank += (v.z > mv || (v.z == mv && 4 * j4 + 2 < lane0)) ? 1 : 0; rank += (v.w > mv || (v.w == mv && 4 * j4 + 3 < lane0)) ? 1 : 0; }
        const unsigned long long msk = __ballot(rank < 8);
        U |= msk; if (((lane0 & 31) >> 2) == i2) mym = msk;
      } }
    float m = -1e30f, l = 0.f;
#define NSA_ONLINE(MINE, LOWPOS, JB) do { \
      f32x16 s[2]; nsa_qk(s, slot, qf, l31, h); \
      const int tmin_ = t0 + wid * 8, tmax_ = tmin_ + 7; \
      const bool interior_ = (64 * (JB) + 63 <= tmin_) && (64 * (JB) > tmax_ - 512 || (LOWPOS) < 0);     \
      float mx = -1e30f, rs = 0.f, mn, alpha; \
      if (interior_) { \
        _Pragma("unroll") for (int r = 0; r < 16; ++r) mx = fmaxf(mx, fmaxf(s[0][r], s[1][r])); \
        mx = xmax32(mx); \
        mn = ((MINE) && mx > m + 5.5f) ? mx : m; alpha = fexp(m - mn);         \
        const float me_ = (MINE) ? mn : 1e30f;                        \
        _Pragma("unroll") for (int r = 0; r < 16; ++r) { const float p0 = fexp(s[0][r] - me_), p1 = fexp(s[1][r] - me_); s[0][r] = p0; s[1][r] = p1; rs += p0 + p1; } \
      } else { \
        unsigned ok0 = 0u, ok1 = 0u; \
        _Pragma("unroll") for (int r = 0; r < 16; ++r) { const int pos = 64 * (JB) + (r & 3) + 8 * (r >> 2) + 4 * h; if ((MINE) && pos <= t && pos > (LOWPOS)) ok0 |= 1u << r; if ((MINE) && pos + 32 <= t && pos + 32 > (LOWPOS)) ok1 |= 1u << r; } \
        _Pragma("unroll") for (int r = 0; r < 16; ++r) { if ((ok0 >> r) & 1u) mx = fmaxf(mx, s[0][r]); if ((ok1 >> r) & 1u) mx = fmaxf(mx, s[1][r]); } \
        mx = xmax32(mx); \
        mn = fmaxf(m, mx); alpha = fexp(m - mn); \
        _Pragma("unroll") for (int r = 0; r < 16; ++r) { const float p0 = ((ok0 >> r) & 1u) ? fexp(s[0][r] - mn) : 0.f, p1 = ((ok1 >> r) & 1u) ? fexp(s[1][r] - mn) : 0.f; s[0][r] = p0; s[1][r] = p1; rs += p0 + p1; } \
      } \
      rs = xsum32(rs); \
      l = l * alpha + rs; \
      if (__any(mn != m)) { _Pragma("unroll") for (int r = 0; r < 16; ++r) { o[0][r] *= alpha; o[1][r] *= alpha; } } \
      m = mn; \
      nsa_pv(o, slot + NSA_KB, s, lane); } while (0)
    for (; it < itD; ++it) {
      NSA_STEP();
      const int j = it - itC;
      if ((U >> j) & 1ull) { const bool mine = (mym >> j) & 1ull; NSA_ONLINE(mine, -1, j); }
    }
    { const float f = p.gates[trow * 24 + hg * 3 + 1] / fmaxf(l, 1e-20f);
#pragma unroll
      for (int r = 0; r < 16; ++r) { obuf[r * 64] += f * o[0][r]; obuf[(16 + r) * 64] += f * o[1][r]; o[0][r] = 0.f; o[1][r] = 0.f; }
      m = -1e30f; l = 0.f; }
    for (; it < NI; ++it) {
      NSA_STEP();
      const int j = jw0 + it - itD;
      NSA_ONLINE(true, t - 512, j);
    }
#undef NSA_ONLINE
#undef NSA_STEP
#undef NSA_ISSUE
    asm volatile("s_waitcnt vmcnt(0)" ::: "memory");
    { const float f = p.gates[trow * 24 + hg * 3 + 2] / fmaxf(l, 1e-20f);
      bf16_t* orow = p.onsab + trow * 512 + hg * 64 + 4 * (lane0 >> 5);
#pragma unroll
      for (int dt = 0; dt < 2; ++dt)
#pragma unroll
        for (int a = 0; a < 4; ++a) { u32x2 w; const int r = 4 * a;
          w.x = pk2(obuf[(16 * dt + r) * 64] + f * o[dt][r], obuf[(16 * dt + r + 1) * 64] + f * o[dt][r + 1]); w.y = pk2(obuf[(16 * dt + r + 2) * 64] + f * o[dt][r + 2], obuf[(16 * dt + r + 3) * 64] + f * o[dt][r + 3]);
          *(u32x2*)(orow + dt * 32 + a * 8) = w; } }
    __syncthreads();
  }
}

__device__ __forceinline__ float ret_logg2(int h) { return logf(1.f - exp2f(-5.f - (float)h)); }
struct WLkminRows {
  typedef XRegB16<128> Regs; const bf16_t* rowp[1];
  __device__ __forceinline__ void load(Regs& R, int k0, int tid) const { xload_b16<128>(R, rowp, k0, tid); }
  __device__ __forceinline__ void store(const Regs& R, lptr img, int, int tid) const { xstore_b16<128>(R, img, tid); }
};
struct XLcmp {
  struct Regs { u32x4 r; }; const bf16_t* src; const float* pe; lptr ximg;
  __device__ __forceinline__ void load(Regs& R, int k0, int tid) const {
    if (tid < 256) { const int l = k0 >> 6, d0 = (k0 & 63) + (tid & 3) * 8;
      const u32x4 v = *(const u32x4*)(src + (size_t)l * PJW + (k0 & 63));
      const f32x4 p0 = *(const f32x4*)(pe + l * 64 + d0), p1 = *(const f32x4*)(pe + l * 64 + d0 + 4);
      R.r.x = pk2(bflo(v.x) + p0.x, bfhi(v.x) + p0.y); R.r.y = pk2(bflo(v.y) + p0.z, bfhi(v.y) + p0.w);
      R.r.z = pk2(bflo(v.z) + p1.x, bfhi(v.z) + p1.y); R.r.w = pk2(bflo(v.w) + p1.z, bfhi(v.w) + p1.w); }
  }
  __device__ __forceinline__ void store(const Regs& R, int tid) const { if (tid < 256) *(LAS u32x4*)(ximg + kmin_off(tid >> 2, tid & 3)) = R.r; }
  __device__ __forceinline__ lptr img(int) const { return ximg; }
};
struct XLretk {
  struct Regs { u32x4 r; }; const bf16_t* src; float lg; lptr ximg;
  __device__ __forceinline__ void load(Regs& R, int k0, int tid) const {
    const u32x4 v = *(const u32x4*)(src + (size_t)k0 * PJW);
    const float z = __expf(lg * (float)(127 - k0 - (tid >> 4)));
    R.r.x = pk2(bflo(v.x) * z, bfhi(v.x) * z); R.r.y = pk2(bflo(v.y) * z, bfhi(v.y) * z); R.r.z = pk2(bflo(v.z) * z, bfhi(v.z) * z); R.r.w = pk2(bflo(v.w) * z, bfhi(v.w) * z);
  }
  __device__ __forceinline__ void store(const Regs& R, int tid) const { *(LAS u32x4*)(ximg + (tid >> 4) * 320 + (tid & 15) * 16) = R.r; }
  __device__ __forceinline__ lptr img(int) const { return ximg; }
};
__device__ __forceinline__ void phase_r1(const P& p, lptr lds, int vcu, int G) {
  const int tid = threadIdx.x, wid = __builtin_amdgcn_readfirstlane(tid >> 6), lane = tid & 63, h = lane >> 5, l31 = lane & 31;
  lptr wimg = lds, ximg = lds + 16 * 1024;
  for (int u = vcu; u < 256 + 512; u += G) {
    if (u < 256) {
      const int isv = u >> 7, rt = (u >> 2) & 31, kq = u & 3, wn = wid >> 1, wt = wid & 1;
      f32x16 acc[1][1]; acc_zero<1, 1>(acc);
      WLb16<128> wl; wl.src = (isv ? p.cw1vb : p.cw1kb) + (size_t)kq * 512 * 128; wl.ld = 128;
      XLcmp xl; { int r = rt * 64 + ((tid >> 2) & 63); r = r < NCR ? r : NCR - 1; const int b = r / (2 * NC), g = (r / NC) & 1, c = r % NC;
        xl.src = p.projb + (size_t)(b * SEQ + 16 * c + kq * 8) * PJW + (isv ? J_VC : J_KC) + g * 64 + (tid & 3) * 8; xl.pe = (isv ? p.cpv : p.cpk) + kq * 512; xl.ximg = ximg; }
      gemm_loop<1, 1>(acc, 512, wl, xl, wimg, 128 * 2 + 64, wn * 32, wt * 32, tid, lane);
      int row = rt * 64 + wt * 32 + l31, nb = wn * 32 + 4 * h; asm volatile("" : "+v"(row), "+v"(nb));
      if (row < NCR) { float* o = p.hidp + (((size_t)(isv * 4 + kq) * 2048 + row) * 128) + nb;
#pragma unroll
        for (int a = 0; a < 4; ++a) { f32x4 v = {acc[0][0][4 * a], acc[0][0][4 * a + 1], acc[0][0][4 * a + 2], acc[0][0][4 * a + 3]}; *(f32x4*)(o + a * 8) = v; } }
    } else {
      const int chunk = u - 256, bh = chunk >> 5, b = bh >> 2, hh = bh & 3, s0 = (chunk & 31) * 128, wn = wid >> 1, wt = wid & 1;
      f32x16 acc[1][2]; acc_zero<1, 2>(acc);
      const bf16_t* base = p.projb + (size_t)(b * SEQ + s0) * PJW + hh * 128;
      WLb16<128> wl; wl.src = base + J_VR; wl.ld = PJW;
      XLretk xl; xl.src = base + J_KR + (size_t)(tid >> 4) * PJW + (tid & 15) * 8; xl.lg = ret_logg2(hh); xl.ximg = ximg;
      gemm_loop<1, 2, WLb16<128>, XLretk, true, true>(acc, 128, wl, xl, wimg, 128 * 2 + 64, wn * 32, wt * 64, tid, lane, 320);
      int dcol = wt * 64 + l31, nb = wn * 32 + 4 * h; asm volatile("" : "+v"(dcol), "+v"(nb));
#pragma unroll
      for (int tn = 0; tn < 2; ++tn) { float* o = p.kv + ((size_t)chunk * 128 + dcol + tn * 32) * 128 + nb;
#pragma unroll
        for (int a = 0; a < 4; ++a) { f32x4 v = {acc[0][tn][4 * a], acc[0][tn][4 * a + 1], acc[0][tn][4 * a + 2], acc[0][tn][4 * a + 3]}; *(f32x4*)(o + a * 8) = v; } }
    }
  }
}
__device__ __forceinline__ void phase_r2(const P& p, lptr lds, int vcu, int G) {
  const int tid = threadIdx.x;
  LAS float* hs = (LAS float*)lds;
  LAS float* os = hs + 1024;
  const LAS float* inv64 = (const LAS float*)(lds + LDS_INV64);
  for (int u = vcu; u < 2 * 255; u += G) {
    const int isv = u >= 255, r0 = (isv ? u - 255 : u) * 8;
    { const int i = tid, row = r0 + (i >> 7), k = i & 127;
#pragma unroll
      for (int q = 0; q < 2; ++q) { const int rr = row + 4 * q; float a = 0.f;
#pragma unroll
        for (int kq = 0; kq < 4; ++kq) a += p.hidp[((size_t)(isv * 4 + kq) * 2048 + rr) * 128 + k];
        hs[(rr - r0) * 128 + k] = gelu_tanh(a); } }
    __syncthreads();
    { const int rl = tid >> 6, n = tid & 63; const float* w2 = isv ? p.cw2v : p.cw2k; float a = 0.f;
#pragma unroll 8
      for (int k = 0; k < 128; ++k) a += hs[rl * 128 + k] * w2[k * 64 + n];
      os[rl * 64 + n] = a; }
    __syncthreads();
    { const int rl = tid >> 6, n = tid & 63, row = r0 + rl; float y = os[rl * 64 + n];
      if (!isv) { const int b = row / (2 * NC), c = row % NC, i = n & 31;
        const float fr = __builtin_amdgcn_fractf((float)p.pos[b * SEQ + 16 * c + 31] * inv64[i]);
        const float sn = __builtin_amdgcn_sinf(fr), cs = __builtin_amdgcn_cosf(fr), x1 = os[rl * 64 + i], x2 = os[rl * 64 + i + 32];
        y = n < 32 ? x1 * cs - x2 * sn : x1 * sn + x2 * cs; }
      (isv ? p.vcmpb : p.kcmpb)[(size_t)row * 64 + n] = (bf16_t)(pk2(y, 0.f) & 0xffffu); }
    __syncthreads();
  }
  for (int id = vcu * 512 + tid; id < 16 * 16384; id += G * 512) {
    const int bh = id >> 14, de = id & 16383; const float gc = __expf(ret_logg2(bh & 3) * 128.f);
    float v[32];
#pragma unroll
    for (int n = 0; n < 32; ++n) v[n] = p.kv[(size_t)(bh * 32 + n) * 16384 + de];
    float st = 0.f;
#pragma unroll
    for (int n = 0; n < 32; ++n) { p.stateb[(size_t)(bh * 32 + n) * 16384 + de] = (bf16_t)(pk2(st, 0.f) & 0xffffu); st = st * gc + v[n]; }
  }
}
__device__ __forceinline__ void phase_r3(const P& p, lptr lds, int vcu, int G) {
  const int tid = threadIdx.x, wid = __builtin_amdgcn_readfirstlane(tid >> 6), lane = tid & 63, h = lane >> 5, l31 = lane & 31, wn = wid >> 2, wt = wid & 3;
  lptr wimg = lds, ximg = lds + 12 * 1024, scb = lds + 20 * 1024;
  LAS float* part = (LAS float*)(lds + 52 * 1024);
  for (int chunk = vcu; chunk < 512; chunk += G) {
    const int bh = chunk >> 5, b = bh >> 2, hh = bh & 3, s0 = (chunk & 31) * 128; const float lg = ret_logg2(hh);
    const bf16_t* base = p.projb + (size_t)(b * SEQ + s0) * PJW + hh * 128;
    f32x16 acc[2][1];
    acc_zero<2, 1>(acc);
    { WLkminRows wl; wl.rowp[0] = base + J_KR + (size_t)((tid >> 2) & 127) * PJW;
      XLrows<128> xl; xl.rowp[0] = base + J_QR + (size_t)((tid >> 2) & 127) * PJW; xl.ximg = ximg;
      gemm_loop<2, 1, WLkminRows, XLrows<128>, false, false>(acc, 128, wl, xl, wimg, 0, wn * 64, wt * 32, tid, lane); }
    { int i = wt * 32 + l31, jb = wn * 64 + 4 * h; asm volatile("" : "+v"(i), "+v"(jb));
#pragma unroll
      for (int tm = 0; tm < 2; ++tm)
#pragma unroll
        for (int a = 0; a < 4; ++a) { const int j = jb + tm * 32 + a * 8; float o[4];
#pragma unroll
          for (int q = 0; q < 4; ++q) o[q] = i >= j + q ? acc[tm][0][4 * a + q] * __expf(lg * (float)(i - j - q)) : 0.f;
          u32x2 w; w.x = pk2(o[0], o[1]); w.y = pk2(o[2], o[3]);
          *(LAS u32x2*)(scb + (j >> 5) * 8192 + kmin_off(i, (j & 31) >> 3) + (j & 7) * 2) = w; } }
    __syncthreads();
    acc_zero<2, 1>(acc);
    { WLb16<128> wl; wl.src = p.stateb + (size_t)chunk * 16384; wl.ld = 128;
      XLrows<128> xl; xl.rowp[0] = base + J_QR + (size_t)((tid >> 2) & 127) * PJW; xl.ximg = ximg;
      gemm_loop<2, 1>(acc, 128, wl, xl, wimg, 128 * 2 + 64, wn * 64, wt * 32, tid, lane); }
    { const float xi = __expf(lg * (float)(wt * 32 + l31 + 1));
#pragma unroll
      for (int tm = 0; tm < 2; ++tm)
#pragma unroll
        for (int r = 0; r < 16; ++r) acc[tm][0][r] *= xi; }
    { WLb16<128> wl; wl.src = base + J_VR; wl.ld = PJW;
      XLres xl; xl.base = scb; xl.bytes = 8192;
      gemm_loop<2, 1>(acc, 128, wl, xl, wimg, 128 * 2 + 64, wn * 64, wt * 32, tid, lane); }
    { float ss = 0.f;
#pragma unroll
      for (int tm = 0; tm < 2; ++tm)
#pragma unroll
        for (int r = 0; r < 16; ++r) ss += acc[tm][0][r] * acc[tm][0][r];
      ss += __shfl_xor(ss, 32);
      if (h == 0) part[wn * 128 + wt * 32 + l31] = ss; }
    __syncthreads();
    { int i = wt * 32 + l31, eb = wn * 64 + 4 * h; asm volatile("" : "+v"(i), "+v"(eb));
      const float rs = rsqrtf((part[i] + part[128 + i]) * (1.f / 128.f) + EPS);
      const size_t trow = (size_t)(b * SEQ + s0 + i);
#pragma unroll
      for (int tm = 0; tm < 2; ++tm)
#pragma unroll
        for (int a = 0; a < 4; ++a) { const int e = eb + tm * 32 + a * 8;
          const f32x4 gr = *(const f32x4*)(p.g_ret + hh * 128 + e); const u32x2 gt = *(const u32x2*)(p.projb + trow * PJW + J_GR + hh * 128 + e);
          u32x2 w; w.x = pk2(acc[tm][0][4 * a] * rs * gr.x * bflo(gt.x), acc[tm][0][4 * a + 1] * rs * gr.y * bfhi(gt.x));
          w.y = pk2(acc[tm][0][4 * a + 2] * rs * gr.z * bflo(gt.y), acc[tm][0][4 * a + 3] * rs * gr.w * bfhi(gt.y));
          *(u32x2*)(p.mixb + trow * D + 512 + hh * 128 + e) = w; } }
    __syncthreads();
  }
  for (int tok = vcu * 8 + wid; tok < T; tok += G * 8) {
    const u32x4 v = *(const u32x4*)(p.onsab + (size_t)tok * 512 + lane * 8);
    float x[8] = {bflo(v.x), bfhi(v.x), bflo(v.y), bfhi(v.y), bflo(v.z), bfhi(v.z), bflo(v.w), bfhi(v.w)};
    float ss = 0.f;
#pragma unroll
    for (int q = 0; q < 8; ++q) ss += x[q] * x[q];
    ss = wave_sum(ss);
    const float rs = rsqrtf(ss * (1.f / 512.f) + EPS);
    const f32x4 g0 = *(const f32x4*)(p.g_nsa + lane * 8), g1 = *(const f32x4*)(p.g_nsa + lane * 8 + 4);
    u32x4 w; w.x = pk2(x[0] * rs * g0.x, x[1] * rs * g0.y); w.y = pk2(x[2] * rs * g0.z, x[3] * rs * g0.w); w.z = pk2(x[4] * rs * g1.x, x[5] * rs * g1.y); w.w = pk2(x[6] * rs * g1.z, x[7] * rs * g1.w);
    *(u32x4*)(p.mixb + (size_t)tok * D + lane * 8) = w;
  }
}

__device__ __forceinline__ void phase5a(const P& p, lptr lds, int vcu, int G) {
  const int tid = threadIdx.x, wid = __builtin_amdgcn_readfirstlane(tid >> 6), lane = tid & 63, wn = wid >> 2, wt = wid & 3;
  for (int u = vcu; u < 4 * 64; u += G) {
    const int j = u & 3, t0 = (u >> 2) * 256, b = t0 / SEQ;
    f32x16 acc[4][2];
    WLb16<256> wl; wl.src = p.woutb + j * 256; wl.ld = D;
    gemm256(acc, wl, p.mixb, D, t0, D, lds, wn, wt, tid, lane);
    int nb = j * 256 + wn * 128 + 4 * (lane >> 5), tb = t0 + wt * 64 + (lane & 31); asm volatile("" : "+v"(nb), "+v"(tb));
#pragma unroll
    for (int tn = 0; tn < 2; ++tn)
#pragma unroll
      for (int tm = 0; tm < 4; ++tm) {
#pragma unroll
        for (int a = 0; a < 4; ++a) { const int n = nb + tm * 32 + a * 8; const size_t o = (size_t)(tb + tn * 32) * D + n;
          const f32x4 xv = *(const f32x4*)(p.x + o), gt = *(const f32x4*)(p.mod + b * 6144 + 2048 + n);
          f32x4 v; v.x = xv.x + gt.x * acc[tm][tn][4 * a]; v.y = xv.y + gt.y * acc[tm][tn][4 * a + 1]; v.z = xv.z + gt.z * acc[tm][tn][4 * a + 2]; v.w = xv.w + gt.w * acc[tm][tn][4 * a + 3];
          *(f32x4*)(p.x1 + o) = v; }
        __builtin_amdgcn_sched_barrier(0);
      }
  }
}
__device__ __forceinline__ void phase5b(const P& p, lptr lds, int vcu, int G) {
  const int tid = threadIdx.x, wid = tid >> 6, lane = tid & 63;
  for (int row = vcu * 8 + wid; row < T; row += G * 8) {
    const int b = row / SEQ;
    f32x4 v[4]; float s = 0.f;
#pragma unroll
    for (int j = 0; j < 4; ++j) { v[j] = *(const f32x4*)(p.x1 + (size_t)row * D + j * 256 + lane * 4); s += v[j].x * v[j].x + v[j].y * v[j].y + v[j].z * v[j].z + v[j].w * v[j].w; }
    s = wave_sum(s);
    const float r = rsqrtf(s * (1.f / D) + EPS);
#pragma unroll
    for (int j = 0; j < 4; ++j) {
      const int k = j * 256 + lane * 4;
      const f32x4 g = *(const f32x4*)(p.g_ffn + k), sc = *(const f32x4*)(p.mod + b * 6144 + 4096 + k), sh = *(const f32x4*)(p.mod + b * 6144 + 3072 + k);
      u32x2 o; o.x = pk2(v[j].x * r * g.x * (1.f + sc.x) + sh.x, v[j].y * r * g.y * (1.f + sc.y) + sh.y); o.y = pk2(v[j].z * r * g.z * (1.f + sc.z) + sh.z, v[j].w * r * g.w * (1.f + sc.w) + sh.w);
      *(u32x2*)(p.h2b + (size_t)row * D + k) = o;
    }
  }
}
__device__ __forceinline__ void phase5c(const P& p, lptr lds, int vcu, int G) {
  const int tid = threadIdx.x, wid = __builtin_amdgcn_readfirstlane(tid >> 6), lane = tid & 63, wn = wid >> 2, wt = wid & 3;
  for (int u = vcu; u < 3 * 64; u += G) {
    const int j = u % 3, t0 = (u / 3) * 256;
    f32x16 acc[4][2];
    if (j == 0) { WLb16<256> wl; wl.src = p.wrb; wl.ld = NE; gemm256(acc, wl, p.h2b, D, t0, D, lds, wn, wt, tid, lane); }
    else { WLgu256 wl; wl.g = p.wgsb; wl.u = p.wusb; wl.abase = (j - 1) * 128; gemm256(acc, wl, p.h2b, D, t0, D, lds, wn, wt, tid, lane); }
    int h4 = 4 * (lane >> 5), tb = t0 + wt * 64 + (lane & 31); asm volatile("" : "+v"(h4), "+v"(tb));
    if (j == 0) {
#pragma unroll
      for (int tn = 0; tn < 2; ++tn)
#pragma unroll
        for (int tm = 0; tm < 4; ++tm)
#pragma unroll
          for (int a = 0; a < 4; ++a) { f32x4 v = {acc[tm][tn][4 * a], acc[tm][tn][4 * a + 1], acc[tm][tn][4 * a + 2], acc[tm][tn][4 * a + 3]};
            *(f32x4*)(p.logits + (size_t)(tb + tn * 32) * NE + wn * 128 + tm * 32 + a * 8 + h4) = v; }
    } else {
#pragma unroll
      for (int tn = 0; tn < 2; ++tn)
#pragma unroll
        for (int tm = 0; tm < 2; ++tm)
#pragma unroll
          for (int a = 0; a < 4; ++a) { float o[4];
#pragma unroll
            for (int q = 0; q < 4; ++q) { const float gv = acc[tm][tn][4 * a + q], uv = acc[tm + 2][tn][4 * a + q]; o[q] = gv * __builtin_amdgcn_rcpf(1.f + __builtin_amdgcn_exp2f(-1.4426950408889634f * gv)) * uv; }
            u32x2 w; w.x = pk2(o[0], o[1]); w.y = pk2(o[2], o[3]);
            *(u32x2*)(p.actsb + (size_t)(tb + tn * 32) * 256 + (j - 1) * 128 + wn * 64 + tm * 32 + a * 8 + h4) = w; }
    }
  }
}
__device__ __forceinline__ void phase5d(const P& p, lptr lds, int vcu, int G) {
  const int tid = threadIdx.x, wid = __builtin_amdgcn_readfirstlane(tid >> 6), lane = tid & 63, wn = wid >> 2, wt = wid & 3;
  { const f32x4 rb = *(const f32x4*)(p.rbias + lane * 4);
    for (int tok = vcu * 8 + wid; tok < T; tok += G * 8) {
      const f32x4 lv = *(const f32x4*)(p.logits + (size_t)tok * NE + lane * 4);
      const float s0 = sigm(lv.x), s1 = sigm(lv.y), s2 = sigm(lv.z), s3 = sigm(lv.w);
      float c0 = s0 + rb.x, c1 = s1 + rb.y, c2 = s2 + rb.z, c3 = s3 + rb.w;
      float m1, m2;
      { const float h1 = fmaxf(c0, c1), l1 = fminf(c0, c1), h2 = fmaxf(c2, c3), l2 = fminf(c2, c3); m1 = fmaxf(h1, h2); m2 = fmaxf(fminf(h1, h2), fmaxf(l1, l2)); }
#pragma unroll
      for (int o = 1; o < 8; o <<= 1) { const float o1 = __shfl_xor(m1, o), o2 = __shfl_xor(m2, o); const float n1 = fmaxf(m1, o1), n2 = fmaxf(fminf(m1, o1), fmaxf(m2, o2)); m1 = n1; m2 = n2; }
      const float gs = m1 + m2; const int myg = lane >> 3; int rank = 0;
#pragma unroll
      for (int g2 = 0; g2 < 8; ++g2) { const float og = __shfl(gs, g2 * 8); rank += (og > gs || (og == gs && g2 < myg)) ? 1 : 0; }
      if (rank >= 4) { c0 = -INFINITY; c1 = -INFINITY; c2 = -INFINITY; c3 = -INFINITY; }
      int my_e = 0; float my_s = 0.f;
#pragma unroll
      for (int k = 0; k < 8; ++k) {
        float bv = c0; int li = lane * 4;
        if (c1 > bv) { bv = c1; li = lane * 4 + 1; }
        if (c2 > bv) { bv = c2; li = lane * 4 + 2; }
        if (c3 > bv) { bv = c3; li = lane * 4 + 3; }
#pragma unroll
        for (int o = 1; o < 64; o <<= 1) { const float ov = __shfl_xor(bv, o); const int oi = __shfl_xor(li, o); if (ov > bv || (ov == bv && oi < li)) { bv = ov; li = oi; } }
        const int jx = li & 3; const float sj = jx == 0 ? s0 : jx == 1 ? s1 : jx == 2 ? s2 : s3;
        const float sv = __shfl(sj, li >> 2);
        if (lane * 4 == li) c0 = -INFINITY;
        if (lane * 4 + 1 == li) c1 = -INFINITY;
        if (lane * 4 + 2 == li) c2 = -INFINITY;
        if (lane * 4 + 3 == li) c3 = -INFINITY;
        if (lane == k) { my_e = li; my_s = sv; }
      }
      const float wsum = wave_sum(lane < 8 ? my_s : 0.f);
      if (lane < 8) { const int pos = atomicAdd(&p.cnt[my_e], 1); p.list[my_e * ECAP + pos] = tok * 8 + lane; p.wts[tok * 8 + lane] = my_s / wsum * 2.5f; }
    } }
  __syncthreads();
  for (int u = vcu; u < 4 * 64; u += G) {
    const int j = u & 3, t0 = (u >> 2) * 256, b = t0 / SEQ;
    f32x16 acc[4][2];
    WLb16<256> wl; wl.src = p.wdsb + j * 256; wl.ld = D;
    gemm256(acc, wl, p.actsb, 256, t0, 256, lds, wn, wt, tid, lane);
    int nb = j * 256 + wn * 128 + 4 * (lane >> 5), tb = t0 + wt * 64 + (lane & 31); asm volatile("" : "+v"(nb), "+v"(tb));
#pragma unroll
    for (int tn = 0; tn < 2; ++tn)
#pragma unroll
      for (int tm = 0; tm < 4; ++tm) {
#pragma unroll
        for (int a = 0; a < 4; ++a) { const int n = nb + tm * 32 + a * 8; const size_t o = (size_t)(tb + tn * 32) * D + n;
          f32x4 v = *(const f32x4*)(p.x1 + o); const f32x4 gt = *(const f32x4*)(p.mod + b * 6144 + 5120 + n);
          v.x += gt.x * acc[tm][tn][4 * a]; v.y += gt.y * acc[tm][tn][4 * a + 1]; v.z += gt.z * acc[tm][tn][4 * a + 2]; v.w += gt.w * acc[tm][tn][4 * a + 3];
          *(f32x4*)(p.x1 + o) = v; }
        __builtin_amdgcn_sched_barrier(0);
      }
  }
}

constexpr int NPHASE = 13;
__global__ void __launch_bounds__(512) mega(P p, int lo, int hi) {
  extern __shared__ __attribute__((aligned(16))) char lds_raw[];
  lptr lds = (lptr)lds_raw;
  const int tid = threadIdx.x, G = gridDim.x;
  const int vcu = (G % 8 == 0) ? ((int)blockIdx.x % 8) * (G / 8) + (int)blockIdx.x / 8 : (int)blockIdx.x;
  if (tid < 32) ((LAS float*)(lds + LDS_INV64))[tid] = exp2f(-(float)(2 * tid) / 64.f * 13.287712379549449f) * 0.15915494309189535f;
  if (tid < 64) ((LAS float*)(lds + LDS_INV128))[tid] = exp2f(-(float)(2 * tid) / 128.f * 13.287712379549449f) * 0.15915494309189535f;
  if (tid < 4) ((LAS unsigned*)(lds + LDS_XB))[tid] = 0u;
  __syncthreads();
  XcdBarrier xb; xb.bar = p.bar; xb.x = 0; xb.st = (volatile LAS unsigned*)(lds + LDS_XB);
  if (hi - lo > 1) xb = xcd_barrier_post(p.bar, (volatile LAS unsigned*)(lds + LDS_XB));
#define PH(k, call) if (lo <= (k) && (k) < hi) { call; if ((k) + 1 < hi) xcd_barrier(xb); }
  PH(0, phase0a(p, lds, vcu, G));
  PH(1, phase0b(p, lds, vcu, G));
  PH(2, phase1(p, lds, vcu, G));
  PH(3, phase_r1(p, lds, vcu, G));
  PH(4, phase_r2(p, lds, vcu, G));
  PH(5, phase_nsa(p, lds, vcu, G));
  PH(6, phase_r3(p, lds, vcu, G));
  PH(7, phase5a(p, lds, vcu, G));
  PH(8, phase5b(p, lds, vcu, G));
  PH(9, phase5c(p, lds, vcu, G));
  PH(10, phase5d(p, lds, vcu, G));
  PH(11, phase6(p, lds, vcu, G));
  PH(12, phase7(p, lds, vcu, G));
#undef PH
}
}

extern "C" void kernel_launch(void* const* d_in, const int* in_sizes, int n_in, void* d_out, int out_size, void* d_ws, size_t ws_size, hipStream_t stream) {
  P p{};
  p.x = (const float*)d_in[0]; p.c = (const float*)d_in[1]; p.pos = (const int*)d_in[2];
  p.w_ada = (const float*)d_in[3]; p.b_ada = (const float*)d_in[4]; p.g_mix = (const float*)d_in[5]; p.w_in = (const float*)d_in[6];
  p.cpk = (const float*)d_in[7]; p.cw1k = (const float*)d_in[8]; p.cw2k = (const float*)d_in[9];
  p.cpv = (const float*)d_in[10]; p.cw1v = (const float*)d_in[11]; p.cw2v = (const float*)d_in[12];
  p.g_nsa = (const float*)d_in[13]; p.g_ret = (const float*)d_in[14]; p.w_out = (const float*)d_in[15]; p.g_ffn = (const float*)d_in[16];
  p.w_router = (const float*)d_in[17]; p.rbias = (const float*)d_in[18]; p.wg_e = (const float*)d_in[19]; p.wu_e = (const float*)d_in[20];
  p.wd_e = (const float*)d_in[21]; p.wg_s = (const float*)d_in[22]; p.wu_s = (const float*)d_in[23]; p.wd_s = (const float*)d_in[24];
  p.g_final = (const float*)d_in[25];
  p.out = (float*)d_out;
  char* w = (char*)d_ws; size_t off = 0;
  auto take = [&](size_t bytes) { char* r = w + off; off += (bytes + 255) & ~(size_t)255; return r; };
  p.bar = (unsigned*)take(XCD_BAR_WORDS * 4);
  p.cnt = (int*)take(NE * 4);
  const size_t zero_bytes = off;
  p.mod = (float*)take(BATCH * 6144 * 4);
  p.hidp = (float*)take((size_t)8 * 2048 * 128 * 4);
  p.kv = (float*)take((size_t)512 * 16384 * 4);
  p.stateb = (bf16_t*)take((size_t)512 * 16384 * 2);
  p.logits = (float*)take((size_t)T * NE * 4); p.actsb = (bf16_t*)take((size_t)T * 256 * 2);
  p.x1 = (float*)take((size_t)T * D * 4);
  p.wts = (float*)take((size_t)T * 8 * 4);
  p.list = (int*)take((size_t)NE * ECAP * 4);
  p.gates = (float*)take((size_t)T * 24 * 4);
  p.winb = (bf16_t*)take((size_t)D * INW * 2); p.woutb = (bf16_t*)take((size_t)D * D * 2); p.wrb = (bf16_t*)take((size_t)D * NE * 2);
  p.wgsb = (bf16_t*)take((size_t)D * 256 * 2); p.wusb = (bf16_t*)take((size_t)D * 256 * 2); p.wdsb = (bf16_t*)take((size_t)256 * D * 2);
  p.cw1kb = (bf16_t*)take(2048 * 128 * 2); p.cw1vb = (bf16_t*)take(2048 * 128 * 2); p.cw2kb = (bf16_t*)take(128 * 64 * 2); p.cw2vb = (bf16_t*)take(128 * 64 * 2);
  p.hb = (bf16_t*)take((size_t)T * D * 2);
  p.projb = (bf16_t*)take((size_t)T * PJW * 2);
  p.mixb = (bf16_t*)take((size_t)T * D * 2); p.h2b = (bf16_t*)take((size_t)T * D * 2);
  p.slab = (bf16_t*)take((size_t)T * 8 * D * 2);
  p.kcmpb = (bf16_t*)take((2048 + 64) * 64 * 2); p.vcmpb = (bf16_t*)take((2048 + 64) * 64 * 2);
  p.onsab = (bf16_t*)take((size_t)T * 512 * 2);
  if (off > ws_size) { fprintf(stderr, "kernel_launch: workspace too small: need %zu have %zu\n", off, ws_size); return; }
  static int grid = 0;
  if (!grid) {
    int dev = 0, cus = 0, per_cu = 0;
    (void)hipGetDevice(&dev);
    (void)hipDeviceGetAttribute(&cus, hipDeviceAttributeMultiprocessorCount, dev);
    (void)hipFuncSetAttribute((const void*)mega, hipFuncAttributeMaxDynamicSharedMemorySize, LDS_BYTES);
    (void)hipOccupancyMaxActiveBlocksPerMultiprocessor(&per_cu, (const void*)mega, 512, LDS_BYTES);
    if (per_cu < 1) fprintf(stderr, "kernel_launch: occupancy query says %d blocks per CU\n", per_cu);
    grid = cus;
  }
  (void)hipMemsetAsync(d_ws, 0, zero_bytes, stream);
  hipLaunchKernelGGL(mega, dim3(grid), dim3(512), LDS_BYTES, stream, p, 0, NPHASE);
}
```

```cpp
#include <hip/hip_runtime.h>
#include <cstdint>
#include <cstdio>

namespace {
constexpr int D = 1024, BATCH = 4, SEQ = 4096, T = BATCH * SEQ;
constexpr int INW = 3352;
constexpr int C_QN = 0, C_KC = 512, C_VC = 640, C_KS = 768, C_VS = 896, C_KW = 1024, C_VW = 1152, C_GN = 1280,
              C_QR = 1304, C_KR = 1816, C_VR = 2328, C_GR = 2840;
constexpr int PJW = 3328, J_QN = 0, J_KC = 512, J_VC = 640, J_KS = 768, J_VS = 896, J_KW = 1024, J_VW = 1152, J_QR = 1280, J_KR = 1792, J_VR = 2304, J_GR = 2816;
constexpr int NC = 255, NCR = BATCH * 2 * NC;
constexpr int NE = 256, ECAP = 16384, CPAD = 32;
constexpr float EPS = 1e-6f;
typedef unsigned short bf16_t;

struct P {
  const float *x, *c; const int* pos;
  const float *w_ada, *b_ada, *g_mix, *w_in, *cpk, *cw1k, *cw2k, *cpv, *cw1v, *cw2v, *g_nsa, *g_ret, *w_out, *g_ffn,
      *w_router, *rbias, *wg_e, *wu_e, *wd_e, *wg_s, *wu_s, *wd_s, *g_final;
  float* out;
  float *mod, *h, *proj, *hidk, *hidv, *kcmp, *vcmp, *onsa, *Sc, *kv, *retout, *mixin, *x1, *logits, *wts, *Gs, *acts,
      *G, *act, *yacc, *gates;
  int *cnt, *list, *tile_e, *tile_off, *ntiles;
  bf16_t *winb, *woutb, *wrb, *wgsb, *wusb, *wdsb, *cw1kb, *cw1vb, *cw2kb, *cw2vb, *hb, *projb, *mixb, *h2b, *slab, *kcmpb, *vcmpb, *onsab, *stateb, *actsb, *ysb;
  float *hidp;
  unsigned* bar;
};

#define LAS __attribute__((address_space(3)))
typedef LAS char* lptr;
typedef short bf16x8 __attribute__((ext_vector_type(8)));
typedef short v4i16_t __attribute__((ext_vector_type(4)));
typedef float f32x16 __attribute__((ext_vector_type(16)));
typedef float f32x4 __attribute__((ext_vector_type(4)));
typedef float f32x2_t __attribute__((ext_vector_type(2)));
typedef __bf16 bf16x2_t __attribute__((ext_vector_type(2)));
typedef unsigned u32x4 __attribute__((ext_vector_type(4)));
typedef unsigned u32x2 __attribute__((ext_vector_type(2)));

#define DPPF(x, ctrl, rm) __int_as_float(__builtin_amdgcn_update_dpp(__float_as_int(x), __float_as_int(x), ctrl, rm, 0xf, false))
__device__ __forceinline__ float wave_max_u(float v) {
  v = fmaxf(v, DPPF(v, 0xb1, 0xf)); v = fmaxf(v, DPPF(v, 0x4e, 0xf)); v = fmaxf(v, DPPF(v, 0x124, 0xf)); v = fmaxf(v, DPPF(v, 0x128, 0xf));
  v = fmaxf(v, DPPF(v, 0x142, 0xa)); v = fmaxf(v, DPPF(v, 0x143, 0xc));
  return __int_as_float(__builtin_amdgcn_readlane(__float_as_int(v), 63));
}
__device__ __forceinline__ float wave_sum(float v) {
  v += DPPF(v, 0xb1, 0xf); v += DPPF(v, 0x4e, 0xf); v += DPPF(v, 0x124, 0xf); v += DPPF(v, 0x128, 0xf);
  { const float t = __int_as_float(__builtin_amdgcn_update_dpp(0, __float_as_int(v), 0x142, 0xa, 0xf, false)); v += t; }
  { const float t = __int_as_float(__builtin_amdgcn_update_dpp(0, __float_as_int(v), 0x143, 0xc, 0xf, false)); v += t; }
  return __int_as_float(__builtin_amdgcn_readlane(__float_as_int(v), 63));
}
__device__ __forceinline__ float wave_max(float v) { return wave_max_u(v); }
__device__ __forceinline__ float silu(float v) { return v / (1.f + expf(-v)); }
__device__ __forceinline__ float sigm(float v) { return 1.f / (1.f + expf(-v)); }
__device__ __forceinline__ float gelu_tanh(float v) { return 0.5f * v * (1.f + tanhf(0.7978845608028654f * (v + 0.044715f * v * v * v))); }
__device__ __forceinline__ unsigned pk2(float lo, float hi) { f32x2_t v = {lo, hi}; bf16x2_t b = __builtin_convertvector(v, bf16x2_t); return __builtin_bit_cast(unsigned, b); }
__device__ __forceinline__ float bf2f(bf16_t u) { return __uint_as_float((unsigned)u << 16); }
__device__ __forceinline__ float bflo(unsigned u) { return __uint_as_float(u << 16); }
__device__ __forceinline__ float bfhi(unsigned u) { return __uint_as_float(u & 0xffff0000u); }

#define XB_TMO      128
#define XB_XCNT(j)  (256  + 64 * (j))
#define XB_XSUB(j)  (1280 + 64 * (j))
#define XB_XGEN(j)  (2304 + 64 * (j))
#define XB_TOP      3328
#define XB_TOPGEN   3392
#define XCD_BAR_WORDS 3456
#define XB_SPIN_CAP (1u << 18)
__device__ __forceinline__ unsigned xb_ld(unsigned* p)              { return __hip_atomic_load(p, __ATOMIC_RELAXED, __HIP_MEMORY_SCOPE_AGENT); }
__device__ __forceinline__ unsigned xb_add(unsigned* p, unsigned v) { return __hip_atomic_fetch_add(p, v, __ATOMIC_RELAXED, __HIP_MEMORY_SCOPE_AGENT); }
__device__ __forceinline__ unsigned xb_xcc_id() { return (unsigned)__builtin_amdgcn_s_getreg((3 << 11) | 20) & 0xFu; }
#define XB_SPIN(cond, bar) do { unsigned _sp = 0; while (cond) { __builtin_amdgcn_s_sleep(1); \
    if ((++_sp & 255u) == 0u) { if (xb_ld(&(bar)[XB_TMO])) break; if (_sp > XB_SPIN_CAP) { atomicAdd(&(bar)[XB_TMO], 1u); break; } } } } while (0)
struct XcdBarrier { unsigned* bar; unsigned x; volatile LAS unsigned* st; };
__device__ __forceinline__ XcdBarrier xcd_barrier_post(unsigned* bar, volatile LAS unsigned* st) {
    XcdBarrier b; b.bar = bar; b.x = xb_xcc_id(); b.st = st;
    if (threadIdx.x == 0) (void)xb_add(&bar[XB_XCNT(b.x)], 1u);
    return b;
}
__device__ __forceinline__ void xcd_barrier_complete(unsigned* bar, unsigned x, unsigned& nloc, unsigned& nx) {
    const unsigned G = gridDim.x * gridDim.y * gridDim.z;
    unsigned sum, cnt, mine, sp = 0u;
    for (;;) {
        sum = 0u; cnt = 0u; mine = 0u;
#pragma unroll
        for (unsigned j = 0; j < 16; ++j) { const unsigned c = xb_ld(&bar[XB_XCNT(j)]); sum += c; cnt += (c > 0u) ? 1u : 0u; mine = (j == x) ? c : mine; }
        if (sum == G) break;
        __builtin_amdgcn_s_sleep(1);
        if ((++sp & 255u) == 0u) { if (xb_ld(&bar[XB_TMO])) break; if (sp > XB_SPIN_CAP) { atomicAdd(&bar[XB_TMO], 1u); break; } }
    }
    nloc = mine > 0u ? mine : 1u; nx = cnt > 0u ? cnt : 1u;
}
__device__ __forceinline__ void xcd_barrier(const XcdBarrier& b) {
    asm volatile("s_waitcnt vmcnt(0)" ::: "memory");
    __syncthreads();
    if (threadIdx.x == 0) {
        unsigned* bar = b.bar;
        __builtin_amdgcn_s_waitcnt(0);
        unsigned nloc = b.st[0], nx = b.st[1];
        if (nloc == 0u) { xcd_barrier_complete(bar, b.x, nloc, nx); b.st[0] = nloc; b.st[1] = nx; }
        const unsigned old = xb_add(&bar[XB_XSUB(b.x)], 1u);
        const unsigned gen = old / nloc;
        if (old + 1u == (gen + 1u) * nloc) {
            __builtin_amdgcn_fence(__ATOMIC_RELEASE, "agent");
            asm volatile("s_waitcnt vmcnt(0)" ::: "memory");
            const unsigned og = xb_add(&bar[XB_TOP], 1u);
            const unsigned tg = og / nx;
            if (og + 1u == (tg + 1u) * nx) xb_add(&bar[XB_TOPGEN], 1u);
            else XB_SPIN(xb_ld(&bar[XB_TOPGEN]) == tg, bar);
            __builtin_amdgcn_fence(__ATOMIC_ACQUIRE, "agent");
            xb_add(&bar[XB_XGEN(b.x)], 1u);
            asm volatile("s_waitcnt vmcnt(0)" ::: "memory");
        } else {
            XB_SPIN(xb_ld(&bar[XB_XGEN(b.x)]) == gen, bar);
            __builtin_amdgcn_fence(__ATOMIC_ACQUIRE, "agent");
            asm volatile("s_waitcnt vmcnt(0)" ::: "memory");
        }
    }
    __syncthreads();
}

__device__ __forceinline__ bf16x8 frag_kmaj(lptr img, int rs, int o, int s, int lane) {
  const int h = lane >> 5, blk = (lane >> 4) & 1, q = (lane & 15) >> 2, pp = lane & 3;
  lptr a = img + (16 * s + 8 * h + q) * rs + (o + 16 * blk + 4 * pp) * 2;
  const v4i16_t lo = __builtin_amdgcn_ds_read_tr16_b64_v4i16((LAS v4i16_t*)a);
  const v4i16_t hi = __builtin_amdgcn_ds_read_tr16_b64_v4i16((LAS v4i16_t*)(a + 4 * rs));
  return (bf16x8){lo[0], lo[1], lo[2], lo[3], hi[0], hi[1], hi[2], hi[3]};
}
__device__ __forceinline__ bf16x8 frag_kmin(lptr img, int o, int s, int lane) {
  const int row = o + (lane & 31), c = 2 * s + (lane >> 5);
  return *(LAS bf16x8*)(img + row * 64 + ((c ^ ((row >> 2) & 3)) << 4));
}
__device__ __forceinline__ int kmin_off(int row, int c) { return row * 64 + ((c ^ ((row >> 2) & 3)) << 4); }

template <int TM, int TN, bool WKMAJ, bool XKMAJ>
__device__ __forceinline__ void mma_step(f32x16 (&acc)[TM][TN], lptr wimg, int wrs, int wn0, lptr ximg, int xrs, int xt0, int lane) {
#pragma unroll
  for (int s = 0; s < 2; ++s) {
    bf16x8 wf[TM], xf[TN];
#pragma unroll
    for (int tm = 0; tm < TM; ++tm) wf[tm] = WKMAJ ? frag_kmaj(wimg, wrs, wn0 + 32 * tm, s, lane) : frag_kmin(wimg, wn0 + 32 * tm, s, lane);
#pragma unroll
    for (int tn = 0; tn < TN; ++tn) xf[tn] = XKMAJ ? frag_kmaj(ximg, xrs, xt0 + 32 * tn, s, lane) : frag_kmin(ximg, xt0 + 32 * tn, s, lane);
#pragma unroll
    for (int tm = 0; tm < TM; ++tm)
#pragma unroll
      for (int tn = 0; tn < TN; ++tn) acc[tm][tn] = __builtin_amdgcn_mfma_f32_32x32x16_bf16(wf[tm], xf[tn], acc[tm][tn], 0, 0, 0);
    if (s == 0) __builtin_amdgcn_sched_barrier(0);
  }
}

template <int BNT> struct WRegB16 { u32x4 r[BNT / 128]; };
template <int BNT> __device__ __forceinline__ void wload_b16(WRegB16<BNT>& R, const bf16_t* src  , int ld, int tid) {
  constexpr int C8 = BNT / 8, KPR = 512 / C8;
  const int c8 = tid % C8, kr = tid / C8;
#pragma unroll
  for (int r = 0; r < BNT / 128; ++r) R.r[r] = *(const u32x4*)(src + (size_t)(kr + r * KPR) * ld + c8 * 8);
}
template <int BNT> __device__ __forceinline__ void wstore_b16(const WRegB16<BNT>& R, lptr img, int rs, int tid) {
  constexpr int C8 = BNT / 8, KPR = 512 / C8;
  const int c8 = tid % C8, kr = tid / C8;
#pragma unroll
  for (int r = 0; r < BNT / 128; ++r) *(LAS u32x4*)(img + (kr + r * KPR) * rs + c8 * 16) = R.r[r];
}
template <int BMT> struct XRegB16 { u32x4 r[(BMT + 127) / 128]; };
template <int BMT> __device__ __forceinline__ void xload_b16(XRegB16<BMT>& R, const bf16_t* const (&rowp)[(BMT + 127) / 128], int k0, int tid) {
#pragma unroll
  for (int r = 0; r < (BMT + 127) / 128; ++r) if (BMT >= 128 || tid < BMT * 4) R.r[r] = *(const u32x4*)(rowp[r] + k0 + (tid & 3) * 8);
}
template <int BMT> __device__ __forceinline__ void xstore_b16(const XRegB16<BMT>& R, lptr img, int tid) {
#pragma unroll
  for (int r = 0; r < (BMT + 127) / 128; ++r) if (BMT >= 128 || tid < BMT * 4) *(LAS u32x4*)(img + kmin_off((tid >> 2) + 128 * r, tid & 3)) = R.r[r];
}

template <int BNT> struct WLb16 {
  typedef WRegB16<BNT> Regs; const bf16_t* src; int ld;
  __device__ __forceinline__ void load(Regs& R, int k0, int tid) const { wload_b16<BNT>(R, src + (size_t)k0 * ld, ld, tid); }
  __device__ __forceinline__ void store(const Regs& R, lptr img, int rs, int tid) const { wstore_b16<BNT>(R, img, rs, tid); }
};
struct WLgu {
  typedef WRegB16<512> Regs; const bf16_t *g, *u;
  __device__ __forceinline__ void load(Regs& R, int k0, int tid) const {
    const int c8 = tid & 63, kr = tid >> 6, col = c8 * 8, grp = col >> 6, w = col & 63;
    const unsigned long long ga = (unsigned long long)g, ua = (unsigned long long)u;
    const bf16_t* s = (const bf16_t*)(w < 32 ? ga : ua) + grp * 32 + (w & 31);
#pragma unroll
    for (int r = 0; r < 4; ++r) R.r[r] = *(const u32x4*)(s + (size_t)(k0 + kr + r * 8) * 256);
  }
  __device__ __forceinline__ void store(const Regs& R, lptr img, int rs, int tid) const { wstore_b16<512>(R, img, rs, tid); }
};
struct WReg32x8 { f32x4 r[8]; };
__device__ __forceinline__ void wstore_f32_512(const WReg32x8& R, lptr img, int rs, int tid) {
  const int c4 = tid & 127, kr = tid >> 7;
#pragma unroll
  for (int r = 0; r < 8; ++r) { u32x2 o; o.x = pk2(R.r[r].x, R.r[r].y); o.y = pk2(R.r[r].z, R.r[r].w); *(LAS u32x2*)(img + (kr + 4 * r) * rs + c4 * 8) = o; }
}
struct WLf32 {
  typedef WReg32x8 Regs; const float* src; int ld;
  __device__ __forceinline__ void load(Regs& R, int k0, int tid) const {
    const float* s = src + (size_t)(k0 + (tid >> 7)) * ld + (tid & 127) * 4;
#pragma unroll
    for (int r = 0; r < 8; ++r) R.r[r] = *(const f32x4*)(s + (size_t)(4 * r) * ld);
  }
  __device__ __forceinline__ void store(const Regs& R, lptr img, int rs, int tid) const { wstore_f32_512(R, img, rs, tid); }
};
struct WLf32gu {
  typedef WReg32x8 Regs; const float *g, *u;
  __device__ __forceinline__ void load(Regs& R, int k0, int tid) const {
    const int col = (tid & 127) * 4, grp = col >> 7, w = col & 127;
    const unsigned long long ga = (unsigned long long)g, ua = (unsigned long long)u;
    const float* s = (const float*)(w < 64 ? ga : ua) + (size_t)(k0 + (tid >> 7)) * 256 + grp * 64 + (w & 63);
#pragma unroll
    for (int r = 0; r < 8; ++r) R.r[r] = *(const f32x4*)(s + (size_t)(4 * r) * 256);
  }
  __device__ __forceinline__ void store(const Regs& R, lptr img, int rs, int tid) const { wstore_f32_512(R, img, rs, tid); }
};
template <int BMT> struct XLrows {
  typedef XRegB16<BMT> Regs; const bf16_t* rowp[(BMT + 127) / 128]; lptr ximg;
  __device__ __forceinline__ void load(Regs& R, int k0, int tid) const { xload_b16<BMT>(R, rowp, k0, tid); }
  __device__ __forceinline__ void store(const Regs& R, int tid) const { xstore_b16<BMT>(R, ximg, tid); }
  __device__ __forceinline__ void store(const Regs& R, int off, int tid) const { xstore_b16<BMT>(R, ximg + off, tid); }
  __device__ __forceinline__ lptr img(int) const { return ximg; }
  __device__ __forceinline__ int staged() const { return 1; }
};
struct XLres {
  struct Regs {}; lptr base; int bytes;
  __device__ __forceinline__ void load(Regs&, int, int) const {}
  __device__ __forceinline__ void store(const Regs&, int) const {}
  __device__ __forceinline__ void store(const Regs&, int, int) const {}
  __device__ __forceinline__ lptr img(int k0) const { return base + (k0 >> 5) * bytes; }
  __device__ __forceinline__ int staged() const { return 0; }
};
template <int TM, int TN, class WL, class XL, bool WK = true, bool XK = false>
__device__ __forceinline__ void gemm_loop(f32x16 (&acc)[TM][TN], int K, const WL& wl, const XL& xl, lptr wimg, int wrs, int wn0, int xt0, int tid, int lane, int xrs = 0) {
  asm volatile("" : "+v"(tid), "+v"(lane));
  typename WL::Regs wr; typename XL::Regs xr;
  wl.load(wr, 0, tid); xl.load(xr, 0, tid);
  for (int k0 = 0; k0 < K; k0 += 32) {
    wl.store(wr, wimg, wrs, tid); xl.store(xr, tid);
    __syncthreads();
    if (k0 + 32 < K) { wl.load(wr, k0 + 32, tid); xl.load(xr, k0 + 32, tid); }
    mma_step<TM, TN, WK, XK>(acc, wimg, wrs, wn0, xl.img(k0), xrs, xt0, lane);
    __syncthreads();
  }
}
template <int TM, int TN, class WL, class XL, bool WK = true, bool XK = false>
__device__ __forceinline__ void gemm_loop2(f32x16 (&acc)[TM][TN], int K, const WL& wl, const XL& xl, lptr wimg, int wrs, int wn0, int xt0, int tid, int lane, int xrs = 0) {
  asm volatile("" : "+v"(tid), "+v"(lane));
  typename WL::Regs wa, wb; typename XL::Regs xa, xb;
  wl.load(wa, 0, tid); xl.load(xa, 0, tid); wl.load(wb, 32, tid); xl.load(xb, 32, tid);
  for (int k0 = 0; k0 < K; k0 += 64) {
    wl.store(wa, wimg, wrs, tid); xl.store(xa, tid);
    __syncthreads();
    if (k0 + 64 < K) { wl.load(wa, k0 + 64, tid); xl.load(xa, k0 + 64, tid); }
    mma_step<TM, TN, WK, XK>(acc, wimg, wrs, wn0, xl.img(k0), xrs, xt0, lane);
    __syncthreads();
    wl.store(wb, wimg, wrs, tid); xl.store(xb, tid);
    __syncthreads();
    if (k0 + 96 < K) { wl.load(wb, k0 + 96, tid); xl.load(xb, k0 + 96, tid); }
    mma_step<TM, TN, WK, XK>(acc, wimg, wrs, wn0, xl.img(k0 + 32), xrs, xt0, lane);
    __syncthreads();
  }
}
template <int TM, int TN, class WL, class XL>
__device__ __forceinline__ void gemm_loop64(f32x16 (&acc)[TM][TN], int K, const WL& wl, const XL& xl, lptr wimg, int wrs, int wn0, int xt0, int xhalf, int tid, int lane) {
  asm volatile("" : "+v"(tid), "+v"(lane));
  typename WL::Regs wa, wb; typename XL::Regs xa, xb;
  wl.load(wa, 0, tid); xl.load(xa, 0, tid); wl.load(wb, 32, tid); xl.load(xb, 32, tid);
  for (int k0 = 0; k0 < K; k0 += 64) {
    wl.store(wa, wimg, wrs, tid); xl.store(xa, 0, tid);
    wl.store(wb, wimg + 32 * wrs, wrs, tid); xl.store(xb, xhalf, tid);
    __syncthreads();
    if (k0 + 64 < K) { wl.load(wa, k0 + 64, tid); xl.load(xa, k0 + 64, tid); wl.load(wb, k0 + 96, tid); xl.load(xb, k0 + 96, tid); }
    mma_step<TM, TN, true, false>(acc, wimg, wrs, wn0, xl.img(k0), 0, xt0, lane);
    mma_step<TM, TN, true, false>(acc, wimg + 32 * wrs, wrs, wn0, xl.img(k0 + 32) + xhalf * xl.staged(), 0, xt0, lane);
    __syncthreads();
  }
}
template <int TM, int TN, class WL, class XL>
__device__ __forceinline__ void gemm_loop_db(f32x16 (&acc)[TM][TN], int K, const WL& wl, const XL& xl, lptr wimg, int wrs, int wn0, int xt0, int xhalf, int tid, int lane) {
  asm volatile("" : "+v"(tid), "+v"(lane));
  const bool early = __builtin_amdgcn_readfirstlane(tid) < 256;
  typename WL::Regs wa, wb; typename XL::Regs xa, xb;
  wl.load(wa, 0, tid); xl.load(xa, 0, tid); wl.load(wb, 32, tid); xl.load(xb, 32, tid);
  wl.store(wa, wimg, wrs, tid); xl.store(xa, 0, tid);
  __syncthreads();
  if (64 < K) { wl.load(wa, 64, tid); xl.load(xa, 64, tid); }
  for (int k0 = 0; k0 < K; k0 += 64) {
    if (early) { wl.store(wb, wimg + 32 * wrs, wrs, tid); xl.store(xb, xhalf, tid); if (k0 + 96 < K) { wl.load(wb, k0 + 96, tid); xl.load(xb, k0 + 96, tid); } }
    mma_step<TM, TN, true, false>(acc, wimg, wrs, wn0, xl.img(k0), 0, xt0, lane);
    if (!early) { wl.store(wb, wimg + 32 * wrs, wrs, tid); xl.store(xb, xhalf, tid); if (k0 + 96 < K) { wl.load(wb, k0 + 96, tid); xl.load(xb, k0 + 96, tid); } }
    __syncthreads();
    if (early && k0 + 64 < K) { wl.store(wa, wimg, wrs, tid); xl.store(xa, 0, tid); if (k0 + 128 < K) { wl.load(wa, k0 + 128, tid); xl.load(xa, k0 + 128, tid); } }
    mma_step<TM, TN, true, false>(acc, wimg + 32 * wrs, wrs, wn0, xl.img(k0 + 32) + xhalf * xl.staged(), 0, xt0, lane);
    if (!early && k0 + 64 < K) { wl.store(wa, wimg, wrs, tid); xl.store(xa, 0, tid); if (k0 + 128 < K) { wl.load(wa, k0 + 128, tid); xl.load(xa, k0 + 128, tid); } }
    __syncthreads();
  }
}
template <int TM, int TN> __device__ __forceinline__ void acc_zero(f32x16 (&acc)[TM][TN]) {
#pragma unroll
  for (int a = 0; a < TM; ++a)
#pragma unroll
    for (int b = 0; b < TN; ++b)
#pragma unroll
      for (int r = 0; r < 16; ++r) acc[a][b][r] = 0.f;
}

struct WLgu256 {
  typedef WRegB16<256> Regs; const bf16_t *g, *u; int abase;
  __device__ __forceinline__ void load(Regs& R, int k0, int tid) const {
    const int col = (tid & 31) * 8, grp = col >> 7, w = col & 127;
    const unsigned long long ga = (unsigned long long)g, ua = (unsigned long long)u;
    const bf16_t* s = (const bf16_t*)(w < 64 ? ga : ua) + abase + grp * 64 + (w & 63) + (size_t)(k0 + (tid >> 5)) * 256;
#pragma unroll
    for (int r = 0; r < 2; ++r) R.r[r] = *(const u32x4*)(s + (size_t)(r * 16) * 256);
  }
  __device__ __forceinline__ void store(const Regs& R, lptr img, int rs, int tid) const { wstore_b16<256>(R, img, rs, tid); }
};
__device__ __forceinline__ void glds16(const void* gsrc, unsigned lds_dst) { unsigned keep;
  asm volatile("s_mov_b32 %0, m0\n\ts_mov_b32 m0, %2\n\ts_nop 0\n\tglobal_load_lds_dwordx4 %1, off\n\ts_mov_b32 m0, %0" : "=&s"(keep) : "v"(gsrc), "s"(lds_dst) : "memory"); }
__device__ __forceinline__ bf16x8 frag_kmaj512(lptr img, int o, int s, int lane) {
  const int h = lane >> 5, blk = (lane >> 4) & 1, q = (lane & 15) >> 2, pp = lane & 3;
  lptr a = img + (16 * s + 8 * h + q) * 512 + ((((o >> 3) + 2 * blk + (pp >> 1)) ^ (q << 2)) << 4) + (pp & 1) * 8;
  const v4i16_t lo = __builtin_amdgcn_ds_read_tr16_b64_v4i16((LAS v4i16_t*)a);
  const v4i16_t hi = __builtin_amdgcn_ds_read_tr16_b64_v4i16((LAS v4i16_t*)(a + 4 * 512));
  return (bf16x8){lo[0], lo[1], lo[2], lo[3], hi[0], hi[1], hi[2], hi[3]};
}
constexpr int G2_SLOT = 32768;
__device__ __forceinline__ void glds16x4(const void* g0, const void* g1, const void* g2, const void* g3, unsigned d0) {
  unsigned keep;
  asm volatile("s_mov_b32 %0, m0\n\ts_mov_b32 m0, %5\n\ts_nop 0\n\tglobal_load_lds_dwordx4 %1, off\n\ts_add_u32 m0, m0, 0x400\n\ts_nop 0\n\tglobal_load_lds_dwordx4 %2, off\n\t"
               "s_add_u32 m0, m0, 0x3c00\n\ts_nop 0\n\tglobal_load_lds_dwordx4 %3, off\n\ts_add_u32 m0, m0, 0x400\n\ts_nop 0\n\tglobal_load_lds_dwordx4 %4, off\n\ts_mov_b32 m0, %0"
               : "=&s"(keep) : "v"(g0), "v"(g1), "v"(g2), "v"(g3), "s"(d0) : "memory", "scc");
}
__device__ __forceinline__ void gemm256_dma(f32x16 (&acc)[4][2], const bf16_t* wp0, const bf16_t* wp1, size_t wstep, const bf16_t* xp0, const bf16_t* xp1, int K,
                                            lptr lds, int wn, int wt, int wid, int lane0) {
  const unsigned ring0 = (unsigned)(uintptr_t)lds + (unsigned)wid * 2048u;
  const int nst = K >> 5;
#define G2_ISSUE(ST) do { const int st_ = (ST) < nst ? (ST) : nst - 1; const unsigned sl_ = (unsigned)__builtin_amdgcn_readfirstlane((int)(ring0 + (unsigned)((ST) & 3) * G2_SLOT)); \
    glds16x4(wp0 + (size_t)st_ * wstep, wp1 + (size_t)st_ * wstep, xp0 + st_ * 32, xp1 + st_ * 32, sl_); } while (0)
  acc_zero<4, 2>(acc);
  G2_ISSUE(0); G2_ISSUE(1); G2_ISSUE(2);
  for (int st = 0; st < nst; ++st) {
    asm volatile("s_waitcnt vmcnt(8)\n\ts_barrier" ::: "memory");
    int lane = lane0; asm volatile("" : "+v"(lane));
    lptr wimg = lds + (st & 3) * G2_SLOT, ximg = wimg + 16384;
    bf16x8 wf0[4], xf0[2], wf1[4], xf1[2];
#pragma unroll
    for (int tm = 0; tm < 4; ++tm) wf0[tm] = frag_kmaj512(wimg, wn * 128 + 32 * tm, 0, lane);
#pragma unroll
    for (int tn = 0; tn < 2; ++tn) xf0[tn] = frag_kmin(ximg, wt * 64 + 32 * tn, 0, lane);
    G2_ISSUE(st + 3);
#pragma unroll
    for (int tm = 0; tm < 4; ++tm) wf1[tm] = frag_kmaj512(wimg, wn * 128 + 32 * tm, 1, lane);
#pragma unroll
    for (int tn = 0; tn < 2; ++tn) xf1[tn] = frag_kmin(ximg, wt * 64 + 32 * tn, 1, lane);
    __builtin_amdgcn_sched_barrier(0);
#pragma unroll
    for (int tm = 0; tm < 4; ++tm)
#pragma unroll
      for (int tn = 0; tn < 2; ++tn) acc[tm][tn] = __builtin_amdgcn_mfma_f32_32x32x16_bf16(wf0[tm], xf0[tn], acc[tm][tn], 0, 0, 0);
#pragma unroll
    for (int tm = 0; tm < 4; ++tm)
#pragma unroll
      for (int tn = 0; tn < 2; ++tn) acc[tm][tn] = __builtin_amdgcn_mfma_f32_32x32x16_bf16(wf1[tm], xf1[tn], acc[tm][tn], 0, 0, 0);
  }
#undef G2_ISSUE
  asm volatile("s_waitcnt vmcnt(0)\n\ts_barrier" ::: "memory");
}
__device__ __forceinline__ int g2_wrow(int wid, int i, int lane) { return 2 * (2 * wid + i) + (lane >> 5); }
__device__ __forceinline__ int g2_wcol(int wid, int i, int lane) { return (((lane & 31) ^ ((g2_wrow(wid, i, lane) & 3) << 2))) * 8; }
__device__ __forceinline__ int g2_xtok(int wid, int i, int lane) { return 16 * (2 * wid + i) + (lane >> 2); }
__device__ __forceinline__ int g2_xk(int wid, int i, int lane) { return (((lane & 3) ^ ((g2_xtok(wid, i, lane) >> 2) & 3))) * 8; }
template <class WL>
__device__ __forceinline__ void gemm256(f32x16 (&acc)[4][2], const WL& wl, const bf16_t* xbase, int ldx, int t0, int K, lptr lds, int wn, int wt, int tid, int lane) {
  constexpr int WRS = 256 * 2 + 64;
  XLrows<256> xl; xl.rowp[0] = xbase + (size_t)(t0 + (tid >> 2)) * ldx; xl.rowp[1] = xl.rowp[0] + (size_t)128 * ldx; xl.ximg = lds + 64 * WRS;
  acc_zero<4, 2>(acc);
  gemm_loop_db<4, 2>(acc, K, wl, xl, lds, WRS, wn * 128, wt * 64, 256 * 64, tid, lane);
}
constexpr int LDS_INV64 = 150 * 1024, LDS_INV128 = LDS_INV64 + 128, LDS_XB = LDS_INV128 + 256, LDS_BYTES = 152 * 1024;

__device__ __forceinline__ void cvt_items(const float* src, bf16_t* dst, size_t n8, int gtid, int gthreads) {
  for (size_t i0 = gtid; i0 < n8; i0 += (size_t)gthreads * 4) {
    f32x4 a[4], b[4];
#pragma unroll
    for (int q = 0; q < 4; ++q) { const size_t i = i0 + (size_t)q * gthreads; if (i < n8) { a[q] = *(const f32x4*)(src + i * 8); b[q] = *(const f32x4*)(src + i * 8 + 4); } }
#pragma unroll
    for (int q = 0; q < 4; ++q) { const size_t i = i0 + (size_t)q * gthreads; if (i < n8) { u32x4 o; o.x = pk2(a[q].x, a[q].y); o.y = pk2(a[q].z, a[q].w); o.z = pk2(b[q].x, b[q].y); o.w = pk2(b[q].z, b[q].w); *(u32x4*)(dst + i * 8) = o; } }
  }
}
__device__ __forceinline__ void phase0a(const P& p, lptr lds, int vcu, int G) {
  const int tid = threadIdx.x, wid = tid >> 6, lane = tid & 63;
  if (vcu < 96) {
    const int j = vcu * 64 + lane;
    LAS float* sc = (LAS float*)(lds + 16384);
    for (int i = tid; i < 4 * D; i += 512) sc[i] = silu(p.c[i]);
    __syncthreads();
    float a0 = 0.f, a1 = 0.f, a2 = 0.f, a3 = 0.f;
    for (int k = wid * 128; k < wid * 128 + 128; k += 32) {
      float w[32];
#pragma unroll
      for (int q = 0; q < 32; ++q) w[q] = p.w_ada[(size_t)(k + q) * 6144 + j];
#pragma unroll
      for (int q = 0; q < 32; ++q) { a0 += sc[k + q] * w[q]; a1 += sc[D + k + q] * w[q]; a2 += sc[2 * D + k + q] * w[q]; a3 += sc[3 * D + k + q] * w[q]; }
    }
    LAS float* part = (LAS float*)lds;
    part[(wid * 4 + 0) * 64 + lane] = a0; part[(wid * 4 + 1) * 64 + lane] = a1; part[(wid * 4 + 2) * 64 + lane] = a2; part[(wid * 4 + 3) * 64 + lane] = a3;
    __syncthreads();
    if (wid < 4) { float s = p.b_ada[j];
#pragma unroll
      for (int w = 0; w < 8; ++w) s += part[(w * 4 + wid) * 64 + lane];
      p.mod[wid * 6144 + j] = s; }
    __syncthreads();
  }
  if (vcu < 96 && G > 96) return;
  const int gtid = (G > 96 ? vcu - 96 : vcu) * 512 + tid, gth = (G > 96 ? G - 96 : G) * 512;
  cvt_items(p.w_in, p.winb, (size_t)D * INW / 8, gtid, gth);
  cvt_items(p.w_out, p.woutb, (size_t)D * D / 8, gtid, gth);
  cvt_items(p.w_router, p.wrb, (size_t)D * NE / 8, gtid, gth);
  cvt_items(p.wg_s, p.wgsb, (size_t)D * 256 / 8, gtid, gth);
  cvt_items(p.wu_s, p.wusb, (size_t)D * 256 / 8, gtid, gth);
  cvt_items(p.wd_s, p.wdsb, (size_t)256 * D / 8, gtid, gth);
  cvt_items(p.cw1k, p.cw1kb, (size_t)2048 * 128 / 8, gtid, gth);
  cvt_items(p.cw1v, p.cw1vb, (size_t)2048 * 128 / 8, gtid, gth);
  cvt_items(p.cw2k, p.cw2kb, (size_t)128 * 64 / 8, gtid, gth);
  cvt_items(p.cw2v, p.cw2vb, (size_t)128 * 64 / 8, gtid, gth);
}

__device__ __forceinline__ void phase0b(const P& p, lptr lds, int vcu, int G) {
  const int tid = threadIdx.x, wid = tid >> 6, lane = tid & 63;
  for (int row = vcu * 8 + wid; row < T; row += G * 8) {
    const int b = row / SEQ;
    f32x4 v[4]; float s = 0.f;
#pragma unroll
    for (int j = 0; j < 4; ++j) { v[j] = *(const f32x4*)(p.x + (size_t)row * D + j * 256 + lane * 4); s += v[j].x * v[j].x + v[j].y * v[j].y + v[j].z * v[j].z + v[j].w * v[j].w; }
    s = wave_sum(s);
    const float r = rsqrtf(s * (1.f / D) + EPS);
#pragma unroll
    for (int j = 0; j < 4; ++j) {
      const int k = j * 256 + lane * 4;
      const f32x4 g = *(const f32x4*)(p.g_mix + k), sc = *(const f32x4*)(p.mod + b * 6144 + 1024 + k), sh = *(const f32x4*)(p.mod + b * 6144 + k);
      u32x2 o; o.x = pk2(v[j].x * r * g.x * (1.f + sc.x) + sh.x, v[j].y * r * g.y * (1.f + sc.y) + sh.y); o.y = pk2(v[j].z * r * g.z * (1.f + sc.z) + sh.z, v[j].w * r * g.w * (1.f + sc.w) + sh.w);
      *(u32x2*)(p.hb + (size_t)row * D + k) = o;
    }
  }
}

#define ROPE_PAIR(X1, X2, posf, invrev, sc) do { float pf_ = (posf); asm volatile("" : "+v"(pf_)); const float fr_ = __builtin_amdgcn_fractf(pf_ * (invrev)); \
    const float sn_ = __builtin_amdgcn_sinf(fr_), cs_ = __builtin_amdgcn_cosf(fr_); const float a_ = (X1), b_ = (X2); \
    float o1_ = (a_ * cs_ - b_ * sn_) * (sc), o2_ = (a_ * sn_ + b_ * cs_) * (sc); asm volatile("" : "+v"(o1_), "+v"(o2_)); (X1) = o1_; (X2) = o2_; } while (0)
__device__ __forceinline__ void phase1(const P& p, lptr lds, int vcu, int G) {
  const int tid = threadIdx.x, wid = __builtin_amdgcn_readfirstlane(tid >> 6), lane = tid & 63, wn = wid >> 2, wt = wid & 3, h = lane >> 5;
  const LAS float* inv64 = (const LAS float*)(lds + LDS_INV64);
  const LAS float* inv128 = (const LAS float*)(lds + LDS_INV128);
  for (int u = vcu; u < 14 * 64; u += G) {
    const int j = u % 14, mt = u / 14, t0 = mt * 256;
    if (j == 13) {
      f32x16 ag[1][1]; acc_zero<1, 1>(ag);
      WLb16<128> wl; wl.src = p.winb + C_GN; wl.ld = INW;
      XLrows<256> xl; xl.rowp[0] = p.hb + (size_t)(t0 + (tid >> 2)) * D; xl.rowp[1] = xl.rowp[0] + (size_t)128 * D; xl.ximg = lds + 32 * 320;
      gemm_loop2<1, 1>(ag, D, wl, xl, lds, 320, 0, wid * 32, tid, lane);
      int tok = t0 + wid * 32 + (lane & 31), nb = 4 * h; asm volatile("" : "+v"(tok), "+v"(nb));
#pragma unroll
      for (int a = 0; a < 3; ++a) { f32x4 v; v.x = sigm(ag[0][0][4 * a]); v.y = sigm(ag[0][0][4 * a + 1]); v.z = sigm(ag[0][0][4 * a + 2]); v.w = sigm(ag[0][0][4 * a + 3]);
        *(f32x4*)(p.gates + (size_t)tok * 24 + nb + a * 8) = v; }
      continue;
    }
    const int wcol = j < 5 ? j * 256 : C_QR + (j - 5) * 256;
    f32x16 acc[4][2];
    { const bf16_t* wb = p.winb + wcol; const bf16_t* xb = p.hb + (size_t)t0 * D;
      gemm256_dma(acc, wb + (size_t)g2_wrow(wid, 0, lane) * INW + g2_wcol(wid, 0, lane), wb + (size_t)g2_wrow(wid, 1, lane) * INW + g2_wcol(wid, 1, lane), (size_t)32 * INW,
                  xb + (size_t)g2_xtok(wid, 0, lane) * D + g2_xk(wid, 0, lane), xb + (size_t)g2_xtok(wid, 1, lane) * D + g2_xk(wid, 1, lane), D, lds, wn, wt, wid, lane); }
    const int kind = (j < 2) ? 0 : (j == 2) ? 3 : (j < 5) ? (wn == 0 ? 1 : 3) : (j < 7) ? 2 : (j < 9) ? 4 : (j < 11) ? 3 : 5;
#pragma unroll
    for (int tn = 0; tn < 2; ++tn) {
      const int tok = t0 + wt * 64 + tn * 32 + (lane & 31);
      const float posf = (float)p.pos[tok];
      if (kind == 0 || kind == 1) {
        const float sc = kind == 0 ? 0.125f * 1.4426950408889634f : 1.f;
#pragma unroll
        for (int r = 0; r < 16; ++r) { const float iv = inv64[(r & 3) + 8 * (r >> 2) + 4 * h];
          ROPE_PAIR(acc[0][tn][r], acc[1][tn][r], posf, iv, sc); ROPE_PAIR(acc[2][tn][r], acc[3][tn][r], posf, iv, sc); if ((r & 3) == 3) __builtin_amdgcn_sched_barrier(0); }
      } else if (kind == 2 || kind == 4) {
        const float sc = kind == 4 ? 0.08838834764831845f : 1.f;
#pragma unroll
        for (int r = 0; r < 16; ++r) { const int i = (r & 3) + 8 * (r >> 2) + 4 * h;
          ROPE_PAIR(acc[0][tn][r], acc[2][tn][r], posf, inv128[i], sc); ROPE_PAIR(acc[1][tn][r], acc[3][tn][r], posf, inv128[32 + i], sc); if ((r & 3) == 3) __builtin_amdgcn_sched_barrier(0); }
      } else if (kind == 5) {
#pragma unroll
        for (int tm = 0; tm < 4; ++tm)
#pragma unroll
          for (int r = 0; r < 16; ++r) { float v = acc[tm][tn][r]; asm volatile("" : "+v"(v)); float o = v * __builtin_amdgcn_rcpf(1.f + __builtin_amdgcn_exp2f(-1.4426950408889634f * v)); asm volatile("" : "+v"(o)); acc[tm][tn][r] = o; }
      }
      { int rl = wt * 32 + (lane & 31), cb = (wn * 128 + 4 * h) * 2; asm volatile("" : "+v"(rl), "+v"(cb));
#pragma unroll
        for (int tm = 0; tm < 4; ++tm)
#pragma unroll
          for (int a = 0; a < 4; ++a) { u32x2 o; o.x = pk2(acc[tm][tn][4 * a], acc[tm][tn][4 * a + 1]); o.y = pk2(acc[tm][tn][4 * a + 2], acc[tm][tn][4 * a + 3]);
            *(LAS u32x2*)(lds + rl * 528 + cb + (tm * 32 + a * 8) * 2) = o; }
        __syncthreads();
#pragma unroll
        for (int rr = 0; rr < 8; ++rr) { const int row = wid * 16 + rr * 2 + (lane >> 5);
          *(u32x4*)(p.projb + (size_t)(t0 + (row >> 5) * 64 + tn * 32 + (row & 31)) * PJW + j * 256 + (lane & 31) * 8) = *(const LAS u32x4*)(lds + row * 528 + (lane & 31) * 16); }
        __syncthreads(); }
    }
  }
}

__device__ __forceinline__ void phase5(const P& p, lptr lds, int vcu, int G) {
  const int tid = threadIdx.x, wid = __builtin_amdgcn_readfirstlane(tid >> 6), lane = tid & 63, h = lane >> 5, l31 = lane & 31;
  constexpr int WRS1 = 1024 * 2 + 64;
  lptr wimg = lds, ximg = lds + 32 * WRS1;
  lptr lgb = lds + 72 * 1024;
  LAS float* part = (LAS float*)(lds + 138 * 1024);
  LAS float* rstd = part + 512;
  for (int u = vcu; u < T / 64; u += G) {
    const int t0 = u * 64, b = t0 / SEQ;
    f32x16 acc[4][2];
    acc_zero<4, 2>(acc);
    { WLb16<1024> wl; wl.src = p.woutb; wl.ld = D;
      XLrows<64> xl; xl.rowp[0] = p.mixb + (size_t)(t0 + ((tid >> 2) & 63)) * D; xl.ximg = ximg;
      gemm_loop<4, 2>(acc, D, wl, xl, wimg, WRS1, wid * 128, 0, tid, lane); }
    int nb = wid * 128 + 4 * h, tb = t0 + l31;
    asm volatile("" : "+v"(nb), "+v"(tb));
#pragma unroll
    for (int tn = 0; tn < 2; ++tn) {
      const int tok = tb + tn * 32; float ss = 0.f;
#pragma unroll
      for (int tm = 0; tm < 4; ++tm)
#pragma unroll
        for (int a = 0; a < 4; ++a) {
          const int n = nb + tm * 32 + a * 8;
          const f32x4 xv = *(const f32x4*)(p.x + (size_t)tok * D + n), gt = *(const f32x4*)(p.mod + b * 6144 + 2048 + n);
          f32x4 v; v.x = xv.x + gt.x * acc[tm][tn][4 * a]; v.y = xv.y + gt.y * acc[tm][tn][4 * a + 1]; v.z = xv.z + gt.z * acc[tm][tn][4 * a + 2]; v.w = xv.w + gt.w * acc[tm][tn][4 * a + 3];
          acc[tm][tn][4 * a] = v.x; acc[tm][tn][4 * a + 1] = v.y; acc[tm][tn][4 * a + 2] = v.z; acc[tm][tn][4 * a + 3] = v.w;
          *(f32x4*)(p.x1 + (size_t)tok * D + n) = v;
          ss += v.x * v.x + v.y * v.y + v.z * v.z + v.w * v.w;
          if (a == 3) __builtin_amdgcn_sched_barrier(0);
        }
      ss += __shfl_xor(ss, 32);
      if (h == 0) part[wid * 64 + tn * 32 + l31] = ss;
    }
    __syncthreads();
    if (tid < 64) { float q = 0.f;
#pragma unroll
      for (int w = 0; w < 8; ++w) q += part[w * 64 + tid];
      rstd[tid] = rsqrtf(q * (1.f / D) + EPS); }
    __syncthreads();
    asm volatile("" : "+v"(nb), "+v"(tb));
#pragma unroll
    for (int tn = 0; tn < 2; ++tn) {
      const int tok = tb + tn * 32; const float r = rstd[tn * 32 + l31];
#pragma unroll
      for (int tm = 0; tm < 4; ++tm)
#pragma unroll
        for (int a = 0; a < 4; ++a) {
          const int n = nb + tm * 32 + a * 8;
          const f32x4 g = *(const f32x4*)(p.g_ffn + n), sc = *(const f32x4*)(p.mod + b * 6144 + 4096 + n), sh = *(const f32x4*)(p.mod + b * 6144 + 3072 + n);
          u32x2 o;
          o.x = pk2(acc[tm][tn][4 * a] * r * g.x * (1.f + sc.x) + sh.x, acc[tm][tn][4 * a + 1] * r * g.y * (1.f + sc.y) + sh.y);
          o.y = pk2(acc[tm][tn][4 * a + 2] * r * g.z * (1.f + sc.z) + sh.z, acc[tm][tn][4 * a + 3] * r * g.w * (1.f + sc.w) + sh.w);
          *(u32x2*)(p.h2b + (size_t)tok * D + n) = o;
          if (a == 3) __builtin_amdgcn_sched_barrier(0);
        }
    }
    asm volatile("s_waitcnt vmcnt(0)" ::: "memory");
    __syncthreads();
    { f32x16 a2[1][2]; acc_zero<1, 2>(a2);
      WLb16<256> wl; wl.src = p.wrb; wl.ld = NE;
      XLrows<64> xl; xl.rowp[0] = p.h2b + (size_t)(t0 + ((tid >> 2) & 63)) * D; xl.ximg = ximg;
      gemm_loop<1, 2>(a2, D, wl, xl, wimg, 256 * 2 + 64, wid * 32, 0, tid, lane);
      int lo = ((l31 * 256 + wid * 32 + 4 * h) * 4);
      asm volatile("" : "+v"(lo));
#pragma unroll
      for (int tn = 0; tn < 2; ++tn)
#pragma unroll
        for (int a = 0; a < 4; ++a) { f32x4 v = {a2[0][tn][4 * a], a2[0][tn][4 * a + 1], a2[0][tn][4 * a + 2], a2[0][tn][4 * a + 3]};
          *(LAS f32x4*)(lgb + lo + (tn * 32 * 256 + a * 8) * 4) = v; } }
    __syncthreads();
    { int lane_ = lane; asm volatile("" : "+v"(lane_));
      const int lane = lane_;
      const f32x4 rb = *(const f32x4*)(p.rbias + lane * 4);
      for (int i = 0; i < 8; ++i) {
        const int tl = wid * 8 + i, tok = t0 + tl;
        const f32x4 lv = *(const LAS f32x4*)(lgb + (tl * 256 + lane * 4) * 4);
        const float s0 = sigm(lv.x), s1 = sigm(lv.y), s2 = sigm(lv.z), s3 = sigm(lv.w);
        float c0 = s0 + rb.x, c1 = s1 + rb.y, c2 = s2 + rb.z, c3 = s3 + rb.w;
        float m1, m2;
        { const float h1 = fmaxf(c0, c1), l1 = fminf(c0, c1), h2 = fmaxf(c2, c3), l2 = fminf(c2, c3); m1 = fmaxf(h1, h2); m2 = fmaxf(fminf(h1, h2), fmaxf(l1, l2)); }
#pragma unroll
        for (int o = 1; o < 8; o <<= 1) { const float o1 = __shfl_xor(m1, o), o2 = __shfl_xor(m2, o); const float n1 = fmaxf(m1, o1), n2 = fmaxf(fminf(m1, o1), fmaxf(m2, o2)); m1 = n1; m2 = n2; }
        const float gs = m1 + m2; const int myg = lane >> 3; int rank = 0;
#pragma unroll
        for (int g2 = 0; g2 < 8; ++g2) { const float og = __shfl(gs, g2 * 8); rank += (og > gs || (og == gs && g2 < myg)) ? 1 : 0; }
        if (rank >= 4) { c0 = -INFINITY; c1 = -INFINITY; c2 = -INFINITY; c3 = -INFINITY; }
        int my_e = 0; float my_s = 0.f;
#pragma unroll
        for (int k = 0; k < 8; ++k) {
          float bv = c0; int li = lane * 4;
          if (c1 > bv) { bv = c1; li = lane * 4 + 1; }
          if (c2 > bv) { bv = c2; li = lane * 4 + 2; }
          if (c3 > bv) { bv = c3; li = lane * 4 + 3; }
#pragma unroll
          for (int o = 1; o < 64; o <<= 1) { const float ov = __shfl_xor(bv, o); const int oi = __shfl_xor(li, o); if (ov > bv || (ov == bv && oi < li)) { bv = ov; li = oi; } }
          const int j = li & 3; const float sj = j == 0 ? s0 : j == 1 ? s1 : j == 2 ? s2 : s3;
          const float sv = __shfl(sj, li >> 2);
          if (lane * 4 == li) c0 = -INFINITY;
          if (lane * 4 + 1 == li) c1 = -INFINITY;
          if (lane * 4 + 2 == li) c2 = -INFINITY;
          if (lane * 4 + 3 == li) c3 = -INFINITY;
          if (lane == k) { my_e = li; my_s = sv; }
        }
        const float wsum = wave_sum(lane < 8 ? my_s : 0.f);
        if (lane < 8) { const int pos = atomicAdd(&p.cnt[my_e * CPAD], 1); p.list[my_e * ECAP + pos] = tok * 8 + lane; p.wts[tok * 8 + lane] = my_s / wsum * 2.5f; }
      } }
    __syncthreads();
    { f32x16 a3[2][2]; acc_zero<2, 2>(a3);
      WLgu wl; wl.g = p.wgsb; wl.u = p.wusb;
      XLrows<64> xl; xl.rowp[0] = p.h2b + (size_t)(t0 + ((tid >> 2) & 63)) * D; xl.ximg = ximg;
      gemm_loop<2, 2>(a3, D, wl, xl, wimg, 512 * 2 + 64, wid * 64, 0, tid, lane);
      int l31_ = l31, h_ = h; asm volatile("" : "+v"(l31_), "+v"(h_));
#pragma unroll
      for (int tn = 0; tn < 2; ++tn)
#pragma unroll
        for (int a = 0; a < 4; ++a) {
          float o[4];
#pragma unroll
          for (int e = 0; e < 4; ++e) { const float gv = a3[0][tn][4 * a + e], uv = a3[1][tn][4 * a + e]; o[e] = gv * __builtin_amdgcn_rcpf(1.f + __builtin_amdgcn_exp2f(-1.4426950408889634f * gv)) * uv; }
          const int col = wid * 32 + a * 8 + 4 * h_;
          u32x2 w2; w2.x = pk2(o[0], o[1]); w2.y = pk2(o[2], o[3]);
          *(LAS u32x2*)(lgb + (col >> 5) * 4096 + kmin_off(tn * 32 + l31_, (col & 31) >> 3) + (col & 7) * 2) = w2;
        } }
    __syncthreads();
    acc_zero<4, 2>(acc);
    { WLb16<1024> wl; wl.src = p.wdsb; wl.ld = D;
      XLres xl; xl.base = lgb; xl.bytes = 4096;
      gemm_loop<4, 2>(acc, 256, wl, xl, wimg, WRS1, wid * 128, 0, tid, lane); }
    asm volatile("" : "+v"(nb), "+v"(tb));
#pragma unroll
    for (int tn = 0; tn < 2; ++tn) {
      const int tok = tb + tn * 32;
#pragma unroll
      for (int tm = 0; tm < 4; ++tm)
#pragma unroll
        for (int a = 0; a < 4; ++a) {
          const int n = nb + tm * 32 + a * 8;
          f32x4 v = *(const f32x4*)(p.x1 + (size_t)tok * D + n); const f32x4 gt = *(const f32x4*)(p.mod + b * 6144 + 5120 + n);
          v.x += gt.x * acc[tm][tn][4 * a]; v.y += gt.y * acc[tm][tn][4 * a + 1]; v.z += gt.z * acc[tm][tn][4 * a + 2]; v.w += gt.w * acc[tm][tn][4 * a + 3];
          *(f32x4*)(p.x1 + (size_t)tok * D + n) = v;
          if (a == 3) __builtin_amdgcn_sched_barrier(0);
        }
    }
    __syncthreads();
  }
}

__device__ __forceinline__ void phase6(const P& p, lptr lds, int vcu, int G) {
  const int tid = threadIdx.x, wid = __builtin_amdgcn_readfirstlane(tid >> 6), lane = tid & 63, h = lane >> 5, l31 = lane & 31, wn = wid >> 1, wt = wid & 1;
  constexpr int WRS = 512 * 2 + 64;
  lptr wimg = lds, ximg = lds + 68 * 1024;
  lptr actb = lds + 84 * 1024;
  LAS int* pre = (LAS int*)(lds + 148 * 1024);
  LAS int* sidl = pre + 320;
  if (tid < NE) pre[tid + 1] = (p.cnt[tid * CPAD] + 127) >> 7;
  if (tid == 0) pre[0] = 0;
  __syncthreads();
  if (tid == 0) { int a = 0; for (int e = 1; e <= NE; ++e) { a += pre[e]; pre[e] = a; } }
  __syncthreads();
  const int nunits = pre[NE];
  for (int u = vcu; u < nunits; u += G) {
    int lo = 0, hi = NE;
    while (hi - lo > 1) { const int mid = (lo + hi) >> 1; if (pre[mid] <= u) lo = mid; else hi = mid; }
    const int e = lo, off = (u - pre[e]) * 128, cnt = p.cnt[e * CPAD];
    if (tid < 128) sidl[tid] = off + tid < cnt ? p.list[e * ECAP + off + tid] : -1;
    __syncthreads();
    f32x16 acc[4][2];
    acc_zero<4, 2>(acc);
    { WLf32gu wl; wl.g = p.wg_e + (size_t)e * D * 256; wl.u = p.wu_e + (size_t)e * D * 256;
      XLrows<128> xl; { const int sd = sidl[(tid >> 2) & 127]; xl.rowp[0] = p.h2b + (size_t)(sd < 0 ? 0 : sd >> 3) * D; } xl.ximg = ximg;
      gemm_loop_db<4, 2>(acc, D, wl, xl, wimg, WRS, wn * 128, wt * 64, 128 * 64, tid, lane); }
    { int l31_ = l31, h_ = h; asm volatile("" : "+v"(l31_), "+v"(h_));
#pragma unroll
      for (int tn = 0; tn < 2; ++tn)
#pragma unroll
        for (int tm = 0; tm < 2; ++tm)
#pragma unroll
          for (int a = 0; a < 4; ++a) {
            float o[4];
#pragma unroll
            for (int q = 0; q < 4; ++q) { const float gv = acc[tm][tn][4 * a + q], uv = acc[tm + 2][tn][4 * a + q]; o[q] = gv * __builtin_amdgcn_rcpf(1.f + __builtin_amdgcn_exp2f(-1.4426950408889634f * gv)) * uv; }
            const int col = wn * 64 + tm * 32 + a * 8 + 4 * h_;
            u32x2 w2; w2.x = pk2(o[0], o[1]); w2.y = pk2(o[2], o[3]);
            *(LAS u32x2*)(actb + (col >> 5) * 8192 + kmin_off(wt * 64 + tn * 32 + l31_, (col & 31) >> 3) + (col & 7) * 2) = w2;
          } }
    __syncthreads();
#pragma unroll 1
    for (int pass = 0; pass < 2; ++pass) {
      acc_zero<4, 2>(acc);
      { WLf32 wl; wl.src = p.wd_e + (size_t)e * 256 * D + pass * 512; wl.ld = D;
        XLres xl; xl.base = actb; xl.bytes = 8192;
        gemm_loop_db<4, 2>(acc, 256, wl, xl, wimg, WRS, wn * 128, wt * 64, 0, tid, lane); }
      { int nbl = wn * 128 + 4 * h, rl = wt * 32 + l31; asm volatile("" : "+v"(nbl), "+v"(rl));
#pragma unroll
        for (int tn = 0; tn < 2; ++tn) {
          const int sd = sidl[wt * 64 + tn * 32 + (rl & 31)]; const float wgt = sd >= 0 ? p.wts[sd] : 0.f;
#pragma unroll
          for (int tm = 0; tm < 4; ++tm)
#pragma unroll
            for (int a = 0; a < 4; ++a) { u32x2 o; o.x = pk2(acc[tm][tn][4 * a] * wgt, acc[tm][tn][4 * a + 1] * wgt); o.y = pk2(acc[tm][tn][4 * a + 2] * wgt, acc[tm][tn][4 * a + 3] * wgt);
              *(LAS u32x2*)(lds + rl * 1040 + (nbl + tm * 32 + a * 8) * 2) = o; }
          __syncthreads();
#pragma unroll
          for (int rr = 0; rr < 8; ++rr) { const int row = wid * 8 + rr, sd2 = sidl[(row >> 5) * 64 + tn * 32 + (row & 31)];
            if (sd2 >= 0) *(u32x4*)(p.slab + (size_t)sd2 * D + pass * 512 + lane * 8) = *(const LAS u32x4*)(lds + row * 1040 + lane * 16); }
          __syncthreads();
        } }
    }
    __syncthreads();
  }
}

__device__ __forceinline__ void phase7(const P& p, lptr lds, int vcu, int G) {
  const int tid = threadIdx.x, wid = tid >> 6, lane = tid & 63;
  for (int tok = vcu * 8 + wid; tok < T; tok += G * 8) {
    const int b = tok / SEQ;
    float v[16]; float ss = 0.f;
#pragma unroll
    for (int j = 0; j < 2; ++j) {
      const int n = j * 512 + lane * 8;
      float a[8];
#pragma unroll
      for (int q = 0; q < 8; ++q) a[q] = 0.f;
#pragma unroll
      for (int k = 0; k < 9; ++k) { const u32x4 w = k < 8 ? *(const u32x4*)(p.slab + ((size_t)tok * 8 + k) * D + n) : *(const u32x4*)(p.ysb + (size_t)tok * D + n);
        a[0] += bflo(w.x); a[1] += bfhi(w.x); a[2] += bflo(w.y); a[3] += bfhi(w.y); a[4] += bflo(w.z); a[5] += bfhi(w.z); a[6] += bflo(w.w); a[7] += bfhi(w.w); }
#pragma unroll
      for (int q4 = 0; q4 < 2; ++q4) {
        const f32x4 xv = *(const f32x4*)(p.x1 + (size_t)tok * D + n + q4 * 4), gt = *(const f32x4*)(p.mod + b * 6144 + 5120 + n + q4 * 4);
        const float y0 = xv.x + gt.x * a[q4 * 4], y1 = xv.y + gt.y * a[q4 * 4 + 1], y2 = xv.z + gt.z * a[q4 * 4 + 2], y3 = xv.w + gt.w * a[q4 * 4 + 3];
        v[j * 8 + q4 * 4] = y0; v[j * 8 + q4 * 4 + 1] = y1; v[j * 8 + q4 * 4 + 2] = y2; v[j * 8 + q4 * 4 + 3] = y3;
        ss += y0 * y0 + y1 * y1 + y2 * y2 + y3 * y3;
      }
    }
    ss = wave_sum(ss);
    const float r = rsqrtf(ss * (1.f / D) + EPS);
#pragma unroll
    for (int j = 0; j < 2; ++j)
#pragma unroll
      for (int q4 = 0; q4 < 2; ++q4) {
        const int n = j * 512 + lane * 8 + q4 * 4;
        const f32x4 g = *(const f32x4*)(p.g_final + n);
        f32x4 o; o.x = v[j * 8 + q4 * 4] * r * g.x; o.y = v[j * 8 + q4 * 4 + 1] * r * g.y; o.z = v[j * 8 + q4 * 4 + 2] * r * g.z; o.w = v[j * 8 + q4 * 4 + 3] * r * g.w;
        *(f32x4*)(p.out + (size_t)tok * D + n) = o;
      }
  }
}

constexpr int NSA_KB = 8192, NSA_VRS = 128, NSA_SLOT = NSA_KB + 64 * NSA_VRS, NSA_NSLOT = 4, NSA_IMP = NSA_NSLOT * NSA_SLOT;
__device__ __forceinline__ void nsa_qk(f32x16 (&s)[2], lptr kimg, const bf16x8 (&qf)[4], int l31, int h) {
#pragma unroll
  for (int kt = 0; kt < 2; ++kt) {
#pragma unroll
    for (int r = 0; r < 16; ++r) s[kt][r] = 0.f;
    const int key = kt * 32 + l31;
#pragma unroll
    for (int ds = 0; ds < 4; ++ds) {
      const bf16x8 a = *(LAS bf16x8*)(kimg + key * 128 + (((2 * ds + h) ^ ((key >> 1) & 7)) << 4));
      s[kt] = __builtin_amdgcn_mfma_f32_32x32x16_bf16(a, qf[ds], s[kt], 0, 0, 0);
    }
  }
}
__device__ __forceinline__ void nsa_pv(f32x16 (&o)[2], lptr vimg, const f32x16 (&pr)[2], int lane) {
  const int h = lane >> 5, blk = (lane >> 4) & 1, q = (lane & 15) >> 2, pp = lane & 3;
  bf16x8 pb[4];
#pragma unroll
  for (int ks = 0; ks < 4; ++ks) {
    const int kt = ks >> 1, rb = 8 * (ks & 1);
    u32x4 w; w.x = pk2(pr[kt][rb], pr[kt][rb + 1]); w.y = pk2(pr[kt][rb + 2], pr[kt][rb + 3]); w.z = pk2(pr[kt][rb + 4], pr[kt][rb + 5]); w.w = pk2(pr[kt][rb + 6], pr[kt][rb + 7]);
    pb[ks] = __builtin_bit_cast(bf16x8, w);
  }
#pragma unroll
  for (int dt = 0; dt < 2; ++dt)
#pragma unroll
    for (int ks = 0; ks < 4; ++ks) {
      lptr a = vimg + (16 * ks + 4 * h + q) * NSA_VRS + (((dt * 4 + 2 * blk + (pp >> 1)) ^ ((q >> 1) << 2)) << 4) + (pp & 1) * 8;
      const v4i16_t lo = __builtin_amdgcn_ds_read_tr16_b64_v4i16((LAS v4i16_t*)a);
      const v4i16_t hi = __builtin_amdgcn_ds_read_tr16_b64_v4i16((LAS v4i16_t*)(a + 8 * NSA_VRS));
      const bf16x8 vf = {lo[0], lo[1], lo[2], lo[3], hi[0], hi[1], hi[2], hi[3]};
      o[dt] = __builtin_amdgcn_mfma_f32_32x32x16_bf16(vf, pb[ks], o[dt], 0, 0, 0);
    }
}
__device__ __forceinline__ float fexp(float x) { return __builtin_amdgcn_exp2f(x); }
__device__ __forceinline__ float xmax32(float x) { const auto rr = __builtin_amdgcn_permlane32_swap(__float_as_uint(x), __float_as_uint(x), false, false); return fmaxf(__uint_as_float(rr[0]), __uint_as_float(rr[1])); }
__device__ __forceinline__ float xsum32(float x) { const auto rr = __builtin_amdgcn_permlane32_swap(__float_as_uint(x), __float_as_uint(x), false, false); return __uint_as_float(rr[0]) + __uint_as_float(rr[1]); }
__device__ __forceinline__ void phase_nsa(const P& p, lptr lds, int vcu, int G) {
  const int tid = threadIdx.x, wid = __builtin_amdgcn_readfirstlane(tid >> 6), lane0 = tid & 63;
  LAS float* imp = (LAS float*)(lds + NSA_IMP);
  LAS float* obuf = (LAS float*)(lds + NSA_IMP + 16384) + wid * 2048 + lane0;
  for (int u = vcu; u < 512; u += G) {
    const int bg = u & 7, j0 = u < 256 ? 63 - (u >> 3) : ((u - 256) >> 3), b = bg >> 1, g = bg & 1, t0 = j0 * 64;
    const int t = t0 + wid * 8 + ((lane0 & 31) >> 2), hg = g * 4 + (lane0 & 3);
    const size_t trow = (size_t)(b * SEQ + t);
    bf16x8 qf[4];
#pragma unroll
    for (int ds = 0; ds < 4; ++ds) qf[ds] = *(const bf16x8*)(p.projb + trow * PJW + J_QN + hg * 64 + 16 * ds + 8 * (lane0 >> 5));
#pragma unroll
    for (int i = 0; i < 8; ++i) imp[(wid * 8 + i) * 64 + lane0] = 0.f;
    const int nct = (((t0 + 32) >> 4) >> 6) + 1, jw0 = j0 > 8 ? j0 - 8 : 0;
    const int itC = 2 * nct, itD = itC + j0 + 1, NI = itD + (j0 - jw0 + 1);
    const int cmaxt = t >= 31 ? (t - 31) >> 4 : -1;
    const int drow = wid * 8 + (lane0 >> 3), dch = lane0 & 7;
    const char* pbt = (const char*)(p.projb + (size_t)(b * SEQ) * PJW + g * 64) + (size_t)drow * (PJW * 2);
    const char* kct = (const char*)(p.kcmpb + (size_t)bg * NC * 64) + drow * 128;
    const char* vct = (const char*)(p.vcmpb + (size_t)bg * NC * 64) + drow * 128;
    const unsigned kx = (unsigned)((dch ^ ((drow >> 1) & 7)) * 16), vx = (unsigned)((dch ^ (((drow >> 1) & 1) << 2)) * 16);
    const unsigned ring0 = (unsigned)(uintptr_t)lds + (unsigned)wid * 1024u;
#define NSA_ISSUE(IT) do { const int it_ = (IT) < NI ? (IT) : NI - 1; const unsigned sl_ = (unsigned)__builtin_amdgcn_readfirstlane((int)(ring0 + (unsigned)((IT) & (NSA_NSLOT - 1)) * NSA_SLOT)); \
      if (it_ < itC) { const unsigned o_ = (unsigned)(it_ < nct ? it_ : it_ - nct) * 8192u; glds16(kct + o_ + kx, sl_); glds16(vct + o_ + vx, sl_ + NSA_KB); } \
      else { const bool sel_ = it_ < itD; const unsigned o_ = (unsigned)(sel_ ? it_ - itC : jw0 + it_ - itD) * (unsigned)(64 * PJW * 2); \
             glds16(pbt + o_ + (sel_ ? J_KS * 2 : J_KW * 2) + kx, sl_); glds16(pbt + o_ + (sel_ ? J_VS * 2 : J_VW * 2) + vx, sl_ + NSA_KB); } } while (0)
#define NSA_STEP() lptr slot = lds + (it & (NSA_NSLOT - 1)) * NSA_SLOT; \
      asm volatile("s_waitcnt vmcnt(4)\n\ts_barrier" ::: "memory"); \
      NSA_ISSUE(it + 3); \
      int lane = lane0; asm volatile("" : "+v"(lane)); const int h = lane >> 5, l31 = lane & 31; (void)l31
    NSA_ISSUE(0); NSA_ISSUE(1); NSA_ISSUE(2);
    int it = 0;
    float m1 = -1e30f, l1 = 0.f;
    for (; it < nct; ++it) {
      NSA_STEP();
      f32x16 s[2]; nsa_qk(s, slot, qf, l31, h);
      float mx = -1e30f;
#pragma unroll
      for (int r = 0; r < 16; ++r) { const int c = 64 * it + (r & 3) + 8 * (r >> 2) + 4 * h; if (c <= cmaxt) mx = fmaxf(mx, s[0][r]); if (c + 32 <= cmaxt) mx = fmaxf(mx, s[1][r]); }
      mx = xmax32(mx);
      const float mn = fmaxf(m1, mx); float rs = 0.f;
#pragma unroll
      for (int r = 0; r < 16; ++r) { const int c = 64 * it + (r & 3) + 8 * (r >> 2) + 4 * h; rs += (c <= cmaxt ? fexp(s[0][r] - mn) : 0.f) + (c + 32 <= cmaxt ? fexp(s[1][r] - mn) : 0.f); }
      rs = xsum32(rs);
      l1 = l1 * fexp(m1 - mn) + rs; m1 = mn;
    }
    f32x16 o[2];
#pragma unroll
    for (int r = 0; r < 16; ++r) { o[0][r] = 0.f; o[1][r] = 0.f; }
    { const float il = 1.f / fmaxf(l1, 1e-20f);
      for (; it < itC; ++it) {
        NSA_STEP();
        const int i = it - nct, tl = l31 >> 2, r4 = l31 & 3;
        f32x16 s[2]; nsa_qk(s, slot, qf, l31, h);
#pragma unroll
        for (int r = 0; r < 16; ++r) { const int c = 64 * i + (r & 3) + 8 * (r >> 2) + 4 * h; s[0][r] = c <= cmaxt ? fexp(s[0][r] - m1) * il : 0.f; s[1][r] = c + 32 <= cmaxt ? fexp(s[1][r] - m1) * il : 0.f; }
#pragma unroll
        for (int kt = 0; kt < 2; ++kt)
#pragma unroll
          for (int a = 0; a < 4; ++a) {
            float v4 = (s[kt][4 * a] + s[kt][4 * a + 1]) + (s[kt][4 * a + 2] + s[kt][4 * a + 3]), cy = s[kt][4 * a + 3];
            v4 += DPPF(v4, 0xb1, 0xf); v4 += DPPF(v4, 0x4e, 0xf); cy += DPPF(cy, 0xb1, 0xf); cy += DPPF(cy, 0x4e, 0xf);
            const int jj = 16 * i + 8 * kt + 2 * a + h;
            if (r4 == 0) { LAS float* ip = imp + (wid * 8 + tl) * 64 + jj; ip[0] += v4; }
            if (r4 == 0 && jj < 63) { LAS float* ip = imp + (wid * 8 + tl) * 64 + jj + 1; ip[0] += cy; }
          }
        nsa_pv(o, slot + NSA_KB, s, lane);
      } }
    { const float g0 = p.gates[trow * 24 + hg * 3];
#pragma unroll
      for (int r = 0; r < 16; ++r) { obuf[r * 64] = g0 * o[0][r]; obuf[(16 + r) * 64] = g0 * o[1][r]; o[0][r] = 0.f; o[1][r] = 0.f; } }
    unsigned long long U = 0ull, mym = 0ull;
    __builtin_amdgcn_s_waitcnt(0xc07f);
    {
      const bool forced = lane0 == 0 || lane0 == j0 || lane0 == j0 - 1;
#pragma unroll
      for (int i2 = 0; i2 < 8; ++i2) { const float v = imp[(wid * 8 + i2) * 64 + lane0]; imp[(wid * 8 + i2) * 64 + lane0] = lane0 <= j0 ? (forced ? v + 1e4f : v) : -1.f; }
      __builtin_amdgcn_s_waitcnt(0xc07f);
      const int lane0_ = lane0;
#pragma unroll 1
      for (int i2 = 0; i2 < 8; ++i2) {
        const LAS float* row = imp + (wid * 8 + i2) * 64;
        int lane0 = lane0_; asm volatile("" : "+v"(lane0));
        const float mv = row[lane0]; int rank = 0;
#pragma unroll
        for (int j4 = 0; j4 < 16; ++j4) { const f32x4 v = *(const LAS f32x4*)(row + 4 * j4);
          rank += (v.x > mv || (v.x == mv && 4 * j4 < lane0)) ? 1 : 0; rank += (v.y > mv || (v.y == mv && 4 * j4 + 1 < lane0)) ? 1 : 0;
          rank += (v.z > mv || (v.z == mv && 4 * j4 + 2 < lane0)) ? 1 : 0; rank += (v.w > mv || (v.w == mv && 4 * j4 + 3 < lane0)) ? 1 : 0; }
        const unsigned long long msk = __ballot(rank < 8);
        U |= msk; if (((lane0 & 31) >> 2) == i2) mym = msk;
      } }
    float m = -1e30f, l = 0.f;
#define NSA_ONLINE(MINE, LOWPOS, JB) do { \
      f32x16 s[2]; nsa_qk(s, slot, qf, l31, h); \
      const int tmin_ = t0 + wid * 8, tmax_ = tmin_ + 7; \
      const bool interior_ = (64 * (JB) + 63 <= tmin_) && (64 * (JB) > tmax_ - 512 || (LOWPOS) < 0);     \
      float mx = -1e30f, rs = 0.f, mn, alpha; \
      if (interior_) { \
        _Pragma("unroll") for (int r = 0; r < 16; ++r) mx = fmaxf(mx, fmaxf(s[0][r], s[1][r])); \
        mx = xmax32(mx); \
        mn = ((MINE) && mx > m + 8.f) ? mx : m; alpha = fexp(m - mn);         \
        const float me_ = (MINE) ? mn : 1e30f;                        \
        _Pragma("unroll") for (int r = 0; r < 16; ++r) { const float p0 = fexp(s[0][r] - me_), p1 = fexp(s[1][r] - me_); s[0][r] = p0; s[1][r] = p1; rs += p0 + p1; } \
      } else { \
        unsigned ok0 = 0u, ok1 = 0u; \
        _Pragma("unroll") for (int r = 0; r < 16; ++r) { const int pos = 64 * (JB) + (r & 3) + 8 * (r >> 2) + 4 * h; if ((MINE) && pos <= t && pos > (LOWPOS)) ok0 |= 1u << r; if ((MINE) && pos + 32 <= t && pos + 32 > (LOWPOS)) ok1 |= 1u << r; } \
        _Pragma("unroll") for (int r = 0; r < 16; ++r) { if ((ok0 >> r) & 1u) mx = fmaxf(mx, s[0][r]); if ((ok1 >> r) & 1u) mx = fmaxf(mx, s[1][r]); } \
        mx = xmax32(mx); \
        mn = fmaxf(m, mx); alpha = fexp(m - mn); \
        _Pragma("unroll") for (int r = 0; r < 16; ++r) { const float p0 = ((ok0 >> r) & 1u) ? fexp(s[0][r] - mn) : 0.f, p1 = ((ok1 >> r) & 1u) ? fexp(s[1][r] - mn) : 0.f; s[0][r] = p0; s[1][r] = p1; rs += p0 + p1; } \
      } \
      rs = xsum32(rs); \
      l = l * alpha + rs; \
      if (__any(mn != m)) { _Pragma("unroll") for (int r = 0; r < 16; ++r) { o[0][r] *= alpha; o[1][r] *= alpha; } } \
      m = mn; \
      nsa_pv(o, slot + NSA_KB, s, lane); } while (0)
    for (; it < itD; ++it) {
      NSA_STEP();
      const int j = it - itC;
      if ((U >> j) & 1ull) { const bool mine = (mym >> j) & 1ull; NSA_ONLINE(mine, -1, j); }
    }
    { const float f = p.gates[trow * 24 + hg * 3 + 1] / fmaxf(l, 1e-20f);
#pragma unroll
      for (int r = 0; r < 16; ++r) { obuf[r * 64] += f * o[0][r]; obuf[(16 + r) * 64] += f * o[1][r]; o[0][r] = 0.f; o[1][r] = 0.f; }
      m = -1e30f; l = 0.f; }
    for (; it < NI; ++it) {
      NSA_STEP();
      const int j = jw0 + it - itD;
      NSA_ONLINE(true, t - 512, j);
    }
#undef NSA_ONLINE
#undef NSA_STEP
#undef NSA_ISSUE
    asm volatile("s_waitcnt vmcnt(0)" ::: "memory");
    { const float f = p.gates[trow * 24 + hg * 3 + 2] / fmaxf(l, 1e-20f);
      bf16_t* orow = p.onsab + trow * 512 + hg * 64 + 4 * (lane0 >> 5);
#pragma unroll
      for (int dt = 0; dt < 2; ++dt)
#pragma unroll
        for (int a = 0; a < 4; ++a) { u32x2 w; const int r = 4 * a;
          w.x = pk2(obuf[(16 * dt + r) * 64] + f * o[dt][r], obuf[(16 * dt + r + 1) * 64] + f * o[dt][r + 1]); w.y = pk2(obuf[(16 * dt + r + 2) * 64] + f * o[dt][r + 2], obuf[(16 * dt + r + 3) * 64] + f * o[dt][r + 3]);
          *(u32x2*)(orow + dt * 32 + a * 8) = w; } }
    __syncthreads();
  }
}

__device__ __forceinline__ float ret_logg2(int h) { return logf(1.f - exp2f(-5.f - (float)h)); }
struct WLkminRows {
  typedef XRegB16<128> Regs; const bf16_t* rowp[1];
  __device__ __forceinline__ void load(Regs& R, int k0, int tid) const { xload_b16<128>(R, rowp, k0, tid); }
  __device__ __forceinline__ void store(const Regs& R, lptr img, int, int tid) const { xstore_b16<128>(R, img, tid); }
};
struct XLcmp {
  struct Regs { u32x4 r; }; const bf16_t* src; const float* pe; lptr ximg;
  __device__ __forceinline__ void load(Regs& R, int k0, int tid) const {
    if (tid < 256) { const int l = k0 >> 6, d0 = (k0 & 63) + (tid & 3) * 8;
      const u32x4 v = *(const u32x4*)(src + (size_t)l * PJW + (k0 & 63));
      const f32x4 p0 = *(const f32x4*)(pe + l * 64 + d0), p1 = *(const f32x4*)(pe + l * 64 + d0 + 4);
      R.r.x = pk2(bflo(v.x) + p0.x, bfhi(v.x) + p0.y); R.r.y = pk2(bflo(v.y) + p0.z, bfhi(v.y) + p0.w);
      R.r.z = pk2(bflo(v.z) + p1.x, bfhi(v.z) + p1.y); R.r.w = pk2(bflo(v.w) + p1.z, bfhi(v.w) + p1.w); }
  }
  __device__ __forceinline__ void store(const Regs& R, int tid) const { if (tid < 256) *(LAS u32x4*)(ximg + kmin_off(tid >> 2, tid & 3)) = R.r; }
  __device__ __forceinline__ lptr img(int) const { return ximg; }
};
struct XLretk {
  struct Regs { u32x4 r; }; const bf16_t* src; float lg; lptr ximg;
  __device__ __forceinline__ void load(Regs& R, int k0, int tid) const {
    const u32x4 v = *(const u32x4*)(src + (size_t)k0 * PJW);
    const float z = __expf(lg * (float)(127 - k0 - (tid >> 4)));
    R.r.x = pk2(bflo(v.x) * z, bfhi(v.x) * z); R.r.y = pk2(bflo(v.y) * z, bfhi(v.y) * z); R.r.z = pk2(bflo(v.z) * z, bfhi(v.z) * z); R.r.w = pk2(bflo(v.w) * z, bfhi(v.w) * z);
  }
  __device__ __forceinline__ void store(const Regs& R, int tid) const { *(LAS u32x4*)(ximg + (tid >> 4) * 320 + (tid & 15) * 16) = R.r; }
  __device__ __forceinline__ lptr img(int) const { return ximg; }
};
__device__ __forceinline__ void phase_r1(const P& p, lptr lds, int vcu, int G) {
  const int tid = threadIdx.x, wid = __builtin_amdgcn_readfirstlane(tid >> 6), lane = tid & 63, h = lane >> 5, l31 = lane & 31;
  lptr wimg = lds, ximg = lds + 16 * 1024;
  for (int u = vcu; u < 256 + 512; u += G) {
    if (u < 256) {
      const int isv = u >> 7, rt = (u >> 2) & 31, kq = u & 3, wn = wid >> 1, wt = wid & 1;
      f32x16 acc[1][1]; acc_zero<1, 1>(acc);
      WLb16<128> wl; wl.src = (isv ? p.cw1vb : p.cw1kb) + (size_t)kq * 512 * 128; wl.ld = 128;
      XLcmp xl; { int r = rt * 64 + ((tid >> 2) & 63); r = r < NCR ? r : NCR - 1; const int b = r / (2 * NC), g = (r / NC) & 1, c = r % NC;
        xl.src = p.projb + (size_t)(b * SEQ + 16 * c + kq * 8) * PJW + (isv ? J_VC : J_KC) + g * 64 + (tid & 3) * 8; xl.pe = (isv ? p.cpv : p.cpk) + kq * 512; xl.ximg = ximg; }
      gemm_loop<1, 1>(acc, 512, wl, xl, wimg, 128 * 2 + 64, wn * 32, wt * 32, tid, lane);
      int row = rt * 64 + wt * 32 + l31, nb = wn * 32 + 4 * h; asm volatile("" : "+v"(row), "+v"(nb));
      if (row < NCR) { float* o = p.hidp + (((size_t)(isv * 4 + kq) * 2048 + row) * 128) + nb;
#pragma unroll
        for (int a = 0; a < 4; ++a) { f32x4 v = {acc[0][0][4 * a], acc[0][0][4 * a + 1], acc[0][0][4 * a + 2], acc[0][0][4 * a + 3]}; *(f32x4*)(o + a * 8) = v; } }
    } else {
      const int chunk = u - 256, bh = chunk >> 5, b = bh >> 2, hh = bh & 3, s0 = (chunk & 31) * 128, wn = wid >> 1, wt = wid & 1;
      f32x16 acc[1][2]; acc_zero<1, 2>(acc);
      const bf16_t* base = p.projb + (size_t)(b * SEQ + s0) * PJW + hh * 128;
      WLb16<128> wl; wl.src = base + J_VR; wl.ld = PJW;
      XLretk xl; xl.src = base + J_KR + (size_t)(tid >> 4) * PJW + (tid & 15) * 8; xl.lg = ret_logg2(hh); xl.ximg = ximg;
      gemm_loop<1, 2, WLb16<128>, XLretk, true, true>(acc, 128, wl, xl, wimg, 128 * 2 + 64, wn * 32, wt * 64, tid, lane, 320);
      int dcol = wt * 64 + l31, nb = wn * 32 + 4 * h; asm volatile("" : "+v"(dcol), "+v"(nb));
#pragma unroll
      for (int tn = 0; tn < 2; ++tn) { float* o = p.kv + ((size_t)chunk * 128 + dcol + tn * 32) * 128 + nb;
#pragma unroll
        for (int a = 0; a < 4; ++a) { f32x4 v = {acc[0][tn][4 * a], acc[0][tn][4 * a + 1], acc[0][tn][4 * a + 2], acc[0][tn][4 * a + 3]}; *(f32x4*)(o + a * 8) = v; } }
    }
  }
}
__device__ __forceinline__ void phase_r2(const P& p, lptr lds, int vcu, int G) {
  const int tid = threadIdx.x;
  LAS float* hs = (LAS float*)lds;
  LAS float* os = hs + 1024;
  const LAS float* inv64 = (const LAS float*)(lds + LDS_INV64);
  for (int u = vcu; u < 2 * 255; u += G) {
    const int isv = u >= 255, r0 = (isv ? u - 255 : u) * 8;
    { const int i = tid, row = r0 + (i >> 7), k = i & 127;
#pragma unroll
      for (int q = 0; q < 2; ++q) { const int rr = row + 4 * q; float a = 0.f;
#pragma unroll
        for (int kq = 0; kq < 4; ++kq) a += p.hidp[((size_t)(isv * 4 + kq) * 2048 + rr) * 128 + k];
        hs[(rr - r0) * 128 + k] = gelu_tanh(a); } }
    __syncthreads();
    { const int rl = tid >> 6, n = tid & 63; const float* w2 = isv ? p.cw2v : p.cw2k; float a = 0.f;
#pragma unroll 8
      for (int k = 0; k < 128; ++k) a += hs[rl * 128 + k] * w2[k * 64 + n];
      os[rl * 64 + n] = a; }
    __syncthreads();
    { const int rl = tid >> 6, n = tid & 63, row = r0 + rl; float y = os[rl * 64 + n];
      if (!isv) { const int b = row / (2 * NC), c = row % NC, i = n & 31;
        const float fr = __builtin_amdgcn_fractf((float)p.pos[b * SEQ + 16 * c + 31] * inv64[i]);
        const float sn = __builtin_amdgcn_sinf(fr), cs = __builtin_amdgcn_cosf(fr), x1 = os[rl * 64 + i], x2 = os[rl * 64 + i + 32];
        y = n < 32 ? x1 * cs - x2 * sn : x1 * sn + x2 * cs; }
      (isv ? p.vcmpb : p.kcmpb)[(size_t)row * 64 + n] = (bf16_t)(pk2(y, 0.f) & 0xffffu); }
    __syncthreads();
  }
  for (int id = vcu * 512 + tid; id < 16 * 16384; id += G * 512) {
    const int bh = id >> 14, de = id & 16383; const float gc = __expf(ret_logg2(bh & 3) * 128.f);
    float v[32];
#pragma unroll
    for (int n = 0; n < 32; ++n) v[n] = p.kv[(size_t)(bh * 32 + n) * 16384 + de];
    float st = 0.f;
#pragma unroll
    for (int n = 0; n < 32; ++n) { p.stateb[(size_t)(bh * 32 + n) * 16384 + de] = (bf16_t)(pk2(st, 0.f) & 0xffffu); st = st * gc + v[n]; }
  }
}
__device__ __forceinline__ void phase_r3(const P& p, lptr lds, int vcu, int G) {
  const int tid = threadIdx.x, wid = __builtin_amdgcn_readfirstlane(tid >> 6), lane = tid & 63, h = lane >> 5, l31 = lane & 31, wn = wid >> 2, wt = wid & 3;
  lptr wimg = lds, ximg = lds + 12 * 1024, scb = lds + 20 * 1024;
  LAS float* part = (LAS float*)(lds + 52 * 1024);
  for (int chunk = vcu; chunk < 512; chunk += G) {
    const int bh = chunk >> 5, b = bh >> 2, hh = bh & 3, s0 = (chunk & 31) * 128; const float lg = ret_logg2(hh);
    const bf16_t* base = p.projb + (size_t)(b * SEQ + s0) * PJW + hh * 128;
    f32x16 acc[2][1];
    acc_zero<2, 1>(acc);
    { WLkminRows wl; wl.rowp[0] = base + J_KR + (size_t)((tid >> 2) & 127) * PJW;
      XLrows<128> xl; xl.rowp[0] = base + J_QR + (size_t)((tid >> 2) & 127) * PJW; xl.ximg = ximg;
      gemm_loop<2, 1, WLkminRows, XLrows<128>, false, false>(acc, 128, wl, xl, wimg, 0, wn * 64, wt * 32, tid, lane); }
    { int i = wt * 32 + l31, jb = wn * 64 + 4 * h; asm volatile("" : "+v"(i), "+v"(jb));
#pragma unroll
      for (int tm = 0; tm < 2; ++tm)
#pragma unroll
        for (int a = 0; a < 4; ++a) { const int j = jb + tm * 32 + a * 8; float o[4];
#pragma unroll
          for (int q = 0; q < 4; ++q) o[q] = i >= j + q ? acc[tm][0][4 * a + q] * __expf(lg * (float)(i - j - q)) : 0.f;
          u32x2 w; w.x = pk2(o[0], o[1]); w.y = pk2(o[2], o[3]);
          *(LAS u32x2*)(scb + (j >> 5) * 8192 + kmin_off(i, (j & 31) >> 3) + (j & 7) * 2) = w; } }
    __syncthreads();
    acc_zero<2, 1>(acc);
    { WLb16<128> wl; wl.src = p.stateb + (size_t)chunk * 16384; wl.ld = 128;
      XLrows<128> xl; xl.rowp[0] = base + J_QR + (size_t)((tid >> 2) & 127) * PJW; xl.ximg = ximg;
      gemm_loop<2, 1>(acc, 128, wl, xl, wimg, 128 * 2 + 64, wn * 64, wt * 32, tid, lane); }
    { const float xi = __expf(lg * (float)(wt * 32 + l31 + 1));
#pragma unroll
      for (int tm = 0; tm < 2; ++tm)
#pragma unroll
        for (int r = 0; r < 16; ++r) acc[tm][0][r] *= xi; }
    { WLb16<128> wl; wl.src = base + J_VR; wl.ld = PJW;
      XLres xl; xl.base = scb; xl.bytes = 8192;
      gemm_loop<2, 1>(acc, 128, wl, xl, wimg, 128 * 2 + 64, wn * 64, wt * 32, tid, lane); }
    { float ss = 0.f;
#pragma unroll
      for (int tm = 0; tm < 2; ++tm)
#pragma unroll
        for (int r = 0; r < 16; ++r) ss += acc[tm][0][r] * acc[tm][0][r];
      ss += __shfl_xor(ss, 32);
      if (h == 0) part[wn * 128 + wt * 32 + l31] = ss; }
    __syncthreads();
    { int i = wt * 32 + l31, eb = wn * 64 + 4 * h; asm volatile("" : "+v"(i), "+v"(eb));
      const float rs = rsqrtf((part[i] + part[128 + i]) * (1.f / 128.f) + EPS);
      const size_t trow = (size_t)(b * SEQ + s0 + i);
#pragma unroll
      for (int tm = 0; tm < 2; ++tm)
#pragma unroll
        for (int a = 0; a < 4; ++a) { const int e = eb + tm * 32 + a * 8;
          const f32x4 gr = *(const f32x4*)(p.g_ret + hh * 128 + e); const u32x2 gt = *(const u32x2*)(p.projb + trow * PJW + J_GR + hh * 128 + e);
          u32x2 w; w.x = pk2(acc[tm][0][4 * a] * rs * gr.x * bflo(gt.x), acc[tm][0][4 * a + 1] * rs * gr.y * bfhi(gt.x));
          w.y = pk2(acc[tm][0][4 * a + 2] * rs * gr.z * bflo(gt.y), acc[tm][0][4 * a + 3] * rs * gr.w * bfhi(gt.y));
          *(u32x2*)(p.mixb + trow * D + 512 + hh * 128 + e) = w; } }
    __syncthreads();
  }
  for (int tok = vcu * 8 + wid; tok < T; tok += G * 8) {
    const u32x4 v = *(const u32x4*)(p.onsab + (size_t)tok * 512 + lane * 8);
    float x[8] = {bflo(v.x), bfhi(v.x), bflo(v.y), bfhi(v.y), bflo(v.z), bfhi(v.z), bflo(v.w), bfhi(v.w)};
    float ss = 0.f;
#pragma unroll
    for (int q = 0; q < 8; ++q) ss += x[q] * x[q];
    ss = wave_sum(ss);
    const float rs = rsqrtf(ss * (1.f / 512.f) + EPS);
    const f32x4 g0 = *(const f32x4*)(p.g_nsa + lane * 8), g1 = *(const f32x4*)(p.g_nsa + lane * 8 + 4);
    u32x4 w; w.x = pk2(x[0] * rs * g0.x, x[1] * rs * g0.y); w.y = pk2(x[2] * rs * g0.z, x[3] * rs * g0.w); w.z = pk2(x[4] * rs * g1.x, x[5] * rs * g1.y); w.w = pk2(x[6] * rs * g1.z, x[7] * rs * g1.w);
    *(u32x4*)(p.mixb + (size_t)tok * D + lane * 8) = w;
  }
}

__device__ __forceinline__ void phase5a(const P& p, lptr lds, int vcu, int G) {
  const int tid = threadIdx.x, wid = __builtin_amdgcn_readfirstlane(tid >> 6), lane = tid & 63, wn = wid >> 2, wt = wid & 3;
  for (int u = vcu; u < 4 * 64; u += G) {
    const int j = u & 3, t0 = (u >> 2) * 256, b = t0 / SEQ;
    f32x16 acc[4][2];
    { const bf16_t* wb = p.woutb + j * 256; const bf16_t* xb = p.mixb + (size_t)t0 * D;
      gemm256_dma(acc, wb + (size_t)g2_wrow(wid, 0, lane) * D + g2_wcol(wid, 0, lane), wb + (size_t)g2_wrow(wid, 1, lane) * D + g2_wcol(wid, 1, lane), (size_t)32 * D,
                  xb + (size_t)g2_xtok(wid, 0, lane) * D + g2_xk(wid, 0, lane), xb + (size_t)g2_xtok(wid, 1, lane) * D + g2_xk(wid, 1, lane), D, lds, wn, wt, wid, lane); }
    int nb = j * 256 + wn * 128 + 4 * (lane >> 5), tb = t0 + wt * 64 + (lane & 31); asm volatile("" : "+v"(nb), "+v"(tb));
#pragma unroll
    for (int tn = 0; tn < 2; ++tn)
#pragma unroll
      for (int tm = 0; tm < 4; ++tm) {
#pragma unroll
        for (int a = 0; a < 4; ++a) { const int n = nb + tm * 32 + a * 8; const size_t o = (size_t)(tb + tn * 32) * D + n;
          const f32x4 xv = *(const f32x4*)(p.x + o), gt = *(const f32x4*)(p.mod + b * 6144 + 2048 + n);
          f32x4 v; v.x = xv.x + gt.x * acc[tm][tn][4 * a]; v.y = xv.y + gt.y * acc[tm][tn][4 * a + 1]; v.z = xv.z + gt.z * acc[tm][tn][4 * a + 2]; v.w = xv.w + gt.w * acc[tm][tn][4 * a + 3];
          *(f32x4*)(p.x1 + o) = v; }
        __builtin_amdgcn_sched_barrier(0);
      }
  }
}
__device__ __forceinline__ void phase5b(const P& p, lptr lds, int vcu, int G) {
  const int tid = threadIdx.x, wid = tid >> 6, lane = tid & 63;
  for (int row = vcu * 8 + wid; row < T; row += G * 8) {
    const int b = row / SEQ;
    f32x4 v[4]; float s = 0.f;
#pragma unroll
    for (int j = 0; j < 4; ++j) { v[j] = *(const f32x4*)(p.x1 + (size_t)row * D + j * 256 + lane * 4); s += v[j].x * v[j].x + v[j].y * v[j].y + v[j].z * v[j].z + v[j].w * v[j].w; }
    s = wave_sum(s);
    const float r = rsqrtf(s * (1.f / D) + EPS);
#pragma unroll
    for (int j = 0; j < 4; ++j) {
      const int k = j * 256 + lane * 4;
      const f32x4 g = *(const f32x4*)(p.g_ffn + k), sc = *(const f32x4*)(p.mod + b * 6144 + 4096 + k), sh = *(const f32x4*)(p.mod + b * 6144 + 3072 + k);
      u32x2 o; o.x = pk2(v[j].x * r * g.x * (1.f + sc.x) + sh.x, v[j].y * r * g.y * (1.f + sc.y) + sh.y); o.y = pk2(v[j].z * r * g.z * (1.f + sc.z) + sh.z, v[j].w * r * g.w * (1.f + sc.w) + sh.w);
      *(u32x2*)(p.h2b + (size_t)row * D + k) = o;
    }
  }
}
__device__ __forceinline__ void phase5c(const P& p, lptr lds, int vcu, int G) {
  const int tid = threadIdx.x, wid = __builtin_amdgcn_readfirstlane(tid >> 6), lane = tid & 63, wn = wid >> 2, wt = wid & 3;
  for (int u = vcu; u < 3 * 64; u += G) {
    const int j = u % 3, t0 = (u / 3) * 256;
    f32x16 acc[4][2];
    { const bf16_t* xb = p.h2b + (size_t)t0 * D; const bf16_t* wq[2];
#pragma unroll
      for (int i = 0; i < 2; ++i) { const int k = g2_wrow(wid, i, lane), col = g2_wcol(wid, i, lane);
        if (j == 0) wq[i] = p.wrb + (size_t)k * NE + col;
        else { const int grp = col >> 7, w = col & 127; const unsigned long long ga = (unsigned long long)p.wgsb, ua = (unsigned long long)p.wusb;
          wq[i] = (const bf16_t*)(w < 64 ? ga : ua) + (size_t)k * 256 + (j - 1) * 128 + grp * 64 + (w & 63); } }
      gemm256_dma(acc, wq[0], wq[1], (size_t)32 * 256, xb + (size_t)g2_xtok(wid, 0, lane) * D + g2_xk(wid, 0, lane), xb + (size_t)g2_xtok(wid, 1, lane) * D + g2_xk(wid, 1, lane), D, lds, wn, wt, wid, lane); }
    int h4 = 4 * (lane >> 5), tb = t0 + wt * 64 + (lane & 31); asm volatile("" : "+v"(h4), "+v"(tb));
    if (j == 0) {
#pragma unroll
      for (int tn = 0; tn < 2; ++tn)
#pragma unroll
        for (int tm = 0; tm < 4; ++tm)
#pragma unroll
          for (int a = 0; a < 4; ++a) { f32x4 v = {acc[tm][tn][4 * a], acc[tm][tn][4 * a + 1], acc[tm][tn][4 * a + 2], acc[tm][tn][4 * a + 3]};
            *(f32x4*)(p.logits + (size_t)(tb + tn * 32) * NE + wn * 128 + tm * 32 + a * 8 + h4) = v; }
    } else {
#pragma unroll
      for (int tn = 0; tn < 2; ++tn)
#pragma unroll
        for (int tm = 0; tm < 2; ++tm)
#pragma unroll
          for (int a = 0; a < 4; ++a) { float o[4];
#pragma unroll
            for (int q = 0; q < 4; ++q) { const float gv = acc[tm][tn][4 * a + q], uv = acc[tm + 2][tn][4 * a + q]; o[q] = gv * __builtin_amdgcn_rcpf(1.f + __builtin_amdgcn_exp2f(-1.4426950408889634f * gv)) * uv; }
            u32x2 w; w.x = pk2(o[0], o[1]); w.y = pk2(o[2], o[3]);
            *(u32x2*)(p.actsb + (size_t)(tb + tn * 32) * 256 + (j - 1) * 128 + wn * 64 + tm * 32 + a * 8 + h4) = w; }
    }
  }
}
__device__ __forceinline__ void phase5d(const P& p, lptr lds, int vcu, int G) {
  const int tid = threadIdx.x, wid = __builtin_amdgcn_readfirstlane(tid >> 6), lane = tid & 63, wn = wid >> 2, wt = wid & 3;
  { const f32x4 rb = *(const f32x4*)(p.rbias + lane * 4);
    for (int tok = vcu * 8 + wid; tok < T; tok += G * 8) {
      const f32x4 lv = *(const f32x4*)(p.logits + (size_t)tok * NE + lane * 4);
      const float s0 = sigm(lv.x), s1 = sigm(lv.y), s2 = sigm(lv.z), s3 = sigm(lv.w);
      float c0 = s0 + rb.x, c1 = s1 + rb.y, c2 = s2 + rb.z, c3 = s3 + rb.w;
      float m1, m2;
      { const float h1 = fmaxf(c0, c1), l1 = fminf(c0, c1), h2 = fmaxf(c2, c3), l2 = fminf(c2, c3); m1 = fmaxf(h1, h2); m2 = fmaxf(fminf(h1, h2), fmaxf(l1, l2)); }
#define TOP2_MERGE(ctrl) { const float o1 = DPPF(m1, ctrl, 0xf), o2 = DPPF(m2, ctrl, 0xf); const float n1 = fmaxf(m1, o1), n2 = fmaxf(fminf(m1, o1), fmaxf(m2, o2)); m1 = n1; m2 = n2; }
      TOP2_MERGE(0xb1) TOP2_MERGE(0x4e) TOP2_MERGE(0x141)
#undef TOP2_MERGE
      const float gs = m1 + m2; const int myg = lane >> 3; int rank = 0;
#pragma unroll
      for (int g2 = 0; g2 < 8; ++g2) { const float og = __int_as_float(__builtin_amdgcn_readlane(__float_as_int(gs), g2 * 8)); rank += (og > gs || (og == gs && g2 < myg)) ? 1 : 0; }
      if (rank >= 4) { c0 = -INFINITY; c1 = -INFINITY; c2 = -INFINITY; c3 = -INFINITY; }
      int my_e = 0; float my_s = 0.f, wsum = 0.f;
#pragma unroll
      for (int k = 0; k < 8; ++k) {
        const float mx = wave_max_u(fmaxf(fmaxf(c0, c1), fmaxf(c2, c3)));
        const unsigned long long b0 = __ballot(c0 == mx), b1 = __ballot(c1 == mx), b2 = __ballot(c2 == mx), b3 = __ballot(c3 == mx);
        int li = 1 << 20;
        if (b0) li = min(li, 4 * (int)__builtin_ctzll(b0));
        if (b1) li = min(li, 4 * (int)__builtin_ctzll(b1) + 1);
        if (b2) li = min(li, 4 * (int)__builtin_ctzll(b2) + 2);
        if (b3) li = min(li, 4 * (int)__builtin_ctzll(b3) + 3);
        li = __builtin_amdgcn_readfirstlane(li);
        const int jx = li & 3; const float sj = jx == 0 ? s0 : jx == 1 ? s1 : jx == 2 ? s2 : s3;
        const float sv = __int_as_float(__builtin_amdgcn_readlane(__float_as_int(sj), li >> 2));
        if (lane * 4 == li) c0 = -INFINITY;
        if (lane * 4 + 1 == li) c1 = -INFINITY;
        if (lane * 4 + 2 == li) c2 = -INFINITY;
        if (lane * 4 + 3 == li) c3 = -INFINITY;
        wsum += sv;
        if (lane == k) { my_e = li; my_s = sv; }
      }
      if (lane < 8) { const int pos = atomicAdd(&p.cnt[my_e * CPAD], 1); p.list[my_e * ECAP + pos] = tok * 8 + lane; p.wts[tok * 8 + lane] = my_s / wsum * 2.5f; }
    } }
  __syncthreads();
  for (int u = vcu; u < 4 * 64; u += G) {
    const int j = u & 3, t0 = (u >> 2) * 256, b = t0 / SEQ;
    f32x16 acc[4][2];
    { const bf16_t* wb = p.wdsb + j * 256; const bf16_t* xb = p.actsb + (size_t)t0 * 256;
      gemm256_dma(acc, wb + (size_t)g2_wrow(wid, 0, lane) * D + g2_wcol(wid, 0, lane), wb + (size_t)g2_wrow(wid, 1, lane) * D + g2_wcol(wid, 1, lane), (size_t)32 * D,
                  xb + (size_t)g2_xtok(wid, 0, lane) * 256 + g2_xk(wid, 0, lane), xb + (size_t)g2_xtok(wid, 1, lane) * 256 + g2_xk(wid, 1, lane), 256, lds, wn, wt, wid, lane); }
    int nb = j * 256 + wn * 128 + 4 * (lane >> 5), tb = t0 + wt * 64 + (lane & 31); asm volatile("" : "+v"(nb), "+v"(tb));
#pragma unroll
    for (int tn = 0; tn < 2; ++tn)
#pragma unroll
      for (int tm = 0; tm < 4; ++tm)
#pragma unroll
        for (int a = 0; a < 4; ++a) { u32x2 w; w.x = pk2(acc[tm][tn][4 * a], acc[tm][tn][4 * a + 1]); w.y = pk2(acc[tm][tn][4 * a + 2], acc[tm][tn][4 * a + 3]);
          *(u32x2*)(p.ysb + (size_t)(tb + tn * 32) * D + nb + tm * 32 + a * 8) = w; }
  }
}

constexpr int NPHASE = 13;
__global__ void __launch_bounds__(512) mega(P p, int lo, int hi) {
  extern __shared__ __attribute__((aligned(16))) char lds_raw[];
  lptr lds = (lptr)lds_raw;
  const int tid = threadIdx.x, G = gridDim.x;
  const int vcu = (G % 8 == 0) ? ((int)blockIdx.x % 8) * (G / 8) + (int)blockIdx.x / 8 : (int)blockIdx.x;
  if (tid < 32) ((LAS float*)(lds + LDS_INV64))[tid] = exp2f(-(float)(2 * tid) / 64.f * 13.287712379549449f) * 0.15915494309189535f;
  if (tid < 64) ((LAS float*)(lds + LDS_INV128))[tid] = exp2f(-(float)(2 * tid) / 128.f * 13.287712379549449f) * 0.15915494309189535f;
  if (tid < 4) ((LAS unsigned*)(lds + LDS_XB))[tid] = 0u;
  __syncthreads();
  XcdBarrier xb; xb.bar = p.bar; xb.x = 0; xb.st = (volatile LAS unsigned*)(lds + LDS_XB);
  if (hi - lo > 1) xb = xcd_barrier_post(p.bar, (volatile LAS unsigned*)(lds + LDS_XB));
#define PH(k, call) if (lo <= (k) && (k) < hi) { call; if ((k) + 1 < hi) xcd_barrier(xb); }
  PH(0, phase0a(p, lds, vcu, G));
  PH(1, phase0b(p, lds, vcu, G));
  PH(2, phase1(p, lds, vcu, G));
  PH(3, phase_r1(p, lds, vcu, G));
  PH(4, phase_r2(p, lds, vcu, G));
  PH(5, phase_nsa(p, lds, vcu, G));
  PH(6, phase_r3(p, lds, vcu, G));
  PH(7, phase5a(p, lds, vcu, G));
  PH(8, phase5b(p, lds, vcu, G));
  PH(9, phase5c(p, lds, vcu, G));
  PH(10, phase5d(p, lds, vcu, G));
  PH(11, phase6(p, lds, vcu, G));
  PH(12, phase7(p, lds, vcu, G));
#undef PH
}
}

extern "C" void kernel_launch(void* const* d_in, const int* in_sizes, int n_in, void* d_out, int out_size, void* d_ws, size_t ws_size, hipStream_t stream) {
  P p{};
  p.x = (const float*)d_in[0]; p.c = (const float*)d_in[1]; p.pos = (const int*)d_in[2];
  p.w_ada = (const float*)d_in[3]; p.b_ada = (const float*)d_in[4]; p.g_mix = (const float*)d_in[5]; p.w_in = (const float*)d_in[6];
  p.cpk = (const float*)d_in[7]; p.cw1k = (const float*)d_in[8]; p.cw2k = (const float*)d_in[9];
  p.cpv = (const float*)d_in[10]; p.cw1v = (const float*)d_in[11]; p.cw2v = (const float*)d_in[12];
  p.g_nsa = (const float*)d_in[13]; p.g_ret = (const float*)d_in[14]; p.w_out = (const float*)d_in[15]; p.g_ffn = (const float*)d_in[16];
  p.w_router = (const float*)d_in[17]; p.rbias = (const float*)d_in[18]; p.wg_e = (const float*)d_in[19]; p.wu_e = (const float*)d_in[20];
  p.wd_e = (const float*)d_in[21]; p.wg_s = (const float*)d_in[22]; p.wu_s = (const float*)d_in[23]; p.wd_s = (const float*)d_in[24];
  p.g_final = (const float*)d_in[25];
  p.out = (float*)d_out;
  char* w = (char*)d_ws; size_t off = 0;
  auto take = [&](size_t bytes) { char* r = w + off; off += (bytes + 255) & ~(size_t)255; return r; };
  p.bar = (unsigned*)take(XCD_BAR_WORDS * 4);
  p.cnt = (int*)take(NE * CPAD * 4);
  const size_t zero_bytes = off;
  p.mod = (float*)take(BATCH * 6144 * 4);
  p.hidp = (float*)take((size_t)8 * 2048 * 128 * 4);
  p.kv = (float*)take((size_t)512 * 16384 * 4);
  p.stateb = (bf16_t*)take((size_t)512 * 16384 * 2);
  p.logits = (float*)take((size_t)T * NE * 4); p.actsb = (bf16_t*)take((size_t)T * 256 * 2); p.ysb = (bf16_t*)take((size_t)T * D * 2);
  p.x1 = (float*)take((size_t)T * D * 4);
  p.wts = (float*)take((size_t)T * 8 * 4);
  p.list = (int*)take((size_t)NE * ECAP * 4);
  p.gates = (float*)take((size_t)T * 24 * 4);
  p.winb = (bf16_t*)take((size_t)D * INW * 2); p.woutb = (bf16_t*)take((size_t)D * D * 2); p.wrb = (bf16_t*)take((size_t)D * NE * 2);
  p.wgsb = (bf16_t*)take((size_t)D * 256 * 2); p.wusb = (bf16_t*)take((size_t)D * 256 * 2); p.wdsb = (bf16_t*)take((size_t)256 * D * 2);
  p.cw1kb = (bf16_t*)take(2048 * 128 * 2); p.cw1vb = (bf16_t*)take(2048 * 128 * 2); p.cw2kb = (bf16_t*)take(128 * 64 * 2); p.cw2vb = (bf16_t*)take(128 * 64 * 2);
  p.hb = (bf16_t*)take((size_t)T * D * 2);
  p.projb = (bf16_t*)take((size_t)T * PJW * 2);
  p.mixb = (bf16_t*)take((size_t)T * D * 2); p.h2b = (bf16_t*)take((size_t)T * D * 2);
  p.slab = (bf16_t*)take((size_t)T * 8 * D * 2);
  p.kcmpb = (bf16_t*)take((2048 + 64) * 64 * 2); p.vcmpb = (bf16_t*)take((2048 + 64) * 64 * 2);
  p.onsab = (bf16_t*)take((size_t)T * 512 * 2);
  if (off > ws_size) { fprintf(stderr, "kernel_launch: workspace too small: need %zu have %zu\n", off, ws_size); return; }
  static int grid = 0;
  if (!grid) {
    int dev = 0, cus = 0, per_cu = 0;
    (void)hipGetDevice(&dev);
    (void)hipDeviceGetAttribute(&cus, hipDeviceAttributeMultiprocessorCount, dev);
    (void)hipFuncSetAttribute((const void*)mega, hipFuncAttributeMaxDynamicSharedMemorySize, LDS_BYTES);
    (void)hipOccupancyMaxActiveBlocksPerMultiprocessor(&per_cu, (const void*)mega, 512, LDS_BYTES);
    if (per_cu < 1) fprintf(stderr, "kernel_launch: occupancy query says %d blocks per CU\n", per_cu);
    grid = cus;
  }
  (void)hipMemsetAsync(d_ws, 0, zero_bytes, stream);
  hipLaunchKernelGGL(mega, dim3(grid), dim3(512), LDS_BYTES, stream, p, 0, NPHASE);
}
```

```cpp
#include <hip/hip_runtime.h>
#include <cstdint>
#include <cstdio>

namespace {
constexpr int D = 1024, BATCH = 4, SEQ = 4096, T = BATCH * SEQ;
constexpr int INW = 3352;
constexpr int C_QN = 0, C_KC = 512, C_VC = 640, C_KS = 768, C_VS = 896, C_KW = 1024, C_VW = 1152, C_GN = 1280,
              C_QR = 1304, C_KR = 1816, C_VR = 2328, C_GR = 2840;
constexpr int PJW = 3328, J_QN = 0, J_KC = 512, J_VC = 640, J_KS = 768, J_VS = 896, J_KW = 1024, J_VW = 1152, J_QR = 1280, J_KR = 1792, J_VR = 2304, J_GR = 2816;
constexpr int NC = 255, NCR = BATCH * 2 * NC;
constexpr int NE = 256, ECAP = 16384, CPAD = 32;
constexpr float EPS = 1e-6f;
typedef unsigned short bf16_t;

struct P {
  const float *x, *c; const int* pos;
  const float *w_ada, *b_ada, *g_mix, *w_in, *cpk, *cw1k, *cw2k, *cpv, *cw1v, *cw2v, *g_nsa, *g_ret, *w_out, *g_ffn,
      *w_router, *rbias, *wg_e, *wu_e, *wd_e, *wg_s, *wu_s, *wd_s, *g_final;
  float* out;
  float *mod, *h, *proj, *hidk, *hidv, *kcmp, *vcmp, *onsa, *Sc, *kv, *retout, *mixin, *x1, *logits, *wts, *Gs, *acts,
      *G, *act, *yacc, *gates;
  int *cnt, *list, *tile_e, *tile_off, *ntiles;
  bf16_t *winb, *woutb, *wrb, *wgsb, *wusb, *wdsb, *cw1kb, *cw1vb, *cw2kb, *cw2vb, *hb, *projb, *mixb, *h2b, *slab, *kcmpb, *vcmpb, *onsab, *stateb, *actsb, *ysb, *mixo;
  float *hidp;
  unsigned* bar;
};

#define LAS __attribute__((address_space(3)))
typedef LAS char* lptr;
typedef short bf16x8 __attribute__((ext_vector_type(8)));
typedef short v4i16_t __attribute__((ext_vector_type(4)));
typedef float f32x16 __attribute__((ext_vector_type(16)));
typedef float f32x4 __attribute__((ext_vector_type(4)));
typedef float f32x2_t __attribute__((ext_vector_type(2)));
typedef __bf16 bf16x2_t __attribute__((ext_vector_type(2)));
typedef unsigned u32x4 __attribute__((ext_vector_type(4)));
typedef unsigned u32x2 __attribute__((ext_vector_type(2)));

#define DPPF(x, ctrl, rm) __int_as_float(__builtin_amdgcn_update_dpp(__float_as_int(x), __float_as_int(x), ctrl, rm, 0xf, false))
__device__ __forceinline__ float wave_max_u(float v) {
  v = fmaxf(v, DPPF(v, 0xb1, 0xf)); v = fmaxf(v, DPPF(v, 0x4e, 0xf)); v = fmaxf(v, DPPF(v, 0x124, 0xf)); v = fmaxf(v, DPPF(v, 0x128, 0xf));
  v = fmaxf(v, DPPF(v, 0x142, 0xa)); v = fmaxf(v, DPPF(v, 0x143, 0xc));
  return __int_as_float(__builtin_amdgcn_readlane(__float_as_int(v), 63));
}
__device__ __forceinline__ float wave_sum(float v) {
  v += DPPF(v, 0xb1, 0xf); v += DPPF(v, 0x4e, 0xf); v += DPPF(v, 0x124, 0xf); v += DPPF(v, 0x128, 0xf);
  { const float t = __int_as_float(__builtin_amdgcn_update_dpp(0, __float_as_int(v), 0x142, 0xa, 0xf, false)); v += t; }
  { const float t = __int_as_float(__builtin_amdgcn_update_dpp(0, __float_as_int(v), 0x143, 0xc, 0xf, false)); v += t; }
  return __int_as_float(__builtin_amdgcn_readlane(__float_as_int(v), 63));
}
__device__ __forceinline__ float wave_max(float v) { return wave_max_u(v); }
__device__ __forceinline__ float silu(float v) { return v / (1.f + expf(-v)); }
__device__ __forceinline__ float sigm(float v) { return 1.f / (1.f + expf(-v)); }
__device__ __forceinline__ float gelu_tanh(float v) { return 0.5f * v * (1.f + tanhf(0.7978845608028654f * (v + 0.044715f * v * v * v))); }
__device__ __forceinline__ unsigned pk2(float lo, float hi) { f32x2_t v = {lo, hi}; bf16x2_t b = __builtin_convertvector(v, bf16x2_t); return __builtin_bit_cast(unsigned, b); }
__device__ __forceinline__ float bf2f(bf16_t u) { return __uint_as_float((unsigned)u << 16); }
__device__ __forceinline__ float bflo(unsigned u) { return __uint_as_float(u << 16); }
__device__ __forceinline__ float bfhi(unsigned u) { return __uint_as_float(u & 0xffff0000u); }

#define XB_TMO      128
#define XB_XCNT(j)  (256  + 64 * (j))
#define XB_XSUB(j)  (1280 + 64 * (j))
#define XB_XGEN(j)  (2304 + 64 * (j))
#define XB_TOP      3328
#define XB_TOPGEN   3392
#define XCD_BAR_WORDS 3456
#define XB_SPIN_CAP (1u << 18)
__device__ __forceinline__ unsigned xb_ld(unsigned* p)              { return __hip_atomic_load(p, __ATOMIC_RELAXED, __HIP_MEMORY_SCOPE_AGENT); }
__device__ __forceinline__ unsigned xb_add(unsigned* p, unsigned v) { return __hip_atomic_fetch_add(p, v, __ATOMIC_RELAXED, __HIP_MEMORY_SCOPE_AGENT); }
__device__ __forceinline__ unsigned xb_xcc_id() { return (unsigned)__builtin_amdgcn_s_getreg((3 << 11) | 20) & 0xFu; }
#define XB_SPIN(cond, bar) do { unsigned _sp = 0; while (cond) { __builtin_amdgcn_s_sleep(1); \
    if ((++_sp & 255u) == 0u) { if (xb_ld(&(bar)[XB_TMO])) break; if (_sp > XB_SPIN_CAP) { atomicAdd(&(bar)[XB_TMO], 1u); break; } } } } while (0)
struct XcdBarrier { unsigned* bar; unsigned x; volatile LAS unsigned* st; };
__device__ __forceinline__ XcdBarrier xcd_barrier_post(unsigned* bar, volatile LAS unsigned* st) {
    XcdBarrier b; b.bar = bar; b.x = xb_xcc_id(); b.st = st;
    if (threadIdx.x == 0) (void)xb_add(&bar[XB_XCNT(b.x)], 1u);
    return b;
}
__device__ __forceinline__ void xcd_barrier_complete(unsigned* bar, unsigned x, unsigned& nloc, unsigned& nx) {
    const unsigned G = gridDim.x * gridDim.y * gridDim.z;
    unsigned sum, cnt, mine, sp = 0u;
    for (;;) {
        sum = 0u; cnt = 0u; mine = 0u;
#pragma unroll
        for (unsigned j = 0; j < 16; ++j) { const unsigned c = xb_ld(&bar[XB_XCNT(j)]); sum += c; cnt += (c > 0u) ? 1u : 0u; mine = (j == x) ? c : mine; }
        if (sum == G) break;
        __builtin_amdgcn_s_sleep(1);
        if ((++sp & 255u) == 0u) { if (xb_ld(&bar[XB_TMO])) break; if (sp > XB_SPIN_CAP) { atomicAdd(&bar[XB_TMO], 1u); break; } }
    }
    nloc = mine > 0u ? mine : 1u; nx = cnt > 0u ? cnt : 1u;
}
__device__ __forceinline__ void xcd_barrier(const XcdBarrier& b) {
    asm volatile("s_waitcnt vmcnt(0)" ::: "memory");
    __syncthreads();
    if (threadIdx.x == 0) {
        unsigned* bar = b.bar;
        __builtin_amdgcn_s_waitcnt(0);
        unsigned nloc = b.st[0], nx = b.st[1];
        if (nloc == 0u) { xcd_barrier_complete(bar, b.x, nloc, nx); b.st[0] = nloc; b.st[1] = nx; }
        const unsigned old = xb_add(&bar[XB_XSUB(b.x)], 1u);
        const unsigned gen = old / nloc;
        if (old + 1u == (gen + 1u) * nloc) {
            __builtin_amdgcn_fence(__ATOMIC_RELEASE, "agent");
            asm volatile("s_waitcnt vmcnt(0)" ::: "memory");
            const unsigned og = xb_add(&bar[XB_TOP], 1u);
            const unsigned tg = og / nx;
            if (og + 1u == (tg + 1u) * nx) xb_add(&bar[XB_TOPGEN], 1u);
            else XB_SPIN(xb_ld(&bar[XB_TOPGEN]) == tg, bar);
            __builtin_amdgcn_fence(__ATOMIC_ACQUIRE, "agent");
            xb_add(&bar[XB_XGEN(b.x)], 1u);
            asm volatile("s_waitcnt vmcnt(0)" ::: "memory");
        } else {
            XB_SPIN(xb_ld(&bar[XB_XGEN(b.x)]) == gen, bar);
            __builtin_amdgcn_fence(__ATOMIC_ACQUIRE, "agent");
            asm volatile("s_waitcnt vmcnt(0)" ::: "memory");
        }
    }
    __syncthreads();
}

__device__ __forceinline__ bf16x8 frag_kmaj(lptr img, int rs, int o, int s, int lane) {
  const int h = lane >> 5, blk = (lane >> 4) & 1, q = (lane & 15) >> 2, pp = lane & 3;
  lptr a = img + (16 * s + 8 * h + q) * rs + (o + 16 * blk + 4 * pp) * 2;
  const v4i16_t lo = __builtin_amdgcn_ds_read_tr16_b64_v4i16((LAS v4i16_t*)a);
  const v4i16_t hi = __builtin_amdgcn_ds_read_tr16_b64_v4i16((LAS v4i16_t*)(a + 4 * rs));
  return (bf16x8){lo[0], lo[1], lo[2], lo[3], hi[0], hi[1], hi[2], hi[3]};
}
__device__ __forceinline__ bf16x8 frag_kmin(lptr img, int o, int s, int lane) {
  const int row = o + (lane & 31), c = 2 * s + (lane >> 5);
  return *(LAS bf16x8*)(img + row * 64 + ((c ^ ((row >> 2) & 3)) << 4));
}
__device__ __forceinline__ int kmin_off(int row, int c) { return row * 64 + ((c ^ ((row >> 2) & 3)) << 4); }

template <int TM, int TN, bool WKMAJ, bool XKMAJ>
__device__ __forceinline__ void mma_step(f32x16 (&acc)[TM][TN], lptr wimg, int wrs, int wn0, lptr ximg, int xrs, int xt0, int lane) {
#pragma unroll
  for (int s = 0; s < 2; ++s) {
    bf16x8 wf[TM], xf[TN];
#pragma unroll
    for (int tm = 0; tm < TM; ++tm) wf[tm] = WKMAJ ? frag_kmaj(wimg, wrs, wn0 + 32 * tm, s, lane) : frag_kmin(wimg, wn0 + 32 * tm, s, lane);
#pragma unroll
    for (int tn = 0; tn < TN; ++tn) xf[tn] = XKMAJ ? frag_kmaj(ximg, xrs, xt0 + 32 * tn, s, lane) : frag_kmin(ximg, xt0 + 32 * tn, s, lane);
#pragma unroll
    for (int tm = 0; tm < TM; ++tm)
#pragma unroll
      for (int tn = 0; tn < TN; ++tn) acc[tm][tn] = __builtin_amdgcn_mfma_f32_32x32x16_bf16(wf[tm], xf[tn], acc[tm][tn], 0, 0, 0);
    if (s == 0) __builtin_amdgcn_sched_barrier(0);
  }
}

template <int BNT> struct WRegB16 { u32x4 r[BNT / 128]; };
template <int BNT> __device__ __forceinline__ void wload_b16(WRegB16<BNT>& R, const bf16_t* src  , int ld, int tid) {
  constexpr int C8 = BNT / 8, KPR = 512 / C8;
  const int c8 = tid % C8, kr = tid / C8;
#pragma unroll
  for (int r = 0; r < BNT / 128; ++r) R.r[r] = *(const u32x4*)(src + (size_t)(kr + r * KPR) * ld + c8 * 8);
}
template <int BNT> __device__ __forceinline__ void wstore_b16(const WRegB16<BNT>& R, lptr img, int rs, int tid) {
  constexpr int C8 = BNT / 8, KPR = 512 / C8;
  const int c8 = tid % C8, kr = tid / C8;
#pragma unroll
  for (int r = 0; r < BNT / 128; ++r) *(LAS u32x4*)(img + (kr + r * KPR) * rs + c8 * 16) = R.r[r];
}
template <int BMT> struct XRegB16 { u32x4 r[(BMT + 127) / 128]; };
template <int BMT> __device__ __forceinline__ void xload_b16(XRegB16<BMT>& R, const bf16_t* const (&rowp)[(BMT + 127) / 128], int k0, int tid) {
#pragma unroll
  for (int r = 0; r < (BMT + 127) / 128; ++r) if (BMT >= 128 || tid < BMT * 4) R.r[r] = *(const u32x4*)(rowp[r] + k0 + (tid & 3) * 8);
}
template <int BMT> __device__ __forceinline__ void xstore_b16(const XRegB16<BMT>& R, lptr img, int tid) {
#pragma unroll
  for (int r = 0; r < (BMT + 127) / 128; ++r) if (BMT >= 128 || tid < BMT * 4) *(LAS u32x4*)(img + kmin_off((tid >> 2) + 128 * r, tid & 3)) = R.r[r];
}

template <int BNT> struct WLb16 {
  typedef WRegB16<BNT> Regs; const bf16_t* src; int ld;
  __device__ __forceinline__ void load(Regs& R, int k0, int tid) const { wload_b16<BNT>(R, src + (size_t)k0 * ld, ld, tid); }
  __device__ __forceinline__ void store(const Regs& R, lptr img, int rs, int tid) const { wstore_b16<BNT>(R, img, rs, tid); }
};
struct WLgu {
  typedef WRegB16<512> Regs; const bf16_t *g, *u;
  __device__ __forceinline__ void load(Regs& R, int k0, int tid) const {
    const int c8 = tid & 63, kr = tid >> 6, col = c8 * 8, grp = col >> 6, w = col & 63;
    const unsigned long long ga = (unsigned long long)g, ua = (unsigned long long)u;
    const bf16_t* s = (const bf16_t*)(w < 32 ? ga : ua) + grp * 32 + (w & 31);
#pragma unroll
    for (int r = 0; r < 4; ++r) R.r[r] = *(const u32x4*)(s + (size_t)(k0 + kr + r * 8) * 256);
  }
  __device__ __forceinline__ void store(const Regs& R, lptr img, int rs, int tid) const { wstore_b16<512>(R, img, rs, tid); }
};
struct WReg32x8 { f32x4 r[8]; };
__device__ __forceinline__ void wstore_f32_512(const WReg32x8& R, lptr img, int rs, int tid) {
  const int c4 = tid & 127, kr = tid >> 7;
#pragma unroll
  for (int r = 0; r < 8; ++r) { u32x2 o; o.x = pk2(R.r[r].x, R.r[r].y); o.y = pk2(R.r[r].z, R.r[r].w); *(LAS u32x2*)(img + (kr + 4 * r) * rs + c4 * 8) = o; }
}
struct WLf32 {
  typedef WReg32x8 Regs; const float* src; int ld;
  __device__ __forceinline__ void load(Regs& R, int k0, int tid) const {
    const float* s = src + (size_t)(k0 + (tid >> 7)) * ld + (tid & 127) * 4;
#pragma unroll
    for (int r = 0; r < 8; ++r) R.r[r] = *(const f32x4*)(s + (size_t)(4 * r) * ld);
  }
  __device__ __forceinline__ void store(const Regs& R, lptr img, int rs, int tid) const { wstore_f32_512(R, img, rs, tid); }
};
struct WLf32gu {
  typedef WReg32x8 Regs; const float *g, *u;
  __device__ __forceinline__ void load(Regs& R, int k0, int tid) const {
    const int col = (tid & 127) * 4, grp = col >> 7, w = col & 127;
    const unsigned long long ga = (unsigned long long)g, ua = (unsigned long long)u;
    const float* s = (const float*)(w < 64 ? ga : ua) + (size_t)(k0 + (tid >> 7)) * 256 + grp * 64 + (w & 63);
#pragma unroll
    for (int r = 0; r < 8; ++r) R.r[r] = *(const f32x4*)(s + (size_t)(4 * r) * 256);
  }
  __device__ __forceinline__ void store(const Regs& R, lptr img, int rs, int tid) const { wstore_f32_512(R, img, rs, tid); }
};
template <int BMT> struct XLrows {
  typedef XRegB16<BMT> Regs; const bf16_t* rowp[(BMT + 127) / 128]; lptr ximg;
  __device__ __forceinline__ void load(Regs& R, int k0, int tid) const { xload_b16<BMT>(R, rowp, k0, tid); }
  __device__ __forceinline__ void store(const Regs& R, int tid) const { xstore_b16<BMT>(R, ximg, tid); }
  __device__ __forceinline__ void store(const Regs& R, int off, int tid) const { xstore_b16<BMT>(R, ximg + off, tid); }
  __device__ __forceinline__ lptr img(int) const { return ximg; }
  __device__ __forceinline__ int staged() const { return 1; }
};
struct XLres {
  struct Regs {}; lptr base; int bytes;
  __device__ __forceinline__ void load(Regs&, int, int) const {}
  __device__ __forceinline__ void store(const Regs&, int) const {}
  __device__ __forceinline__ void store(const Regs&, int, int) const {}
  __device__ __forceinline__ lptr img(int k0) const { return base + (k0 >> 5) * bytes; }
  __device__ __forceinline__ int staged() const { return 0; }
};
template <int TM, int TN, class WL, class XL, bool WK = true, bool XK = false>
__device__ __forceinline__ void gemm_loop(f32x16 (&acc)[TM][TN], int K, const WL& wl, const XL& xl, lptr wimg, int wrs, int wn0, int xt0, int tid, int lane, int xrs = 0) {
  asm volatile("" : "+v"(tid), "+v"(lane));
  typename WL::Regs wr; typename XL::Regs xr;
  wl.load(wr, 0, tid); xl.load(xr, 0, tid);
  for (int k0 = 0; k0 < K; k0 += 32) {
    wl.store(wr, wimg, wrs, tid); xl.store(xr, tid);
    __syncthreads();
    if (k0 + 32 < K) { wl.load(wr, k0 + 32, tid); xl.load(xr, k0 + 32, tid); }
    mma_step<TM, TN, WK, XK>(acc, wimg, wrs, wn0, xl.img(k0), xrs, xt0, lane);
    __syncthreads();
  }
}
template <int TM, int TN, class WL, class XL, bool WK = true, bool XK = false>
__device__ __forceinline__ void gemm_loop2(f32x16 (&acc)[TM][TN], int K, const WL& wl, const XL& xl, lptr wimg, int wrs, int wn0, int xt0, int tid, int lane, int xrs = 0) {
  asm volatile("" : "+v"(tid), "+v"(lane));
  typename WL::Regs wa, wb; typename XL::Regs xa, xb;
  wl.load(wa, 0, tid); xl.load(xa, 0, tid); wl.load(wb, 32, tid); xl.load(xb, 32, tid);
  for (int k0 = 0; k0 < K; k0 += 64) {
    wl.store(wa, wimg, wrs, tid); xl.store(xa, tid);
    __syncthreads();
    if (k0 + 64 < K) { wl.load(wa, k0 + 64, tid); xl.load(xa, k0 + 64, tid); }
    mma_step<TM, TN, WK, XK>(acc, wimg, wrs, wn0, xl.img(k0), xrs, xt0, lane);
    __syncthreads();
    wl.store(wb, wimg, wrs, tid); xl.store(xb, tid);
    __syncthreads();
    if (k0 + 96 < K) { wl.load(wb, k0 + 96, tid); xl.load(xb, k0 + 96, tid); }
    mma_step<TM, TN, WK, XK>(acc, wimg, wrs, wn0, xl.img(k0 + 32), xrs, xt0, lane);
    __syncthreads();
  }
}
template <int TM, int TN, class WL, class XL>
__device__ __forceinline__ void gemm_loop64(f32x16 (&acc)[TM][TN], int K, const WL& wl, const XL& xl, lptr wimg, int wrs, int wn0, int xt0, int xhalf, int tid, int lane) {
  asm volatile("" : "+v"(tid), "+v"(lane));
  typename WL::Regs wa, wb; typename XL::Regs xa, xb;
  wl.load(wa, 0, tid); xl.load(xa, 0, tid); wl.load(wb, 32, tid); xl.load(xb, 32, tid);
  for (int k0 = 0; k0 < K; k0 += 64) {
    wl.store(wa, wimg, wrs, tid); xl.store(xa, 0, tid);
    wl.store(wb, wimg + 32 * wrs, wrs, tid); xl.store(xb, xhalf, tid);
    __syncthreads();
    if (k0 + 64 < K) { wl.load(wa, k0 + 64, tid); xl.load(xa, k0 + 64, tid); wl.load(wb, k0 + 96, tid); xl.load(xb, k0 + 96, tid); }
    mma_step<TM, TN, true, false>(acc, wimg, wrs, wn0, xl.img(k0), 0, xt0, lane);
    mma_step<TM, TN, true, false>(acc, wimg + 32 * wrs, wrs, wn0, xl.img(k0 + 32) + xhalf * xl.staged(), 0, xt0, lane);
    __syncthreads();
  }
}
template <int TM, int TN, class WL, class XL>
__device__ __forceinline__ void gemm_loop_db(f32x16 (&acc)[TM][TN], int K, const WL& wl, const XL& xl, lptr wimg, int wrs, int wn0, int xt0, int xhalf, int tid, int lane) {
  asm volatile("" : "+v"(tid), "+v"(lane));
  const bool early = __builtin_amdgcn_readfirstlane(tid) < 256;
  typename WL::Regs wa, wb; typename XL::Regs xa, xb;
  wl.load(wa, 0, tid); xl.load(xa, 0, tid); wl.load(wb, 32, tid); xl.load(xb, 32, tid);
  wl.store(wa, wimg, wrs, tid); xl.store(xa, 0, tid);
  __syncthreads();
  if (64 < K) { wl.load(wa, 64, tid); xl.load(xa, 64, tid); }
  for (int k0 = 0; k0 < K; k0 += 64) {
    if (early) { wl.store(wb, wimg + 32 * wrs, wrs, tid); xl.store(xb, xhalf, tid); if (k0 + 96 < K) { wl.load(wb, k0 + 96, tid); xl.load(xb, k0 + 96, tid); } }
    mma_step<TM, TN, true, false>(acc, wimg, wrs, wn0, xl.img(k0), 0, xt0, lane);
    if (!early) { wl.store(wb, wimg + 32 * wrs, wrs, tid); xl.store(xb, xhalf, tid); if (k0 + 96 < K) { wl.load(wb, k0 + 96, tid); xl.load(xb, k0 + 96, tid); } }
    __syncthreads();
    if (early && k0 + 64 < K) { wl.store(wa, wimg, wrs, tid); xl.store(xa, 0, tid); if (k0 + 128 < K) { wl.load(wa, k0 + 128, tid); xl.load(xa, k0 + 128, tid); } }
    mma_step<TM, TN, true, false>(acc, wimg + 32 * wrs, wrs, wn0, xl.img(k0 + 32) + xhalf * xl.staged(), 0, xt0, lane);
    if (!early && k0 + 64 < K) { wl.store(wa, wimg, wrs, tid); xl.store(xa, 0, tid); if (k0 + 128 < K) { wl.load(wa, k0 + 128, tid); xl.load(xa, k0 + 128, tid); } }
    __syncthreads();
  }
}
template <int TM, int TN> __device__ __forceinline__ void acc_zero(f32x16 (&acc)[TM][TN]) {
#pragma unroll
  for (int a = 0; a < TM; ++a)
#pragma unroll
    for (int b = 0; b < TN; ++b)
#pragma unroll
      for (int r = 0; r < 16; ++r) acc[a][b][r] = 0.f;
}

struct WLgu256 {
  typedef WRegB16<256> Regs; const bf16_t *g, *u; int abase;
  __device__ __forceinline__ void load(Regs& R, int k0, int tid) const {
    const int col = (tid & 31) * 8, grp = col >> 7, w = col & 127;
    const unsigned long long ga = (unsigned long long)g, ua = (unsigned long long)u;
    const bf16_t* s = (const bf16_t*)(w < 64 ? ga : ua) + abase + grp * 64 + (w & 63) + (size_t)(k0 + (tid >> 5)) * 256;
#pragma unroll
    for (int r = 0; r < 2; ++r) R.r[r] = *(const u32x4*)(s + (size_t)(r * 16) * 256);
  }
  __device__ __forceinline__ void store(const Regs& R, lptr img, int rs, int tid) const { wstore_b16<256>(R, img, rs, tid); }
};
__device__ __forceinline__ void glds16(const void* gsrc, unsigned lds_dst) { unsigned keep;
  asm volatile("s_mov_b32 %0, m0\n\ts_mov_b32 m0, %2\n\ts_nop 0\n\tglobal_load_lds_dwordx4 %1, off\n\ts_mov_b32 m0, %0" : "=&s"(keep) : "v"(gsrc), "s"(lds_dst) : "memory"); }
__device__ __forceinline__ bf16x8 frag_kmaj512(lptr img, int o, int s, int lane) {
  const int h = lane >> 5, blk = (lane >> 4) & 1, q = (lane & 15) >> 2, pp = lane & 3;
  lptr a = img + (16 * s + 8 * h + q) * 512 + ((((o >> 3) + 2 * blk + (pp >> 1)) ^ (q << 2)) << 4) + (pp & 1) * 8;
  const v4i16_t lo = __builtin_amdgcn_ds_read_tr16_b64_v4i16((LAS v4i16_t*)a);
  const v4i16_t hi = __builtin_amdgcn_ds_read_tr16_b64_v4i16((LAS v4i16_t*)(a + 4 * 512));
  return (bf16x8){lo[0], lo[1], lo[2], lo[3], hi[0], hi[1], hi[2], hi[3]};
}
constexpr int G2_SLOT = 32768;
__device__ __forceinline__ void glds16x4(const void* g0, const void* g1, const void* g2, const void* g3, unsigned d0) {
  unsigned keep;
  asm volatile("s_mov_b32 %0, m0\n\ts_mov_b32 m0, %5\n\ts_nop 0\n\tglobal_load_lds_dwordx4 %1, off\n\ts_add_u32 m0, m0, 0x400\n\ts_nop 0\n\tglobal_load_lds_dwordx4 %2, off\n\t"
               "s_add_u32 m0, m0, 0x3c00\n\ts_nop 0\n\tglobal_load_lds_dwordx4 %3, off\n\ts_add_u32 m0, m0, 0x400\n\ts_nop 0\n\tglobal_load_lds_dwordx4 %4, off\n\ts_mov_b32 m0, %0"
               : "=&s"(keep) : "v"(g0), "v"(g1), "v"(g2), "v"(g3), "s"(d0) : "memory", "scc");
}
__device__ __forceinline__ void gemm256_dma(f32x16 (&acc)[4][2], const bf16_t* wp0, const bf16_t* wp1, size_t wstep, const bf16_t* xp0, const bf16_t* xp1, int K,
                                            lptr lds, int wn, int wt, int wid, int lane0) {
  const unsigned ring0 = (unsigned)(uintptr_t)lds + (unsigned)wid * 2048u;
  const int nst = K >> 5;
#define G2_ISSUE(ST) do { const int st_ = (ST) < nst ? (ST) : nst - 1; const unsigned sl_ = (unsigned)__builtin_amdgcn_readfirstlane((int)(ring0 + (unsigned)((ST) & 3) * G2_SLOT)); \
    glds16x4(wp0 + (size_t)st_ * wstep, wp1 + (size_t)st_ * wstep, xp0 + st_ * 32, xp1 + st_ * 32, sl_); } while (0)
#define G2_READ(WF, XF, ST, S) do { lptr wi_ = lds + ((ST) & 3) * G2_SLOT; \
    _Pragma("unroll") for (int tm = 0; tm < 4; ++tm) WF[tm] = frag_kmaj512(wi_, wn * 128 + 32 * tm, S, lane); \
    _Pragma("unroll") for (int tn = 0; tn < 2; ++tn) XF[tn] = frag_kmin(wi_ + 16384, wt * 64 + 32 * tn, S, lane); } while (0)
#define G2_MMA(WF, XF) do { _Pragma("unroll") for (int tm = 0; tm < 4; ++tm) _Pragma("unroll") for (int tn = 0; tn < 2; ++tn) \
    acc[tm][tn] = __builtin_amdgcn_mfma_f32_32x32x16_bf16(WF[tm], XF[tn], acc[tm][tn], 0, 0, 0); } while (0)
  acc_zero<4, 2>(acc);
  int lane = lane0; asm volatile("" : "+v"(lane));
  bf16x8 wfa[4], xfa[2], wfb[4], xfb[2];
  G2_ISSUE(0); G2_ISSUE(1); G2_ISSUE(2);
  asm volatile("s_waitcnt vmcnt(8)\n\ts_barrier" ::: "memory");
  G2_READ(wfa, xfa, 0, 0);
  for (int st = 0; st < nst; ++st) {
    G2_READ(wfb, xfb, st, 1);
    __builtin_amdgcn_sched_barrier(0);
    G2_MMA(wfa, xfa);
    __builtin_amdgcn_sched_barrier(0);
    asm volatile("s_waitcnt vmcnt(4)\n\ts_barrier" ::: "memory");
    G2_ISSUE(st + 3);
    if (st + 1 < nst) G2_READ(wfa, xfa, st + 1, 0);
    __builtin_amdgcn_sched_barrier(0);
    G2_MMA(wfb, xfb);
    __builtin_amdgcn_sched_barrier(0);
  }
#undef G2_ISSUE
#undef G2_READ
#undef G2_MMA
  asm volatile("s_waitcnt vmcnt(0)\n\ts_barrier" ::: "memory");
}
__device__ __forceinline__ int g2_wrow(int wid, int i, int lane) { return 2 * (2 * wid + i) + (lane >> 5); }
__device__ __forceinline__ int g2_wcol(int wid, int i, int lane) { return (((lane & 31) ^ ((g2_wrow(wid, i, lane) & 3) << 2))) * 8; }
__device__ __forceinline__ int g2_xtok(int wid, int i, int lane) { return 16 * (2 * wid + i) + (lane >> 2); }
__device__ __forceinline__ int g2_xk(int wid, int i, int lane) { return (((lane & 3) ^ ((g2_xtok(wid, i, lane) >> 2) & 3))) * 8; }
template <class WL>
__device__ __forceinline__ void gemm256(f32x16 (&acc)[4][2], const WL& wl, const bf16_t* xbase, int ldx, int t0, int K, lptr lds, int wn, int wt, int tid, int lane) {
  constexpr int WRS = 256 * 2 + 64;
  XLrows<256> xl; xl.rowp[0] = xbase + (size_t)(t0 + (tid >> 2)) * ldx; xl.rowp[1] = xl.rowp[0] + (size_t)128 * ldx; xl.ximg = lds + 64 * WRS;
  acc_zero<4, 2>(acc);
  gemm_loop_db<4, 2>(acc, K, wl, xl, lds, WRS, wn * 128, wt * 64, 256 * 64, tid, lane);
}
constexpr int LDS_INV64 = 150 * 1024, LDS_INV128 = LDS_INV64 + 128, LDS_XB = LDS_INV128 + 256, LDS_BYTES = 152 * 1024;

__device__ __forceinline__ void cvt_items(const float* src, bf16_t* dst, size_t n8, int gtid, int gthreads) {
  for (size_t i0 = gtid; i0 < n8; i0 += (size_t)gthreads * 4) {
    f32x4 a[4], b[4];
#pragma unroll
    for (int q = 0; q < 4; ++q) { const size_t i = i0 + (size_t)q * gthreads; if (i < n8) { a[q] = *(const f32x4*)(src + i * 8); b[q] = *(const f32x4*)(src + i * 8 + 4); } }
#pragma unroll
    for (int q = 0; q < 4; ++q) { const size_t i = i0 + (size_t)q * gthreads; if (i < n8) { u32x4 o; o.x = pk2(a[q].x, a[q].y); o.y = pk2(a[q].z, a[q].w); o.z = pk2(b[q].x, b[q].y); o.w = pk2(b[q].z, b[q].w); *(u32x4*)(dst + i * 8) = o; } }
  }
}
__device__ __forceinline__ void phase0a(const P& p, lptr lds, int vcu, int G) {
  const int tid = threadIdx.x, wid = tid >> 6, lane = tid & 63;
  if (vcu < 96) {
    const int j = vcu * 64 + lane;
    LAS float* sc = (LAS float*)(lds + 16384);
    for (int i = tid; i < 4 * D; i += 512) sc[i] = silu(p.c[i]);
    __syncthreads();
    float a0 = 0.f, a1 = 0.f, a2 = 0.f, a3 = 0.f;
    for (int k = wid * 128; k < wid * 128 + 128; k += 32) {
      float w[32];
#pragma unroll
      for (int q = 0; q < 32; ++q) w[q] = p.w_ada[(size_t)(k + q) * 6144 + j];
#pragma unroll
      for (int q = 0; q < 32; ++q) { a0 += sc[k + q] * w[q]; a1 += sc[D + k + q] * w[q]; a2 += sc[2 * D + k + q] * w[q]; a3 += sc[3 * D + k + q] * w[q]; }
    }
    LAS float* part = (LAS float*)lds;
    part[(wid * 4 + 0) * 64 + lane] = a0; part[(wid * 4 + 1) * 64 + lane] = a1; part[(wid * 4 + 2) * 64 + lane] = a2; part[(wid * 4 + 3) * 64 + lane] = a3;
    __syncthreads();
    if (wid < 4) { float s = p.b_ada[j];
#pragma unroll
      for (int w = 0; w < 8; ++w) s += part[(w * 4 + wid) * 64 + lane];
      p.mod[wid * 6144 + j] = s; }
    __syncthreads();
  }
  if (vcu < 96 && G > 96) return;
  const int gtid = (G > 96 ? vcu - 96 : vcu) * 512 + tid, gth = (G > 96 ? G - 96 : G) * 512;
  cvt_items(p.w_in, p.winb, (size_t)D * INW / 8, gtid, gth);
  cvt_items(p.w_out, p.woutb, (size_t)D * D / 8, gtid, gth);
  cvt_items(p.w_router, p.wrb, (size_t)D * NE / 8, gtid, gth);
  cvt_items(p.wg_s, p.wgsb, (size_t)D * 256 / 8, gtid, gth);
  cvt_items(p.wu_s, p.wusb, (size_t)D * 256 / 8, gtid, gth);
  cvt_items(p.wd_s, p.wdsb, (size_t)256 * D / 8, gtid, gth);
  cvt_items(p.cw1k, p.cw1kb, (size_t)2048 * 128 / 8, gtid, gth);
  cvt_items(p.cw1v, p.cw1vb, (size_t)2048 * 128 / 8, gtid, gth);
  cvt_items(p.cw2k, p.cw2kb, (size_t)128 * 64 / 8, gtid, gth);
  cvt_items(p.cw2v, p.cw2vb, (size_t)128 * 64 / 8, gtid, gth);
}

__device__ __forceinline__ void phase0b(const P& p, lptr lds, int vcu, int G) {
  const int tid = threadIdx.x, wid = tid >> 6, lane = tid & 63;
  for (int row = vcu * 8 + wid; row < T; row += G * 8) {
    const int b = row / SEQ;
    f32x4 v[4]; float s = 0.f;
#pragma unroll
    for (int j = 0; j < 4; ++j) { v[j] = *(const f32x4*)(p.x + (size_t)row * D + j * 256 + lane * 4); s += v[j].x * v[j].x + v[j].y * v[j].y + v[j].z * v[j].z + v[j].w * v[j].w; }
    s = wave_sum(s);
    const float r = rsqrtf(s * (1.f / D) + EPS);
#pragma unroll
    for (int j = 0; j < 4; ++j) {
      const int k = j * 256 + lane * 4;
      const f32x4 g = *(const f32x4*)(p.g_mix + k), sc = *(const f32x4*)(p.mod + b * 6144 + 1024 + k), sh = *(const f32x4*)(p.mod + b * 6144 + k);
      u32x2 o; o.x = pk2(v[j].x * r * g.x * (1.f + sc.x) + sh.x, v[j].y * r * g.y * (1.f + sc.y) + sh.y); o.y = pk2(v[j].z * r * g.z * (1.f + sc.z) + sh.z, v[j].w * r * g.w * (1.f + sc.w) + sh.w);
      *(u32x2*)(p.hb + (size_t)row * D + k) = o;
    }
  }
}

#define ROPE_PAIR(X1, X2, posf, invrev, sc) do { float pf_ = (posf); asm volatile("" : "+v"(pf_)); const float fr_ = __builtin_amdgcn_fractf(pf_ * (invrev)); \
    const float sn_ = __builtin_amdgcn_sinf(fr_), cs_ = __builtin_amdgcn_cosf(fr_); const float a_ = (X1), b_ = (X2); \
    float o1_ = (a_ * cs_ - b_ * sn_) * (sc), o2_ = (a_ * sn_ + b_ * cs_) * (sc); asm volatile("" : "+v"(o1_), "+v"(o2_)); (X1) = o1_; (X2) = o2_; } while (0)
__device__ __forceinline__ void phase1(const P& p, lptr lds, int vcu, int G) {
  const int tid = threadIdx.x, wid = __builtin_amdgcn_readfirstlane(tid >> 6), lane = tid & 63, wn = wid >> 2, wt = wid & 3, h = lane >> 5;
  const LAS float* inv64 = (const LAS float*)(lds + LDS_INV64);
  const LAS float* inv128 = (const LAS float*)(lds + LDS_INV128);
  for (int u = vcu; u < 14 * 64; u += G) {
    const int j = u % 14, mt = u / 14, t0 = mt * 256;
    if (j == 13) {
      f32x16 ag[1][1]; acc_zero<1, 1>(ag);
      WLb16<128> wl; wl.src = p.winb + C_GN; wl.ld = INW;
      XLrows<256> xl; xl.rowp[0] = p.hb + (size_t)(t0 + (tid >> 2)) * D; xl.rowp[1] = xl.rowp[0] + (size_t)128 * D; xl.ximg = lds + 32 * 320;
      gemm_loop2<1, 1>(ag, D, wl, xl, lds, 320, 0, wid * 32, tid, lane);
      int tok = t0 + wid * 32 + (lane & 31), nb = 4 * h; asm volatile("" : "+v"(tok), "+v"(nb));
#pragma unroll
      for (int a = 0; a < 3; ++a) { f32x4 v; v.x = sigm(ag[0][0][4 * a]); v.y = sigm(ag[0][0][4 * a + 1]); v.z = sigm(ag[0][0][4 * a + 2]); v.w = sigm(ag[0][0][4 * a + 3]);
        *(f32x4*)(p.gates + (size_t)tok * 24 + nb + a * 8) = v; }
      continue;
    }
    const int wcol = j < 5 ? j * 256 : C_QR + (j - 5) * 256;
    f32x16 acc[4][2];
    { const bf16_t* wb = p.winb + wcol; const bf16_t* xb = p.hb + (size_t)t0 * D;
      gemm256_dma(acc, wb + (size_t)g2_wrow(wid, 0, lane) * INW + g2_wcol(wid, 0, lane), wb + (size_t)g2_wrow(wid, 1, lane) * INW + g2_wcol(wid, 1, lane), (size_t)32 * INW,
                  xb + (size_t)g2_xtok(wid, 0, lane) * D + g2_xk(wid, 0, lane), xb + (size_t)g2_xtok(wid, 1, lane) * D + g2_xk(wid, 1, lane), D, lds, wn, wt, wid, lane); }
    const int kind = (j < 2) ? 0 : (j == 2) ? 3 : (j < 5) ? (wn == 0 ? 1 : 3) : (j < 7) ? 2 : (j < 9) ? 4 : (j < 11) ? 3 : 5;
#pragma unroll
    for (int tn = 0; tn < 2; ++tn) {
      const int tok = t0 + wt * 64 + tn * 32 + (lane & 31);
      const float posf = (float)p.pos[tok];
      if (kind == 0 || kind == 1) {
        const float sc = kind == 0 ? 0.125f * 1.4426950408889634f : 1.f;
#pragma unroll
        for (int r = 0; r < 16; ++r) { const float iv = inv64[(r & 3) + 8 * (r >> 2) + 4 * h];
          ROPE_PAIR(acc[0][tn][r], acc[1][tn][r], posf, iv, sc); ROPE_PAIR(acc[2][tn][r], acc[3][tn][r], posf, iv, sc); if ((r & 3) == 3) __builtin_amdgcn_sched_barrier(0); }
      } else if (kind == 2 || kind == 4) {
        const float sc = kind == 4 ? 0.08838834764831845f : 1.f;
#pragma unroll
        for (int r = 0; r < 16; ++r) { const int i = (r & 3) + 8 * (r >> 2) + 4 * h;
          ROPE_PAIR(acc[0][tn][r], acc[2][tn][r], posf, inv128[i], sc); ROPE_PAIR(acc[1][tn][r], acc[3][tn][r], posf, inv128[32 + i], sc); if ((r & 3) == 3) __builtin_amdgcn_sched_barrier(0); }
      } else if (kind == 5) {
#pragma unroll
        for (int tm = 0; tm < 4; ++tm)
#pragma unroll
          for (int r = 0; r < 16; ++r) { float v = acc[tm][tn][r]; asm volatile("" : "+v"(v)); float o = v * __builtin_amdgcn_rcpf(1.f + __builtin_amdgcn_exp2f(-1.4426950408889634f * v)); asm volatile("" : "+v"(o)); acc[tm][tn][r] = o; }
      }
      { int rl = wt * 32 + (lane & 31), cb = (wn * 128 + 4 * h) * 2; asm volatile("" : "+v"(rl), "+v"(cb));
#pragma unroll
        for (int tm = 0; tm < 4; ++tm)
#pragma unroll
          for (int a = 0; a < 4; ++a) { u32x2 o; o.x = pk2(acc[tm][tn][4 * a], acc[tm][tn][4 * a + 1]); o.y = pk2(acc[tm][tn][4 * a + 2], acc[tm][tn][4 * a + 3]);
            *(LAS u32x2*)(lds + rl * 528 + cb + (tm * 32 + a * 8) * 2) = o; }
        __syncthreads();
#pragma unroll
        for (int rr = 0; rr < 8; ++rr) { const int row = wid * 16 + rr * 2 + (lane >> 5);
          *(u32x4*)(p.projb + (size_t)(t0 + (row >> 5) * 64 + tn * 32 + (row & 31)) * PJW + j * 256 + (lane & 31) * 8) = *(const LAS u32x4*)(lds + row * 528 + (lane & 31) * 16); }
        __syncthreads(); }
    }
  }
}

__device__ __forceinline__ void phase5(const P& p, lptr lds, int vcu, int G) {
  const int tid = threadIdx.x, wid = __builtin_amdgcn_readfirstlane(tid >> 6), lane = tid & 63, h = lane >> 5, l31 = lane & 31;
  constexpr int WRS1 = 1024 * 2 + 64;
  lptr wimg = lds, ximg = lds + 32 * WRS1;
  lptr lgb = lds + 72 * 1024;
  LAS float* part = (LAS float*)(lds + 138 * 1024);
  LAS float* rstd = part + 512;
  for (int u = vcu; u < T / 64; u += G) {
    const int t0 = u * 64, b = t0 / SEQ;
    f32x16 acc[4][2];
    acc_zero<4, 2>(acc);
    { WLb16<1024> wl; wl.src = p.woutb; wl.ld = D;
      XLrows<64> xl; xl.rowp[0] = p.mixb + (size_t)(t0 + ((tid >> 2) & 63)) * D; xl.ximg = ximg;
      gemm_loop<4, 2>(acc, D, wl, xl, wimg, WRS1, wid * 128, 0, tid, lane); }
    int nb = wid * 128 + 4 * h, tb = t0 + l31;
    asm volatile("" : "+v"(nb), "+v"(tb));
#pragma unroll
    for (int tn = 0; tn < 2; ++tn) {
      const int tok = tb + tn * 32; float ss = 0.f;
#pragma unroll
      for (int tm = 0; tm < 4; ++tm)
#pragma unroll
        for (int a = 0; a < 4; ++a) {
          const int n = nb + tm * 32 + a * 8;
          const f32x4 xv = *(const f32x4*)(p.x + (size_t)tok * D + n), gt = *(const f32x4*)(p.mod + b * 6144 + 2048 + n);
          f32x4 v; v.x = xv.x + gt.x * acc[tm][tn][4 * a]; v.y = xv.y + gt.y * acc[tm][tn][4 * a + 1]; v.z = xv.z + gt.z * acc[tm][tn][4 * a + 2]; v.w = xv.w + gt.w * acc[tm][tn][4 * a + 3];
          acc[tm][tn][4 * a] = v.x; acc[tm][tn][4 * a + 1] = v.y; acc[tm][tn][4 * a + 2] = v.z; acc[tm][tn][4 * a + 3] = v.w;
          *(f32x4*)(p.x1 + (size_t)tok * D + n) = v;
          ss += v.x * v.x + v.y * v.y + v.z * v.z + v.w * v.w;
          if (a == 3) __builtin_amdgcn_sched_barrier(0);
        }
      ss += __shfl_xor(ss, 32);
      if (h == 0) part[wid * 64 + tn * 32 + l31] = ss;
    }
    __syncthreads();
    if (tid < 64) { float q = 0.f;
#pragma unroll
      for (int w = 0; w < 8; ++w) q += part[w * 64 + tid];
      rstd[tid] = rsqrtf(q * (1.f / D) + EPS); }
    __syncthreads();
    asm volatile("" : "+v"(nb), "+v"(tb));
#pragma unroll
    for (int tn = 0; tn < 2; ++tn) {
      const int tok = tb + tn * 32; const float r = rstd[tn * 32 + l31];
#pragma unroll
      for (int tm = 0; tm < 4; ++tm)
#pragma unroll
        for (int a = 0; a < 4; ++a) {
          const int n = nb + tm * 32 + a * 8;
          const f32x4 g = *(const f32x4*)(p.g_ffn + n), sc = *(const f32x4*)(p.mod + b * 6144 + 4096 + n), sh = *(const f32x4*)(p.mod + b * 6144 + 3072 + n);
          u32x2 o;
          o.x = pk2(acc[tm][tn][4 * a] * r * g.x * (1.f + sc.x) + sh.x, acc[tm][tn][4 * a + 1] * r * g.y * (1.f + sc.y) + sh.y);
          o.y = pk2(acc[tm][tn][4 * a + 2] * r * g.z * (1.f + sc.z) + sh.z, acc[tm][tn][4 * a + 3] * r * g.w * (1.f + sc.w) + sh.w);
          *(u32x2*)(p.h2b + (size_t)tok * D + n) = o;
          if (a == 3) __builtin_amdgcn_sched_barrier(0);
        }
    }
    asm volatile("s_waitcnt vmcnt(0)" ::: "memory");
    __syncthreads();
    { f32x16 a2[1][2]; acc_zero<1, 2>(a2);
      WLb16<256> wl; wl.src = p.wrb; wl.ld = NE;
      XLrows<64> xl; xl.rowp[0] = p.h2b + (size_t)(t0 + ((tid >> 2) & 63)) * D; xl.ximg = ximg;
      gemm_loop<1, 2>(a2, D, wl, xl, wimg, 256 * 2 + 64, wid * 32, 0, tid, lane);
      int lo = ((l31 * 256 + wid * 32 + 4 * h) * 4);
      asm volatile("" : "+v"(lo));
#pragma unroll
      for (int tn = 0; tn < 2; ++tn)
#pragma unroll
        for (int a = 0; a < 4; ++a) { f32x4 v = {a2[0][tn][4 * a], a2[0][tn][4 * a + 1], a2[0][tn][4 * a + 2], a2[0][tn][4 * a + 3]};
          *(LAS f32x4*)(lgb + lo + (tn * 32 * 256 + a * 8) * 4) = v; } }
    __syncthreads();
    { int lane_ = lane; asm volatile("" : "+v"(lane_));
      const int lane = lane_;
      const f32x4 rb = *(const f32x4*)(p.rbias + lane * 4);
      for (int i = 0; i < 8; ++i) {
        const int tl = wid * 8 + i, tok = t0 + tl;
        const f32x4 lv = *(const LAS f32x4*)(lgb + (tl * 256 + lane * 4) * 4);
        const float s0 = sigm(lv.x), s1 = sigm(lv.y), s2 = sigm(lv.z), s3 = sigm(lv.w);
        float c0 = s0 + rb.x, c1 = s1 + rb.y, c2 = s2 + rb.z, c3 = s3 + rb.w;
        float m1, m2;
        { const float h1 = fmaxf(c0, c1), l1 = fminf(c0, c1), h2 = fmaxf(c2, c3), l2 = fminf(c2, c3); m1 = fmaxf(h1, h2); m2 = fmaxf(fminf(h1, h2), fmaxf(l1, l2)); }
#pragma unroll
        for (int o = 1; o < 8; o <<= 1) { const float o1 = __shfl_xor(m1, o), o2 = __shfl_xor(m2, o); const float n1 = fmaxf(m1, o1), n2 = fmaxf(fminf(m1, o1), fmaxf(m2, o2)); m1 = n1; m2 = n2; }
        const float gs = m1 + m2; const int myg = lane >> 3; int rank = 0;
#pragma unroll
        for (int g2 = 0; g2 < 8; ++g2) { const float og = __shfl(gs, g2 * 8); rank += (og > gs || (og == gs && g2 < myg)) ? 1 : 0; }
        if (rank >= 4) { c0 = -INFINITY; c1 = -INFINITY; c2 = -INFINITY; c3 = -INFINITY; }
        int my_e = 0; float my_s = 0.f;
#pragma unroll
        for (int k = 0; k < 8; ++k) {
          float bv = c0; int li = lane * 4;
          if (c1 > bv) { bv = c1; li = lane * 4 + 1; }
          if (c2 > bv) { bv = c2; li = lane * 4 + 2; }
          if (c3 > bv) { bv = c3; li = lane * 4 + 3; }
#pragma unroll
          for (int o = 1; o < 64; o <<= 1) { const float ov = __shfl_xor(bv, o); const int oi = __shfl_xor(li, o); if (ov > bv || (ov == bv && oi < li)) { bv = ov; li = oi; } }
          const int j = li & 3; const float sj = j == 0 ? s0 : j == 1 ? s1 : j == 2 ? s2 : s3;
          const float sv = __shfl(sj, li >> 2);
          if (lane * 4 == li) c0 = -INFINITY;
          if (lane * 4 + 1 == li) c1 = -INFINITY;
          if (lane * 4 + 2 == li) c2 = -INFINITY;
          if (lane * 4 + 3 == li) c3 = -INFINITY;
          if (lane == k) { my_e = li; my_s = sv; }
        }
        const float wsum = wave_sum(lane < 8 ? my_s : 0.f);
        if (lane < 8) { const int pos = atomicAdd(&p.cnt[my_e * CPAD], 1); p.list[my_e * ECAP + pos] = tok * 8 + lane; p.wts[tok * 8 + lane] = my_s / wsum * 2.5f; }
      } }
    __syncthreads();
    { f32x16 a3[2][2]; acc_zero<2, 2>(a3);
      WLgu wl; wl.g = p.wgsb; wl.u = p.wusb;
      XLrows<64> xl; xl.rowp[0] = p.h2b + (size_t)(t0 + ((tid >> 2) & 63)) * D; xl.ximg = ximg;
      gemm_loop<2, 2>(a3, D, wl, xl, wimg, 512 * 2 + 64, wid * 64, 0, tid, lane);
      int l31_ = l31, h_ = h; asm volatile("" : "+v"(l31_), "+v"(h_));
#pragma unroll
      for (int tn = 0; tn < 2; ++tn)
#pragma unroll
        for (int a = 0; a < 4; ++a) {
          float o[4];
#pragma unroll
          for (int e = 0; e < 4; ++e) { const float gv = a3[0][tn][4 * a + e], uv = a3[1][tn][4 * a + e]; o[e] = gv * __builtin_amdgcn_rcpf(1.f + __builtin_amdgcn_exp2f(-1.4426950408889634f * gv)) * uv; }
          const int col = wid * 32 + a * 8 + 4 * h_;
          u32x2 w2; w2.x = pk2(o[0], o[1]); w2.y = pk2(o[2], o[3]);
          *(LAS u32x2*)(lgb + (col >> 5) * 4096 + kmin_off(tn * 32 + l31_, (col & 31) >> 3) + (col & 7) * 2) = w2;
        } }
    __syncthreads();
    acc_zero<4, 2>(acc);
    { WLb16<1024> wl; wl.src = p.wdsb; wl.ld = D;
      XLres xl; xl.base = lgb; xl.bytes = 4096;
      gemm_loop<4, 2>(acc, 256, wl, xl, wimg, WRS1, wid * 128, 0, tid, lane); }
    asm volatile("" : "+v"(nb), "+v"(tb));
#pragma unroll
    for (int tn = 0; tn < 2; ++tn) {
      const int tok = tb + tn * 32;
#pragma unroll
      for (int tm = 0; tm < 4; ++tm)
#pragma unroll
        for (int a = 0; a < 4; ++a) {
          const int n = nb + tm * 32 + a * 8;
          f32x4 v = *(const f32x4*)(p.x1 + (size_t)tok * D + n); const f32x4 gt = *(const f32x4*)(p.mod + b * 6144 + 5120 + n);
          v.x += gt.x * acc[tm][tn][4 * a]; v.y += gt.y * acc[tm][tn][4 * a + 1]; v.z += gt.z * acc[tm][tn][4 * a + 2]; v.w += gt.w * acc[tm][tn][4 * a + 3];
          *(f32x4*)(p.x1 + (size_t)tok * D + n) = v;
          if (a == 3) __builtin_amdgcn_sched_barrier(0);
        }
    }
    __syncthreads();
  }
}

__device__ __forceinline__ void phase6(const P& p, lptr lds, int vcu, int G) {
  const int tid = threadIdx.x, wid = __builtin_amdgcn_readfirstlane(tid >> 6), lane = tid & 63, h = lane >> 5, l31 = lane & 31, wn = wid >> 1, wt = wid & 1;
  constexpr int WRS = 512 * 2 + 64;
  lptr wimg = lds, ximg = lds + 68 * 1024;
  lptr actb = lds + 84 * 1024;
  LAS int* pre = (LAS int*)(lds + 148 * 1024);
  LAS int* sidl = pre + 320;
  if (tid < NE) pre[tid + 1] = (p.cnt[tid * CPAD] + 127) >> 7;
  if (tid == 0) pre[0] = 0;
  __syncthreads();
  if (tid == 0) { int a = 0; for (int e = 1; e <= NE; ++e) { a += pre[e]; pre[e] = a; } }
  __syncthreads();
  const int nunits = pre[NE];
  for (int u = vcu; u < nunits; u += G) {
    int lo = 0, hi = NE;
    while (hi - lo > 1) { const int mid = (lo + hi) >> 1; if (pre[mid] <= u) lo = mid; else hi = mid; }
    const int e = lo, off = (u - pre[e]) * 128, cnt = p.cnt[e * CPAD];
    if (tid < 128) sidl[tid] = off + tid < cnt ? p.list[e * ECAP + off + tid] : -1;
    __syncthreads();
    f32x16 acc[4][2];
    acc_zero<4, 2>(acc);
    { WLf32gu wl; wl.g = p.wg_e + (size_t)e * D * 256; wl.u = p.wu_e + (size_t)e * D * 256;
      XLrows<128> xl; { const int sd = sidl[(tid >> 2) & 127]; xl.rowp[0] = p.h2b + (size_t)(sd < 0 ? 0 : sd >> 3) * D; } xl.ximg = ximg;
      gemm_loop_db<4, 2>(acc, D, wl, xl, wimg, WRS, wn * 128, wt * 64, 128 * 64, tid, lane); }
    { int l31_ = l31, h_ = h; asm volatile("" : "+v"(l31_), "+v"(h_));
#pragma unroll
      for (int tn = 0; tn < 2; ++tn)
#pragma unroll
        for (int tm = 0; tm < 2; ++tm)
#pragma unroll
          for (int a = 0; a < 4; ++a) {
            float o[4];
#pragma unroll
            for (int q = 0; q < 4; ++q) { const float gv = acc[tm][tn][4 * a + q], uv = acc[tm + 2][tn][4 * a + q]; o[q] = gv * __builtin_amdgcn_rcpf(1.f + __builtin_amdgcn_exp2f(-1.4426950408889634f * gv)) * uv; }
            const int col = wn * 64 + tm * 32 + a * 8 + 4 * h_;
            u32x2 w2; w2.x = pk2(o[0], o[1]); w2.y = pk2(o[2], o[3]);
            *(LAS u32x2*)(actb + (col >> 5) * 8192 + kmin_off(wt * 64 + tn * 32 + l31_, (col & 31) >> 3) + (col & 7) * 2) = w2;
          } }
    __syncthreads();
#pragma unroll 1
    for (int pass = 0; pass < 2; ++pass) {
      acc_zero<4, 2>(acc);
      { WLf32 wl; wl.src = p.wd_e + (size_t)e * 256 * D + pass * 512; wl.ld = D;
        XLres xl; xl.base = actb; xl.bytes = 8192;
        gemm_loop_db<4, 2>(acc, 256, wl, xl, wimg, WRS, wn * 128, wt * 64, 0, tid, lane); }
      { int nbl = wn * 128 + 4 * h, rl = wt * 32 + l31; asm volatile("" : "+v"(nbl), "+v"(rl));
#pragma unroll
        for (int tn = 0; tn < 2; ++tn) {
          const int sd = sidl[wt * 64 + tn * 32 + (rl & 31)]; const float wgt = sd >= 0 ? p.wts[sd] : 0.f;
#pragma unroll
          for (int tm = 0; tm < 4; ++tm)
#pragma unroll
            for (int a = 0; a < 4; ++a) { u32x2 o; o.x = pk2(acc[tm][tn][4 * a] * wgt, acc[tm][tn][4 * a + 1] * wgt); o.y = pk2(acc[tm][tn][4 * a + 2] * wgt, acc[tm][tn][4 * a + 3] * wgt);
              *(LAS u32x2*)(lds + rl * 1040 + (nbl + tm * 32 + a * 8) * 2) = o; }
          __syncthreads();
#pragma unroll
          for (int rr = 0; rr < 8; ++rr) { const int row = wid * 8 + rr, sd2 = sidl[(row >> 5) * 64 + tn * 32 + (row & 31)];
            if (sd2 >= 0) *(u32x4*)(p.slab + (size_t)sd2 * D + pass * 512 + lane * 8) = *(const LAS u32x4*)(lds + row * 1040 + lane * 16); }
          __syncthreads();
        } }
    }
    __syncthreads();
  }
}

__device__ __forceinline__ void phase7(const P& p, lptr lds, int vcu, int G) {
  const int tid = threadIdx.x, wid = tid >> 6, lane = tid & 63;
  for (int tok = vcu * 8 + wid; tok < T; tok += G * 8) {
    const int b = tok / SEQ;
    float v[16]; float ss = 0.f;
#pragma unroll
    for (int j = 0; j < 2; ++j) {
      const int n = j * 512 + lane * 8;
      float a[8];
#pragma unroll
      for (int q = 0; q < 8; ++q) a[q] = 0.f;
#pragma unroll
      for (int k = 0; k < 9; ++k) { const u32x4 w = k < 8 ? *(const u32x4*)(p.slab + ((size_t)tok * 8 + k) * D + n) : *(const u32x4*)(p.ysb + (size_t)tok * D + n);
        a[0] += bflo(w.x); a[1] += bfhi(w.x); a[2] += bflo(w.y); a[3] += bfhi(w.y); a[4] += bflo(w.z); a[5] += bfhi(w.z); a[6] += bflo(w.w); a[7] += bfhi(w.w); }
#pragma unroll
      for (int q4 = 0; q4 < 2; ++q4) {
        const f32x4 xv = *(const f32x4*)(p.x + (size_t)tok * D + n + q4 * 4), gt = *(const f32x4*)(p.mod + b * 6144 + 5120 + n + q4 * 4), ga = *(const f32x4*)(p.mod + b * 6144 + 2048 + n + q4 * 4);
        const u32x2 mo = *(const u32x2*)(p.mixo + (size_t)tok * D + n + q4 * 4);
        const float y0 = xv.x + ga.x * bflo(mo.x) + gt.x * a[q4 * 4], y1 = xv.y + ga.y * bfhi(mo.x) + gt.y * a[q4 * 4 + 1], y2 = xv.z + ga.z * bflo(mo.y) + gt.z * a[q4 * 4 + 2], y3 = xv.w + ga.w * bfhi(mo.y) + gt.w * a[q4 * 4 + 3];
        v[j * 8 + q4 * 4] = y0; v[j * 8 + q4 * 4 + 1] = y1; v[j * 8 + q4 * 4 + 2] = y2; v[j * 8 + q4 * 4 + 3] = y3;
        ss += y0 * y0 + y1 * y1 + y2 * y2 + y3 * y3;
      }
    }
    ss = wave_sum(ss);
    const float r = rsqrtf(ss * (1.f / D) + EPS);
#pragma unroll
    for (int j = 0; j < 2; ++j)
#pragma unroll
      for (int q4 = 0; q4 < 2; ++q4) {
        const int n = j * 512 + lane * 8 + q4 * 4;
        const f32x4 g = *(const f32x4*)(p.g_final + n);
        f32x4 o; o.x = v[j * 8 + q4 * 4] * r * g.x; o.y = v[j * 8 + q4 * 4 + 1] * r * g.y; o.z = v[j * 8 + q4 * 4 + 2] * r * g.z; o.w = v[j * 8 + q4 * 4 + 3] * r * g.w;
        *(f32x4*)(p.out + (size_t)tok * D + n) = o;
      }
  }
}

constexpr int NSA_KB = 8192, NSA_VRS = 128, NSA_SLOT = NSA_KB + 64 * NSA_VRS, NSA_NSLOT = 4, NSA_IMP = NSA_NSLOT * NSA_SLOT;
__device__ __forceinline__ void nsa_offsets(int (&koff)[4], int (&voff)[2], int lane) {
  const int h = lane >> 5, l31 = lane & 31, blk = (lane >> 4) & 1, q = (lane & 15) >> 2, pp = lane & 3;
#pragma unroll
  for (int ds = 0; ds < 4; ++ds) koff[ds] = l31 * 128 + (((2 * ds + h) ^ ((l31 >> 1) & 7)) << 4);
#pragma unroll
  for (int dt = 0; dt < 2; ++dt) voff[dt] = (4 * h + q) * NSA_VRS + (((dt * 4 + 2 * blk + (pp >> 1)) ^ ((q >> 1) << 2)) << 4) + (pp & 1) * 8;
}
__device__ __forceinline__ void nsa_qk(f32x16 (&s)[2], lptr kimg, const bf16x8 (&qf)[4], const int (&koff)[4]) {
#pragma unroll
  for (int kt = 0; kt < 2; ++kt) {
#pragma unroll
    for (int r = 0; r < 16; ++r) s[kt][r] = 0.f;
#pragma unroll
    for (int ds = 0; ds < 4; ++ds) {
      const bf16x8 a = *(LAS bf16x8*)(kimg + koff[ds] + kt * 4096);
      s[kt] = __builtin_amdgcn_mfma_f32_32x32x16_bf16(a, qf[ds], s[kt], 0, 0, 0);
    }
  }
}
__device__ __forceinline__ void nsa_pv(f32x16 (&o)[2], lptr vimg, const f32x16 (&pr)[2], const int (&voff)[2]) {
  bf16x8 pb[4];
#pragma unroll
  for (int ks = 0; ks < 4; ++ks) {
    const int kt = ks >> 1, rb = 8 * (ks & 1);
    u32x4 w; w.x = pk2(pr[kt][rb], pr[kt][rb + 1]); w.y = pk2(pr[kt][rb + 2], pr[kt][rb + 3]); w.z = pk2(pr[kt][rb + 4], pr[kt][rb + 5]); w.w = pk2(pr[kt][rb + 6], pr[kt][rb + 7]);
    pb[ks] = __builtin_bit_cast(bf16x8, w);
  }
#pragma unroll
  for (int dt = 0; dt < 2; ++dt)
#pragma unroll
    for (int ks = 0; ks < 4; ++ks) {
      lptr a = vimg + voff[dt] + ks * 2048;
      const v4i16_t lo = __builtin_amdgcn_ds_read_tr16_b64_v4i16((LAS v4i16_t*)a);
      const v4i16_t hi = __builtin_amdgcn_ds_read_tr16_b64_v4i16((LAS v4i16_t*)(a + 1024));
      const bf16x8 vf = {lo[0], lo[1], lo[2], lo[3], hi[0], hi[1], hi[2], hi[3]};
      o[dt] = __builtin_amdgcn_mfma_f32_32x32x16_bf16(vf, pb[ks], o[dt], 0, 0, 0);
    }
}
__device__ __forceinline__ float fexp(float x) { return __builtin_amdgcn_exp2f(x); }
__device__ __forceinline__ float xmax32(float x) { const auto rr = __builtin_amdgcn_permlane32_swap(__float_as_uint(x), __float_as_uint(x), false, false); return fmaxf(__uint_as_float(rr[0]), __uint_as_float(rr[1])); }
__device__ __forceinline__ float xsum32(float x) { const auto rr = __builtin_amdgcn_permlane32_swap(__float_as_uint(x), __float_as_uint(x), false, false); return __uint_as_float(rr[0]) + __uint_as_float(rr[1]); }
__device__ __forceinline__ void phase_nsa(const P& p, lptr lds, int vcu, int G) {
  const int tid = threadIdx.x, wid = __builtin_amdgcn_readfirstlane(tid >> 6), lane0 = tid & 63;
  int koff[4], voff[2]; nsa_offsets(koff, voff, lane0);
  LAS float* imp = (LAS float*)(lds + NSA_IMP);
  LAS float* obuf = (LAS float*)(lds + NSA_IMP + 16384) + wid * 2048 + lane0;
  for (int u = vcu; u < 512; u += G) {
    const int bg = u & 7, j0 = u < 256 ? 63 - (u >> 3) : ((u - 256) >> 3), b = bg >> 1, g = bg & 1, t0 = j0 * 64;
    const int t = t0 + wid * 8 + ((lane0 & 31) >> 2), hg = g * 4 + (lane0 & 3);
    const size_t trow = (size_t)(b * SEQ + t);
    bf16x8 qf[4];
#pragma unroll
    for (int ds = 0; ds < 4; ++ds) qf[ds] = *(const bf16x8*)(p.projb + trow * PJW + J_QN + hg * 64 + 16 * ds + 8 * (lane0 >> 5));
#pragma unroll
    for (int i = 0; i < 8; ++i) imp[(wid * 8 + i) * 64 + lane0] = 0.f;
    const int nct = (((t0 + 32) >> 4) >> 6) + 1, jw0 = j0 > 8 ? j0 - 8 : 0;
    const int itC = 2 * nct, itD = itC + j0 + 1, NI = itD + (j0 - jw0 + 1);
    const int cmaxt = t >= 31 ? (t - 31) >> 4 : -1;
    const int drow = wid * 8 + (lane0 >> 3), dch = lane0 & 7;
    const char* pbt = (const char*)(p.projb + (size_t)(b * SEQ) * PJW + g * 64) + (size_t)drow * (PJW * 2);
    const char* kct = (const char*)(p.kcmpb + (size_t)bg * NC * 64) + drow * 128;
    const char* vct = (const char*)(p.vcmpb + (size_t)bg * NC * 64) + drow * 128;
    const unsigned kx = (unsigned)((dch ^ ((drow >> 1) & 7)) * 16), vx = (unsigned)((dch ^ (((drow >> 1) & 1) << 2)) * 16);
    const unsigned ring0 = (unsigned)(uintptr_t)lds + (unsigned)wid * 1024u;
#define NSA_ISSUE(IT) do { const int it_ = (IT) < NI ? (IT) : NI - 1; const unsigned sl_ = (unsigned)__builtin_amdgcn_readfirstlane((int)(ring0 + (unsigned)((IT) & (NSA_NSLOT - 1)) * NSA_SLOT)); \
      if (it_ < itC) { const unsigned o_ = (unsigned)(it_ < nct ? it_ : it_ - nct) * 8192u; glds16(kct + o_ + kx, sl_); glds16(vct + o_ + vx, sl_ + NSA_KB); } \
      else { const bool sel_ = it_ < itD; const unsigned o_ = (unsigned)(sel_ ? it_ - itC : jw0 + it_ - itD) * (unsigned)(64 * PJW * 2); \
             glds16(pbt + o_ + (sel_ ? J_KS * 2 : J_KW * 2) + kx, sl_); glds16(pbt + o_ + (sel_ ? J_VS * 2 : J_VW * 2) + vx, sl_ + NSA_KB); } } while (0)
#define NSA_STEP() lptr slot = lds + (it & (NSA_NSLOT - 1)) * NSA_SLOT; \
      asm volatile("s_waitcnt vmcnt(4)\n\ts_barrier" ::: "memory"); \
      NSA_ISSUE(it + 3); \
      int lane = lane0; asm volatile("" : "+v"(lane)); const int h = lane >> 5, l31 = lane & 31; (void)l31
    NSA_ISSUE(0); NSA_ISSUE(1); NSA_ISSUE(2);
    int it = 0;
    float m1 = -1e30f, l1 = 0.f;
    for (; it < nct; ++it) {
      NSA_STEP();
      f32x16 s[2]; nsa_qk(s, slot, qf, koff);
      float mx = -1e30f;
#pragma unroll
      for (int r = 0; r < 16; ++r) { const int c = 64 * it + (r & 3) + 8 * (r >> 2) + 4 * h; if (c <= cmaxt) mx = fmaxf(mx, s[0][r]); if (c + 32 <= cmaxt) mx = fmaxf(mx, s[1][r]); }
      mx = xmax32(mx);
      const float mn = fmaxf(m1, mx); float rs = 0.f;
#pragma unroll
      for (int r = 0; r < 16; ++r) { const int c = 64 * it + (r & 3) + 8 * (r >> 2) + 4 * h; rs += (c <= cmaxt ? fexp(s[0][r] - mn) : 0.f) + (c + 32 <= cmaxt ? fexp(s[1][r] - mn) : 0.f); }
      rs = xsum32(rs);
      l1 = l1 * fexp(m1 - mn) + rs; m1 = mn;
    }
    f32x16 o[2];
#pragma unroll
    for (int r = 0; r < 16; ++r) { o[0][r] = 0.f; o[1][r] = 0.f; }
    { const float il = 1.f / fmaxf(l1, 1e-20f);
      for (; it < itC; ++it) {
        NSA_STEP();
        const int i = it - nct, tl = l31 >> 2, r4 = l31 & 3;
        f32x16 s[2]; nsa_qk(s, slot, qf, koff);
#pragma unroll
        for (int r = 0; r < 16; ++r) { const int c = 64 * i + (r & 3) + 8 * (r >> 2) + 4 * h; s[0][r] = c <= cmaxt ? fexp(s[0][r] - m1) * il : 0.f; s[1][r] = c + 32 <= cmaxt ? fexp(s[1][r] - m1) * il : 0.f; }
#pragma unroll
        for (int kt = 0; kt < 2; ++kt)
#pragma unroll
          for (int a = 0; a < 4; ++a) {
            float v4 = (s[kt][4 * a] + s[kt][4 * a + 1]) + (s[kt][4 * a + 2] + s[kt][4 * a + 3]), cy = s[kt][4 * a + 3];
            v4 += DPPF(v4, 0xb1, 0xf); v4 += DPPF(v4, 0x4e, 0xf); cy += DPPF(cy, 0xb1, 0xf); cy += DPPF(cy, 0x4e, 0xf);
            const int jj = 16 * i + 8 * kt + 2 * a + h;
            if (r4 == 0) { LAS float* ip = imp + (wid * 8 + tl) * 64 + jj; ip[0] += v4; }
            if (r4 == 0 && jj < 63) { LAS float* ip = imp + (wid * 8 + tl) * 64 + jj + 1; ip[0] += cy; }
          }
        nsa_pv(o, slot + NSA_KB, s, voff);
      } }
    { const float g0 = p.gates[trow * 24 + hg * 3];
#pragma unroll
      for (int r = 0; r < 16; ++r) { obuf[r * 64] = g0 * o[0][r]; obuf[(16 + r) * 64] = g0 * o[1][r]; o[0][r] = 0.f; o[1][r] = 0.f; } }
    unsigned long long U = 0ull, mym = 0ull;
    __builtin_amdgcn_s_waitcnt(0xc07f);
    {
      const bool forced = lane0 == 0 || lane0 == j0 || lane0 == j0 - 1;
#pragma unroll
      for (int i2 = 0; i2 < 8; ++i2) { const float v = imp[(wid * 8 + i2) * 64 + lane0]; imp[(wid * 8 + i2) * 64 + lane0] = lane0 <= j0 ? (forced ? v + 1e4f : v) : -1.f; }
      __builtin_amdgcn_s_waitcnt(0xc07f);
      const int lane0_ = lane0;
#pragma unroll 1
      for (int i2 = 0; i2 < 8; ++i2) {
        const LAS float* row = imp + (wid * 8 + i2) * 64;
        int lane0 = lane0_; asm volatile("" : "+v"(lane0));
        const float mv = row[lane0]; int rank = 0;
#pragma unroll
        for (int j4 = 0; j4 < 16; ++j4) { const f32x4 v = *(const LAS f32x4*)(row + 4 * j4);
          rank += (v.x > mv || (v.x == mv && 4 * j4 < lane0)) ? 1 : 0; rank += (v.y > mv || (v.y == mv && 4 * j4 + 1 < lane0)) ? 1 : 0;
          rank += (v.z > mv || (v.z == mv && 4 * j4 + 2 < lane0)) ? 1 : 0; rank += (v.w > mv || (v.w == mv && 4 * j4 + 3 < lane0)) ? 1 : 0; }
        const unsigned long long msk = __ballot(rank < 8);
        U |= msk; if (((lane0 & 31) >> 2) == i2) mym = msk;
      } }
    float m = -1e30f, l = 0.f;
#define NSA_ONLINE(MINE, LOWPOS, JB) do { \
      f32x16 s[2]; nsa_qk(s, slot, qf, koff); \
      const int tmin_ = t0 + wid * 8, tmax_ = tmin_ + 7; \
      const bool interior_ = (64 * (JB) + 63 <= tmin_) && (64 * (JB) > tmax_ - 512 || (LOWPOS) < 0);     \
      float mx = -1e30f, rs = 0.f, mn, alpha; \
      if (interior_) { \
        _Pragma("unroll") for (int r = 0; r < 16; ++r) mx = fmaxf(mx, fmaxf(s[0][r], s[1][r])); \
        mx = xmax32(mx); \
        mn = ((MINE) && mx > m + 8.f) ? mx : m; alpha = fexp(m - mn);         \
        const float me_ = (MINE) ? mn : 1e30f;                        \
        _Pragma("unroll") for (int r = 0; r < 16; ++r) { const float p0 = fexp(s[0][r] - me_), p1 = fexp(s[1][r] - me_); s[0][r] = p0; s[1][r] = p1; rs += p0 + p1; } \
      } else { \
        unsigned ok0 = 0u, ok1 = 0u; \
        _Pragma("unroll") for (int r = 0; r < 16; ++r) { const int pos = 64 * (JB) + (r & 3) + 8 * (r >> 2) + 4 * h; if ((MINE) && pos <= t && pos > (LOWPOS)) ok0 |= 1u << r; if ((MINE) && pos + 32 <= t && pos + 32 > (LOWPOS)) ok1 |= 1u << r; } \
        _Pragma("unroll") for (int r = 0; r < 16; ++r) { if ((ok0 >> r) & 1u) mx = fmaxf(mx, s[0][r]); if ((ok1 >> r) & 1u) mx = fmaxf(mx, s[1][r]); } \
        mx = xmax32(mx); \
        mn = fmaxf(m, mx); alpha = fexp(m - mn); \
        _Pragma("unroll") for (int r = 0; r < 16; ++r) { const float p0 = ((ok0 >> r) & 1u) ? fexp(s[0][r] - mn) : 0.f, p1 = ((ok1 >> r) & 1u) ? fexp(s[1][r] - mn) : 0.f; s[0][r] = p0; s[1][r] = p1; rs += p0 + p1; } \
      } \
      rs = xsum32(rs); \
      l = l * alpha + rs; \
      if (__any(mn != m)) { _Pragma("unroll") for (int r = 0; r < 16; ++r) { o[0][r] *= alpha; o[1][r] *= alpha; } } \
      m = mn; \
      nsa_pv(o, slot + NSA_KB, s, voff); } while (0)
    for (; it < itD; ++it) {
      NSA_STEP();
      const int j = it - itC;
      if ((U >> j) & 1ull) { const bool mine = (mym >> j) & 1ull; NSA_ONLINE(mine, -1, j); }
    }
    { const float f = p.gates[trow * 24 + hg * 3 + 1] / fmaxf(l, 1e-20f);
#pragma unroll
      for (int r = 0; r < 16; ++r) { obuf[r * 64] += f * o[0][r]; obuf[(16 + r) * 64] += f * o[1][r]; o[0][r] = 0.f; o[1][r] = 0.f; }
      m = -1e30f; l = 0.f; }
    for (; it < NI; ++it) {
      NSA_STEP();
      const int j = jw0 + it - itD;
      NSA_ONLINE(true, t - 512, j);
    }
#undef NSA_ONLINE
#undef NSA_STEP
#undef NSA_ISSUE
    asm volatile("s_waitcnt vmcnt(0)" ::: "memory");
    { const float f = p.gates[trow * 24 + hg * 3 + 2] / fmaxf(l, 1e-20f);
      bf16_t* orow = p.onsab + trow * 512 + hg * 64 + 4 * (lane0 >> 5);
#pragma unroll
      for (int dt = 0; dt < 2; ++dt)
#pragma unroll
        for (int a = 0; a < 4; ++a) { u32x2 w; const int r = 4 * a;
          w.x = pk2(obuf[(16 * dt + r) * 64] + f * o[dt][r], obuf[(16 * dt + r + 1) * 64] + f * o[dt][r + 1]); w.y = pk2(obuf[(16 * dt + r + 2) * 64] + f * o[dt][r + 2], obuf[(16 * dt + r + 3) * 64] + f * o[dt][r + 3]);
          *(u32x2*)(orow + dt * 32 + a * 8) = w; } }
    __syncthreads();
  }
}

__device__ __forceinline__ float ret_logg2(int h) { return logf(1.f - exp2f(-5.f - (float)h)); }
struct WLkminRows {
  typedef XRegB16<128> Regs; const bf16_t* rowp[1];
  __device__ __forceinline__ void load(Regs& R, int k0, int tid) const { xload_b16<128>(R, rowp, k0, tid); }
  __device__ __forceinline__ void store(const Regs& R, lptr img, int, int tid) const { xstore_b16<128>(R, img, tid); }
};
struct XLcmp {
  struct Regs { u32x4 r; }; const bf16_t* src; const float* pe; lptr ximg;
  __device__ __forceinline__ void load(Regs& R, int k0, int tid) const {
    if (tid < 256) { const int l = k0 >> 6, d0 = (k0 & 63) + (tid & 3) * 8;
      const u32x4 v = *(const u32x4*)(src + (size_t)l * PJW + (k0 & 63));
      const f32x4 p0 = *(const f32x4*)(pe + l * 64 + d0), p1 = *(const f32x4*)(pe + l * 64 + d0 + 4);
      R.r.x = pk2(bflo(v.x) + p0.x, bfhi(v.x) + p0.y); R.r.y = pk2(bflo(v.y) + p0.z, bfhi(v.y) + p0.w);
      R.r.z = pk2(bflo(v.z) + p1.x, bfhi(v.z) + p1.y); R.r.w = pk2(bflo(v.w) + p1.z, bfhi(v.w) + p1.w); }
  }
  __device__ __forceinline__ void store(const Regs& R, int tid) const { if (tid < 256) *(LAS u32x4*)(ximg + kmin_off(tid >> 2, tid & 3)) = R.r; }
  __device__ __forceinline__ lptr img(int) const { return ximg; }
};
struct XLretk {
  struct Regs { u32x4 r; }; const bf16_t* src; float lg; lptr ximg;
  __device__ __forceinline__ void load(Regs& R, int k0, int tid) const {
    const u32x4 v = *(const u32x4*)(src + (size_t)k0 * PJW);
    const float z = __expf(lg * (float)(127 - k0 - (tid >> 4)));
    R.r.x = pk2(bflo(v.x) * z, bfhi(v.x) * z); R.r.y = pk2(bflo(v.y) * z, bfhi(v.y) * z); R.r.z = pk2(bflo(v.z) * z, bfhi(v.z) * z); R.r.w = pk2(bflo(v.w) * z, bfhi(v.w) * z);
  }
  __device__ __forceinline__ void store(const Regs& R, int tid) const { *(LAS u32x4*)(ximg + (tid >> 4) * 320 + (tid & 15) * 16) = R.r; }
  __device__ __forceinline__ lptr img(int) const { return ximg; }
};
__device__ __forceinline__ void phase_r1(const P& p, lptr lds, int vcu, int G) {
  const int tid = threadIdx.x, wid = __builtin_amdgcn_readfirstlane(tid >> 6), lane = tid & 63, h = lane >> 5, l31 = lane & 31;
  lptr wimg = lds, ximg = lds + 16 * 1024;
  for (int u = vcu; u < 256 + 512; u += G) {
    if (u < 256) {
      const int isv = u >> 7, rt = (u >> 2) & 31, kq = u & 3, wn = wid >> 1, wt = wid & 1;
      f32x16 acc[1][1]; acc_zero<1, 1>(acc);
      WLb16<128> wl; wl.src = (isv ? p.cw1vb : p.cw1kb) + (size_t)kq * 512 * 128; wl.ld = 128;
      XLcmp xl; { int r = rt * 64 + ((tid >> 2) & 63); r = r < NCR ? r : NCR - 1; const int b = r / (2 * NC), g = (r / NC) & 1, c = r % NC;
        xl.src = p.projb + (size_t)(b * SEQ + 16 * c + kq * 8) * PJW + (isv ? J_VC : J_KC) + g * 64 + (tid & 3) * 8; xl.pe = (isv ? p.cpv : p.cpk) + kq * 512; xl.ximg = ximg; }
      gemm_loop<1, 1>(acc, 512, wl, xl, wimg, 128 * 2 + 64, wn * 32, wt * 32, tid, lane);
      int row = rt * 64 + wt * 32 + l31, nb = wn * 32 + 4 * h; asm volatile("" : "+v"(row), "+v"(nb));
      if (row < NCR) { float* o = p.hidp + (((size_t)(isv * 4 + kq) * 2048 + row) * 128) + nb;
#pragma unroll
        for (int a = 0; a < 4; ++a) { f32x4 v = {acc[0][0][4 * a], acc[0][0][4 * a + 1], acc[0][0][4 * a + 2], acc[0][0][4 * a + 3]}; *(f32x4*)(o + a * 8) = v; } }
    } else {
      const int chunk = u - 256, bh = chunk >> 5, b = bh >> 2, hh = bh & 3, s0 = (chunk & 31) * 128, wn = wid >> 1, wt = wid & 1;
      f32x16 acc[1][2]; acc_zero<1, 2>(acc);
      const bf16_t* base = p.projb + (size_t)(b * SEQ + s0) * PJW + hh * 128;
      WLb16<128> wl; wl.src = base + J_VR; wl.ld = PJW;
      XLretk xl; xl.src = base + J_KR + (size_t)(tid >> 4) * PJW + (tid & 15) * 8; xl.lg = ret_logg2(hh); xl.ximg = ximg;
      gemm_loop<1, 2, WLb16<128>, XLretk, true, true>(acc, 128, wl, xl, wimg, 128 * 2 + 64, wn * 32, wt * 64, tid, lane, 320);
      int dcol = wt * 64 + l31, nb = wn * 32 + 4 * h; asm volatile("" : "+v"(dcol), "+v"(nb));
#pragma unroll
      for (int tn = 0; tn < 2; ++tn) { float* o = p.kv + ((size_t)chunk * 128 + dcol + tn * 32) * 128 + nb;
#pragma unroll
        for (int a = 0; a < 4; ++a) { f32x4 v = {acc[0][tn][4 * a], acc[0][tn][4 * a + 1], acc[0][tn][4 * a + 2], acc[0][tn][4 * a + 3]}; *(f32x4*)(o + a * 8) = v; } }
    }
  }
}
__device__ __forceinline__ void phase_r2(const P& p, lptr lds, int vcu, int G) {
  const int tid = threadIdx.x;
  LAS float* hs = (LAS float*)lds;
  LAS float* os = hs + 1024;
  const LAS float* inv64 = (const LAS float*)(lds + LDS_INV64);
  for (int u = vcu; u < 2 * 255; u += G) {
    const int isv = u >= 255, r0 = (isv ? u - 255 : u) * 8;
    { const int i = tid, row = r0 + (i >> 7), k = i & 127;
#pragma unroll
      for (int q = 0; q < 2; ++q) { const int rr = row + 4 * q; float a = 0.f;
#pragma unroll
        for (int kq = 0; kq < 4; ++kq) a += p.hidp[((size_t)(isv * 4 + kq) * 2048 + rr) * 128 + k];
        hs[(rr - r0) * 128 + k] = gelu_tanh(a); } }
    __syncthreads();
    { const int rl = tid >> 6, n = tid & 63; const float* w2 = isv ? p.cw2v : p.cw2k; float a = 0.f;
#pragma unroll 8
      for (int k = 0; k < 128; ++k) a += hs[rl * 128 + k] * w2[k * 64 + n];
      os[rl * 64 + n] = a; }
    __syncthreads();
    { const int rl = tid >> 6, n = tid & 63, row = r0 + rl; float y = os[rl * 64 + n];
      if (!isv) { const int b = row / (2 * NC), c = row % NC, i = n & 31;
        const float fr = __builtin_amdgcn_fractf((float)p.pos[b * SEQ + 16 * c + 31] * inv64[i]);
        const float sn = __builtin_amdgcn_sinf(fr), cs = __builtin_amdgcn_cosf(fr), x1 = os[rl * 64 + i], x2 = os[rl * 64 + i + 32];
        y = n < 32 ? x1 * cs - x2 * sn : x1 * sn + x2 * cs; }
      (isv ? p.vcmpb : p.kcmpb)[(size_t)row * 64 + n] = (bf16_t)(pk2(y, 0.f) & 0xffffu); }
    __syncthreads();
  }
  for (int id = vcu * 512 + tid; id < 16 * 16384; id += G * 512) {
    const int bh = id >> 14, de = id & 16383; const float gc = __expf(ret_logg2(bh & 3) * 128.f);
    float v[32];
#pragma unroll
    for (int n = 0; n < 32; ++n) v[n] = p.kv[(size_t)(bh * 32 + n) * 16384 + de];
    float st = 0.f;
#pragma unroll
    for (int n = 0; n < 32; ++n) { p.stateb[(size_t)(bh * 32 + n) * 16384 + de] = (bf16_t)(pk2(st, 0.f) & 0xffffu); st = st * gc + v[n]; }
  }
}
__device__ __forceinline__ void phase_r3(const P& p, lptr lds, int vcu, int G) {
  const int tid = threadIdx.x, wid = __builtin_amdgcn_readfirstlane(tid >> 6), lane = tid & 63, h = lane >> 5, l31 = lane & 31, wn = wid >> 2, wt = wid & 3;
  lptr wimg = lds, ximg = lds + 12 * 1024, scb = lds + 20 * 1024;
  LAS float* part = (LAS float*)(lds + 52 * 1024);
  for (int chunk = vcu; chunk < 512; chunk += G) {
    const int bh = chunk >> 5, b = bh >> 2, hh = bh & 3, s0 = (chunk & 31) * 128; const float lg = ret_logg2(hh);
    const bf16_t* base = p.projb + (size_t)(b * SEQ + s0) * PJW + hh * 128;
    f32x16 acc[2][1];
    acc_zero<2, 1>(acc);
    { WLkminRows wl; wl.rowp[0] = base + J_KR + (size_t)((tid >> 2) & 127) * PJW;
      XLrows<128> xl; xl.rowp[0] = base + J_QR + (size_t)((tid >> 2) & 127) * PJW; xl.ximg = ximg;
      gemm_loop<2, 1, WLkminRows, XLrows<128>, false, false>(acc, 128, wl, xl, wimg, 0, wn * 64, wt * 32, tid, lane); }
    { int i = wt * 32 + l31, jb = wn * 64 + 4 * h; asm volatile("" : "+v"(i), "+v"(jb));
#pragma unroll
      for (int tm = 0; tm < 2; ++tm)
#pragma unroll
        for (int a = 0; a < 4; ++a) { const int j = jb + tm * 32 + a * 8; float o[4];
#pragma unroll
          for (int q = 0; q < 4; ++q) o[q] = i >= j + q ? acc[tm][0][4 * a + q] * __expf(lg * (float)(i - j - q)) : 0.f;
          u32x2 w; w.x = pk2(o[0], o[1]); w.y = pk2(o[2], o[3]);
          *(LAS u32x2*)(scb + (j >> 5) * 8192 + kmin_off(i, (j & 31) >> 3) + (j & 7) * 2) = w; } }
    __syncthreads();
    acc_zero<2, 1>(acc);
    { WLb16<128> wl; wl.src = p.stateb + (size_t)chunk * 16384; wl.ld = 128;
      XLrows<128> xl; xl.rowp[0] = base + J_QR + (size_t)((tid >> 2) & 127) * PJW; xl.ximg = ximg;
      gemm_loop<2, 1>(acc, 128, wl, xl, wimg, 128 * 2 + 64, wn * 64, wt * 32, tid, lane); }
    { const float xi = __expf(lg * (float)(wt * 32 + l31 + 1));
#pragma unroll
      for (int tm = 0; tm < 2; ++tm)
#pragma unroll
        for (int r = 0; r < 16; ++r) acc[tm][0][r] *= xi; }
    { WLb16<128> wl; wl.src = base + J_VR; wl.ld = PJW;
      XLres xl; xl.base = scb; xl.bytes = 8192;
      gemm_loop<2, 1>(acc, 128, wl, xl, wimg, 128 * 2 + 64, wn * 64, wt * 32, tid, lane); }
    { float ss = 0.f;
#pragma unroll
      for (int tm = 0; tm < 2; ++tm)
#pragma unroll
        for (int r = 0; r < 16; ++r) ss += acc[tm][0][r] * acc[tm][0][r];
      ss += __shfl_xor(ss, 32);
      if (h == 0) part[wn * 128 + wt * 32 + l31] = ss; }
    __syncthreads();
    { int i = wt * 32 + l31, eb = wn * 64 + 4 * h; asm volatile("" : "+v"(i), "+v"(eb));
      const float rs = rsqrtf((part[i] + part[128 + i]) * (1.f / 128.f) + EPS);
      const size_t trow = (size_t)(b * SEQ + s0 + i);
#pragma unroll
      for (int tm = 0; tm < 2; ++tm)
#pragma unroll
        for (int a = 0; a < 4; ++a) { const int e = eb + tm * 32 + a * 8;
          const f32x4 gr = *(const f32x4*)(p.g_ret + hh * 128 + e); const u32x2 gt = *(const u32x2*)(p.projb + trow * PJW + J_GR + hh * 128 + e);
          u32x2 w; w.x = pk2(acc[tm][0][4 * a] * rs * gr.x * bflo(gt.x), acc[tm][0][4 * a + 1] * rs * gr.y * bfhi(gt.x));
          w.y = pk2(acc[tm][0][4 * a + 2] * rs * gr.z * bflo(gt.y), acc[tm][0][4 * a + 3] * rs * gr.w * bfhi(gt.y));
          *(u32x2*)(p.mixb + trow * D + 512 + hh * 128 + e) = w; } }
    __syncthreads();
  }
  for (int tok = vcu * 8 + wid; tok < T; tok += G * 8) {
    const u32x4 v = *(const u32x4*)(p.onsab + (size_t)tok * 512 + lane * 8);
    float x[8] = {bflo(v.x), bfhi(v.x), bflo(v.y), bfhi(v.y), bflo(v.z), bfhi(v.z), bflo(v.w), bfhi(v.w)};
    float ss = 0.f;
#pragma unroll
    for (int q = 0; q < 8; ++q) ss += x[q] * x[q];
    ss = wave_sum(ss);
    const float rs = rsqrtf(ss * (1.f / 512.f) + EPS);
    const f32x4 g0 = *(const f32x4*)(p.g_nsa + lane * 8), g1 = *(const f32x4*)(p.g_nsa + lane * 8 + 4);
    u32x4 w; w.x = pk2(x[0] * rs * g0.x, x[1] * rs * g0.y); w.y = pk2(x[2] * rs * g0.z, x[3] * rs * g0.w); w.z = pk2(x[4] * rs * g1.x, x[5] * rs * g1.y); w.w = pk2(x[6] * rs * g1.z, x[7] * rs * g1.w);
    *(u32x4*)(p.mixb + (size_t)tok * D + lane * 8) = w;
  }
}

__device__ __forceinline__ void phase5a(const P& p, lptr lds, int vcu, int G) {
  const int tid = threadIdx.x, wid = __builtin_amdgcn_readfirstlane(tid >> 6), lane = tid & 63, wn = wid >> 2, wt = wid & 3;
  for (int u = vcu; u < 4 * 64; u += G) {
    const int j = u & 3, t0 = (u >> 2) * 256, b = t0 / SEQ;
    f32x16 acc[4][2];
    { const bf16_t* wb = p.woutb + j * 256; const bf16_t* xb = p.mixb + (size_t)t0 * D;
      gemm256_dma(acc, wb + (size_t)g2_wrow(wid, 0, lane) * D + g2_wcol(wid, 0, lane), wb + (size_t)g2_wrow(wid, 1, lane) * D + g2_wcol(wid, 1, lane), (size_t)32 * D,
                  xb + (size_t)g2_xtok(wid, 0, lane) * D + g2_xk(wid, 0, lane), xb + (size_t)g2_xtok(wid, 1, lane) * D + g2_xk(wid, 1, lane), D, lds, wn, wt, wid, lane); }
#pragma unroll
    for (int tn = 0; tn < 2; ++tn) {
      { int rl = wt * 32 + (lane & 31), cb = (wn * 128 + 4 * (lane >> 5)) * 2; asm volatile("" : "+v"(rl), "+v"(cb));
#pragma unroll
        for (int tm = 0; tm < 4; ++tm)
#pragma unroll
          for (int a = 0; a < 4; ++a) { u32x2 o; o.x = pk2(acc[tm][tn][4 * a], acc[tm][tn][4 * a + 1]); o.y = pk2(acc[tm][tn][4 * a + 2], acc[tm][tn][4 * a + 3]);
            *(LAS u32x2*)(lds + rl * 528 + cb + (tm * 32 + a * 8) * 2) = o; } }
      __syncthreads();
#pragma unroll
      for (int rr = 0; rr < 8; ++rr) { const int row = wid * 16 + rr * 2 + (lane >> 5);
        *(u32x4*)(p.mixo + (size_t)(t0 + (row >> 5) * 64 + tn * 32 + (row & 31)) * D + j * 256 + (lane & 31) * 8) = *(const LAS u32x4*)(lds + row * 528 + (lane & 31) * 16); }
      __syncthreads();
    }
  }
}
__device__ __forceinline__ void phase5b(const P& p, lptr lds, int vcu, int G) {
  const int tid = threadIdx.x, wid = tid >> 6, lane = tid & 63;
  for (int row = vcu * 8 + wid; row < T; row += G * 8) {
    const int b = row / SEQ;
    f32x4 v[4]; float s = 0.f;
#pragma unroll
    for (int j = 0; j < 4; ++j) { const int k = j * 256 + lane * 4;
      const f32x4 xv = *(const f32x4*)(p.x + (size_t)row * D + k), gt = *(const f32x4*)(p.mod + b * 6144 + 2048 + k); const u32x2 mo = *(const u32x2*)(p.mixo + (size_t)row * D + k);
      v[j].x = xv.x + gt.x * bflo(mo.x); v[j].y = xv.y + gt.y * bfhi(mo.x); v[j].z = xv.z + gt.z * bflo(mo.y); v[j].w = xv.w + gt.w * bfhi(mo.y);
      s += v[j].x * v[j].x + v[j].y * v[j].y + v[j].z * v[j].z + v[j].w * v[j].w; }
    s = wave_sum(s);
    const float r = rsqrtf(s * (1.f / D) + EPS);
#pragma unroll
    for (int j = 0; j < 4; ++j) {
      const int k = j * 256 + lane * 4;
      const f32x4 g = *(const f32x4*)(p.g_ffn + k), sc = *(const f32x4*)(p.mod + b * 6144 + 4096 + k), sh = *(const f32x4*)(p.mod + b * 6144 + 3072 + k);
      u32x2 o; o.x = pk2(v[j].x * r * g.x * (1.f + sc.x) + sh.x, v[j].y * r * g.y * (1.f + sc.y) + sh.y); o.y = pk2(v[j].z * r * g.z * (1.f + sc.z) + sh.z, v[j].w * r * g.w * (1.f + sc.w) + sh.w);
      *(u32x2*)(p.h2b + (size_t)row * D + k) = o;
    }
  }
}
__device__ __forceinline__ void phase5c(const P& p, lptr lds, int vcu, int G) {
  const int tid = threadIdx.x, wid = __builtin_amdgcn_readfirstlane(tid >> 6), lane = tid & 63, wn = wid >> 2, wt = wid & 3;
  for (int u = vcu; u < 3 * 64; u += G) {
    const int j = u % 3, t0 = (u / 3) * 256;
    f32x16 acc[4][2];
    { const bf16_t* xb = p.h2b + (size_t)t0 * D; const bf16_t* wq[2];
#pragma unroll
      for (int i = 0; i < 2; ++i) { const int k = g2_wrow(wid, i, lane), col = g2_wcol(wid, i, lane);
        if (j == 0) wq[i] = p.wrb + (size_t)k * NE + col;
        else { const int grp = col >> 7, w = col & 127; const unsigned long long ga = (unsigned long long)p.wgsb, ua = (unsigned long long)p.wusb;
          wq[i] = (const bf16_t*)(w < 64 ? ga : ua) + (size_t)k * 256 + (j - 1) * 128 + grp * 64 + (w & 63); } }
      gemm256_dma(acc, wq[0], wq[1], (size_t)32 * 256, xb + (size_t)g2_xtok(wid, 0, lane) * D + g2_xk(wid, 0, lane), xb + (size_t)g2_xtok(wid, 1, lane) * D + g2_xk(wid, 1, lane), D, lds, wn, wt, wid, lane); }
    int h4 = 4 * (lane >> 5), tb = t0 + wt * 64 + (lane & 31); asm volatile("" : "+v"(h4), "+v"(tb));
    if (j == 0) {
#pragma unroll
      for (int tn = 0; tn < 2; ++tn)
#pragma unroll
        for (int tm = 0; tm < 4; ++tm)
#pragma unroll
          for (int a = 0; a < 4; ++a) { f32x4 v = {acc[tm][tn][4 * a], acc[tm][tn][4 * a + 1], acc[tm][tn][4 * a + 2], acc[tm][tn][4 * a + 3]};
            *(f32x4*)(p.logits + (size_t)(tb + tn * 32) * NE + wn * 128 + tm * 32 + a * 8 + h4) = v; }
    } else {
#pragma unroll
      for (int tn = 0; tn < 2; ++tn)
#pragma unroll
        for (int tm = 0; tm < 2; ++tm)
#pragma unroll
          for (int a = 0; a < 4; ++a) { float o[4];
#pragma unroll
            for (int q = 0; q < 4; ++q) { const float gv = acc[tm][tn][4 * a + q], uv = acc[tm + 2][tn][4 * a + q]; o[q] = gv * __builtin_amdgcn_rcpf(1.f + __builtin_amdgcn_exp2f(-1.4426950408889634f * gv)) * uv; }
            u32x2 w; w.x = pk2(o[0], o[1]); w.y = pk2(o[2], o[3]);
            *(u32x2*)(p.actsb + (size_t)(tb + tn * 32) * 256 + (j - 1) * 128 + wn * 64 + tm * 32 + a * 8 + h4) = w; }
    }
  }
}
__device__ __forceinline__ void phase5d(const P& p, lptr lds, int vcu, int G) {
  const int tid = threadIdx.x, wid = __builtin_amdgcn_readfirstlane(tid >> 6), lane = tid & 63, wn = wid >> 2, wt = wid & 3;
  { const f32x4 rb = *(const f32x4*)(p.rbias + lane * 4);
    for (int tok = vcu * 8 + wid; tok < T; tok += G * 8) {
      const f32x4 lv = *(const f32x4*)(p.logits + (size_t)tok * NE + lane * 4);
      const float s0 = sigm(lv.x), s1 = sigm(lv.y), s2 = sigm(lv.z), s3 = sigm(lv.w);
      float c0 = s0 + rb.x, c1 = s1 + rb.y, c2 = s2 + rb.z, c3 = s3 + rb.w;
      float m1, m2;
      { const float h1 = fmaxf(c0, c1), l1 = fminf(c0, c1), h2 = fmaxf(c2, c3), l2 = fminf(c2, c3); m1 = fmaxf(h1, h2); m2 = fmaxf(fminf(h1, h2), fmaxf(l1, l2)); }
#define TOP2_MERGE(ctrl) { const float o1 = DPPF(m1, ctrl, 0xf), o2 = DPPF(m2, ctrl, 0xf); const float n1 = fmaxf(m1, o1), n2 = fmaxf(fminf(m1, o1), fmaxf(m2, o2)); m1 = n1; m2 = n2; }
      TOP2_MERGE(0xb1) TOP2_MERGE(0x4e) TOP2_MERGE(0x141)
#undef TOP2_MERGE
      const float gs = m1 + m2; const int myg = lane >> 3; int rank = 0;
#pragma unroll
      for (int g2 = 0; g2 < 8; ++g2) { const float og = __int_as_float(__builtin_amdgcn_readlane(__float_as_int(gs), g2 * 8)); rank += (og > gs || (og == gs && g2 < myg)) ? 1 : 0; }
      if (rank >= 4) { c0 = -INFINITY; c1 = -INFINITY; c2 = -INFINITY; c3 = -INFINITY; }
      int my_e = 0; float my_s = 0.f, wsum = 0.f;
#pragma unroll
      for (int k = 0; k < 8; ++k) {
        const float mx = wave_max_u(fmaxf(fmaxf(c0, c1), fmaxf(c2, c3)));
        const unsigned long long b0 = __ballot(c0 == mx), b1 = __ballot(c1 == mx), b2 = __ballot(c2 == mx), b3 = __ballot(c3 == mx);
        int li = 1 << 20;
        if (b0) li = min(li, 4 * (int)__builtin_ctzll(b0));
        if (b1) li = min(li, 4 * (int)__builtin_ctzll(b1) + 1);
        if (b2) li = min(li, 4 * (int)__builtin_ctzll(b2) + 2);
        if (b3) li = min(li, 4 * (int)__builtin_ctzll(b3) + 3);
        li = __builtin_amdgcn_readfirstlane(li);
        const int jx = li & 3; const float sj = jx == 0 ? s0 : jx == 1 ? s1 : jx == 2 ? s2 : s3;
        const float sv = __int_as_float(__builtin_amdgcn_readlane(__float_as_int(sj), li >> 2));
        if (lane * 4 == li) c0 = -INFINITY;
        if (lane * 4 + 1 == li) c1 = -INFINITY;
        if (lane * 4 + 2 == li) c2 = -INFINITY;
        if (lane * 4 + 3 == li) c3 = -INFINITY;
        wsum += sv;
        if (lane == k) { my_e = li; my_s = sv; }
      }
      if (lane < 8) { const int pos = atomicAdd(&p.cnt[my_e * CPAD], 1); p.list[my_e * ECAP + pos] = tok * 8 + lane; p.wts[tok * 8 + lane] = my_s / wsum * 2.5f; }
    } }
  __syncthreads();
  for (int u = vcu; u < 4 * 64; u += G) {
    const int j = u & 3, t0 = (u >> 2) * 256, b = t0 / SEQ;
    f32x16 acc[4][2];
    { const bf16_t* wb = p.wdsb + j * 256; const bf16_t* xb = p.actsb + (size_t)t0 * 256;
      gemm256_dma(acc, wb + (size_t)g2_wrow(wid, 0, lane) * D + g2_wcol(wid, 0, lane), wb + (size_t)g2_wrow(wid, 1, lane) * D + g2_wcol(wid, 1, lane), (size_t)32 * D,
                  xb + (size_t)g2_xtok(wid, 0, lane) * 256 + g2_xk(wid, 0, lane), xb + (size_t)g2_xtok(wid, 1, lane) * 256 + g2_xk(wid, 1, lane), 256, lds, wn, wt, wid, lane); }
    int nb = j * 256 + wn * 128 + 4 * (lane >> 5), tb = t0 + wt * 64 + (lane & 31); asm volatile("" : "+v"(nb), "+v"(tb));
#pragma unroll
    for (int tn = 0; tn < 2; ++tn)
#pragma unroll
      for (int tm = 0; tm < 4; ++tm)
#pragma unroll
        for (int a = 0; a < 4; ++a) { u32x2 w; w.x = pk2(acc[tm][tn][4 * a], acc[tm][tn][4 * a + 1]); w.y = pk2(acc[tm][tn][4 * a + 2], acc[tm][tn][4 * a + 3]);
          *(u32x2*)(p.ysb + (size_t)(tb + tn * 32) * D + nb + tm * 32 + a * 8) = w; }
  }
}

constexpr int NPHASE = 13;
__global__ void __launch_bounds__(512) mega(P p, int lo, int hi) {
  extern __shared__ __attribute__((aligned(16))) char lds_raw[];
  lptr lds = (lptr)lds_raw;
  const int tid = threadIdx.x, G = gridDim.x;
  const int vcu = (G % 8 == 0) ? ((int)blockIdx.x % 8) * (G / 8) + (int)blockIdx.x / 8 : (int)blockIdx.x;
  if (tid < 32) ((LAS float*)(lds + LDS_INV64))[tid] = exp2f(-(float)(2 * tid) / 64.f * 13.287712379549449f) * 0.15915494309189535f;
  if (tid < 64) ((LAS float*)(lds + LDS_INV128))[tid] = exp2f(-(float)(2 * tid) / 128.f * 13.287712379549449f) * 0.15915494309189535f;
  if (tid < 4) ((LAS unsigned*)(lds + LDS_XB))[tid] = 0u;
  __syncthreads();
  XcdBarrier xb; xb.bar = p.bar; xb.x = 0; xb.st = (volatile LAS unsigned*)(lds + LDS_XB);
  if (hi - lo > 1) xb = xcd_barrier_post(p.bar, (volatile LAS unsigned*)(lds + LDS_XB));
#define PH(k, call) if (lo <= (k) && (k) < hi) { call; if ((k) + 1 < hi) xcd_barrier(xb); }
  PH(0, phase0a(p, lds, vcu, G));
  PH(1, phase0b(p, lds, vcu, G));
  PH(2, phase1(p, lds, vcu, G));
  PH(3, phase_r1(p, lds, vcu, G));
  PH(4, phase_r2(p, lds, vcu, G));
  PH(5, phase_nsa(p, lds, vcu, G));
  PH(6, phase_r3(p, lds, vcu, G));
  PH(7, phase5a(p, lds, vcu, G));
  PH(8, phase5b(p, lds, vcu, G));
  PH(9, phase5c(p, lds, vcu, G));
  PH(10, phase5d(p, lds, vcu, G));
  PH(11, phase6(p, lds, vcu, G));
  PH(12, phase7(p, lds, vcu, G));
#undef PH
}
}

extern "C" void kernel_launch(void* const* d_in, const int* in_sizes, int n_in, void* d_out, int out_size, void* d_ws, size_t ws_size, hipStream_t stream) {
  P p{};
  p.x = (const float*)d_in[0]; p.c = (const float*)d_in[1]; p.pos = (const int*)d_in[2];
  p.w_ada = (const float*)d_in[3]; p.b_ada = (const float*)d_in[4]; p.g_mix = (const float*)d_in[5]; p.w_in = (const float*)d_in[6];
  p.cpk = (const float*)d_in[7]; p.cw1k = (const float*)d_in[8]; p.cw2k = (const float*)d_in[9];
  p.cpv = (const float*)d_in[10]; p.cw1v = (const float*)d_in[11]; p.cw2v = (const float*)d_in[12];
  p.g_nsa = (const float*)d_in[13]; p.g_ret = (const float*)d_in[14]; p.w_out = (const float*)d_in[15]; p.g_ffn = (const float*)d_in[16];
  p.w_router = (const float*)d_in[17]; p.rbias = (const float*)d_in[18]; p.wg_e = (const float*)d_in[19]; p.wu_e = (const float*)d_in[20];
  p.wd_e = (const float*)d_in[21]; p.wg_s = (const float*)d_in[22]; p.wu_s = (const float*)d_in[23]; p.wd_s = (const float*)d_in[24];
  p.g_final = (const float*)d_in[25];
  p.out = (float*)d_out;
  char* w = (char*)d_ws; size_t off = 0;
  auto take = [&](size_t bytes) { char* r = w + off; off += (bytes + 255) & ~(size_t)255; return r; };
  p.bar = (unsigned*)take(XCD_BAR_WORDS * 4);
  p.cnt = (int*)take(NE * CPAD * 4);
  const size_t zero_bytes = off;
  p.mod = (float*)take(BATCH * 6144 * 4);
  p.hidp = (float*)take((size_t)8 * 2048 * 128 * 4);
  p.kv = (float*)take((size_t)512 * 16384 * 4);
  p.stateb = (bf16_t*)take((size_t)512 * 16384 * 2);
  p.logits = (float*)take((size_t)T * NE * 4); p.actsb = (bf16_t*)take((size_t)T * 256 * 2); p.ysb = (bf16_t*)take((size_t)T * D * 2); p.mixo = (bf16_t*)take((size_t)T * D * 2);
  p.wts = (float*)take((size_t)T * 8 * 4);
  p.list = (int*)take((size_t)NE * ECAP * 4);
  p.gates = (float*)take((size_t)T * 24 * 4);
  p.winb = (bf16_t*)take((size_t)D * INW * 2); p.woutb = (bf16_t*)take((size_t)D * D * 2); p.wrb = (bf16_t*)take((size_t)D * NE * 2);
  p.wgsb = (bf16_t*)take((size_t)D * 256 * 2); p.wusb = (bf16_t*)take((size_t)D * 256 * 2); p.wdsb = (bf16_t*)take((size_t)256 * D * 2);
  p.cw1kb = (bf16_t*)take(2048 * 128 * 2); p.cw1vb = (bf16_t*)take(2048 * 128 * 2); p.cw2kb = (bf16_t*)take(128 * 64 * 2); p.cw2vb = (bf16_t*)take(128 * 64 * 2);
  p.hb = (bf16_t*)take((size_t)T * D * 2);
  p.projb = (bf16_t*)take((size_t)T * PJW * 2);
  p.mixb = (bf16_t*)take((size_t)T * D * 2); p.h2b = (bf16_t*)take((size_t)T * D * 2);
  p.slab = (bf16_t*)take((size_t)T * 8 * D * 2);
  p.kcmpb = (bf16_t*)take((2048 + 64) * 64 * 2); p.vcmpb = (bf16_t*)take((2048 + 64) * 64 * 2);
  p.onsab = (bf16_t*)take((size_t)T * 512 * 2);
  if (off > ws_size) { fprintf(stderr, "kernel_launch: workspace too small: need %zu have %zu\n", off, ws_size); return; }
  static int grid = 0;
  if (!grid) {
    int dev = 0, cus = 0, per_cu = 0;
    (void)hipGetDevice(&dev);
    (void)hipDeviceGetAttribute(&cus, hipDeviceAttributeMultiprocessorCount, dev);
    (void)hipFuncSetAttribute((const void*)mega, hipFuncAttributeMaxDynamicSharedMemorySize, LDS_BYTES);
    (void)hipOccupancyMaxActiveBlocksPerMultiprocessor(&per_cu, (const void*)mega, 512, LDS_BYTES);
    if (per_cu < 1) fprintf(stderr, "kernel_launch: occupancy query says %d blocks per CU\n", per_cu);
    grid = cus;
  }
  (void)hipMemsetAsync(d_ws, 0, zero_bytes, stream);
  hipLaunchKernelGGL(mega, dim3(grid), dim3(512), LDS_BYTES, stream, p, 0, NPHASE);
}
```

```cpp
#include <hip/hip_runtime.h>
#include <cstdint>
#include <cstdio>

namespace {
constexpr int D = 1024, BATCH = 4, SEQ = 4096, T = BATCH * SEQ;
constexpr int INW = 3352;
constexpr int C_QN = 0, C_KC = 512, C_VC = 640, C_KS = 768, C_VS = 896, C_KW = 1024, C_VW = 1152, C_GN = 1280,
              C_QR = 1304, C_KR = 1816, C_VR = 2328, C_GR = 2840;
constexpr int PJW = 3328, J_QN = 0, J_KC = 512, J_VC = 640, J_KS = 768, J_VS = 896, J_KW = 1024, J_VW = 1152, J_QR = 1280, J_KR = 1792, J_VR = 2304, J_GR = 2816;
constexpr int NC = 255, NCR = BATCH * 2 * NC;
constexpr int NE = 256, ECAP = 16384, CPAD = 32;
constexpr float EPS = 1e-6f;
typedef unsigned short bf16_t;

struct P {
  const float *x, *c; const int* pos;
  const float *w_ada, *b_ada, *g_mix, *w_in, *cpk, *cw1k, *cw2k, *cpv, *cw1v, *cw2v, *g_nsa, *g_ret, *w_out, *g_ffn,
      *w_router, *rbias, *wg_e, *wu_e, *wd_e, *wg_s, *wu_s, *wd_s, *g_final;
  float* out;
  float *mod, *kv, *logits, *wts, *gates;
  int *cnt, *list;
  bf16_t *winb, *woutb, *wrb, *wgsb, *wusb, *wdsb, *cw1kb, *cw1vb, *cw2kb, *cw2vb, *hb, *projb, *mixb, *h2b, *slab, *kcmpb, *vcmpb, *onsab, *stateb, *actsb, *ysb, *mixo;
  float *hidp;
  unsigned* bar;
};

#define LAS __attribute__((address_space(3)))
typedef LAS char* lptr;
typedef short bf16x8 __attribute__((ext_vector_type(8)));
typedef short v4i16_t __attribute__((ext_vector_type(4)));
typedef float f32x16 __attribute__((ext_vector_type(16)));
typedef float f32x4 __attribute__((ext_vector_type(4)));
typedef float f32x2_t __attribute__((ext_vector_type(2)));
typedef __bf16 bf16x2_t __attribute__((ext_vector_type(2)));
typedef unsigned u32x4 __attribute__((ext_vector_type(4)));
typedef unsigned u32x2 __attribute__((ext_vector_type(2)));

#define DPPF(x, ctrl, rm) __int_as_float(__builtin_amdgcn_update_dpp(__float_as_int(x), __float_as_int(x), ctrl, rm, 0xf, false))
__device__ __forceinline__ float wave_max_u(float v) {
  v = fmaxf(v, DPPF(v, 0xb1, 0xf)); v = fmaxf(v, DPPF(v, 0x4e, 0xf)); v = fmaxf(v, DPPF(v, 0x124, 0xf)); v = fmaxf(v, DPPF(v, 0x128, 0xf));
  v = fmaxf(v, DPPF(v, 0x142, 0xa)); v = fmaxf(v, DPPF(v, 0x143, 0xc));
  return __int_as_float(__builtin_amdgcn_readlane(__float_as_int(v), 63));
}
__device__ __forceinline__ float wave_sum(float v) {
  v += DPPF(v, 0xb1, 0xf); v += DPPF(v, 0x4e, 0xf); v += DPPF(v, 0x124, 0xf); v += DPPF(v, 0x128, 0xf);
  { const float t = __int_as_float(__builtin_amdgcn_update_dpp(0, __float_as_int(v), 0x142, 0xa, 0xf, false)); v += t; }
  { const float t = __int_as_float(__builtin_amdgcn_update_dpp(0, __float_as_int(v), 0x143, 0xc, 0xf, false)); v += t; }
  return __int_as_float(__builtin_amdgcn_readlane(__float_as_int(v), 63));
}
__device__ __forceinline__ float wave_max(float v) { return wave_max_u(v); }
__device__ __forceinline__ float silu(float v) { return v / (1.f + expf(-v)); }
__device__ __forceinline__ float sigm(float v) { return 1.f / (1.f + expf(-v)); }
__device__ __forceinline__ float gelu_tanh(float v) { return 0.5f * v * (1.f + tanhf(0.7978845608028654f * (v + 0.044715f * v * v * v))); }
__device__ __forceinline__ unsigned pk2(float lo, float hi) { f32x2_t v = {lo, hi}; bf16x2_t b = __builtin_convertvector(v, bf16x2_t); return __builtin_bit_cast(unsigned, b); }
__device__ __forceinline__ float bf2f(bf16_t u) { return __uint_as_float((unsigned)u << 16); }
__device__ __forceinline__ float bflo(unsigned u) { return __uint_as_float(u << 16); }
__device__ __forceinline__ float bfhi(unsigned u) { return __uint_as_float(u & 0xffff0000u); }

#define XB_TMO      128
#define XB_XCNT(j)  (256  + 64 * (j))
#define XB_XSUB(j)  (1280 + 64 * (j))
#define XB_XGEN(j)  (2304 + 64 * (j))
#define XB_TOP      3328
#define XB_TOPGEN   3392
#define XCD_BAR_WORDS 3456
#define XB_SPIN_CAP (1u << 18)
__device__ __forceinline__ unsigned xb_ld(unsigned* p)              { return __hip_atomic_load(p, __ATOMIC_RELAXED, __HIP_MEMORY_SCOPE_AGENT); }
__device__ __forceinline__ unsigned xb_add(unsigned* p, unsigned v) { return __hip_atomic_fetch_add(p, v, __ATOMIC_RELAXED, __HIP_MEMORY_SCOPE_AGENT); }
__device__ __forceinline__ unsigned xb_xcc_id() { return (unsigned)__builtin_amdgcn_s_getreg((3 << 11) | 20) & 0xFu; }
#define XB_SPIN(cond, bar) do { unsigned _sp = 0; while (cond) { __builtin_amdgcn_s_sleep(1); \
    if ((++_sp & 255u) == 0u) { if (xb_ld(&(bar)[XB_TMO])) break; if (_sp > XB_SPIN_CAP) { atomicAdd(&(bar)[XB_TMO], 1u); break; } } } } while (0)
struct XcdBarrier { unsigned* bar; unsigned x; volatile LAS unsigned* st; };
__device__ __forceinline__ XcdBarrier xcd_barrier_post(unsigned* bar, volatile LAS unsigned* st) {
    XcdBarrier b; b.bar = bar; b.x = xb_xcc_id(); b.st = st;
    if (threadIdx.x == 0) (void)xb_add(&bar[XB_XCNT(b.x)], 1u);
    return b;
}
__device__ __forceinline__ void xcd_barrier_complete(unsigned* bar, unsigned x, unsigned& nloc, unsigned& nx) {
    const unsigned G = gridDim.x * gridDim.y * gridDim.z;
    unsigned sum, cnt, mine, sp = 0u;
    for (;;) {
        sum = 0u; cnt = 0u; mine = 0u;
#pragma unroll
        for (unsigned j = 0; j < 16; ++j) { const unsigned c = xb_ld(&bar[XB_XCNT(j)]); sum += c; cnt += (c > 0u) ? 1u : 0u; mine = (j == x) ? c : mine; }
        if (sum == G) break;
        __builtin_amdgcn_s_sleep(1);
        if ((++sp & 255u) == 0u) { if (xb_ld(&bar[XB_TMO])) break; if (sp > XB_SPIN_CAP) { atomicAdd(&bar[XB_TMO], 1u); break; } }
    }
    nloc = mine > 0u ? mine : 1u; nx = cnt > 0u ? cnt : 1u;
}
__device__ __forceinline__ void xcd_barrier(const XcdBarrier& b) {
    asm volatile("s_waitcnt vmcnt(0)" ::: "memory");
    __syncthreads();
    if (threadIdx.x == 0) {
        unsigned* bar = b.bar;
        __builtin_amdgcn_s_waitcnt(0);
        unsigned nloc = b.st[0], nx = b.st[1];
        if (nloc == 0u) { xcd_barrier_complete(bar, b.x, nloc, nx); b.st[0] = nloc; b.st[1] = nx; }
        const unsigned old = xb_add(&bar[XB_XSUB(b.x)], 1u);
        const unsigned gen = old / nloc;
        if (old + 1u == (gen + 1u) * nloc) {
            __builtin_amdgcn_fence(__ATOMIC_RELEASE, "agent");
            asm volatile("s_waitcnt vmcnt(0)" ::: "memory");
            const unsigned og = xb_add(&bar[XB_TOP], 1u);
            const unsigned tg = og / nx;
            if (og + 1u == (tg + 1u) * nx) xb_add(&bar[XB_TOPGEN], 1u);
            else XB_SPIN(xb_ld(&bar[XB_TOPGEN]) == tg, bar);
            __builtin_amdgcn_fence(__ATOMIC_ACQUIRE, "agent");
            xb_add(&bar[XB_XGEN(b.x)], 1u);
            asm volatile("s_waitcnt vmcnt(0)" ::: "memory");
        } else {
            XB_SPIN(xb_ld(&bar[XB_XGEN(b.x)]) == gen, bar);
            __builtin_amdgcn_fence(__ATOMIC_ACQUIRE, "agent");
            asm volatile("s_waitcnt vmcnt(0)" ::: "memory");
        }
    }
    __syncthreads();
}

__device__ __forceinline__ bf16x8 frag_kmaj(lptr img, int rs, int o, int s, int lane) {
  const int h = lane >> 5, blk = (lane >> 4) & 1, q = (lane & 15) >> 2, pp = lane & 3;
  lptr a = img + (16 * s + 8 * h + q) * rs + (o + 16 * blk + 4 * pp) * 2;
  const v4i16_t lo = __builtin_amdgcn_ds_read_tr16_b64_v4i16((LAS v4i16_t*)a);
  const v4i16_t hi = __builtin_amdgcn_ds_read_tr16_b64_v4i16((LAS v4i16_t*)(a + 4 * rs));
  return (bf16x8){lo[0], lo[1], lo[2], lo[3], hi[0], hi[1], hi[2], hi[3]};
}
__device__ __forceinline__ bf16x8 frag_kmin(lptr img, int o, int s, int lane) {
  const int row = o + (lane & 31), c = 2 * s + (lane >> 5);
  return *(LAS bf16x8*)(img + row * 64 + ((c ^ ((row >> 2) & 3)) << 4));
}
__device__ __forceinline__ int kmin_off(int row, int c) { return row * 64 + ((c ^ ((row >> 2) & 3)) << 4); }

template <int TM, int TN, bool WKMAJ, bool XKMAJ>
__device__ __forceinline__ void mma_step(f32x16 (&acc)[TM][TN], lptr wimg, int wrs, int wn0, lptr ximg, int xrs, int xt0, int lane) {
#pragma unroll
  for (int s = 0; s < 2; ++s) {
    bf16x8 wf[TM], xf[TN];
#pragma unroll
    for (int tm = 0; tm < TM; ++tm) wf[tm] = WKMAJ ? frag_kmaj(wimg, wrs, wn0 + 32 * tm, s, lane) : frag_kmin(wimg, wn0 + 32 * tm, s, lane);
#pragma unroll
    for (int tn = 0; tn < TN; ++tn) xf[tn] = XKMAJ ? frag_kmaj(ximg, xrs, xt0 + 32 * tn, s, lane) : frag_kmin(ximg, xt0 + 32 * tn, s, lane);
#pragma unroll
    for (int tm = 0; tm < TM; ++tm)
#pragma unroll
      for (int tn = 0; tn < TN; ++tn) acc[tm][tn] = __builtin_amdgcn_mfma_f32_32x32x16_bf16(wf[tm], xf[tn], acc[tm][tn], 0, 0, 0);
    if (s == 0) __builtin_amdgcn_sched_barrier(0);
  }
}

template <int BNT> struct WRegB16 { u32x4 r[BNT / 128]; };
template <int BNT> __device__ __forceinline__ void wload_b16(WRegB16<BNT>& R, const bf16_t* src  , int ld, int tid) {
  constexpr int C8 = BNT / 8, KPR = 512 / C8;
  const int c8 = tid % C8, kr = tid / C8;
#pragma unroll
  for (int r = 0; r < BNT / 128; ++r) R.r[r] = *(const u32x4*)(src + (size_t)(kr + r * KPR) * ld + c8 * 8);
}
template <int BNT> __device__ __forceinline__ void wstore_b16(const WRegB16<BNT>& R, lptr img, int rs, int tid) {
  constexpr int C8 = BNT / 8, KPR = 512 / C8;
  const int c8 = tid % C8, kr = tid / C8;
#pragma unroll
  for (int r = 0; r < BNT / 128; ++r) *(LAS u32x4*)(img + (kr + r * KPR) * rs + c8 * 16) = R.r[r];
}
template <int BMT> struct XRegB16 { u32x4 r[(BMT + 127) / 128]; };
template <int BMT> __device__ __forceinline__ void xload_b16(XRegB16<BMT>& R, const bf16_t* const (&rowp)[(BMT + 127) / 128], int k0, int tid) {
#pragma unroll
  for (int r = 0; r < (BMT + 127) / 128; ++r) if (BMT >= 128 || tid < BMT * 4) R.r[r] = *(const u32x4*)(rowp[r] + k0 + (tid & 3) * 8);
}
template <int BMT> __device__ __forceinline__ void xstore_b16(const XRegB16<BMT>& R, lptr img, int tid) {
#pragma unroll
  for (int r = 0; r < (BMT + 127) / 128; ++r) if (BMT >= 128 || tid < BMT * 4) *(LAS u32x4*)(img + kmin_off((tid >> 2) + 128 * r, tid & 3)) = R.r[r];
}

template <int BNT> struct WLb16 {
  typedef WRegB16<BNT> Regs; const bf16_t* src; int ld;
  __device__ __forceinline__ void load(Regs& R, int k0, int tid) const { wload_b16<BNT>(R, src + (size_t)k0 * ld, ld, tid); }
  __device__ __forceinline__ void store(const Regs& R, lptr img, int rs, int tid) const { wstore_b16<BNT>(R, img, rs, tid); }
};
struct WReg32x8 { f32x4 r[8]; };
__device__ __forceinline__ void wstore_f32_512(const WReg32x8& R, lptr img, int rs, int tid) {
  const int c4 = tid & 127, kr = tid >> 7;
#pragma unroll
  for (int r = 0; r < 8; ++r) { u32x2 o; o.x = pk2(R.r[r].x, R.r[r].y); o.y = pk2(R.r[r].z, R.r[r].w); *(LAS u32x2*)(img + (kr + 4 * r) * rs + c4 * 8) = o; }
}
struct WLf32 {
  typedef WReg32x8 Regs; const float* src; int ld;
  __device__ __forceinline__ void load(Regs& R, int k0, int tid) const {
    const float* s = src + (size_t)(k0 + (tid >> 7)) * ld + (tid & 127) * 4;
#pragma unroll
    for (int r = 0; r < 8; ++r) R.r[r] = *(const f32x4*)(s + (size_t)(4 * r) * ld);
  }
  __device__ __forceinline__ void store(const Regs& R, lptr img, int rs, int tid) const { wstore_f32_512(R, img, rs, tid); }
};
struct WLf32gu {
  typedef WReg32x8 Regs; const float *g, *u;
  __device__ __forceinline__ void load(Regs& R, int k0, int tid) const {
    const int col = (tid & 127) * 4, grp = col >> 7, w = col & 127;
    const unsigned long long ga = (unsigned long long)g, ua = (unsigned long long)u;
    const float* s = (const float*)(w < 64 ? ga : ua) + (size_t)(k0 + (tid >> 7)) * 256 + grp * 64 + (w & 63);
#pragma unroll
    for (int r = 0; r < 8; ++r) R.r[r] = *(const f32x4*)(s + (size_t)(4 * r) * 256);
  }
  __device__ __forceinline__ void store(const Regs& R, lptr img, int rs, int tid) const { wstore_f32_512(R, img, rs, tid); }
};
template <int BMT> struct XLrows {
  typedef XRegB16<BMT> Regs; const bf16_t* rowp[(BMT + 127) / 128]; lptr ximg;
  __device__ __forceinline__ void load(Regs& R, int k0, int tid) const { xload_b16<BMT>(R, rowp, k0, tid); }
  __device__ __forceinline__ void store(const Regs& R, int tid) const { xstore_b16<BMT>(R, ximg, tid); }
  __device__ __forceinline__ void store(const Regs& R, int off, int tid) const { xstore_b16<BMT>(R, ximg + off, tid); }
  __device__ __forceinline__ lptr img(int) const { return ximg; }
  __device__ __forceinline__ int staged() const { return 1; }
};
struct XLres {
  struct Regs {}; lptr base; int bytes;
  __device__ __forceinline__ void load(Regs&, int, int) const {}
  __device__ __forceinline__ void store(const Regs&, int) const {}
  __device__ __forceinline__ void store(const Regs&, int, int) const {}
  __device__ __forceinline__ lptr img(int k0) const { return base + (k0 >> 5) * bytes; }
  __device__ __forceinline__ int staged() const { return 0; }
};
template <int TM, int TN, class WL, class XL, bool WK = true, bool XK = false>
__device__ __forceinline__ void gemm_loop(f32x16 (&acc)[TM][TN], int K, const WL& wl, const XL& xl, lptr wimg, int wrs, int wn0, int xt0, int tid, int lane, int xrs = 0) {
  asm volatile("" : "+v"(tid), "+v"(lane));
  typename WL::Regs wr; typename XL::Regs xr;
  wl.load(wr, 0, tid); xl.load(xr, 0, tid);
  for (int k0 = 0; k0 < K; k0 += 32) {
    wl.store(wr, wimg, wrs, tid); xl.store(xr, tid);
    __syncthreads();
    if (k0 + 32 < K) { wl.load(wr, k0 + 32, tid); xl.load(xr, k0 + 32, tid); }
    mma_step<TM, TN, WK, XK>(acc, wimg, wrs, wn0, xl.img(k0), xrs, xt0, lane);
    __syncthreads();
  }
}
template <int TM, int TN, class WL, class XL, bool WK = true, bool XK = false>
__device__ __forceinline__ void gemm_loop2(f32x16 (&acc)[TM][TN], int K, const WL& wl, const XL& xl, lptr wimg, int wrs, int wn0, int xt0, int tid, int lane, int xrs = 0) {
  asm volatile("" : "+v"(tid), "+v"(lane));
  typename WL::Regs wa, wb; typename XL::Regs xa, xb;
  wl.load(wa, 0, tid); xl.load(xa, 0, tid); wl.load(wb, 32, tid); xl.load(xb, 32, tid);
  for (int k0 = 0; k0 < K; k0 += 64) {
    wl.store(wa, wimg, wrs, tid); xl.store(xa, tid);
    __syncthreads();
    if (k0 + 64 < K) { wl.load(wa, k0 + 64, tid); xl.load(xa, k0 + 64, tid); }
    mma_step<TM, TN, WK, XK>(acc, wimg, wrs, wn0, xl.img(k0), xrs, xt0, lane);
    __syncthreads();
    wl.store(wb, wimg, wrs, tid); xl.store(xb, tid);
    __syncthreads();
    if (k0 + 96 < K) { wl.load(wb, k0 + 96, tid); xl.load(xb, k0 + 96, tid); }
    mma_step<TM, TN, WK, XK>(acc, wimg, wrs, wn0, xl.img(k0 + 32), xrs, xt0, lane);
    __syncthreads();
  }
}
template <int TM, int TN, class WL, class XL>
__device__ __forceinline__ void gemm_loop_db(f32x16 (&acc)[TM][TN], int K, const WL& wl, const XL& xl, lptr wimg, int wrs, int wn0, int xt0, int xhalf, int tid, int lane) {
  asm volatile("" : "+v"(tid), "+v"(lane));
  const bool early = __builtin_amdgcn_readfirstlane(tid) < 256;
  typename WL::Regs wa, wb; typename XL::Regs xa, xb;
  wl.load(wa, 0, tid); xl.load(xa, 0, tid); wl.load(wb, 32, tid); xl.load(xb, 32, tid);
  wl.store(wa, wimg, wrs, tid); xl.store(xa, 0, tid);
  __syncthreads();
  if (64 < K) { wl.load(wa, 64, tid); xl.load(xa, 64, tid); }
  for (int k0 = 0; k0 < K; k0 += 64) {
    if (early) { wl.store(wb, wimg + 32 * wrs, wrs, tid); xl.store(xb, xhalf, tid); if (k0 + 96 < K) { wl.load(wb, k0 + 96, tid); xl.load(xb, k0 + 96, tid); } }
    mma_step<TM, TN, true, false>(acc, wimg, wrs, wn0, xl.img(k0), 0, xt0, lane);
    if (!early) { wl.store(wb, wimg + 32 * wrs, wrs, tid); xl.store(xb, xhalf, tid); if (k0 + 96 < K) { wl.load(wb, k0 + 96, tid); xl.load(xb, k0 + 96, tid); } }
    __syncthreads();
    if (early && k0 + 64 < K) { wl.store(wa, wimg, wrs, tid); xl.store(xa, 0, tid); if (k0 + 128 < K) { wl.load(wa, k0 + 128, tid); xl.load(xa, k0 + 128, tid); } }
    mma_step<TM, TN, true, false>(acc, wimg + 32 * wrs, wrs, wn0, xl.img(k0 + 32) + xhalf * xl.staged(), 0, xt0, lane);
    if (!early && k0 + 64 < K) { wl.store(wa, wimg, wrs, tid); xl.store(xa, 0, tid); if (k0 + 128 < K) { wl.load(wa, k0 + 128, tid); xl.load(xa, k0 + 128, tid); } }
    __syncthreads();
  }
}
template <int TM, int TN> __device__ __forceinline__ void acc_zero(f32x16 (&acc)[TM][TN]) {
#pragma unroll
  for (int a = 0; a < TM; ++a)
#pragma unroll
    for (int b = 0; b < TN; ++b)
#pragma unroll
      for (int r = 0; r < 16; ++r) acc[a][b][r] = 0.f;
}

__device__ __forceinline__ void glds16(const void* gsrc, unsigned lds_dst) { unsigned keep;
  asm volatile("s_mov_b32 %0, m0\n\ts_mov_b32 m0, %2\n\ts_nop 0\n\tglobal_load_lds_dwordx4 %1, off\n\ts_mov_b32 m0, %0" : "=&s"(keep) : "v"(gsrc), "s"(lds_dst) : "memory"); }
__device__ __forceinline__ bf16x8 frag_kmaj512(lptr img, int o, int s, int lane) {
  const int h = lane >> 5, blk = (lane >> 4) & 1, q = (lane & 15) >> 2, pp = lane & 3;
  lptr a = img + (16 * s + 8 * h + q) * 512 + ((((o >> 3) + 2 * blk + (pp >> 1)) ^ (q << 2)) << 4) + (pp & 1) * 8;
  const v4i16_t lo = __builtin_amdgcn_ds_read_tr16_b64_v4i16((LAS v4i16_t*)a);
  const v4i16_t hi = __builtin_amdgcn_ds_read_tr16_b64_v4i16((LAS v4i16_t*)(a + 4 * 512));
  return (bf16x8){lo[0], lo[1], lo[2], lo[3], hi[0], hi[1], hi[2], hi[3]};
}
constexpr int G2_SLOT = 32768;
__device__ __forceinline__ void glds16x4(const void* g0, const void* g1, const void* g2, const void* g3, unsigned d0) {
  unsigned keep;
  asm volatile("s_mov_b32 %0, m0\n\ts_mov_b32 m0, %5\n\ts_nop 0\n\tglobal_load_lds_dwordx4 %1, off\n\ts_add_u32 m0, m0, 0x400\n\ts_nop 0\n\tglobal_load_lds_dwordx4 %2, off\n\t"
               "s_add_u32 m0, m0, 0x3c00\n\ts_nop 0\n\tglobal_load_lds_dwordx4 %3, off\n\ts_add_u32 m0, m0, 0x400\n\ts_nop 0\n\tglobal_load_lds_dwordx4 %4, off\n\ts_mov_b32 m0, %0"
               : "=&s"(keep) : "v"(g0), "v"(g1), "v"(g2), "v"(g3), "s"(d0) : "memory", "scc");
}
__device__ __forceinline__ void gemm256_dma(f32x16 (&acc)[4][2], const bf16_t* wp0, const bf16_t* wp1, size_t wstep, const bf16_t* xp0, const bf16_t* xp1, int K,
                                            lptr lds, int wn, int wt, int wid, int lane0) {
  const unsigned ring0 = (unsigned)(uintptr_t)lds + (unsigned)wid * 2048u;
  const int nst = K >> 5;
#define G2_ISSUE(ST) do { const int st_ = (ST) < nst ? (ST) : nst - 1; const unsigned sl_ = (unsigned)__builtin_amdgcn_readfirstlane((int)(ring0 + (unsigned)((ST) & 3) * G2_SLOT)); \
    glds16x4(wp0 + (size_t)st_ * wstep, wp1 + (size_t)st_ * wstep, xp0 + st_ * 32, xp1 + st_ * 32, sl_); } while (0)
#define G2_READ(WF, XF, ST, S) do { lptr wi_ = lds + ((ST) & 3) * G2_SLOT; \
    _Pragma("unroll") for (int tm = 0; tm < 4; ++tm) WF[tm] = frag_kmaj512(wi_, wn * 128 + 32 * tm, S, lane); \
    _Pragma("unroll") for (int tn = 0; tn < 2; ++tn) XF[tn] = frag_kmin(wi_ + 16384, wt * 64 + 32 * tn, S, lane); } while (0)
#define G2_MMA(WF, XF) do { _Pragma("unroll") for (int tm = 0; tm < 4; ++tm) _Pragma("unroll") for (int tn = 0; tn < 2; ++tn) \
    acc[tm][tn] = __builtin_amdgcn_mfma_f32_32x32x16_bf16(WF[tm], XF[tn], acc[tm][tn], 0, 0, 0); } while (0)
  acc_zero<4, 2>(acc);
  int lane = lane0; asm volatile("" : "+v"(lane));
  bf16x8 wfa[4], xfa[2], wfb[4], xfb[2];
  G2_ISSUE(0); G2_ISSUE(1); G2_ISSUE(2);
  asm volatile("s_waitcnt vmcnt(8)\n\ts_barrier" ::: "memory");
  G2_READ(wfa, xfa, 0, 0);
  for (int st = 0; st < nst; ++st) {
    G2_READ(wfb, xfb, st, 1);
    __builtin_amdgcn_sched_barrier(0);
    G2_MMA(wfa, xfa);
    __builtin_amdgcn_sched_barrier(0);
    asm volatile("s_waitcnt vmcnt(4)\n\ts_barrier" ::: "memory");
    G2_ISSUE(st + 3);
    if (st + 1 < nst) G2_READ(wfa, xfa, st + 1, 0);
    __builtin_amdgcn_sched_barrier(0);
    G2_MMA(wfb, xfb);
    __builtin_amdgcn_sched_barrier(0);
  }
#undef G2_ISSUE
#undef G2_READ
#undef G2_MMA
  asm volatile("s_waitcnt vmcnt(0)\n\ts_barrier" ::: "memory");
}
__device__ __forceinline__ int g2_wrow(int wid, int i, int lane) { return 2 * (2 * wid + i) + (lane >> 5); }
__device__ __forceinline__ int g2_wcol(int wid, int i, int lane) { return (((lane & 31) ^ ((g2_wrow(wid, i, lane) & 3) << 2))) * 8; }
__device__ __forceinline__ int g2_xtok(int wid, int i, int lane) { return 16 * (2 * wid + i) + (lane >> 2); }
__device__ __forceinline__ int g2_xk(int wid, int i, int lane) { return (((lane & 3) ^ ((g2_xtok(wid, i, lane) >> 2) & 3))) * 8; }
constexpr int LDS_INV64 = 150 * 1024, LDS_INV128 = LDS_INV64 + 128, LDS_XB = LDS_INV128 + 256, LDS_BYTES = 152 * 1024;

__device__ __forceinline__ void cvt_items(const float* src, bf16_t* dst, size_t n8, int gtid, int gthreads) {
  for (size_t i0 = gtid; i0 < n8; i0 += (size_t)gthreads * 4) {
    f32x4 a[4], b[4];
#pragma unroll
    for (int q = 0; q < 4; ++q) { const size_t i = i0 + (size_t)q * gthreads; if (i < n8) { a[q] = *(const f32x4*)(src + i * 8); b[q] = *(const f32x4*)(src + i * 8 + 4); } }
#pragma unroll
    for (int q = 0; q < 4; ++q) { const size_t i = i0 + (size_t)q * gthreads; if (i < n8) { u32x4 o; o.x = pk2(a[q].x, a[q].y); o.y = pk2(a[q].z, a[q].w); o.z = pk2(b[q].x, b[q].y); o.w = pk2(b[q].z, b[q].w); *(u32x4*)(dst + i * 8) = o; } }
  }
}
__device__ __forceinline__ void phase0a(const P& p, lptr lds, int vcu, int G) {
  const int tid = threadIdx.x, wid = tid >> 6, lane = tid & 63;
  if (vcu < 96) {
    const int j = vcu * 64 + lane;
    LAS float* sc = (LAS float*)(lds + 16384);
    for (int i = tid; i < 4 * D; i += 512) sc[i] = silu(p.c[i]);
    __syncthreads();
    float a0 = 0.f, a1 = 0.f, a2 = 0.f, a3 = 0.f;
    for (int k = wid * 128; k < wid * 128 + 128; k += 32) {
      float w[32];
#pragma unroll
      for (int q = 0; q < 32; ++q) w[q] = p.w_ada[(size_t)(k + q) * 6144 + j];
#pragma unroll
      for (int q = 0; q < 32; ++q) { a0 += sc[k + q] * w[q]; a1 += sc[D + k + q] * w[q]; a2 += sc[2 * D + k + q] * w[q]; a3 += sc[3 * D + k + q] * w[q]; }
    }
    LAS float* part = (LAS float*)lds;
    part[(wid * 4 + 0) * 64 + lane] = a0; part[(wid * 4 + 1) * 64 + lane] = a1; part[(wid * 4 + 2) * 64 + lane] = a2; part[(wid * 4 + 3) * 64 + lane] = a3;
    __syncthreads();
    if (wid < 4) { float s = p.b_ada[j];
#pragma unroll
      for (int w = 0; w < 8; ++w) s += part[(w * 4 + wid) * 64 + lane];
      p.mod[wid * 6144 + j] = s; }
    __syncthreads();
  }
  if (vcu < 96 && G > 96) return;
  const int gtid = (G > 96 ? vcu - 96 : vcu) * 512 + tid, gth = (G > 96 ? G - 96 : G) * 512;
  cvt_items(p.w_in, p.winb, (size_t)D * INW / 8, gtid, gth);
  cvt_items(p.w_out, p.woutb, (size_t)D * D / 8, gtid, gth);
  cvt_items(p.w_router, p.wrb, (size_t)D * NE / 8, gtid, gth);
  cvt_items(p.wg_s, p.wgsb, (size_t)D * 256 / 8, gtid, gth);
  cvt_items(p.wu_s, p.wusb, (size_t)D * 256 / 8, gtid, gth);
  cvt_items(p.wd_s, p.wdsb, (size_t)256 * D / 8, gtid, gth);
  cvt_items(p.cw1k, p.cw1kb, (size_t)2048 * 128 / 8, gtid, gth);
  cvt_items(p.cw1v, p.cw1vb, (size_t)2048 * 128 / 8, gtid, gth);
  cvt_items(p.cw2k, p.cw2kb, (size_t)128 * 64 / 8, gtid, gth);
  cvt_items(p.cw2v, p.cw2vb, (size_t)128 * 64 / 8, gtid, gth);
}

__device__ __forceinline__ void phase0b(const P& p, lptr lds, int vcu, int G) {
  const int tid = threadIdx.x, wid = tid >> 6, lane = tid & 63;
  for (int row = vcu * 8 + wid; row < T; row += G * 8) {
    const int b = row / SEQ;
    f32x4 v[4]; float s = 0.f;
#pragma unroll
    for (int j = 0; j < 4; ++j) { v[j] = *(const f32x4*)(p.x + (size_t)row * D + j * 256 + lane * 4); s += v[j].x * v[j].x + v[j].y * v[j].y + v[j].z * v[j].z + v[j].w * v[j].w; }
    s = wave_sum(s);
    const float r = rsqrtf(s * (1.f / D) + EPS);
#pragma unroll
    for (int j = 0; j < 4; ++j) {
      const int k = j * 256 + lane * 4;
      const f32x4 g = *(const f32x4*)(p.g_mix + k), sc = *(const f32x4*)(p.mod + b * 6144 + 1024 + k), sh = *(const f32x4*)(p.mod + b * 6144 + k);
      u32x2 o; o.x = pk2(v[j].x * r * g.x * (1.f + sc.x) + sh.x, v[j].y * r * g.y * (1.f + sc.y) + sh.y); o.y = pk2(v[j].z * r * g.z * (1.f + sc.z) + sh.z, v[j].w * r * g.w * (1.f + sc.w) + sh.w);
      *(u32x2*)(p.hb + (size_t)row * D + k) = o;
    }
  }
}

#define ROPE_PAIR(X1, X2, posf, invrev, sc) do { float pf_ = (posf); asm volatile("" : "+v"(pf_)); const float fr_ = __builtin_amdgcn_fractf(pf_ * (invrev)); \
    const float sn_ = __builtin_amdgcn_sinf(fr_), cs_ = __builtin_amdgcn_cosf(fr_); const float a_ = (X1), b_ = (X2); \
    float o1_ = (a_ * cs_ - b_ * sn_) * (sc), o2_ = (a_ * sn_ + b_ * cs_) * (sc); asm volatile("" : "+v"(o1_), "+v"(o2_)); (X1) = o1_; (X2) = o2_; } while (0)
__device__ __forceinline__ void phase1(const P& p, lptr lds, int vcu, int G) {
  const int tid = threadIdx.x, wid = __builtin_amdgcn_readfirstlane(tid >> 6), lane = tid & 63, wn = wid >> 2, wt = wid & 3, h = lane >> 5;
  const LAS float* inv64 = (const LAS float*)(lds + LDS_INV64);
  const LAS float* inv128 = (const LAS float*)(lds + LDS_INV128);
  for (int u = vcu; u < 14 * 64; u += G) {
    const int j = u % 14, mt = u / 14, t0 = mt * 256;
    if (j == 13) {
      f32x16 ag[1][1]; acc_zero<1, 1>(ag);
      WLb16<128> wl; wl.src = p.winb + C_GN; wl.ld = INW;
      XLrows<256> xl; xl.rowp[0] = p.hb + (size_t)(t0 + (tid >> 2)) * D; xl.rowp[1] = xl.rowp[0] + (size_t)128 * D; xl.ximg = lds + 32 * 320;
      gemm_loop2<1, 1>(ag, D, wl, xl, lds, 320, 0, wid * 32, tid, lane);
      int tok = t0 + wid * 32 + (lane & 31), nb = 4 * h; asm volatile("" : "+v"(tok), "+v"(nb));
#pragma unroll
      for (int a = 0; a < 3; ++a) { f32x4 v; v.x = sigm(ag[0][0][4 * a]); v.y = sigm(ag[0][0][4 * a + 1]); v.z = sigm(ag[0][0][4 * a + 2]); v.w = sigm(ag[0][0][4 * a + 3]);
        *(f32x4*)(p.gates + (size_t)tok * 24 + nb + a * 8) = v; }
      continue;
    }
    const int wcol = j < 5 ? j * 256 : C_QR + (j - 5) * 256;
    f32x16 acc[4][2];
    { const bf16_t* wb = p.winb + wcol; const bf16_t* xb = p.hb + (size_t)t0 * D;
      gemm256_dma(acc, wb + (size_t)g2_wrow(wid, 0, lane) * INW + g2_wcol(wid, 0, lane), wb + (size_t)g2_wrow(wid, 1, lane) * INW + g2_wcol(wid, 1, lane), (size_t)32 * INW,
                  xb + (size_t)g2_xtok(wid, 0, lane) * D + g2_xk(wid, 0, lane), xb + (size_t)g2_xtok(wid, 1, lane) * D + g2_xk(wid, 1, lane), D, lds, wn, wt, wid, lane); }
    const int kind = (j < 2) ? 0 : (j == 2) ? 3 : (j < 5) ? (wn == 0 ? 1 : 3) : (j < 7) ? 2 : (j < 9) ? 4 : (j < 11) ? 3 : 5;
#pragma unroll
    for (int tn = 0; tn < 2; ++tn) {
      const int tok = t0 + wt * 64 + tn * 32 + (lane & 31);
      const float posf = (float)p.pos[tok];
      if (kind == 0 || kind == 1) {
        const float sc = kind == 0 ? 0.125f * 1.4426950408889634f : 1.f;
#pragma unroll
        for (int r = 0; r < 16; ++r) { const float iv = inv64[(r & 3) + 8 * (r >> 2) + 4 * h];
          ROPE_PAIR(acc[0][tn][r], acc[1][tn][r], posf, iv, sc); ROPE_PAIR(acc[2][tn][r], acc[3][tn][r], posf, iv, sc); if ((r & 3) == 3) __builtin_amdgcn_sched_barrier(0); }
      } else if (kind == 2 || kind == 4) {
        const float sc = kind == 4 ? 0.08838834764831845f : 1.f;
#pragma unroll
        for (int r = 0; r < 16; ++r) { const int i = (r & 3) + 8 * (r >> 2) + 4 * h;
          ROPE_PAIR(acc[0][tn][r], acc[2][tn][r], posf, inv128[i], sc); ROPE_PAIR(acc[1][tn][r], acc[3][tn][r], posf, inv128[32 + i], sc); if ((r & 3) == 3) __builtin_amdgcn_sched_barrier(0); }
      } else if (kind == 5) {
#pragma unroll
        for (int tm = 0; tm < 4; ++tm)
#pragma unroll
          for (int r = 0; r < 16; ++r) { float v = acc[tm][tn][r]; asm volatile("" : "+v"(v)); float o = v * __builtin_amdgcn_rcpf(1.f + __builtin_amdgcn_exp2f(-1.4426950408889634f * v)); asm volatile("" : "+v"(o)); acc[tm][tn][r] = o; }
      }
      { int rl = wt * 32 + (lane & 31), cb = (wn * 128 + 4 * h) * 2; asm volatile("" : "+v"(rl), "+v"(cb));
#pragma unroll
        for (int tm = 0; tm < 4; ++tm)
#pragma unroll
          for (int a = 0; a < 4; ++a) { u32x2 o; o.x = pk2(acc[tm][tn][4 * a], acc[tm][tn][4 * a + 1]); o.y = pk2(acc[tm][tn][4 * a + 2], acc[tm][tn][4 * a + 3]);
            *(LAS u32x2*)(lds + rl * 528 + cb + (tm * 32 + a * 8) * 2) = o; }
        __syncthreads();
#pragma unroll
        for (int rr = 0; rr < 8; ++rr) { const int row = wid * 16 + rr * 2 + (lane >> 5);
          *(u32x4*)(p.projb + (size_t)(t0 + (row >> 5) * 64 + tn * 32 + (row & 31)) * PJW + j * 256 + (lane & 31) * 8) = *(const LAS u32x4*)(lds + row * 528 + (lane & 31) * 16); }
        __syncthreads(); }
    }
  }
}

__device__ __forceinline__ void phase6(const P& p, lptr lds, int vcu, int G) {
  const int tid = threadIdx.x, wid = __builtin_amdgcn_readfirstlane(tid >> 6), lane = tid & 63, h = lane >> 5, l31 = lane & 31, wn = wid >> 1, wt = wid & 1;
  constexpr int WRS = 512 * 2 + 64;
  lptr wimg = lds, ximg = lds + 68 * 1024;
  lptr actb = lds + 84 * 1024;
  LAS int* pre = (LAS int*)(lds + 148 * 1024);
  LAS int* sidl = pre + 320;
  if (tid < NE) pre[tid + 1] = (p.cnt[tid * CPAD] + 127) >> 7;
  if (tid == 0) pre[0] = 0;
  __syncthreads();
  if (tid == 0) { int a = 0; for (int e = 1; e <= NE; ++e) { a += pre[e]; pre[e] = a; } }
  __syncthreads();
  const int nunits = pre[NE];
  for (int u = vcu; u < nunits; u += G) {
    int lo = 0, hi = NE;
    while (hi - lo > 1) { const int mid = (lo + hi) >> 1; if (pre[mid] <= u) lo = mid; else hi = mid; }
    const int e = lo, off = (u - pre[e]) * 128, cnt = p.cnt[e * CPAD];
    if (tid < 128) sidl[tid] = off + tid < cnt ? p.list[e * ECAP + off + tid] : -1;
    __syncthreads();
    f32x16 acc[4][2];
    acc_zero<4, 2>(acc);
    { WLf32gu wl; wl.g = p.wg_e + (size_t)e * D * 256; wl.u = p.wu_e + (size_t)e * D * 256;
      XLrows<128> xl; { const int sd = sidl[(tid >> 2) & 127]; xl.rowp[0] = p.h2b + (size_t)(sd < 0 ? 0 : sd >> 3) * D; } xl.ximg = ximg;
      gemm_loop_db<4, 2>(acc, D, wl, xl, wimg, WRS, wn * 128, wt * 64, 128 * 64, tid, lane); }
    { int l31_ = l31, h_ = h; asm volatile("" : "+v"(l31_), "+v"(h_));
#pragma unroll
      for (int tn = 0; tn < 2; ++tn)
#pragma unroll
        for (int tm = 0; tm < 2; ++tm)
#pragma unroll
          for (int a = 0; a < 4; ++a) {
            float o[4];
#pragma unroll
            for (int q = 0; q < 4; ++q) { const float gv = acc[tm][tn][4 * a + q], uv = acc[tm + 2][tn][4 * a + q]; o[q] = gv * __builtin_amdgcn_rcpf(1.f + __builtin_amdgcn_exp2f(-1.4426950408889634f * gv)) * uv; }
            const int col = wn * 64 + tm * 32 + a * 8 + 4 * h_;
            u32x2 w2; w2.x = pk2(o[0], o[1]); w2.y = pk2(o[2], o[3]);
            *(LAS u32x2*)(actb + (col >> 5) * 8192 + kmin_off(wt * 64 + tn * 32 + l31_, (col & 31) >> 3) + (col & 7) * 2) = w2;
          } }
    __syncthreads();
#pragma unroll 1
    for (int pass = 0; pass < 2; ++pass) {
      acc_zero<4, 2>(acc);
      { WLf32 wl; wl.src = p.wd_e + (size_t)e * 256 * D + pass * 512; wl.ld = D;
        XLres xl; xl.base = actb; xl.bytes = 8192;
        gemm_loop_db<4, 2>(acc, 256, wl, xl, wimg, WRS, wn * 128, wt * 64, 0, tid, lane); }
      { int nbl = wn * 128 + 4 * h, rl = wt * 32 + l31; asm volatile("" : "+v"(nbl), "+v"(rl));
#pragma unroll
        for (int tn = 0; tn < 2; ++tn) {
          const int sd = sidl[wt * 64 + tn * 32 + (rl & 31)]; const float wgt = sd >= 0 ? p.wts[sd] : 0.f;
#pragma unroll
          for (int tm = 0; tm < 4; ++tm)
#pragma unroll
            for (int a = 0; a < 4; ++a) { u32x2 o; o.x = pk2(acc[tm][tn][4 * a] * wgt, acc[tm][tn][4 * a + 1] * wgt); o.y = pk2(acc[tm][tn][4 * a + 2] * wgt, acc[tm][tn][4 * a + 3] * wgt);
              *(LAS u32x2*)(lds + rl * 1040 + (nbl + tm * 32 + a * 8) * 2) = o; }
          __syncthreads();
#pragma unroll
          for (int rr = 0; rr < 8; ++rr) { const int row = wid * 8 + rr, sd2 = sidl[(row >> 5) * 64 + tn * 32 + (row & 31)];
            if (sd2 >= 0) *(u32x4*)(p.slab + (size_t)sd2 * D + pass * 512 + lane * 8) = *(const LAS u32x4*)(lds + row * 1040 + lane * 16); }
          __syncthreads();
        } }
    }
    __syncthreads();
  }
}

__device__ __forceinline__ void phase7(const P& p, lptr lds, int vcu, int G) {
  const int tid = threadIdx.x, wid = tid >> 6, lane = tid & 63;
  for (int tok = vcu * 8 + wid; tok < T; tok += G * 8) {
    const int b = tok / SEQ;
    float v[16]; float ss = 0.f;
#pragma unroll
    for (int j = 0; j < 2; ++j) {
      const int n = j * 512 + lane * 8;
      float a[8];
#pragma unroll
      for (int q = 0; q < 8; ++q) a[q] = 0.f;
#pragma unroll
      for (int k = 0; k < 9; ++k) { const u32x4 w = k < 8 ? *(const u32x4*)(p.slab + ((size_t)tok * 8 + k) * D + n) : *(const u32x4*)(p.ysb + (size_t)tok * D + n);
        a[0] += bflo(w.x); a[1] += bfhi(w.x); a[2] += bflo(w.y); a[3] += bfhi(w.y); a[4] += bflo(w.z); a[5] += bfhi(w.z); a[6] += bflo(w.w); a[7] += bfhi(w.w); }
#pragma unroll
      for (int q4 = 0; q4 < 2; ++q4) {
        const f32x4 xv = *(const f32x4*)(p.x + (size_t)tok * D + n + q4 * 4), gt = *(const f32x4*)(p.mod + b * 6144 + 5120 + n + q4 * 4), ga = *(const f32x4*)(p.mod + b * 6144 + 2048 + n + q4 * 4);
        const u32x2 mo = *(const u32x2*)(p.mixo + (size_t)tok * D + n + q4 * 4);
        const float y0 = xv.x + ga.x * bflo(mo.x) + gt.x * a[q4 * 4], y1 = xv.y + ga.y * bfhi(mo.x) + gt.y * a[q4 * 4 + 1], y2 = xv.z + ga.z * bflo(mo.y) + gt.z * a[q4 * 4 + 2], y3 = xv.w + ga.w * bfhi(mo.y) + gt.w * a[q4 * 4 + 3];
        v[j * 8 + q4 * 4] = y0; v[j * 8 + q4 * 4 + 1] = y1; v[j * 8 + q4 * 4 + 2] = y2; v[j * 8 + q4 * 4 + 3] = y3;
        ss += y0 * y0 + y1 * y1 + y2 * y2 + y3 * y3;
      }
    }
    ss = wave_sum(ss);
    const float r = rsqrtf(ss * (1.f / D) + EPS);
#pragma unroll
    for (int j = 0; j < 2; ++j)
#pragma unroll
      for (int q4 = 0; q4 < 2; ++q4) {
        const int n = j * 512 + lane * 8 + q4 * 4;
        const f32x4 g = *(const f32x4*)(p.g_final + n);
        f32x4 o; o.x = v[j * 8 + q4 * 4] * r * g.x; o.y = v[j * 8 + q4 * 4 + 1] * r * g.y; o.z = v[j * 8 + q4 * 4 + 2] * r * g.z; o.w = v[j * 8 + q4 * 4 + 3] * r * g.w;
        *(f32x4*)(p.out + (size_t)tok * D + n) = o;
      }
  }
}

constexpr int NSA_KB = 8192, NSA_VRS = 128, NSA_SLOT = NSA_KB + 64 * NSA_VRS, NSA_NSLOT = 4, NSA_IMP = NSA_NSLOT * NSA_SLOT;
__device__ __forceinline__ void nsa_offsets(int (&koff)[4], int (&voff)[2], int lane) {
  const int h = lane >> 5, l31 = lane & 31, blk = (lane >> 4) & 1, q = (lane & 15) >> 2, pp = lane & 3;
#pragma unroll
  for (int ds = 0; ds < 4; ++ds) koff[ds] = l31 * 128 + (((2 * ds + h) ^ ((l31 >> 1) & 7)) << 4);
#pragma unroll
  for (int dt = 0; dt < 2; ++dt) voff[dt] = (4 * h + q) * NSA_VRS + (((dt * 4 + 2 * blk + (pp >> 1)) ^ ((q >> 1) << 2)) << 4) + (pp & 1) * 8;
}
__device__ __forceinline__ void nsa_qk(f32x16 (&s)[2], lptr kimg, const bf16x8 (&qf)[4], const int (&koff)[4]) {
#pragma unroll
  for (int kt = 0; kt < 2; ++kt) {
#pragma unroll
    for (int r = 0; r < 16; ++r) s[kt][r] = 0.f;
#pragma unroll
    for (int ds = 0; ds < 4; ++ds) {
      const bf16x8 a = *(LAS bf16x8*)(kimg + koff[ds] + kt * 4096);
      s[kt] = __builtin_amdgcn_mfma_f32_32x32x16_bf16(a, qf[ds], s[kt], 0, 0, 0);
    }
  }
}
__device__ __forceinline__ void nsa_pv(f32x16 (&o)[2], lptr vimg, const f32x16 (&pr)[2], const int (&voff)[2]) {
  bf16x8 pb[4];
#pragma unroll
  for (int ks = 0; ks < 4; ++ks) {
    const int kt = ks >> 1, rb = 8 * (ks & 1);
    u32x4 w; w.x = pk2(pr[kt][rb], pr[kt][rb + 1]); w.y = pk2(pr[kt][rb + 2], pr[kt][rb + 3]); w.z = pk2(pr[kt][rb + 4], pr[kt][rb + 5]); w.w = pk2(pr[kt][rb + 6], pr[kt][rb + 7]);
    pb[ks] = __builtin_bit_cast(bf16x8, w);
  }
#pragma unroll
  for (int dt = 0; dt < 2; ++dt)
#pragma unroll
    for (int ks = 0; ks < 4; ++ks) {
      lptr a = vimg + voff[dt] + ks * 2048;
      const v4i16_t lo = __builtin_amdgcn_ds_read_tr16_b64_v4i16((LAS v4i16_t*)a);
      const v4i16_t hi = __builtin_amdgcn_ds_read_tr16_b64_v4i16((LAS v4i16_t*)(a + 1024));
      const bf16x8 vf = {lo[0], lo[1], lo[2], lo[3], hi[0], hi[1], hi[2], hi[3]};
      o[dt] = __builtin_amdgcn_mfma_f32_32x32x16_bf16(vf, pb[ks], o[dt], 0, 0, 0);
    }
}
__device__ __forceinline__ float fexp(float x) { return __builtin_amdgcn_exp2f(x); }
__device__ __forceinline__ float xmax32(float x) { const auto rr = __builtin_amdgcn_permlane32_swap(__float_as_uint(x), __float_as_uint(x), false, false); return fmaxf(__uint_as_float(rr[0]), __uint_as_float(rr[1])); }
__device__ __forceinline__ float xsum32(float x) { const auto rr = __builtin_amdgcn_permlane32_swap(__float_as_uint(x), __float_as_uint(x), false, false); return __uint_as_float(rr[0]) + __uint_as_float(rr[1]); }
__device__ __forceinline__ void phase_nsa(const P& p, lptr lds, int vcu, int G) {
  const int tid = threadIdx.x, wid = __builtin_amdgcn_readfirstlane(tid >> 6), lane0 = tid & 63;
  int koff[4], voff[2]; nsa_offsets(koff, voff, lane0);
  LAS float* imp = (LAS float*)(lds + NSA_IMP);
  LAS float* obuf = (LAS float*)(lds + NSA_IMP + 16384) + wid * 2048 + lane0;
  for (int u = vcu; u < 512; u += G) {
    const int bg = u & 7, j0 = u < 256 ? 63 - (u >> 3) : ((u - 256) >> 3), b = bg >> 1, g = bg & 1, t0 = j0 * 64;
    const int t = t0 + wid * 8 + ((lane0 & 31) >> 2), hg = g * 4 + (lane0 & 3);
    const size_t trow = (size_t)(b * SEQ + t);
    bf16x8 qf[4];
#pragma unroll
    for (int ds = 0; ds < 4; ++ds) qf[ds] = *(const bf16x8*)(p.projb + trow * PJW + J_QN + hg * 64 + 16 * ds + 8 * (lane0 >> 5));
#pragma unroll
    for (int i = 0; i < 8; ++i) imp[(wid * 8 + i) * 64 + lane0] = 0.f;
    const int nct = (((t0 + 32) >> 4) >> 6) + 1, jw0 = j0 > 8 ? j0 - 8 : 0;
    const int itC = 2 * nct, itD = itC + j0 + 1, NI = itD + (j0 - jw0 + 1);
    const int cmaxt = t >= 31 ? (t - 31) >> 4 : -1;
    const int drow = wid * 8 + (lane0 >> 3), dch = lane0 & 7;
    const char* pbt = (const char*)(p.projb + (size_t)(b * SEQ) * PJW + g * 64) + (size_t)drow * (PJW * 2);
    const char* kct = (const char*)(p.kcmpb + (size_t)bg * NC * 64) + drow * 128;
    const char* vct = (const char*)(p.vcmpb + (size_t)bg * NC * 64) + drow * 128;
    const unsigned kx = (unsigned)((dch ^ ((drow >> 1) & 7)) * 16), vx = (unsigned)((dch ^ (((drow >> 1) & 1) << 2)) * 16);
    const unsigned ring0 = (unsigned)(uintptr_t)lds + (unsigned)wid * 1024u;
#define NSA_ISSUE(IT) do { const int it_ = (IT) < NI ? (IT) : NI - 1; const unsigned sl_ = (unsigned)__builtin_amdgcn_readfirstlane((int)(ring0 + (unsigned)((IT) & (NSA_NSLOT - 1)) * NSA_SLOT)); \
      if (it_ < itC) { const unsigned o_ = (unsigned)(it_ < nct ? it_ : it_ - nct) * 8192u; glds16(kct + o_ + kx, sl_); glds16(vct + o_ + vx, sl_ + NSA_KB); } \
      else { const bool sel_ = it_ < itD; const unsigned o_ = (unsigned)(sel_ ? it_ - itC : jw0 + it_ - itD) * (unsigned)(64 * PJW * 2); \
             glds16(pbt + o_ + (sel_ ? J_KS * 2 : J_KW * 2) + kx, sl_); glds16(pbt + o_ + (sel_ ? J_VS * 2 : J_VW * 2) + vx, sl_ + NSA_KB); } } while (0)
#define NSA_STEP() lptr slot = lds + (it & (NSA_NSLOT - 1)) * NSA_SLOT; \
      asm volatile("s_waitcnt vmcnt(4)\n\ts_barrier" ::: "memory"); \
      NSA_ISSUE(it + 3); \
      int lane = lane0; asm volatile("" : "+v"(lane)); const int h = lane >> 5, l31 = lane & 31; (void)l31
    NSA_ISSUE(0); NSA_ISSUE(1); NSA_ISSUE(2);
    int it = 0;
    float m1 = -1e30f, l1 = 0.f;
    for (; it < nct; ++it) {
      NSA_STEP();
      f32x16 s[2]; nsa_qk(s, slot, qf, koff);
      float mx = -1e30f;
#pragma unroll
      for (int r = 0; r < 16; ++r) { const int c = 64 * it + (r & 3) + 8 * (r >> 2) + 4 * h; if (c <= cmaxt) mx = fmaxf(mx, s[0][r]); if (c + 32 <= cmaxt) mx = fmaxf(mx, s[1][r]); }
      mx = xmax32(mx);
      const float mn = fmaxf(m1, mx); float rs = 0.f;
#pragma unroll
      for (int r = 0; r < 16; ++r) { const int c = 64 * it + (r & 3) + 8 * (r >> 2) + 4 * h; rs += (c <= cmaxt ? fexp(s[0][r] - mn) : 0.f) + (c + 32 <= cmaxt ? fexp(s[1][r] - mn) : 0.f); }
      rs = xsum32(rs);
      l1 = l1 * fexp(m1 - mn) + rs; m1 = mn;
    }
    f32x16 o[2];
#pragma unroll
    for (int r = 0; r < 16; ++r) { o[0][r] = 0.f; o[1][r] = 0.f; }
    { const float il = 1.f / fmaxf(l1, 1e-20f);
      for (; it < itC; ++it) {
        NSA_STEP();
        const int i = it - nct, tl = l31 >> 2, r4 = l31 & 3;
        f32x16 s[2]; nsa_qk(s, slot, qf, koff);
#pragma unroll
        for (int r = 0; r < 16; ++r) { const int c = 64 * i + (r & 3) + 8 * (r >> 2) + 4 * h; s[0][r] = c <= cmaxt ? fexp(s[0][r] - m1) * il : 0.f; s[1][r] = c + 32 <= cmaxt ? fexp(s[1][r] - m1) * il : 0.f; }
#pragma unroll
        for (int kt = 0; kt < 2; ++kt)
#pragma unroll
          for (int a = 0; a < 4; ++a) {
            float v4 = (s[kt][4 * a] + s[kt][4 * a + 1]) + (s[kt][4 * a + 2] + s[kt][4 * a + 3]), cy = s[kt][4 * a + 3];
            v4 += DPPF(v4, 0xb1, 0xf); v4 += DPPF(v4, 0x4e, 0xf); cy += DPPF(cy, 0xb1, 0xf); cy += DPPF(cy, 0x4e, 0xf);
            const int jj = 16 * i + 8 * kt + 2 * a + h;
            if (r4 == 0) { LAS float* ip = imp + (wid * 8 + tl) * 64 + jj; ip[0] += v4; }
            if (r4 == 0 && jj < 63) { LAS float* ip = imp + (wid * 8 + tl) * 64 + jj + 1; ip[0] += cy; }
          }
        nsa_pv(o, slot + NSA_KB, s, voff);
      } }
    { const float g0 = p.gates[trow * 24 + hg * 3];
#pragma unroll
      for (int r = 0; r < 16; ++r) { obuf[r * 64] = g0 * o[0][r]; obuf[(16 + r) * 64] = g0 * o[1][r]; o[0][r] = 0.f; o[1][r] = 0.f; } }
    unsigned long long U = 0ull, mym = 0ull;
    __builtin_amdgcn_s_waitcnt(0xc07f);
    {
      const bool forced = lane0 == 0 || lane0 == j0 || lane0 == j0 - 1;
#pragma unroll
      for (int i2 = 0; i2 < 8; ++i2) { const float v = imp[(wid * 8 + i2) * 64 + lane0]; imp[(wid * 8 + i2) * 64 + lane0] = lane0 <= j0 ? (forced ? v + 1e4f : v) : -1.f; }
      __builtin_amdgcn_s_waitcnt(0xc07f);
      const int lane0_ = lane0;
#pragma unroll 1
      for (int i2 = 0; i2 < 8; ++i2) {
        const LAS float* row = imp + (wid * 8 + i2) * 64;
        int lane0 = lane0_; asm volatile("" : "+v"(lane0));
        const float mv = row[lane0]; int rank = 0;
#pragma unroll
        for (int j4 = 0; j4 < 16; ++j4) { const f32x4 v = *(const LAS f32x4*)(row + 4 * j4);
          rank += (v.x > mv || (v.x == mv && 4 * j4 < lane0)) ? 1 : 0; rank += (v.y > mv || (v.y == mv && 4 * j4 + 1 < lane0)) ? 1 : 0;
          rank += (v.z > mv || (v.z == mv && 4 * j4 + 2 < lane0)) ? 1 : 0; rank += (v.w > mv || (v.w == mv && 4 * j4 + 3 < lane0)) ? 1 : 0; }
        const unsigned long long msk = __ballot(rank < 8);
        U |= msk; if (((lane0 & 31) >> 2) == i2) mym = msk;
      } }
    float m = -1e30f, l = 0.f;
#define NSA_ONLINE(MINE, LOWPOS, JB) do { \
      f32x16 s[2]; nsa_qk(s, slot, qf, koff); \
      const int tmin_ = t0 + wid * 8, tmax_ = tmin_ + 7; \
      const bool interior_ = (64 * (JB) + 63 <= tmin_) && (64 * (JB) > tmax_ - 512 || (LOWPOS) < 0);     \
      float mx = -1e30f, rs = 0.f, mn, alpha; \
      if (interior_) { \
        _Pragma("unroll") for (int r = 0; r < 16; ++r) mx = fmaxf(mx, fmaxf(s[0][r], s[1][r])); \
        mx = xmax32(mx); \
        mn = ((MINE) && mx > m + 8.f) ? mx : m; alpha = fexp(m - mn);         \
        const float me_ = (MINE) ? mn : 1e30f;                        \
        _Pragma("unroll") for (int r = 0; r < 16; ++r) { const float p0 = fexp(s[0][r] - me_), p1 = fexp(s[1][r] - me_); s[0][r] = p0; s[1][r] = p1; rs += p0 + p1; } \
      } else { \
        unsigned ok0 = 0u, ok1 = 0u; \
        _Pragma("unroll") for (int r = 0; r < 16; ++r) { const int pos = 64 * (JB) + (r & 3) + 8 * (r >> 2) + 4 * h; if ((MINE) && pos <= t && pos > (LOWPOS)) ok0 |= 1u << r; if ((MINE) && pos + 32 <= t && pos + 32 > (LOWPOS)) ok1 |= 1u << r; } \
        _Pragma("unroll") for (int r = 0; r < 16; ++r) { if ((ok0 >> r) & 1u) mx = fmaxf(mx, s[0][r]); if ((ok1 >> r) & 1u) mx = fmaxf(mx, s[1][r]); } \
        mx = xmax32(mx); \
        mn = fmaxf(m, mx); alpha = fexp(m - mn); \
        _Pragma("unroll") for (int r = 0; r < 16; ++r) { const float p0 = ((ok0 >> r) & 1u) ? fexp(s[0][r] - mn) : 0.f, p1 = ((ok1 >> r) & 1u) ? fexp(s[1][r] - mn) : 0.f; s[0][r] = p0; s[1][r] = p1; rs += p0 + p1; } \
      } \
      rs = xsum32(rs); \
      l = l * alpha + rs; \
      if (__any(mn != m)) { _Pragma("unroll") for (int r = 0; r < 16; ++r) { o[0][r] *= alpha; o[1][r] *= alpha; } } \
      m = mn; \
      nsa_pv(o, slot + NSA_KB, s, voff); } while (0)
    for (; it < itD; ++it) {
      NSA_STEP();
      const int j = it - itC;
      if ((U >> j) & 1ull) { const bool mine = (mym >> j) & 1ull; NSA_ONLINE(mine, -1, j); }
    }
    { const float f = p.gates[trow * 24 + hg * 3 + 1] / fmaxf(l, 1e-20f);
#pragma unroll
      for (int r = 0; r < 16; ++r) { obuf[r * 64] += f * o[0][r]; obuf[(16 + r) * 64] += f * o[1][r]; o[0][r] = 0.f; o[1][r] = 0.f; }
      m = -1e30f; l = 0.f; }
    for (; it < NI; ++it) {
      NSA_STEP();
      const int j = jw0 + it - itD;
      NSA_ONLINE(true, t - 512, j);
    }
#undef NSA_ONLINE
#undef NSA_STEP
#undef NSA_ISSUE
    asm volatile("s_waitcnt vmcnt(0)" ::: "memory");
    { const float f = p.gates[trow * 24 + hg * 3 + 2] / fmaxf(l, 1e-20f);
      bf16_t* orow = p.onsab + trow * 512 + hg * 64 + 4 * (lane0 >> 5);
#pragma unroll
      for (int dt = 0; dt < 2; ++dt)
#pragma unroll
        for (int a = 0; a < 4; ++a) { u32x2 w; const int r = 4 * a;
          w.x = pk2(obuf[(16 * dt + r) * 64] + f * o[dt][r], obuf[(16 * dt + r + 1) * 64] + f * o[dt][r + 1]); w.y = pk2(obuf[(16 * dt + r + 2) * 64] + f * o[dt][r + 2], obuf[(16 * dt + r + 3) * 64] + f * o[dt][r + 3]);
          *(u32x2*)(orow + dt * 32 + a * 8) = w; } }
    __syncthreads();
  }
}

__device__ __forceinline__ float ret_logg2(int h) { return logf(1.f - exp2f(-5.f - (float)h)); }
struct WLkminRows {
  typedef XRegB16<128> Regs; const bf16_t* rowp[1];
  __device__ __forceinline__ void load(Regs& R, int k0, int tid) const { xload_b16<128>(R, rowp, k0, tid); }
  __device__ __forceinline__ void store(const Regs& R, lptr img, int, int tid) const { xstore_b16<128>(R, img, tid); }
};
struct XLcmp {
  struct Regs { u32x4 r; }; const bf16_t* src; const float* pe; lptr ximg;
  __device__ __forceinline__ void load(Regs& R, int k0, int tid) const {
    if (tid < 256) { const int l = k0 >> 6, d0 = (k0 & 63) + (tid & 3) * 8;
      const u32x4 v = *(const u32x4*)(src + (size_t)l * PJW + (k0 & 63));
      const f32x4 p0 = *(const f32x4*)(pe + l * 64 + d0), p1 = *(const f32x4*)(pe + l * 64 + d0 + 4);
      R.r.x = pk2(bflo(v.x) + p0.x, bfhi(v.x) + p0.y); R.r.y = pk2(bflo(v.y) + p0.z, bfhi(v.y) + p0.w);
      R.r.z = pk2(bflo(v.z) + p1.x, bfhi(v.z) + p1.y); R.r.w = pk2(bflo(v.w) + p1.z, bfhi(v.w) + p1.w); }
  }
  __device__ __forceinline__ void store(const Regs& R, int tid) const { if (tid < 256) *(LAS u32x4*)(ximg + kmin_off(tid >> 2, tid & 3)) = R.r; }
  __device__ __forceinline__ lptr img(int) const { return ximg; }
};
struct XLretk {
  struct Regs { u32x4 r; }; const bf16_t* src; float lg; lptr ximg;
  __device__ __forceinline__ void load(Regs& R, int k0, int tid) const {
    const u32x4 v = *(const u32x4*)(src + (size_t)k0 * PJW);
    const float z = __expf(lg * (float)(127 - k0 - (tid >> 4)));
    R.r.x = pk2(bflo(v.x) * z, bfhi(v.x) * z); R.r.y = pk2(bflo(v.y) * z, bfhi(v.y) * z); R.r.z = pk2(bflo(v.z) * z, bfhi(v.z) * z); R.r.w = pk2(bflo(v.w) * z, bfhi(v.w) * z);
  }
  __device__ __forceinline__ void store(const Regs& R, int tid) const { *(LAS u32x4*)(ximg + (tid >> 4) * 320 + (tid & 15) * 16) = R.r; }
  __device__ __forceinline__ lptr img(int) const { return ximg; }
};
__device__ __forceinline__ void phase_r1(const P& p, lptr lds, int vcu, int G) {
  const int tid = threadIdx.x, wid = __builtin_amdgcn_readfirstlane(tid >> 6), lane = tid & 63, h = lane >> 5, l31 = lane & 31;
  lptr wimg = lds, ximg = lds + 16 * 1024;
  for (int u = vcu; u < 256 + 512; u += G) {
    if (u < 256) {
      const int isv = u >> 7, rt = (u >> 2) & 31, kq = u & 3, wn = wid >> 1, wt = wid & 1;
      f32x16 acc[1][1]; acc_zero<1, 1>(acc);
      WLb16<128> wl; wl.src = (isv ? p.cw1vb : p.cw1kb) + (size_t)kq * 512 * 128; wl.ld = 128;
      XLcmp xl; { int r = rt * 64 + ((tid >> 2) & 63); r = r < NCR ? r : NCR - 1; const int b = r / (2 * NC), g = (r / NC) & 1, c = r % NC;
        xl.src = p.projb + (size_t)(b * SEQ + 16 * c + kq * 8) * PJW + (isv ? J_VC : J_KC) + g * 64 + (tid & 3) * 8; xl.pe = (isv ? p.cpv : p.cpk) + kq * 512; xl.ximg = ximg; }
      gemm_loop<1, 1>(acc, 512, wl, xl, wimg, 128 * 2 + 64, wn * 32, wt * 32, tid, lane);
      int row = rt * 64 + wt * 32 + l31, nb = wn * 32 + 4 * h; asm volatile("" : "+v"(row), "+v"(nb));
      if (row < NCR) { float* o = p.hidp + (((size_t)(isv * 4 + kq) * 2048 + row) * 128) + nb;
#pragma unroll
        for (int a = 0; a < 4; ++a) { f32x4 v = {acc[0][0][4 * a], acc[0][0][4 * a + 1], acc[0][0][4 * a + 2], acc[0][0][4 * a + 3]}; *(f32x4*)(o + a * 8) = v; } }
    } else {
      const int chunk = u - 256, bh = chunk >> 5, b = bh >> 2, hh = bh & 3, s0 = (chunk & 31) * 128, wn = wid >> 1, wt = wid & 1;
      f32x16 acc[1][2]; acc_zero<1, 2>(acc);
      const bf16_t* base = p.projb + (size_t)(b * SEQ + s0) * PJW + hh * 128;
      WLb16<128> wl; wl.src = base + J_VR; wl.ld = PJW;
      XLretk xl; xl.src = base + J_KR + (size_t)(tid >> 4) * PJW + (tid & 15) * 8; xl.lg = ret_logg2(hh); xl.ximg = ximg;
      gemm_loop<1, 2, WLb16<128>, XLretk, true, true>(acc, 128, wl, xl, wimg, 128 * 2 + 64, wn * 32, wt * 64, tid, lane, 320);
      int dcol = wt * 64 + l31, nb = wn * 32 + 4 * h; asm volatile("" : "+v"(dcol), "+v"(nb));
#pragma unroll
      for (int tn = 0; tn < 2; ++tn) { float* o = p.kv + ((size_t)chunk * 128 + dcol + tn * 32) * 128 + nb;
#pragma unroll
        for (int a = 0; a < 4; ++a) { f32x4 v = {acc[0][tn][4 * a], acc[0][tn][4 * a + 1], acc[0][tn][4 * a + 2], acc[0][tn][4 * a + 3]}; *(f32x4*)(o + a * 8) = v; } }
    }
  }
}
__device__ __forceinline__ void phase_r2(const P& p, lptr lds, int vcu, int G) {
  const int tid = threadIdx.x;
  LAS float* hs = (LAS float*)lds;
  LAS float* os = hs + 1024;
  const LAS float* inv64 = (const LAS float*)(lds + LDS_INV64);
  for (int u = vcu; u < 2 * 255; u += G) {
    const int isv = u >= 255, r0 = (isv ? u - 255 : u) * 8;
    { const int i = tid, row = r0 + (i >> 7), k = i & 127;
#pragma unroll
      for (int q = 0; q < 2; ++q) { const int rr = row + 4 * q; float a = 0.f;
#pragma unroll
        for (int kq = 0; kq < 4; ++kq) a += p.hidp[((size_t)(isv * 4 + kq) * 2048 + rr) * 128 + k];
        hs[(rr - r0) * 128 + k] = gelu_tanh(a); } }
    __syncthreads();
    { const int rl = tid >> 6, n = tid & 63; const float* w2 = isv ? p.cw2v : p.cw2k; float a = 0.f;
#pragma unroll 8
      for (int k = 0; k < 128; ++k) a += hs[rl * 128 + k] * w2[k * 64 + n];
      os[rl * 64 + n] = a; }
    __syncthreads();
    { const int rl = tid >> 6, n = tid & 63, row = r0 + rl; float y = os[rl * 64 + n];
      if (!isv) { const int b = row / (2 * NC), c = row % NC, i = n & 31;
        const float fr = __builtin_amdgcn_fractf((float)p.pos[b * SEQ + 16 * c + 31] * inv64[i]);
        const float sn = __builtin_amdgcn_sinf(fr), cs = __builtin_amdgcn_cosf(fr), x1 = os[rl * 64 + i], x2 = os[rl * 64 + i + 32];
        y = n < 32 ? x1 * cs - x2 * sn : x1 * sn + x2 * cs; }
      (isv ? p.vcmpb : p.kcmpb)[(size_t)row * 64 + n] = (bf16_t)(pk2(y, 0.f) & 0xffffu); }
    __syncthreads();
  }
  for (int id = vcu * 512 + tid; id < 16 * 16384; id += G * 512) {
    const int bh = id >> 14, de = id & 16383; const float gc = __expf(ret_logg2(bh & 3) * 128.f);
    float v[32];
#pragma unroll
    for (int n = 0; n < 32; ++n) v[n] = p.kv[(size_t)(bh * 32 + n) * 16384 + de];
    float st = 0.f;
#pragma unroll
    for (int n = 0; n < 32; ++n) { p.stateb[(size_t)(bh * 32 + n) * 16384 + de] = (bf16_t)(pk2(st, 0.f) & 0xffffu); st = st * gc + v[n]; }
  }
}
__device__ __forceinline__ void phase_r3(const P& p, lptr lds, int vcu, int G) {
  const int tid = threadIdx.x, wid = __builtin_amdgcn_readfirstlane(tid >> 6), lane = tid & 63, h = lane >> 5, l31 = lane & 31, wn = wid >> 2, wt = wid & 3;
  lptr wimg = lds, ximg = lds + 12 * 1024, scb = lds + 20 * 1024;
  LAS float* part = (LAS float*)(lds + 52 * 1024);
  for (int chunk = vcu; chunk < 512; chunk += G) {
    const int bh = chunk >> 5, b = bh >> 2, hh = bh & 3, s0 = (chunk & 31) * 128; const float lg = ret_logg2(hh);
    const bf16_t* base = p.projb + (size_t)(b * SEQ + s0) * PJW + hh * 128;
    f32x16 acc[2][1];
    acc_zero<2, 1>(acc);
    { WLkminRows wl; wl.rowp[0] = base + J_KR + (size_t)((tid >> 2) & 127) * PJW;
      XLrows<128> xl; xl.rowp[0] = base + J_QR + (size_t)((tid >> 2) & 127) * PJW; xl.ximg = ximg;
      gemm_loop<2, 1, WLkminRows, XLrows<128>, false, false>(acc, 128, wl, xl, wimg, 0, wn * 64, wt * 32, tid, lane); }
    { int i = wt * 32 + l31, jb = wn * 64 + 4 * h; asm volatile("" : "+v"(i), "+v"(jb));
#pragma unroll
      for (int tm = 0; tm < 2; ++tm)
#pragma unroll
        for (int a = 0; a < 4; ++a) { const int j = jb + tm * 32 + a * 8; float o[4];
#pragma unroll
          for (int q = 0; q < 4; ++q) o[q] = i >= j + q ? acc[tm][0][4 * a + q] * __expf(lg * (float)(i - j - q)) : 0.f;
          u32x2 w; w.x = pk2(o[0], o[1]); w.y = pk2(o[2], o[3]);
          *(LAS u32x2*)(scb + (j >> 5) * 8192 + kmin_off(i, (j & 31) >> 3) + (j & 7) * 2) = w; } }
    __syncthreads();
    acc_zero<2, 1>(acc);
    { WLb16<128> wl; wl.src = p.stateb + (size_t)chunk * 16384; wl.ld = 128;
      XLrows<128> xl; xl.rowp[0] = base + J_QR + (size_t)((tid >> 2) & 127) * PJW; xl.ximg = ximg;
      gemm_loop<2, 1>(acc, 128, wl, xl, wimg, 128 * 2 + 64, wn * 64, wt * 32, tid, lane); }
    { const float xi = __expf(lg * (float)(wt * 32 + l31 + 1));
#pragma unroll
      for (int tm = 0; tm < 2; ++tm)
#pragma unroll
        for (int r = 0; r < 16; ++r) acc[tm][0][r] *= xi; }
    { WLb16<128> wl; wl.src = base + J_VR; wl.ld = PJW;
      XLres xl; xl.base = scb; xl.bytes = 8192;
      gemm_loop<2, 1>(acc, 128, wl, xl, wimg, 128 * 2 + 64, wn * 64, wt * 32, tid, lane); }
    { float ss = 0.f;
#pragma unroll
      for (int tm = 0; tm < 2; ++tm)
#pragma unroll
        for (int r = 0; r < 16; ++r) ss += acc[tm][0][r] * acc[tm][0][r];
      ss += __shfl_xor(ss, 32);
      if (h == 0) part[wn * 128 + wt * 32 + l31] = ss; }
    __syncthreads();
    { int i = wt * 32 + l31, eb = wn * 64 + 4 * h; asm volatile("" : "+v"(i), "+v"(eb));
      const float rs = rsqrtf((part[i] + part[128 + i]) * (1.f / 128.f) + EPS);
      const size_t trow = (size_t)(b * SEQ + s0 + i);
#pragma unroll
      for (int tm = 0; tm < 2; ++tm)
#pragma unroll
        for (int a = 0; a < 4; ++a) { const int e = eb + tm * 32 + a * 8;
          const f32x4 gr = *(const f32x4*)(p.g_ret + hh * 128 + e); const u32x2 gt = *(const u32x2*)(p.projb + trow * PJW + J_GR + hh * 128 + e);
          u32x2 w; w.x = pk2(acc[tm][0][4 * a] * rs * gr.x * bflo(gt.x), acc[tm][0][4 * a + 1] * rs * gr.y * bfhi(gt.x));
          w.y = pk2(acc[tm][0][4 * a + 2] * rs * gr.z * bflo(gt.y), acc[tm][0][4 * a + 3] * rs * gr.w * bfhi(gt.y));
          *(u32x2*)(p.mixb + trow * D + 512 + hh * 128 + e) = w; } }
    __syncthreads();
  }
  for (int tok = vcu * 8 + wid; tok < T; tok += G * 8) {
    const u32x4 v = *(const u32x4*)(p.onsab + (size_t)tok * 512 + lane * 8);
    float x[8] = {bflo(v.x), bfhi(v.x), bflo(v.y), bfhi(v.y), bflo(v.z), bfhi(v.z), bflo(v.w), bfhi(v.w)};
    float ss = 0.f;
#pragma unroll
    for (int q = 0; q < 8; ++q) ss += x[q] * x[q];
    ss = wave_sum(ss);
    const float rs = rsqrtf(ss * (1.f / 512.f) + EPS);
    const f32x4 g0 = *(const f32x4*)(p.g_nsa + lane * 8), g1 = *(const f32x4*)(p.g_nsa + lane * 8 + 4);
    u32x4 w; w.x = pk2(x[0] * rs * g0.x, x[1] * rs * g0.y); w.y = pk2(x[2] * rs * g0.z, x[3] * rs * g0.w); w.z = pk2(x[4] * rs * g1.x, x[5] * rs * g1.y); w.w = pk2(x[6] * rs * g1.z, x[7] * rs * g1.w);
    *(u32x4*)(p.mixb + (size_t)tok * D + lane * 8) = w;
  }
}

__device__ __forceinline__ void phase5a(const P& p, lptr lds, int vcu, int G) {
  const int tid = threadIdx.x, wid = __builtin_amdgcn_readfirstlane(tid >> 6), lane = tid & 63, wn = wid >> 2, wt = wid & 3;
  for (int u = vcu; u < 4 * 64; u += G) {
    const int j = u & 3, t0 = (u >> 2) * 256, b = t0 / SEQ;
    f32x16 acc[4][2];
    { const bf16_t* wb = p.woutb + j * 256; const bf16_t* xb = p.mixb + (size_t)t0 * D;
      gemm256_dma(acc, wb + (size_t)g2_wrow(wid, 0, lane) * D + g2_wcol(wid, 0, lane), wb + (size_t)g2_wrow(wid, 1, lane) * D + g2_wcol(wid, 1, lane), (size_t)32 * D,
                  xb + (size_t)g2_xtok(wid, 0, lane) * D + g2_xk(wid, 0, lane), xb + (size_t)g2_xtok(wid, 1, lane) * D + g2_xk(wid, 1, lane), D, lds, wn, wt, wid, lane); }
#pragma unroll
    for (int tn = 0; tn < 2; ++tn) {
      { int rl = wt * 32 + (lane & 31), cb = (wn * 128 + 4 * (lane >> 5)) * 2; asm volatile("" : "+v"(rl), "+v"(cb));
#pragma unroll
        for (int tm = 0; tm < 4; ++tm)
#pragma unroll
          for (int a = 0; a < 4; ++a) { u32x2 o; o.x = pk2(acc[tm][tn][4 * a], acc[tm][tn][4 * a + 1]); o.y = pk2(acc[tm][tn][4 * a + 2], acc[tm][tn][4 * a + 3]);
            *(LAS u32x2*)(lds + rl * 528 + cb + (tm * 32 + a * 8) * 2) = o; } }
      __syncthreads();
#pragma unroll
      for (int rr = 0; rr < 8; ++rr) { const int row = wid * 16 + rr * 2 + (lane >> 5);
        *(u32x4*)(p.mixo + (size_t)(t0 + (row >> 5) * 64 + tn * 32 + (row & 31)) * D + j * 256 + (lane & 31) * 8) = *(const LAS u32x4*)(lds + row * 528 + (lane & 31) * 16); }
      __syncthreads();
    }
  }
}
__device__ __forceinline__ void phase5b(const P& p, lptr lds, int vcu, int G) {
  const int tid = threadIdx.x, wid = tid >> 6, lane = tid & 63;
  for (int row = vcu * 8 + wid; row < T; row += G * 8) {
    const int b = row / SEQ;
    f32x4 v[4]; float s = 0.f;
#pragma unroll
    for (int j = 0; j < 4; ++j) { const int k = j * 256 + lane * 4;
      const f32x4 xv = *(const f32x4*)(p.x + (size_t)row * D + k), gt = *(const f32x4*)(p.mod + b * 6144 + 2048 + k); const u32x2 mo = *(const u32x2*)(p.mixo + (size_t)row * D + k);
      v[j].x = xv.x + gt.x * bflo(mo.x); v[j].y = xv.y + gt.y * bfhi(mo.x); v[j].z = xv.z + gt.z * bflo(mo.y); v[j].w = xv.w + gt.w * bfhi(mo.y);
      s += v[j].x * v[j].x + v[j].y * v[j].y + v[j].z * v[j].z + v[j].w * v[j].w; }
    s = wave_sum(s);
    const float r = rsqrtf(s * (1.f / D) + EPS);
#pragma unroll
    for (int j = 0; j < 4; ++j) {
      const int k = j * 256 + lane * 4;
      const f32x4 g = *(const f32x4*)(p.g_ffn + k), sc = *(const f32x4*)(p.mod + b * 6144 + 4096 + k), sh = *(const f32x4*)(p.mod + b * 6144 + 3072 + k);
      u32x2 o; o.x = pk2(v[j].x * r * g.x * (1.f + sc.x) + sh.x, v[j].y * r * g.y * (1.f + sc.y) + sh.y); o.y = pk2(v[j].z * r * g.z * (1.f + sc.z) + sh.z, v[j].w * r * g.w * (1.f + sc.w) + sh.w);
      *(u32x2*)(p.h2b + (size_t)row * D + k) = o;
    }
  }
}
__device__ __forceinline__ void phase5c(const P& p, lptr lds, int vcu, int G) {
  const int tid = threadIdx.x, wid = __builtin_amdgcn_readfirstlane(tid >> 6), lane = tid & 63, wn = wid >> 2, wt = wid & 3;
  for (int u = vcu; u < 3 * 64; u += G) {
    const int j = u % 3, t0 = (u / 3) * 256;
    f32x16 acc[4][2];
    { const bf16_t* xb = p.h2b + (size_t)t0 * D; const bf16_t* wq[2];
#pragma unroll
      for (int i = 0; i < 2; ++i) { const int k = g2_wrow(wid, i, lane), col = g2_wcol(wid, i, lane);
        if (j == 0) wq[i] = p.wrb + (size_t)k * NE + col;
        else { const int grp = col >> 7, w = col & 127; const unsigned long long ga = (unsigned long long)p.wgsb, ua = (unsigned long long)p.wusb;
          wq[i] = (const bf16_t*)(w < 64 ? ga : ua) + (size_t)k * 256 + (j - 1) * 128 + grp * 64 + (w & 63); } }
      gemm256_dma(acc, wq[0], wq[1], (size_t)32 * 256, xb + (size_t)g2_xtok(wid, 0, lane) * D + g2_xk(wid, 0, lane), xb + (size_t)g2_xtok(wid, 1, lane) * D + g2_xk(wid, 1, lane), D, lds, wn, wt, wid, lane); }
    int h4 = 4 * (lane >> 5), tb = t0 + wt * 64 + (lane & 31); asm volatile("" : "+v"(h4), "+v"(tb));
    if (j == 0) {
#pragma unroll
      for (int tn = 0; tn < 2; ++tn)
#pragma unroll
        for (int tm = 0; tm < 4; ++tm)
#pragma unroll
          for (int a = 0; a < 4; ++a) { f32x4 v = {acc[tm][tn][4 * a], acc[tm][tn][4 * a + 1], acc[tm][tn][4 * a + 2], acc[tm][tn][4 * a + 3]};
            *(f32x4*)(p.logits + (size_t)(tb + tn * 32) * NE + wn * 128 + tm * 32 + a * 8 + h4) = v; }
    } else {
#pragma unroll
      for (int tn = 0; tn < 2; ++tn)
#pragma unroll
        for (int tm = 0; tm < 2; ++tm)
#pragma unroll
          for (int a = 0; a < 4; ++a) { float o[4];
#pragma unroll
            for (int q = 0; q < 4; ++q) { const float gv = acc[tm][tn][4 * a + q], uv = acc[tm + 2][tn][4 * a + q]; o[q] = gv * __builtin_amdgcn_rcpf(1.f + __builtin_amdgcn_exp2f(-1.4426950408889634f * gv)) * uv; }
            u32x2 w; w.x = pk2(o[0], o[1]); w.y = pk2(o[2], o[3]);
            *(u32x2*)(p.actsb + (size_t)(tb + tn * 32) * 256 + (j - 1) * 128 + wn * 64 + tm * 32 + a * 8 + h4) = w; }
    }
  }
}
__device__ __forceinline__ void phase5d(const P& p, lptr lds, int vcu, int G) {
  const int tid = threadIdx.x, wid = __builtin_amdgcn_readfirstlane(tid >> 6), lane = tid & 63, wn = wid >> 2, wt = wid & 3;
  { const f32x4 rb = *(const f32x4*)(p.rbias + lane * 4);
    for (int tok = vcu * 8 + wid; tok < T; tok += G * 8) {
      const f32x4 lv = *(const f32x4*)(p.logits + (size_t)tok * NE + lane * 4);
      const float s0 = sigm(lv.x), s1 = sigm(lv.y), s2 = sigm(lv.z), s3 = sigm(lv.w);
      float c0 = s0 + rb.x, c1 = s1 + rb.y, c2 = s2 + rb.z, c3 = s3 + rb.w;
      float m1, m2;
      { const float h1 = fmaxf(c0, c1), l1 = fminf(c0, c1), h2 = fmaxf(c2, c3), l2 = fminf(c2, c3); m1 = fmaxf(h1, h2); m2 = fmaxf(fminf(h1, h2), fmaxf(l1, l2)); }
#define TOP2_MERGE(ctrl) { const float o1 = DPPF(m1, ctrl, 0xf), o2 = DPPF(m2, ctrl, 0xf); const float n1 = fmaxf(m1, o1), n2 = fmaxf(fminf(m1, o1), fmaxf(m2, o2)); m1 = n1; m2 = n2; }
      TOP2_MERGE(0xb1) TOP2_MERGE(0x4e) TOP2_MERGE(0x141)
#undef TOP2_MERGE
      const float gs = m1 + m2; const int myg = lane >> 3; int rank = 0;
#pragma unroll
      for (int g2 = 0; g2 < 8; ++g2) { const float og = __int_as_float(__builtin_amdgcn_readlane(__float_as_int(gs), g2 * 8)); rank += (og > gs || (og == gs && g2 < myg)) ? 1 : 0; }
      if (rank >= 4) { c0 = -INFINITY; c1 = -INFINITY; c2 = -INFINITY; c3 = -INFINITY; }
      int my_e = 0; float my_s = 0.f, wsum = 0.f;
#pragma unroll
      for (int k = 0; k < 8; ++k) {
        const float mx = wave_max_u(fmaxf(fmaxf(c0, c1), fmaxf(c2, c3)));
        const unsigned long long b0 = __ballot(c0 == mx), b1 = __ballot(c1 == mx), b2 = __ballot(c2 == mx), b3 = __ballot(c3 == mx);
        int li = 1 << 20;
        if (b0) li = min(li, 4 * (int)__builtin_ctzll(b0));
        if (b1) li = min(li, 4 * (int)__builtin_ctzll(b1) + 1);
        if (b2) li = min(li, 4 * (int)__builtin_ctzll(b2) + 2);
        if (b3) li = min(li, 4 * (int)__builtin_ctzll(b3) + 3);
        li = __builtin_amdgcn_readfirstlane(li);
        const int jx = li & 3; const float sj = jx == 0 ? s0 : jx == 1 ? s1 : jx == 2 ? s2 : s3;
        const float sv = __int_as_float(__builtin_amdgcn_readlane(__float_as_int(sj), li >> 2));
        if (lane * 4 == li) c0 = -INFINITY;
        if (lane * 4 + 1 == li) c1 = -INFINITY;
        if (lane * 4 + 2 == li) c2 = -INFINITY;
        if (lane * 4 + 3 == li) c3 = -INFINITY;
        wsum += sv;
        if (lane == k) { my_e = li; my_s = sv; }
      }
      if (lane < 8) { const int pos = atomicAdd(&p.cnt[my_e * CPAD], 1); p.list[my_e * ECAP + pos] = tok * 8 + lane; p.wts[tok * 8 + lane] = my_s / wsum * 2.5f; }
    } }
  __syncthreads();
  for (int u = vcu; u < 4 * 64; u += G) {
    const int j = u & 3, t0 = (u >> 2) * 256, b = t0 / SEQ;
    f32x16 acc[4][2];
    { const bf16_t* wb = p.wdsb + j * 256; const bf16_t* xb = p.actsb + (size_t)t0 * 256;
      gemm256_dma(acc, wb + (size_t)g2_wrow(wid, 0, lane) * D + g2_wcol(wid, 0, lane), wb + (size_t)g2_wrow(wid, 1, lane) * D + g2_wcol(wid, 1, lane), (size_t)32 * D,
                  xb + (size_t)g2_xtok(wid, 0, lane) * 256 + g2_xk(wid, 0, lane), xb + (size_t)g2_xtok(wid, 1, lane) * 256 + g2_xk(wid, 1, lane), 256, lds, wn, wt, wid, lane); }
    int nb = j * 256 + wn * 128 + 4 * (lane >> 5), tb = t0 + wt * 64 + (lane & 31); asm volatile("" : "+v"(nb), "+v"(tb));
#pragma unroll
    for (int tn = 0; tn < 2; ++tn)
#pragma unroll
      for (int tm = 0; tm < 4; ++tm)
#pragma unroll
        for (int a = 0; a < 4; ++a) { u32x2 w; w.x = pk2(acc[tm][tn][4 * a], acc[tm][tn][4 * a + 1]); w.y = pk2(acc[tm][tn][4 * a + 2], acc[tm][tn][4 * a + 3]);
          *(u32x2*)(p.ysb + (size_t)(tb + tn * 32) * D + nb + tm * 32 + a * 8) = w; }
  }
}

constexpr int NPHASE = 13;
__global__ void __launch_bounds__(512) mega(P p, int lo, int hi) {
  extern __shared__ __attribute__((aligned(16))) char lds_raw[];
  lptr lds = (lptr)lds_raw;
  const int tid = threadIdx.x, G = gridDim.x;
  const int vcu = (G % 8 == 0) ? ((int)blockIdx.x % 8) * (G / 8) + (int)blockIdx.x / 8 : (int)blockIdx.x;
  if (tid < 32) ((LAS float*)(lds + LDS_INV64))[tid] = exp2f(-(float)(2 * tid) / 64.f * 13.287712379549449f) * 0.15915494309189535f;
  if (tid < 64) ((LAS float*)(lds + LDS_INV128))[tid] = exp2f(-(float)(2 * tid) / 128.f * 13.287712379549449f) * 0.15915494309189535f;
  if (tid < 4) ((LAS unsigned*)(lds + LDS_XB))[tid] = 0u;
  __syncthreads();
  XcdBarrier xb; xb.bar = p.bar; xb.x = 0; xb.st = (volatile LAS unsigned*)(lds + LDS_XB);
  if (hi - lo > 1) xb = xcd_barrier_post(p.bar, (volatile LAS unsigned*)(lds + LDS_XB));
#define PH(k, call) if (lo <= (k) && (k) < hi) { call; if ((k) + 1 < hi) xcd_barrier(xb); }
  PH(0, phase0a(p, lds, vcu, G));
  PH(1, phase0b(p, lds, vcu, G));
  PH(2, phase1(p, lds, vcu, G));
  PH(3, phase_r1(p, lds, vcu, G));
  PH(4, phase_r2(p, lds, vcu, G));
  PH(5, phase_nsa(p, lds, vcu, G));
  PH(6, phase_r3(p, lds, vcu, G));
  PH(7, phase5a(p, lds, vcu, G));
  PH(8, phase5b(p, lds, vcu, G));
  PH(9, phase5c(p, lds, vcu, G));
  PH(10, phase5d(p, lds, vcu, G));
  PH(11, phase6(p, lds, vcu, G));
  PH(12, phase7(p, lds, vcu, G));
#undef PH
}
}

extern "C" void kernel_launch(void* const* d_in, const int* in_sizes, int n_in, void* d_out, int out_size, void* d_ws, size_t ws_size, hipStream_t stream) {
  P p{};
  p.x = (const float*)d_in[0]; p.c = (const float*)d_in[1]; p.pos = (const int*)d_in[2];
  p.w_ada = (const float*)d_in[3]; p.b_ada = (const float*)d_in[4]; p.g_mix = (const float*)d_in[5]; p.w_in = (const float*)d_in[6];
  p.cpk = (const float*)d_in[7]; p.cw1k = (const float*)d_in[8]; p.cw2k = (const float*)d_in[9];
  p.cpv = (const float*)d_in[10]; p.cw1v = (const float*)d_in[11]; p.cw2v = (const float*)d_in[12];
  p.g_nsa = (const float*)d_in[13]; p.g_ret = (const float*)d_in[14]; p.w_out = (const float*)d_in[15]; p.g_ffn = (const float*)d_in[16];
  p.w_router = (const float*)d_in[17]; p.rbias = (const float*)d_in[18]; p.wg_e = (const float*)d_in[19]; p.wu_e = (const float*)d_in[20];
  p.wd_e = (const float*)d_in[21]; p.wg_s = (const float*)d_in[22]; p.wu_s = (const float*)d_in[23]; p.wd_s = (const float*)d_in[24];
  p.g_final = (const float*)d_in[25];
  p.out = (float*)d_out;
  char* w = (char*)d_ws; size_t off = 0;
  auto take = [&](size_t bytes) { char* r = w + off; off += (bytes + 255) & ~(size_t)255; return r; };
  p.bar = (unsigned*)take(XCD_BAR_WORDS * 4);
  p.cnt = (int*)take(NE * CPAD * 4);
  const size_t zero_bytes = off;
  p.mod = (float*)take(BATCH * 6144 * 4);
  p.hidp = (float*)take((size_t)8 * 2048 * 128 * 4);
  p.kv = (float*)take((size_t)512 * 16384 * 4);
  p.stateb = (bf16_t*)take((size_t)512 * 16384 * 2);
  p.logits = (float*)take((size_t)T * NE * 4); p.actsb = (bf16_t*)take((size_t)T * 256 * 2); p.ysb = (bf16_t*)take((size_t)T * D * 2); p.mixo = (bf16_t*)take((size_t)T * D * 2);
  p.wts = (float*)take((size_t)T * 8 * 4);
  p.list = (int*)take((size_t)NE * ECAP * 4);
  p.gates = (float*)take((size_t)T * 24 * 4);
  p.winb = (bf16_t*)take((size_t)D * INW * 2); p.woutb = (bf16_t*)take((size_t)D * D * 2); p.wrb = (bf16_t*)take((size_t)D * NE * 2);
  p.wgsb = (bf16_t*)take((size_t)D * 256 * 2); p.wusb = (bf16_t*)take((size_t)D * 256 * 2); p.wdsb = (bf16_t*)take((size_t)256 * D * 2);
  p.cw1kb = (bf16_t*)take(2048 * 128 * 2); p.cw1vb = (bf16_t*)take(2048 * 128 * 2); p.cw2kb = (bf16_t*)take(128 * 64 * 2); p.cw2vb = (bf16_t*)take(128 * 64 * 2);
  p.hb = (bf16_t*)take((size_t)T * D * 2);
  p.projb = (bf16_t*)take((size_t)T * PJW * 2);
  p.mixb = (bf16_t*)take((size_t)T * D * 2); p.h2b = (bf16_t*)take((size_t)T * D * 2);
  p.slab = (bf16_t*)take((size_t)T * 8 * D * 2);
  p.kcmpb = (bf16_t*)take((2048 + 64) * 64 * 2); p.vcmpb = (bf16_t*)take((2048 + 64) * 64 * 2);
  p.onsab = (bf16_t*)take((size_t)T * 512 * 2);
  if (off > ws_size) { fprintf(stderr, "kernel_launch: workspace too small: need %zu have %zu\n", off, ws_size); return; }
  static int grid = 0;
  if (!grid) {
    int dev = 0, cus = 0, per_cu = 0;
    (void)hipGetDevice(&dev);
    (void)hipDeviceGetAttribute(&cus, hipDeviceAttributeMultiprocessorCount, dev);
    (void)hipFuncSetAttribute((const void*)mega, hipFuncAttributeMaxDynamicSharedMemorySize, LDS_BYTES);
    (void)hipOccupancyMaxActiveBlocksPerMultiprocessor(&per_cu, (const void*)mega, 512, LDS_BYTES);
    if (per_cu < 1) fprintf(stderr, "kernel_launch: occupancy query says %d blocks per CU\n", per_cu);
    grid = cus;
  }
  (void)hipMemsetAsync(d_ws, 0, zero_bytes, stream);
  hipLaunchKernelGGL(mega, dim3(grid), dim3(512), LDS_BYTES, stream, p, 0, NPHASE);
}
```

```cpp
#include <hip/hip_runtime.h>
#include <cstdint>
#include <cstdio>

namespace {
constexpr int D = 1024, BATCH = 4, SEQ = 4096, T = BATCH * SEQ;
constexpr int INW = 3352;
constexpr int C_QN = 0, C_KC = 512, C_VC = 640, C_KS = 768, C_VS = 896, C_KW = 1024, C_VW = 1152, C_GN = 1280,
              C_QR = 1304, C_KR = 1816, C_VR = 2328, C_GR = 2840;
constexpr int PJW = 3328, J_QN = 0, J_KC = 512, J_VC = 640, J_KS = 768, J_VS = 896, J_KW = 1024, J_VW = 1152, J_QR = 1280, J_KR = 1792, J_VR = 2304, J_GR = 2816;
constexpr int NC = 255, NCR = BATCH * 2 * NC;
constexpr int NE = 256, CPAD = 32;
constexpr int NXCD = 8, XCAP = 2048;
constexpr float EPS = 1e-6f;
typedef unsigned short bf16_t;

struct P {
  const float *x, *c; const int* pos;
  const float *w_ada, *b_ada, *g_mix, *w_in, *cpk, *cw1k, *cw2k, *cpv, *cw1v, *cw2v, *g_nsa, *g_ret, *w_out, *g_ffn,
      *w_router, *rbias, *wg_e, *wu_e, *wd_e, *wg_s, *wu_s, *wd_s, *g_final;
  float* out;
  float *mod, *kv, *wts, *gates;
  int *cnt, *list;
  bf16_t *winb, *woutb, *wrb, *cw1kb, *cw1vb, *cw2kb, *cw2vb, *hb, *projb, *mixb, *h2b, *slab, *kcmpb, *vcmpb, *onsab, *stateb, *ysb, *mixo, *x1b;
  float *hidp;
  unsigned* bar;
};

#define LAS __attribute__((address_space(3)))
typedef LAS char* lptr;
typedef short bf16x8 __attribute__((ext_vector_type(8)));
typedef short v4i16_t __attribute__((ext_vector_type(4)));
typedef float f32x16 __attribute__((ext_vector_type(16)));
typedef float f32x4 __attribute__((ext_vector_type(4)));
typedef float f32x2_t __attribute__((ext_vector_type(2)));
typedef __bf16 bf16x2_t __attribute__((ext_vector_type(2)));
typedef unsigned u32x4 __attribute__((ext_vector_type(4)));
typedef unsigned u32x2 __attribute__((ext_vector_type(2)));

#define DPPF(x, ctrl, rm) __int_as_float(__builtin_amdgcn_update_dpp(__float_as_int(x), __float_as_int(x), ctrl, rm, 0xf, false))
__device__ __forceinline__ float wave_max_u(float v) {
  v = fmaxf(v, DPPF(v, 0xb1, 0xf)); v = fmaxf(v, DPPF(v, 0x4e, 0xf)); v = fmaxf(v, DPPF(v, 0x124, 0xf)); v = fmaxf(v, DPPF(v, 0x128, 0xf));
  v = fmaxf(v, DPPF(v, 0x142, 0xa)); v = fmaxf(v, DPPF(v, 0x143, 0xc));
  return __int_as_float(__builtin_amdgcn_readlane(__float_as_int(v), 63));
}
__device__ __forceinline__ float wave_sum(float v) {
  v += DPPF(v, 0xb1, 0xf); v += DPPF(v, 0x4e, 0xf); v += DPPF(v, 0x124, 0xf); v += DPPF(v, 0x128, 0xf);
  { const float t = __int_as_float(__builtin_amdgcn_update_dpp(0, __float_as_int(v), 0x142, 0xa, 0xf, false)); v += t; }
  { const float t = __int_as_float(__builtin_amdgcn_update_dpp(0, __float_as_int(v), 0x143, 0xc, 0xf, false)); v += t; }
  return __int_as_float(__builtin_amdgcn_readlane(__float_as_int(v), 63));
}
__device__ __forceinline__ float wave_max(float v) { return wave_max_u(v); }
__device__ __forceinline__ float silu(float v) { return v / (1.f + expf(-v)); }
__device__ __forceinline__ float sigm(float v) { return 1.f / (1.f + expf(-v)); }
__device__ __forceinline__ float gelu_tanh(float v) { return 0.5f * v * (1.f + tanhf(0.7978845608028654f * (v + 0.044715f * v * v * v))); }
__device__ __forceinline__ unsigned pk2(float lo, float hi) { f32x2_t v = {lo, hi}; bf16x2_t b = __builtin_convertvector(v, bf16x2_t); return __builtin_bit_cast(unsigned, b); }
__device__ __forceinline__ float bf2f(bf16_t u) { return __uint_as_float((unsigned)u << 16); }
__device__ __forceinline__ float bflo(unsigned u) { return __uint_as_float(u << 16); }
__device__ __forceinline__ float bfhi(unsigned u) { return __uint_as_float(u & 0xffff0000u); }

#define XB_TMO      128
#define XB_XCNT(j)  (256  + 64 * (j))
#define XB_XSUB(j)  (1280 + 64 * (j))
#define XB_XGEN(j)  (2304 + 64 * (j))
#define XB_TOP      3328
#define XB_TOPGEN   3392
#define XCD_BAR_WORDS 3456
#define XB_SPIN_CAP (1u << 18)
__device__ __forceinline__ unsigned xb_ld(unsigned* p)              { return __hip_atomic_load(p, __ATOMIC_RELAXED, __HIP_MEMORY_SCOPE_AGENT); }
__device__ __forceinline__ unsigned xb_add(unsigned* p, unsigned v) { return __hip_atomic_fetch_add(p, v, __ATOMIC_RELAXED, __HIP_MEMORY_SCOPE_AGENT); }
__device__ __forceinline__ unsigned xb_xcc_id() { return (unsigned)__builtin_amdgcn_s_getreg((3 << 11) | 20) & 0xFu; }
#define XB_SPIN(cond, bar) do { unsigned _sp = 0; while (cond) { __builtin_amdgcn_s_sleep(1); \
    if ((++_sp & 255u) == 0u) { if (xb_ld(&(bar)[XB_TMO])) break; if (_sp > XB_SPIN_CAP) { atomicAdd(&(bar)[XB_TMO], 1u); break; } } } } while (0)
struct XcdBarrier { unsigned* bar; unsigned x; volatile LAS unsigned* st; };
__device__ __forceinline__ XcdBarrier xcd_barrier_post(unsigned* bar, volatile LAS unsigned* st) {
    XcdBarrier b; b.bar = bar; b.x = xb_xcc_id(); b.st = st;
    if (threadIdx.x == 0) (void)xb_add(&bar[XB_XCNT(b.x)], 1u);
    return b;
}
__device__ __forceinline__ void xcd_barrier_complete(unsigned* bar, unsigned x, unsigned& nloc, unsigned& nx) {
    const unsigned G = gridDim.x * gridDim.y * gridDim.z;
    unsigned sum, cnt, mine, sp = 0u;
    for (;;) {
        sum = 0u; cnt = 0u; mine = 0u;
#pragma unroll
        for (unsigned j = 0; j < 16; ++j) { const unsigned c = xb_ld(&bar[XB_XCNT(j)]); sum += c; cnt += (c > 0u) ? 1u : 0u; mine = (j == x) ? c : mine; }
        if (sum == G) break;
        __builtin_amdgcn_s_sleep(1);
        if ((++sp & 255u) == 0u) { if (xb_ld(&bar[XB_TMO])) break; if (sp > XB_SPIN_CAP) { atomicAdd(&bar[XB_TMO], 1u); break; } }
    }
    nloc = mine > 0u ? mine : 1u; nx = cnt > 0u ? cnt : 1u;
}
__device__ __forceinline__ void xcd_barrier(const XcdBarrier& b) {
    asm volatile("s_waitcnt vmcnt(0)" ::: "memory");
    __syncthreads();
    if (threadIdx.x == 0) {
        unsigned* bar = b.bar;
        __builtin_amdgcn_s_waitcnt(0);
        unsigned nloc = b.st[0], nx = b.st[1];
        if (nloc == 0u) { xcd_barrier_complete(bar, b.x, nloc, nx); b.st[0] = nloc; b.st[1] = nx; }
        const unsigned old = xb_add(&bar[XB_XSUB(b.x)], 1u);
        const unsigned gen = old / nloc;
        if (old + 1u == (gen + 1u) * nloc) {
            __builtin_amdgcn_fence(__ATOMIC_RELEASE, "agent");
            asm volatile("s_waitcnt vmcnt(0)" ::: "memory");
            const unsigned og = xb_add(&bar[XB_TOP], 1u);
            const unsigned tg = og / nx;
            if (og + 1u != (tg + 1u) * nx) XB_SPIN(xb_ld(&bar[XB_TOP]) < (tg + 1u) * nx, bar);
            __builtin_amdgcn_fence(__ATOMIC_ACQUIRE, "agent");
            xb_add(&bar[XB_XGEN(b.x)], 1u);
            asm volatile("s_waitcnt vmcnt(0)" ::: "memory");
        } else {
            XB_SPIN(xb_ld(&bar[XB_XGEN(b.x)]) == gen, bar);
            asm volatile("buffer_inv sc0\n\ts_waitcnt vmcnt(0)" ::: "memory");
        }
    }
    __syncthreads();
}

__device__ __forceinline__ bf16x8 frag_kmaj(lptr img, int rs, int o, int s, int lane) {
  const int h = lane >> 5, blk = (lane >> 4) & 1, q = (lane & 15) >> 2, pp = lane & 3;
  lptr a = img + (16 * s + 8 * h + q) * rs + (o + 16 * blk + 4 * pp) * 2;
  const v4i16_t lo = __builtin_amdgcn_ds_read_tr16_b64_v4i16((LAS v4i16_t*)a);
  const v4i16_t hi = __builtin_amdgcn_ds_read_tr16_b64_v4i16((LAS v4i16_t*)(a + 4 * rs));
  return (bf16x8){lo[0], lo[1], lo[2], lo[3], hi[0], hi[1], hi[2], hi[3]};
}
__device__ __forceinline__ bf16x8 frag_kmin(lptr img, int o, int s, int lane) {
  const int row = o + (lane & 31), c = 2 * s + (lane >> 5);
  return *(LAS bf16x8*)(img + row * 64 + ((c ^ ((row >> 2) & 3)) << 4));
}
__device__ __forceinline__ int kmin_off(int row, int c) { return row * 64 + ((c ^ ((row >> 2) & 3)) << 4); }

template <int TM, int TN, bool WKMAJ, bool XKMAJ>
__device__ __forceinline__ void mma_step(f32x16 (&acc)[TM][TN], lptr wimg, int wrs, int wn0, lptr ximg, int xrs, int xt0, int lane) {
#pragma unroll
  for (int s = 0; s < 2; ++s) {
    bf16x8 wf[TM], xf[TN];
#pragma unroll
    for (int tm = 0; tm < TM; ++tm) wf[tm] = WKMAJ ? frag_kmaj(wimg, wrs, wn0 + 32 * tm, s, lane) : frag_kmin(wimg, wn0 + 32 * tm, s, lane);
#pragma unroll
    for (int tn = 0; tn < TN; ++tn) xf[tn] = XKMAJ ? frag_kmaj(ximg, xrs, xt0 + 32 * tn, s, lane) : frag_kmin(ximg, xt0 + 32 * tn, s, lane);
#pragma unroll
    for (int tm = 0; tm < TM; ++tm)
#pragma unroll
      for (int tn = 0; tn < TN; ++tn) acc[tm][tn] = __builtin_amdgcn_mfma_f32_32x32x16_bf16(wf[tm], xf[tn], acc[tm][tn], 0, 0, 0);
    if (s == 0) __builtin_amdgcn_sched_barrier(0);
  }
}

template <int BNT> struct WRegB16 { u32x4 r[BNT / 128]; };
template <int BNT> __device__ __forceinline__ void wload_b16(WRegB16<BNT>& R, const bf16_t* src  , int ld, int tid) {
  constexpr int C8 = BNT / 8, KPR = 512 / C8;
  const int c8 = tid % C8, kr = tid / C8;
#pragma unroll
  for (int r = 0; r < BNT / 128; ++r) R.r[r] = *(const u32x4*)(src + (size_t)(kr + r * KPR) * ld + c8 * 8);
}
template <int BNT> __device__ __forceinline__ void wstore_b16(const WRegB16<BNT>& R, lptr img, int rs, int tid) {
  constexpr int C8 = BNT / 8, KPR = 512 / C8;
  const int c8 = tid % C8, kr = tid / C8;
#pragma unroll
  for (int r = 0; r < BNT / 128; ++r) *(LAS u32x4*)(img + (kr + r * KPR) * rs + c8 * 16) = R.r[r];
}
template <int BMT> struct XRegB16 { u32x4 r[(BMT + 127) / 128]; };
template <int BMT> __device__ __forceinline__ void xload_b16(XRegB16<BMT>& R, const bf16_t* const (&rowp)[(BMT + 127) / 128], int k0, int tid) {
#pragma unroll
  for (int r = 0; r < (BMT + 127) / 128; ++r) if (BMT >= 128 || tid < BMT * 4) R.r[r] = *(const u32x4*)(rowp[r] + k0 + (tid & 3) * 8);
}
template <int BMT> __device__ __forceinline__ void xstore_b16(const XRegB16<BMT>& R, lptr img, int tid) {
#pragma unroll
  for (int r = 0; r < (BMT + 127) / 128; ++r) if (BMT >= 128 || tid < BMT * 4) *(LAS u32x4*)(img + kmin_off((tid >> 2) + 128 * r, tid & 3)) = R.r[r];
}

template <int BNT> struct WLb16 {
  typedef WRegB16<BNT> Regs; const bf16_t* src; int ld;
  __device__ __forceinline__ void load(Regs& R, int k0, int tid) const { wload_b16<BNT>(R, src + (size_t)k0 * ld, ld, tid); }
  __device__ __forceinline__ void store(const Regs& R, lptr img, int rs, int tid) const { wstore_b16<BNT>(R, img, rs, tid); }
};
struct WReg32x8 { f32x4 r[8]; };
__device__ __forceinline__ void wstore_f32_512(const WReg32x8& R, lptr img, int rs, int tid) {
  const int c4 = tid & 127, kr = tid >> 7;
#pragma unroll
  for (int r = 0; r < 8; ++r) { u32x2 o; o.x = pk2(R.r[r].x, R.r[r].y); o.y = pk2(R.r[r].z, R.r[r].w); *(LAS u32x2*)(img + (kr + 4 * r) * rs + c4 * 8) = o; }
}
struct WLf32 {
  typedef WReg32x8 Regs; const float* src; int ld;
  __device__ __forceinline__ void load(Regs& R, int k0, int tid) const {
    const float* s = src + (size_t)(k0 + (tid >> 7)) * ld + (tid & 127) * 4;
#pragma unroll
    for (int r = 0; r < 8; ++r) R.r[r] = *(const f32x4*)(s + (size_t)(4 * r) * ld);
  }
  __device__ __forceinline__ void store(const Regs& R, lptr img, int rs, int tid) const { wstore_f32_512(R, img, rs, tid); }
};
struct WLf32gu {
  typedef WReg32x8 Regs; const float *g, *u;
  __device__ __forceinline__ void load(Regs& R, int k0, int tid) const {
    const int col = (tid & 127) * 4, grp = col >> 7, w = col & 127;
    const unsigned long long ga = (unsigned long long)g, ua = (unsigned long long)u;
    const float* s = (const float*)(w < 64 ? ga : ua) + (size_t)(k0 + (tid >> 7)) * 256 + grp * 64 + (w & 63);
#pragma unroll
    for (int r = 0; r < 8; ++r) R.r[r] = *(const f32x4*)(s + (size_t)(4 * r) * 256);
  }
  __device__ __forceinline__ void store(const Regs& R, lptr img, int rs, int tid) const { wstore_f32_512(R, img, rs, tid); }
};
template <int BMT> struct XLrows {
  typedef XRegB16<BMT> Regs; const bf16_t* rowp[(BMT + 127) / 128]; lptr ximg;
  __device__ __forceinline__ void load(Regs& R, int k0, int tid) const { xload_b16<BMT>(R, rowp, k0, tid); }
  __device__ __forceinline__ void store(const Regs& R, int tid) const { xstore_b16<BMT>(R, ximg, tid); }
  __device__ __forceinline__ void store(const Regs& R, int off, int tid) const { xstore_b16<BMT>(R, ximg + off, tid); }
  __device__ __forceinline__ lptr img(int) const { return ximg; }
  __device__ __forceinline__ int staged() const { return 1; }
};
struct XLres {
  struct Regs {}; lptr base; int bytes;
  __device__ __forceinline__ void load(Regs&, int, int) const {}
  __device__ __forceinline__ void store(const Regs&, int) const {}
  __device__ __forceinline__ void store(const Regs&, int, int) const {}
  __device__ __forceinline__ lptr img(int k0) const { return base + (k0 >> 5) * bytes; }
  __device__ __forceinline__ int staged() const { return 0; }
};
template <int TM, int TN, class WL, class XL, bool WK = true, bool XK = false>
__device__ __forceinline__ void gemm_loop(f32x16 (&acc)[TM][TN], int K, const WL& wl, const XL& xl, lptr wimg, int wrs, int wn0, int xt0, int tid, int lane, int xrs = 0) {
  asm volatile("" : "+v"(tid), "+v"(lane));
  typename WL::Regs wr; typename XL::Regs xr;
  wl.load(wr, 0, tid); xl.load(xr, 0, tid);
  for (int k0 = 0; k0 < K; k0 += 32) {
    wl.store(wr, wimg, wrs, tid); xl.store(xr, tid);
    __syncthreads();
    if (k0 + 32 < K) { wl.load(wr, k0 + 32, tid); xl.load(xr, k0 + 32, tid); }
    mma_step<TM, TN, WK, XK>(acc, wimg, wrs, wn0, xl.img(k0), xrs, xt0, lane);
    __syncthreads();
  }
}
template <int TM, int TN, class WL, class XL, bool WK = true, bool XK = false>
__device__ __forceinline__ void gemm_loop2(f32x16 (&acc)[TM][TN], int K, const WL& wl, const XL& xl, lptr wimg, int wrs, int wn0, int xt0, int tid, int lane, int xrs = 0) {
  asm volatile("" : "+v"(tid), "+v"(lane));
  typename WL::Regs wa, wb; typename XL::Regs xa, xb;
  wl.load(wa, 0, tid); xl.load(xa, 0, tid); wl.load(wb, 32, tid); xl.load(xb, 32, tid);
  for (int k0 = 0; k0 < K; k0 += 64) {
    wl.store(wa, wimg, wrs, tid); xl.store(xa, tid);
    __syncthreads();
    if (k0 + 64 < K) { wl.load(wa, k0 + 64, tid); xl.load(xa, k0 + 64, tid); }
    mma_step<TM, TN, WK, XK>(acc, wimg, wrs, wn0, xl.img(k0), xrs, xt0, lane);
    __syncthreads();
    wl.store(wb, wimg, wrs, tid); xl.store(xb, tid);
    __syncthreads();
    if (k0 + 96 < K) { wl.load(wb, k0 + 96, tid); xl.load(xb, k0 + 96, tid); }
    mma_step<TM, TN, WK, XK>(acc, wimg, wrs, wn0, xl.img(k0 + 32), xrs, xt0, lane);
    __syncthreads();
  }
}
template <int TM, int TN, class WL, class XL>
__device__ __forceinline__ void gemm_loop_db(f32x16 (&acc)[TM][TN], int K, const WL& wl, const XL& xl, lptr wimg, int wrs, int wn0, int xt0, int xhalf, int tid, int lane) {
  asm volatile("" : "+v"(tid), "+v"(lane));
  const bool early = __builtin_amdgcn_readfirstlane(tid) < 256;
  typename WL::Regs wa, wb; typename XL::Regs xa, xb;
  wl.load(wa, 0, tid); xl.load(xa, 0, tid); wl.load(wb, 32, tid); xl.load(xb, 32, tid);
  wl.store(wa, wimg, wrs, tid); xl.store(xa, 0, tid);
  __syncthreads();
  if (64 < K) { wl.load(wa, 64, tid); xl.load(xa, 64, tid); }
  for (int k0 = 0; k0 < K; k0 += 64) {
    if (early) { wl.store(wb, wimg + 32 * wrs, wrs, tid); xl.store(xb, xhalf, tid); if (k0 + 96 < K) { wl.load(wb, k0 + 96, tid); xl.load(xb, k0 + 96, tid); } }
    mma_step<TM, TN, true, false>(acc, wimg, wrs, wn0, xl.img(k0), 0, xt0, lane);
    if (!early) { wl.store(wb, wimg + 32 * wrs, wrs, tid); xl.store(xb, xhalf, tid); if (k0 + 96 < K) { wl.load(wb, k0 + 96, tid); xl.load(xb, k0 + 96, tid); } }
    __syncthreads();
    if (early && k0 + 64 < K) { wl.store(wa, wimg, wrs, tid); xl.store(xa, 0, tid); if (k0 + 128 < K) { wl.load(wa, k0 + 128, tid); xl.load(xa, k0 + 128, tid); } }
    mma_step<TM, TN, true, false>(acc, wimg + 32 * wrs, wrs, wn0, xl.img(k0 + 32) + xhalf * xl.staged(), 0, xt0, lane);
    if (!early && k0 + 64 < K) { wl.store(wa, wimg, wrs, tid); xl.store(xa, 0, tid); if (k0 + 128 < K) { wl.load(wa, k0 + 128, tid); xl.load(xa, k0 + 128, tid); } }
    __syncthreads();
  }
}
template <int TM, int TN, class WL, class XL>
__device__ __forceinline__ void gemm_loop_db_pre(f32x16 (&acc)[TM][TN], int K, const WL& wl, const XL& xl, typename WL::Regs& wa, typename WL::Regs& wb,
                                                 lptr wimg, int wrs, int wn0, int xt0, int tid, int lane) {
  asm volatile("" : "+v"(tid), "+v"(lane));
  const bool early = __builtin_amdgcn_readfirstlane(tid) < 256;
  wl.store(wa, wimg, wrs, tid);
  __syncthreads();
  if (64 < K) wl.load(wa, 64, tid);
  for (int k0 = 0; k0 < K; k0 += 64) {
    if (early) { wl.store(wb, wimg + 32 * wrs, wrs, tid); if (k0 + 96 < K) wl.load(wb, k0 + 96, tid); }
    mma_step<TM, TN, true, false>(acc, wimg, wrs, wn0, xl.img(k0), 0, xt0, lane);
    if (!early) { wl.store(wb, wimg + 32 * wrs, wrs, tid); if (k0 + 96 < K) wl.load(wb, k0 + 96, tid); }
    __syncthreads();
    if (early && k0 + 64 < K) { wl.store(wa, wimg, wrs, tid); if (k0 + 128 < K) wl.load(wa, k0 + 128, tid); }
    mma_step<TM, TN, true, false>(acc, wimg + 32 * wrs, wrs, wn0, xl.img(k0 + 32), 0, xt0, lane);
    if (!early && k0 + 64 < K) { wl.store(wa, wimg, wrs, tid); if (k0 + 128 < K) wl.load(wa, k0 + 128, tid); }
    __syncthreads();
  }
}
template <int TM, int TN> __device__ __forceinline__ void acc_zero(f32x16 (&acc)[TM][TN]) {
#pragma unroll
  for (int a = 0; a < TM; ++a)
#pragma unroll
    for (int b = 0; b < TN; ++b)
#pragma unroll
      for (int r = 0; r < 16; ++r) acc[a][b][r] = 0.f;
}

__device__ __forceinline__ void glds16(const void* gsrc, unsigned lds_dst) { unsigned keep;
  asm volatile("s_mov_b32 %0, m0\n\ts_mov_b32 m0, %2\n\ts_nop 0\n\tglobal_load_lds_dwordx4 %1, off\n\ts_mov_b32 m0, %0" : "=&s"(keep) : "v"(gsrc), "s"(lds_dst) : "memory"); }
__device__ __forceinline__ bf16x8 frag_kmaj512(lptr img, int o, int s, int lane) {
  const int h = lane >> 5, blk = (lane >> 4) & 1, q = (lane & 15) >> 2, pp = lane & 3;
  lptr a = img + (16 * s + 8 * h + q) * 512 + ((((o >> 3) + 2 * blk + (pp >> 1)) ^ (q << 2)) << 4) + (pp & 1) * 8;
  const v4i16_t lo = __builtin_amdgcn_ds_read_tr16_b64_v4i16((LAS v4i16_t*)a);
  const v4i16_t hi = __builtin_amdgcn_ds_read_tr16_b64_v4i16((LAS v4i16_t*)(a + 4 * 512));
  return (bf16x8){lo[0], lo[1], lo[2], lo[3], hi[0], hi[1], hi[2], hi[3]};
}
constexpr int G2_SLOT = 32768;
__device__ __forceinline__ void glds16x4(const void* g0, const void* g1, const void* g2, const void* g3, unsigned d0) {
  unsigned keep;
  asm volatile("s_mov_b32 %0, m0\n\ts_mov_b32 m0, %5\n\ts_nop 0\n\tglobal_load_lds_dwordx4 %1, off\n\ts_add_u32 m0, m0, 0x400\n\ts_nop 0\n\tglobal_load_lds_dwordx4 %2, off\n\t"
               "s_add_u32 m0, m0, 0x3c00\n\ts_nop 0\n\tglobal_load_lds_dwordx4 %3, off\n\ts_add_u32 m0, m0, 0x400\n\ts_nop 0\n\tglobal_load_lds_dwordx4 %4, off\n\ts_mov_b32 m0, %0"
               : "=&s"(keep) : "v"(g0), "v"(g1), "v"(g2), "v"(g3), "s"(d0) : "memory", "scc");
}
__device__ __forceinline__ void gemm256_dma(f32x16 (&acc)[4][2], const bf16_t* wp0, const bf16_t* wp1, size_t wstep, const bf16_t* xp0, const bf16_t* xp1, int K,
                                            lptr lds, int wn, int wt, int wid, int lane0, bool pre = false) {
  const unsigned ring0 = (unsigned)(uintptr_t)lds + (unsigned)wid * 2048u;
  const int nst = K >> 5;
#define G2_ISSUE(ST) do { const int st_ = (ST) < nst ? (ST) : nst - 1; const unsigned sl_ = (unsigned)__builtin_amdgcn_readfirstlane((int)(ring0 + (unsigned)((ST) & 3) * G2_SLOT)); \
    glds16x4(wp0 + (size_t)st_ * wstep, wp1 + (size_t)st_ * wstep, xp0 + st_ * 32, xp1 + st_ * 32, sl_); } while (0)
#define G2_READ(WF, XF, ST, S) do { lptr wi_ = lds + ((ST) & 3) * G2_SLOT; \
    _Pragma("unroll") for (int tm = 0; tm < 4; ++tm) WF[tm] = frag_kmaj512(wi_, wn * 128 + 32 * tm, S, lane); \
    _Pragma("unroll") for (int tn = 0; tn < 2; ++tn) XF[tn] = frag_kmin(wi_ + 16384, wt * 64 + 32 * tn, S, lane); } while (0)
#define G2_MMA(WF, XF) do { _Pragma("unroll") for (int tm = 0; tm < 4; ++tm) _Pragma("unroll") for (int tn = 0; tn < 2; ++tn) \
    acc[tm][tn] = __builtin_amdgcn_mfma_f32_32x32x16_bf16(WF[tm], XF[tn], acc[tm][tn], 0, 0, 0); } while (0)
  acc_zero<4, 2>(acc);
  int lane = lane0; asm volatile("" : "+v"(lane));
  bf16x8 wfa[4], xfa[2], wfb[4], xfb[2];
  if (!pre) { G2_ISSUE(0); G2_ISSUE(1); }
  G2_ISSUE(2);
  if (pre) asm volatile("s_waitcnt vmcnt(4)\n\ts_barrier" ::: "memory"); else asm volatile("s_waitcnt vmcnt(8)\n\ts_barrier" ::: "memory");
  G2_READ(wfa, xfa, 0, 0);
  for (int st = 0; st < nst; ++st) {
    G2_READ(wfb, xfb, st, 1);
    __builtin_amdgcn_sched_barrier(0);
    G2_MMA(wfa, xfa);
    __builtin_amdgcn_sched_barrier(0);
    asm volatile("s_waitcnt vmcnt(4)\n\ts_barrier" ::: "memory");
    G2_ISSUE(st + 3);
    if (st + 1 < nst) G2_READ(wfa, xfa, st + 1, 0);
    __builtin_amdgcn_sched_barrier(0);
    G2_MMA(wfb, xfb);
    __builtin_amdgcn_sched_barrier(0);
  }
#undef G2_ISSUE
#undef G2_READ
#undef G2_MMA
  asm volatile("s_waitcnt vmcnt(0)\n\ts_barrier" ::: "memory");
}
__device__ __forceinline__ void gemm256_pre(const bf16_t* wp0, const bf16_t* wp1, size_t wstep, const bf16_t* xp0, const bf16_t* xp1, lptr lds, int wid) {
  const unsigned ring0 = (unsigned)(uintptr_t)lds + (unsigned)wid * 2048u;
  glds16x4(wp0, wp1, xp0, xp1, (unsigned)__builtin_amdgcn_readfirstlane((int)ring0));
  glds16x4(wp0 + wstep, wp1 + wstep, xp0 + 32, xp1 + 32, (unsigned)__builtin_amdgcn_readfirstlane((int)(ring0 + G2_SLOT)));
}
__device__ __forceinline__ int g2_wrow(int wid, int i, int lane) { return 2 * (2 * wid + i) + (lane >> 5); }
__device__ __forceinline__ int g2_wcol(int wid, int i, int lane) { return (((lane & 31) ^ ((g2_wrow(wid, i, lane) & 3) << 2))) * 8; }
__device__ __forceinline__ int g2_xtok(int wid, int i, int lane) { return 16 * (2 * wid + i) + (lane >> 2); }
__device__ __forceinline__ int g2_xk(int wid, int i, int lane) { return (((lane & 3) ^ ((g2_xtok(wid, i, lane) >> 2) & 3))) * 8; }
constexpr int LDS_INV64 = 150 * 1024, LDS_INV128 = LDS_INV64 + 128, LDS_XB = LDS_INV128 + 256, LDS_BYTES = 152 * 1024;

__device__ __forceinline__ void cvt_items(const float* src, bf16_t* dst, size_t n8, int gtid, int gthreads) {
  for (size_t i0 = gtid; i0 < n8; i0 += (size_t)gthreads * 8) {
    f32x4 a[8], b[8];
#pragma unroll
    for (int q = 0; q < 8; ++q) { const size_t i = i0 + (size_t)q * gthreads; if (i < n8) { a[q] = *(const f32x4*)(src + i * 8); b[q] = *(const f32x4*)(src + i * 8 + 4); } }
#pragma unroll
    for (int q = 0; q < 8; ++q) { const size_t i = i0 + (size_t)q * gthreads; if (i < n8) { u32x4 o; o.x = pk2(a[q].x, a[q].y); o.y = pk2(a[q].z, a[q].w); o.z = pk2(b[q].x, b[q].y); o.w = pk2(b[q].z, b[q].w); *(u32x4*)(dst + i * 8) = o; } }
  }
}
__device__ __forceinline__ void phase0a(const P& p, lptr lds, int vcu, int G) {
  const int tid = threadIdx.x, wid = tid >> 6, lane = tid & 63;
  for (int i = vcu * 512 + tid; i < NXCD * NE; i += G * 512) p.cnt[i * CPAD] = 0;
  if (vcu < 96) {
    const int j = vcu * 64 + lane;
    LAS float* sc = (LAS float*)(lds + 16384);
    float w0[64], w1[64];
    { const float* wp = p.w_ada + (size_t)(wid * 128) * 6144 + j;
#pragma unroll
      for (int q = 0; q < 64; ++q) w0[q] = wp[(size_t)q * 6144];
#pragma unroll
      for (int q = 0; q < 64; ++q) w1[q] = wp[(size_t)(64 + q) * 6144]; }
    for (int i = tid; i < 4 * D; i += 512) sc[i] = silu(p.c[i]);
    __syncthreads();
    float a0 = 0.f, a1 = 0.f, a2 = 0.f, a3 = 0.f;
    { const int k = wid * 128;
#pragma unroll
      for (int q = 0; q < 64; ++q) { a0 += sc[k + q] * w0[q]; a1 += sc[D + k + q] * w0[q]; a2 += sc[2 * D + k + q] * w0[q]; a3 += sc[3 * D + k + q] * w0[q]; }
#pragma unroll
      for (int q = 0; q < 64; ++q) { a0 += sc[k + 64 + q] * w1[q]; a1 += sc[D + k + 64 + q] * w1[q]; a2 += sc[2 * D + k + 64 + q] * w1[q]; a3 += sc[3 * D + k + 64 + q] * w1[q]; } }
    LAS float* part = (LAS float*)lds;
    part[(wid * 4 + 0) * 64 + lane] = a0; part[(wid * 4 + 1) * 64 + lane] = a1; part[(wid * 4 + 2) * 64 + lane] = a2; part[(wid * 4 + 3) * 64 + lane] = a3;
    __syncthreads();
    if (wid < 4) { float s = p.b_ada[j];
#pragma unroll
      for (int w = 0; w < 8; ++w) s += part[(w * 4 + wid) * 64 + lane];
      p.mod[wid * 6144 + j] = s; }
    __syncthreads();
  }
  if (vcu < 96 && G > 96) return;
  if (G == 256) {
    const int cb = vcu - 96;
    if (cb < 100)      cvt_items(p.w_in, p.winb, (size_t)D * INW / 8, cb * 512 + tid, 100 * 512);
    else if (cb < 130) cvt_items(p.w_out, p.woutb, (size_t)D * D / 8, (cb - 100) * 512 + tid, 30 * 512);
    else if (cb < 138) cvt_items(p.w_router, p.wrb, (size_t)D * NE / 8, (cb - 130) * 512 + tid, 8 * 512);
    else if (cb < 146) cvt_items(p.cw1k, p.cw1kb, (size_t)2048 * 128 / 8, (cb - 138) * 512 + tid, 8 * 512);
    else if (cb < 154) cvt_items(p.cw1v, p.cw1vb, (size_t)2048 * 128 / 8, (cb - 146) * 512 + tid, 8 * 512);
    else if (cb < 157) cvt_items(p.cw2k, p.cw2kb, (size_t)128 * 64 / 8, (cb - 154) * 512 + tid, 3 * 512);
    else               cvt_items(p.cw2v, p.cw2vb, (size_t)128 * 64 / 8, (cb - 157) * 512 + tid, 3 * 512);
    return;
  }
  const int gtid = (G > 96 ? vcu - 96 : vcu) * 512 + tid, gth = (G > 96 ? G - 96 : G) * 512;
  cvt_items(p.w_in, p.winb, (size_t)D * INW / 8, gtid, gth);
  cvt_items(p.w_out, p.woutb, (size_t)D * D / 8, gtid, gth);
  cvt_items(p.w_router, p.wrb, (size_t)D * NE / 8, gtid, gth);
  cvt_items(p.cw1k, p.cw1kb, (size_t)2048 * 128 / 8, gtid, gth);
  cvt_items(p.cw1v, p.cw1vb, (size_t)2048 * 128 / 8, gtid, gth);
  cvt_items(p.cw2k, p.cw2kb, (size_t)128 * 64 / 8, gtid, gth);
  cvt_items(p.cw2v, p.cw2vb, (size_t)128 * 64 / 8, gtid, gth);
}

__device__ __forceinline__ void phase0b(const P& p, lptr lds, int vcu, int G) {
  const int tid = threadIdx.x, wid = tid >> 6, lane = tid & 63;
  for (int row = vcu * 8 + wid; row < T; row += G * 8) {
    const int b = row / SEQ;
    f32x4 v[4]; float s = 0.f;
#pragma unroll
    for (int j = 0; j < 4; ++j) { v[j] = *(const f32x4*)(p.x + (size_t)row * D + j * 256 + lane * 4); s += v[j].x * v[j].x + v[j].y * v[j].y + v[j].z * v[j].z + v[j].w * v[j].w; }
    s = wave_sum(s);
    const float r = rsqrtf(s * (1.f / D) + EPS);
#pragma unroll
    for (int j = 0; j < 4; ++j) {
      const int k = j * 256 + lane * 4;
      const f32x4 g = *(const f32x4*)(p.g_mix + k), sc = *(const f32x4*)(p.mod + b * 6144 + 1024 + k), sh = *(const f32x4*)(p.mod + b * 6144 + k);
      u32x2 o; o.x = pk2(v[j].x * r * g.x * (1.f + sc.x) + sh.x, v[j].y * r * g.y * (1.f + sc.y) + sh.y); o.y = pk2(v[j].z * r * g.z * (1.f + sc.z) + sh.z, v[j].w * r * g.w * (1.f + sc.w) + sh.w);
      *(u32x2*)(p.hb + (size_t)row * D + k) = o;
    }
  }
}

#define ROPE_PAIR(X1, X2, posf, invrev, sc) do { float pf_ = (posf); asm volatile("" : "+v"(pf_)); const float fr_ = __builtin_amdgcn_fractf(pf_ * (invrev)); \
    const float sn_ = __builtin_amdgcn_sinf(fr_), cs_ = __builtin_amdgcn_cosf(fr_); const float a_ = (X1), b_ = (X2); \
    float o1_ = (a_ * cs_ - b_ * sn_) * (sc), o2_ = (a_ * sn_ + b_ * cs_) * (sc); asm volatile("" : "+v"(o1_), "+v"(o2_)); (X1) = o1_; (X2) = o2_; } while (0)
__device__ __forceinline__ void phase1(const P& p, lptr lds, int vcu, int G) {
  const int tid = threadIdx.x, wid = __builtin_amdgcn_readfirstlane(tid >> 6), lane = tid & 63, wn = wid >> 2, wt = wid & 3, h = lane >> 5;
  const LAS float* inv64 = (const LAS float*)(lds + LDS_INV64);
  const LAS float* inv128 = (const LAS float*)(lds + LDS_INV128);
  bool pre = false;
  for (int u = vcu; u < 14 * 64; u += G) {
    const int j = u % 14, mt = u / 14, t0 = mt * 256;
    if (j == 13) {
      f32x16 ag[1][1]; acc_zero<1, 1>(ag);
      WLb16<128> wl; wl.src = p.winb + C_GN; wl.ld = INW;
      XLrows<256> xl; xl.rowp[0] = p.hb + (size_t)(t0 + (tid >> 2)) * D; xl.rowp[1] = xl.rowp[0] + (size_t)128 * D; xl.ximg = lds + 32 * 320;
      gemm_loop2<1, 1>(ag, D, wl, xl, lds, 320, 0, wid * 32, tid, lane);
      int tok = t0 + wid * 32 + (lane & 31), nb = 4 * h; asm volatile("" : "+v"(tok), "+v"(nb));
#pragma unroll
      for (int a = 0; a < 3; ++a) { f32x4 v; v.x = sigm(ag[0][0][4 * a]); v.y = sigm(ag[0][0][4 * a + 1]); v.z = sigm(ag[0][0][4 * a + 2]); v.w = sigm(ag[0][0][4 * a + 3]);
        *(f32x4*)(p.gates + (size_t)tok * 24 + nb + a * 8) = v; }
      continue;
    }
    const int wcol = j < 5 ? j * 256 : C_QR + (j - 5) * 256;
    f32x16 acc[4][2];
    int pos0 = p.pos[t0 + wt * 64 + (lane & 31)], pos1 = p.pos[t0 + wt * 64 + 32 + (lane & 31)];
    { const bf16_t* wb = p.winb + wcol; const bf16_t* xb = p.hb + (size_t)t0 * D;
      gemm256_dma(acc, wb + (size_t)g2_wrow(wid, 0, lane) * INW + g2_wcol(wid, 0, lane), wb + (size_t)g2_wrow(wid, 1, lane) * INW + g2_wcol(wid, 1, lane), (size_t)32 * INW,
                  xb + (size_t)g2_xtok(wid, 0, lane) * D + g2_xk(wid, 0, lane), xb + (size_t)g2_xtok(wid, 1, lane) * D + g2_xk(wid, 1, lane), D, lds, wn, wt, wid, lane, pre); }
    asm volatile("" : "+v"(pos0), "+v"(pos1));
    pre = false;
    { const int un = u + G, jn = un % 14, tn0 = (un / 14) * 256;
      if (un < 14 * 64 && jn != 13) { const bf16_t* wb = p.winb + (jn < 5 ? jn * 256 : C_QR + (jn - 5) * 256); const bf16_t* xb = p.hb + (size_t)tn0 * D;
        gemm256_pre(wb + (size_t)g2_wrow(wid, 0, lane) * INW + g2_wcol(wid, 0, lane), wb + (size_t)g2_wrow(wid, 1, lane) * INW + g2_wcol(wid, 1, lane), (size_t)32 * INW,
                    xb + (size_t)g2_xtok(wid, 0, lane) * D + g2_xk(wid, 0, lane), xb + (size_t)g2_xtok(wid, 1, lane) * D + g2_xk(wid, 1, lane), lds, wid);
        pre = true; } }
    const int kind = (j < 2) ? 0 : (j == 2) ? 3 : (j < 5) ? (wn == 0 ? 1 : 3) : (j < 7) ? 2 : (j < 9) ? 4 : (j < 11) ? 3 : 5;
#pragma unroll
    for (int tn = 0; tn < 2; ++tn) {
      const float posf = (float)(tn == 0 ? pos0 : pos1);
      if (kind == 0 || kind == 1) {
        const float sc = kind == 0 ? 0.125f * 1.4426950408889634f : 1.f;
#pragma unroll
        for (int r = 0; r < 16; ++r) { const float iv = inv64[(r & 3) + 8 * (r >> 2) + 4 * h];
          ROPE_PAIR(acc[0][tn][r], acc[1][tn][r], posf, iv, sc); ROPE_PAIR(acc[2][tn][r], acc[3][tn][r], posf, iv, sc); if ((r & 3) == 3) __builtin_amdgcn_sched_barrier(0); }
      } else if (kind == 2 || kind == 4) {
        const float sc = kind == 4 ? 0.08838834764831845f : 1.f;
#pragma unroll
        for (int r = 0; r < 16; ++r) { const int i = (r & 3) + 8 * (r >> 2) + 4 * h;
          ROPE_PAIR(acc[0][tn][r], acc[2][tn][r], posf, inv128[i], sc); ROPE_PAIR(acc[1][tn][r], acc[3][tn][r], posf, inv128[32 + i], sc); if ((r & 3) == 3) __builtin_amdgcn_sched_barrier(0); }
      } else if (kind == 5) {
#pragma unroll
        for (int tm = 0; tm < 4; ++tm)
#pragma unroll
          for (int r = 0; r < 16; ++r) { float v = acc[tm][tn][r]; asm volatile("" : "+v"(v)); float o = v * __builtin_amdgcn_rcpf(1.f + __builtin_amdgcn_exp2f(-1.4426950408889634f * v)); asm volatile("" : "+v"(o)); acc[tm][tn][r] = o; }
      }
      { int rl = wt * 32 + (lane & 31), cb = (wn * 128 + 4 * h) * 2; asm volatile("" : "+v"(rl), "+v"(cb));
#pragma unroll
        for (int tm = 0; tm < 4; ++tm)
#pragma unroll
          for (int a = 0; a < 4; ++a) { u32x2 o; o.x = pk2(acc[tm][tn][4 * a], acc[tm][tn][4 * a + 1]); o.y = pk2(acc[tm][tn][4 * a + 2], acc[tm][tn][4 * a + 3]);
            *(LAS u32x2*)(lds + 65536 + rl * 528 + cb + (tm * 32 + a * 8) * 2) = o; }
        __syncthreads();
#pragma unroll
        for (int rr = 0; rr < 8; ++rr) { const int row = wid * 16 + rr * 2 + (lane >> 5);
          *(u32x4*)(p.projb + (size_t)(t0 + (row >> 5) * 64 + tn * 32 + (row & 31)) * PJW + j * 256 + (lane & 31) * 8) = *(const LAS u32x4*)(lds + 65536 + row * 528 + (lane & 31) * 16); }
        __syncthreads(); }
    }
  }
}

__device__ __forceinline__ void phase6(const P& p, lptr lds, int vcu, int G) {
  const int tid = threadIdx.x, wid = __builtin_amdgcn_readfirstlane(tid >> 6), lane = tid & 63, h = lane >> 5, l31 = lane & 31, wn = wid >> 1, wt = wid & 1;
  constexpr int WRS = 512 * 2 + 64;
  lptr wimg = lds, ximg = lds + 68 * 1024;
  lptr actb = lds + 84 * 1024;
  LAS int* pre = (LAS int*)(lds + 148 * 1024);
  LAS int* sidl = pre + 320;
  if (tid < NE) { int c = 0;
#pragma unroll
    for (int x = 0; x < NXCD; ++x) c += p.cnt[(x * NE + tid) * CPAD];
    pre[tid + 1] = (c + 127) >> 7; }
  if (tid == 0) pre[0] = 0;
  __syncthreads();
  if (tid == 0) { int a = 0; for (int e = 1; e <= NE; ++e) { a += pre[e]; pre[e] = a; } }
  __syncthreads();
  const int nrouted = pre[NE], nunits = nrouted + T / 128;
  for (int u = vcu; u < nunits; u += G) {
    const bool sh = u >= nrouted;
    int lo = 0, hi = NE;
    if (!sh) while (hi - lo > 1) { const int mid = (lo + hi) >> 1; if (pre[mid] <= u) lo = mid; else hi = mid; }
    const int e = lo, off = sh ? (u - nrouted) * 128 : (u - pre[e]) * 128;
    if (tid < 128) { int sd = -1;
      if (sh) sd = (off + tid) * 8;
      else { int cx[NXCD];
#pragma unroll
        for (int x = 0; x < NXCD; ++x) cx[x] = p.cnt[(x * NE + e) * CPAD];
        int i = off + tid;
#pragma unroll
        for (int x = 0; x < NXCD; ++x) { if (i >= 0 && i < cx[x]) sd = p.list[(size_t)(x * NE + e) * XCAP + i]; i = i >= 0 && i < cx[x] ? -1 : i - cx[x]; } }
      sidl[tid] = sd; }
    const unsigned long long gA = sh ? (unsigned long long)p.wg_s : (unsigned long long)(p.wg_e + (size_t)e * D * 256), uA = sh ? (unsigned long long)p.wu_s : (unsigned long long)(p.wu_e + (size_t)e * D * 256),
        dA = sh ? (unsigned long long)p.wd_s : (unsigned long long)(p.wd_e + (size_t)e * 256 * D), oA = sh ? (unsigned long long)p.ysb : (unsigned long long)p.slab;
    const int osh = sh ? 3 : 0;
    __syncthreads();
    float wgt2[2];
#pragma unroll
    for (int tn = 0; tn < 2; ++tn) { const int sd = sidl[wt * 64 + tn * 32 + l31]; wgt2[tn] = sd < 0 ? 0.f : sh ? 1.f : p.wts[sd]; }
    f32x16 acc[4][2];
    acc_zero<4, 2>(acc);
    { WLf32gu wl; wl.g = (const float*)gA; wl.u = (const float*)uA;
      XLrows<128> xl; { const int sd = sidl[(tid >> 2) & 127]; xl.rowp[0] = p.h2b + (size_t)(sd < 0 ? 0 : sd >> 3) * D; } xl.ximg = ximg;
      gemm_loop_db<4, 2>(acc, D, wl, xl, wimg, WRS, wn * 128, wt * 64, 128 * 64, tid, lane); }
    WReg32x8 wa, wb;
    { WLf32 wl; wl.src = (const float*)dA; wl.ld = D; wl.load(wa, 0, tid); wl.load(wb, 32, tid); }
    { int l31_ = l31, h_ = h; asm volatile("" : "+v"(l31_), "+v"(h_));
#pragma unroll
      for (int tn = 0; tn < 2; ++tn)
#pragma unroll
        for (int tm = 0; tm < 2; ++tm)
#pragma unroll
          for (int a = 0; a < 4; ++a) {
            float o[4];
#pragma unroll
            for (int q = 0; q < 4; ++q) { const float gv = acc[tm][tn][4 * a + q], uv = acc[tm + 2][tn][4 * a + q]; o[q] = gv * __builtin_amdgcn_rcpf(1.f + __builtin_amdgcn_exp2f(-1.4426950408889634f * gv)) * uv; }
            const int col = wn * 64 + tm * 32 + a * 8 + 4 * h_;
            u32x2 w2; w2.x = pk2(o[0], o[1]); w2.y = pk2(o[2], o[3]);
            *(LAS u32x2*)(actb + (col >> 5) * 8192 + kmin_off(wt * 64 + tn * 32 + l31_, (col & 31) >> 3) + (col & 7) * 2) = w2;
          } }
    __syncthreads();
#pragma unroll 1
    for (int pass = 0; pass < 2; ++pass) {
      acc_zero<4, 2>(acc);
      { WLf32 wl; wl.src = (const float*)dA + pass * 512; wl.ld = D;
        XLres xl; xl.base = actb; xl.bytes = 8192;
        gemm_loop_db_pre<4, 2>(acc, 256, wl, xl, wa, wb, wimg, WRS, wn * 128, wt * 64, tid, lane);
        if (pass == 0) { wl.src += 512; wl.load(wa, 0, tid); wl.load(wb, 32, tid); } }
      { int nbl = wn * 128 + 4 * h, rl = wt * 32 + l31; asm volatile("" : "+v"(nbl), "+v"(rl));
#pragma unroll
        for (int tn = 0; tn < 2; ++tn) {
          const float wgt = wgt2[tn];
#pragma unroll
          for (int tm = 0; tm < 4; ++tm)
#pragma unroll
            for (int a = 0; a < 4; ++a) { u32x2 o; o.x = pk2(acc[tm][tn][4 * a] * wgt, acc[tm][tn][4 * a + 1] * wgt); o.y = pk2(acc[tm][tn][4 * a + 2] * wgt, acc[tm][tn][4 * a + 3] * wgt);
              *(LAS u32x2*)(lds + rl * 1040 + (nbl + tm * 32 + a * 8) * 2) = o; }
          __syncthreads();
#pragma unroll
          for (int rr = 0; rr < 8; ++rr) { const int row = wid * 8 + rr, sd2 = sidl[(row >> 5) * 64 + tn * 32 + (row & 31)];
            if (sd2 >= 0) *(u32x4*)((bf16_t*)oA + (size_t)(sd2 >> osh) * D + pass * 512 + lane * 8) = *(const LAS u32x4*)(lds + row * 1040 + lane * 16); }
          __syncthreads();
        } }
    }
    __syncthreads();
  }
}

__device__ __forceinline__ void phase7(const P& p, lptr lds, int vcu, int G) {
  const int tid = threadIdx.x, wid = tid >> 6, lane = tid & 63;
  for (int tok = vcu * 8 + wid; tok < T; tok += G * 8) {
    const int b = tok / SEQ;
    float v[16]; float ss = 0.f;
#pragma unroll
    for (int j = 0; j < 2; ++j) {
      const int n = j * 512 + lane * 8;
      float a[8];
#pragma unroll
      for (int q = 0; q < 8; ++q) a[q] = 0.f;
#pragma unroll
      for (int k = 0; k < 9; ++k) { const u32x4 w = k < 8 ? *(const u32x4*)(p.slab + ((size_t)tok * 8 + k) * D + n) : *(const u32x4*)(p.ysb + (size_t)tok * D + n);
        a[0] += bflo(w.x); a[1] += bfhi(w.x); a[2] += bflo(w.y); a[3] += bfhi(w.y); a[4] += bflo(w.z); a[5] += bfhi(w.z); a[6] += bflo(w.w); a[7] += bfhi(w.w); }
#pragma unroll
      for (int q4 = 0; q4 < 2; ++q4) {
        const f32x4 gt = *(const f32x4*)(p.mod + b * 6144 + 5120 + n + q4 * 4);
        const u32x2 x1 = *(const u32x2*)(p.x1b + (size_t)tok * D + n + q4 * 4);
        const float y0 = bflo(x1.x) + gt.x * a[q4 * 4], y1 = bfhi(x1.x) + gt.y * a[q4 * 4 + 1], y2 = bflo(x1.y) + gt.z * a[q4 * 4 + 2], y3 = bfhi(x1.y) + gt.w * a[q4 * 4 + 3];
        v[j * 8 + q4 * 4] = y0; v[j * 8 + q4 * 4 + 1] = y1; v[j * 8 + q4 * 4 + 2] = y2; v[j * 8 + q4 * 4 + 3] = y3;
        ss += y0 * y0 + y1 * y1 + y2 * y2 + y3 * y3;
      }
    }
    ss = wave_sum(ss);
    const float r = rsqrtf(ss * (1.f / D) + EPS);
#pragma unroll
    for (int j = 0; j < 2; ++j)
#pragma unroll
      for (int q4 = 0; q4 < 2; ++q4) {
        const int n = j * 512 + lane * 8 + q4 * 4;
        const f32x4 g = *(const f32x4*)(p.g_final + n);
        f32x4 o; o.x = v[j * 8 + q4 * 4] * r * g.x; o.y = v[j * 8 + q4 * 4 + 1] * r * g.y; o.z = v[j * 8 + q4 * 4 + 2] * r * g.z; o.w = v[j * 8 + q4 * 4 + 3] * r * g.w;
        *(f32x4*)(p.out + (size_t)tok * D + n) = o;
      }
  }
}

constexpr int NSA_KB = 8192, NSA_VRS = 128, NSA_SLOT = NSA_KB + 64 * NSA_VRS, NSA_NSLOT = 4, NSA_IMP = NSA_NSLOT * NSA_SLOT;
__device__ __forceinline__ void nsa_offsets(int (&koff)[4], int (&voff)[2], int lane) {
  const int h = lane >> 5, l31 = lane & 31, blk = (lane >> 4) & 1, q = (lane & 15) >> 2, pp = lane & 3;
#pragma unroll
  for (int ds = 0; ds < 4; ++ds) koff[ds] = l31 * 128 + (((2 * ds + h) ^ ((l31 >> 1) & 7)) << 4);
#pragma unroll
  for (int dt = 0; dt < 2; ++dt) voff[dt] = (4 * h + q) * NSA_VRS + (((dt * 4 + 2 * blk + (pp >> 1)) ^ ((q >> 1) << 2)) << 4) + (pp & 1) * 8;
}
__device__ __forceinline__ void nsa_qk(f32x16 (&s)[2], lptr kimg, const bf16x8 (&qf)[4], const int (&koff)[4]) {
#pragma unroll
  for (int kt = 0; kt < 2; ++kt) {
#pragma unroll
    for (int r = 0; r < 16; ++r) s[kt][r] = 0.f;
#pragma unroll
    for (int ds = 0; ds < 4; ++ds) {
      const bf16x8 a = *(LAS bf16x8*)(kimg + koff[ds] + kt * 4096);
      s[kt] = __builtin_amdgcn_mfma_f32_32x32x16_bf16(a, qf[ds], s[kt], 0, 0, 0);
    }
  }
}
__device__ __forceinline__ void nsa_pv(f32x16 (&o)[2], lptr vimg, const f32x16 (&pr)[2], const int (&voff)[2]) {
  bf16x8 pb[4];
#pragma unroll
  for (int ks = 0; ks < 4; ++ks) {
    const int kt = ks >> 1, rb = 8 * (ks & 1);
    u32x4 w; w.x = pk2(pr[kt][rb], pr[kt][rb + 1]); w.y = pk2(pr[kt][rb + 2], pr[kt][rb + 3]); w.z = pk2(pr[kt][rb + 4], pr[kt][rb + 5]); w.w = pk2(pr[kt][rb + 6], pr[kt][rb + 7]);
    pb[ks] = __builtin_bit_cast(bf16x8, w);
  }
#pragma unroll
  for (int dt = 0; dt < 2; ++dt)
#pragma unroll
    for (int ks = 0; ks < 4; ++ks) {
      lptr a = vimg + voff[dt] + ks * 2048;
      const v4i16_t lo = __builtin_amdgcn_ds_read_tr16_b64_v4i16((LAS v4i16_t*)a);
      const v4i16_t hi = __builtin_amdgcn_ds_read_tr16_b64_v4i16((LAS v4i16_t*)(a + 1024));
      const bf16x8 vf = {lo[0], lo[1], lo[2], lo[3], hi[0], hi[1], hi[2], hi[3]};
      o[dt] = __builtin_amdgcn_mfma_f32_32x32x16_bf16(vf, pb[ks], o[dt], 0, 0, 0);
    }
}
__device__ __forceinline__ float fexp(float x) { return __builtin_amdgcn_exp2f(x); }
__device__ __forceinline__ float xmax32(float x) { const auto rr = __builtin_amdgcn_permlane32_swap(__float_as_uint(x), __float_as_uint(x), false, false); return fmaxf(__uint_as_float(rr[0]), __uint_as_float(rr[1])); }
__device__ __forceinline__ float xsum32(float x) { const auto rr = __builtin_amdgcn_permlane32_swap(__float_as_uint(x), __float_as_uint(x), false, false); return __uint_as_float(rr[0]) + __uint_as_float(rr[1]); }
__device__ __forceinline__ void phase_nsa(const P& p, lptr lds, int vcu, int G) {
  const int tid = threadIdx.x, wid = __builtin_amdgcn_readfirstlane(tid >> 6), lane0 = tid & 63;
  int koff[4], voff[2]; nsa_offsets(koff, voff, lane0);
  LAS float* imp = (LAS float*)(lds + NSA_IMP);
  LAS float* obuf = (LAS float*)(lds + NSA_IMP + 16384) + wid * 2048 + lane0;
  for (int u = vcu; u < 512; u += G) {
    const int bg = u & 7, j0 = u < 256 ? 63 - (u >> 3) : ((u - 256) >> 3), b = bg >> 1, g = bg & 1, t0 = j0 * 64;
    const int t = t0 + wid * 8 + ((lane0 & 31) >> 2), hg = g * 4 + (lane0 & 3);
    const size_t trow = (size_t)(b * SEQ + t);
    bf16x8 qf[4];
#pragma unroll
    for (int ds = 0; ds < 4; ++ds) qf[ds] = *(const bf16x8*)(p.projb + trow * PJW + J_QN + hg * 64 + 16 * ds + 8 * (lane0 >> 5));
#pragma unroll
    for (int i = 0; i < 8; ++i) imp[(wid * 8 + i) * 64 + lane0] = 0.f;
    const int nct = (((t0 + 32) >> 4) >> 6) + 1, jw0 = j0 > 8 ? j0 - 8 : 0;
    const int itC = 2 * nct, itD = itC + j0 + 1, NI = itD + (j0 - jw0 + 1);
    const int cmaxt = t >= 31 ? (t - 31) >> 4 : -1;
    const int drow = wid * 8 + (lane0 >> 3), dch = lane0 & 7;
    const char* pbt = (const char*)(p.projb + (size_t)(b * SEQ) * PJW + g * 64) + (size_t)drow * (PJW * 2);
    const char* kct = (const char*)(p.kcmpb + (size_t)bg * NC * 64) + drow * 128;
    const char* vct = (const char*)(p.vcmpb + (size_t)bg * NC * 64) + drow * 128;
    const unsigned kx = (unsigned)((dch ^ ((drow >> 1) & 7)) * 16), vx = (unsigned)((dch ^ (((drow >> 1) & 1) << 2)) * 16);
    const unsigned ring0 = (unsigned)(uintptr_t)lds + (unsigned)wid * 1024u;
#define NSA_ISSUE(IT) do { const int it_ = (IT) < NI ? (IT) : NI - 1; const unsigned sl_ = (unsigned)__builtin_amdgcn_readfirstlane((int)(ring0 + (unsigned)((IT) & (NSA_NSLOT - 1)) * NSA_SLOT)); \
      if (it_ < itC) { const unsigned o_ = (unsigned)(it_ < nct ? it_ : it_ - nct) * 8192u; glds16(kct + o_ + kx, sl_); glds16(vct + o_ + vx, sl_ + NSA_KB); } \
      else { const bool sel_ = it_ < itD; const unsigned o_ = (unsigned)(sel_ ? it_ - itC : jw0 + it_ - itD) * (unsigned)(64 * PJW * 2); \
             glds16(pbt + o_ + (sel_ ? J_KS * 2 : J_KW * 2) + kx, sl_); glds16(pbt + o_ + (sel_ ? J_VS * 2 : J_VW * 2) + vx, sl_ + NSA_KB); } } while (0)
#define NSA_STEP() lptr slot = lds + (it & (NSA_NSLOT - 1)) * NSA_SLOT; \
      asm volatile("s_waitcnt vmcnt(4)\n\ts_barrier" ::: "memory"); \
      NSA_ISSUE(it + 3); \
      int lane = lane0; asm volatile("" : "+v"(lane)); const int h = lane >> 5, l31 = lane & 31; (void)l31
    NSA_ISSUE(0); NSA_ISSUE(1); NSA_ISSUE(2);
    int it = 0;
    float m1 = -1e30f, l1 = 0.f;
    for (; it < nct; ++it) {
      NSA_STEP();
      f32x16 s[2]; nsa_qk(s, slot, qf, koff);
      float mx = -1e30f;
#pragma unroll
      for (int r = 0; r < 16; ++r) { const int c = 64 * it + (r & 3) + 8 * (r >> 2) + 4 * h; if (c <= cmaxt) mx = fmaxf(mx, s[0][r]); if (c + 32 <= cmaxt) mx = fmaxf(mx, s[1][r]); }
      mx = xmax32(mx);
      const float mn = fmaxf(m1, mx); float rs = 0.f;
#pragma unroll
      for (int r = 0; r < 16; ++r) { const int c = 64 * it + (r & 3) + 8 * (r >> 2) + 4 * h; rs += (c <= cmaxt ? fexp(s[0][r] - mn) : 0.f) + (c + 32 <= cmaxt ? fexp(s[1][r] - mn) : 0.f); }
      rs = xsum32(rs);
      l1 = l1 * fexp(m1 - mn) + rs; m1 = mn;
    }
    f32x16 o[2];
#pragma unroll
    for (int r = 0; r < 16; ++r) { o[0][r] = 0.f; o[1][r] = 0.f; }
    { const float il = 1.f / fmaxf(l1, 1e-20f);
      for (; it < itC; ++it) {
        NSA_STEP();
        const int i = it - nct, tl = l31 >> 2, r4 = l31 & 3;
        f32x16 s[2]; nsa_qk(s, slot, qf, koff);
#pragma unroll
        for (int r = 0; r < 16; ++r) { const int c = 64 * i + (r & 3) + 8 * (r >> 2) + 4 * h; s[0][r] = c <= cmaxt ? fexp(s[0][r] - m1) * il : 0.f; s[1][r] = c + 32 <= cmaxt ? fexp(s[1][r] - m1) * il : 0.f; }
#pragma unroll
        for (int kt = 0; kt < 2; ++kt)
#pragma unroll
          for (int a = 0; a < 4; ++a) {
            float v4 = (s[kt][4 * a] + s[kt][4 * a + 1]) + (s[kt][4 * a + 2] + s[kt][4 * a + 3]), cy = s[kt][4 * a + 3];
            v4 += DPPF(v4, 0xb1, 0xf); v4 += DPPF(v4, 0x4e, 0xf); cy += DPPF(cy, 0xb1, 0xf); cy += DPPF(cy, 0x4e, 0xf);
            const int jj = 16 * i + 8 * kt + 2 * a + h;
            if (r4 == 0) { LAS float* ip = imp + (wid * 8 + tl) * 64 + jj; ip[0] += v4; }
            if (r4 == 0 && jj < 63) { LAS float* ip = imp + (wid * 8 + tl) * 64 + jj + 1; ip[0] += cy; }
          }
        nsa_pv(o, slot + NSA_KB, s, voff);
      } }
    { const float g0 = p.gates[trow * 24 + hg * 3];
#pragma unroll
      for (int r = 0; r < 16; ++r) { obuf[r * 64] = g0 * o[0][r]; obuf[(16 + r) * 64] = g0 * o[1][r]; o[0][r] = 0.f; o[1][r] = 0.f; } }
    unsigned long long U = 0ull, mym = 0ull;
    __builtin_amdgcn_s_waitcnt(0xc07f);
    {
      const bool forced = lane0 == 0 || lane0 == j0 || lane0 == j0 - 1;
#pragma unroll
      for (int i2 = 0; i2 < 8; ++i2) { const float v = imp[(wid * 8 + i2) * 64 + lane0]; imp[(wid * 8 + i2) * 64 + lane0] = lane0 <= j0 ? (forced ? v + 1e4f : v) : -1.f; }
      __builtin_amdgcn_s_waitcnt(0xc07f);
      const int lane0_ = lane0;
#pragma unroll 1
      for (int i2 = 0; i2 < 8; ++i2) {
        const LAS float* row = imp + (wid * 8 + i2) * 64;
        int lane0 = lane0_; asm volatile("" : "+v"(lane0));
        const float mv = row[lane0]; int rank = 0;
#pragma unroll
        for (int j4 = 0; j4 < 16; ++j4) { const f32x4 v = *(const LAS f32x4*)(row + 4 * j4);
          rank += (v.x > mv || (v.x == mv && 4 * j4 < lane0)) ? 1 : 0; rank += (v.y > mv || (v.y == mv && 4 * j4 + 1 < lane0)) ? 1 : 0;
          rank += (v.z > mv || (v.z == mv && 4 * j4 + 2 < lane0)) ? 1 : 0; rank += (v.w > mv || (v.w == mv && 4 * j4 + 3 < lane0)) ? 1 : 0; }
        const unsigned long long msk = __ballot(rank < 8);
        U |= msk; if (((lane0 & 31) >> 2) == i2) mym = msk;
      } }
    float m = -1e30f, l = 0.f;
#define NSA_ONLINE(MINE, LOWPOS, JB) do { \
      f32x16 s[2]; nsa_qk(s, slot, qf, koff); \
      const int tmin_ = t0 + wid * 8, tmax_ = tmin_ + 7; \
      const bool interior_ = (64 * (JB) + 63 <= tmin_) && (64 * (JB) > tmax_ - 512 || (LOWPOS) < 0);     \
      float mx = -1e30f, rs = 0.f, mn, alpha; \
      if (interior_) { \
        _Pragma("unroll") for (int r = 0; r < 16; ++r) mx = fmaxf(mx, fmaxf(s[0][r], s[1][r])); \
        mx = xmax32(mx); \
        mn = ((MINE) && mx > m + 8.f) ? mx : m; alpha = fexp(m - mn);         \
        const float me_ = (MINE) ? mn : 1e30f;                        \
        _Pragma("unroll") for (int r = 0; r < 16; ++r) { const float p0 = fexp(s[0][r] - me_), p1 = fexp(s[1][r] - me_); s[0][r] = p0; s[1][r] = p1; rs += p0 + p1; } \
      } else { \
        unsigned ok0 = 0u, ok1 = 0u; \
        _Pragma("unroll") for (int r = 0; r < 16; ++r) { const int pos = 64 * (JB) + (r & 3) + 8 * (r >> 2) + 4 * h; if ((MINE) && pos <= t && pos > (LOWPOS)) ok0 |= 1u << r; if ((MINE) && pos + 32 <= t && pos + 32 > (LOWPOS)) ok1 |= 1u << r; } \
        _Pragma("unroll") for (int r = 0; r < 16; ++r) { if ((ok0 >> r) & 1u) mx = fmaxf(mx, s[0][r]); if ((ok1 >> r) & 1u) mx = fmaxf(mx, s[1][r]); } \
        mx = xmax32(mx); \
        mn = fmaxf(m, mx); alpha = fexp(m - mn); \
        _Pragma("unroll") for (int r = 0; r < 16; ++r) { const float p0 = ((ok0 >> r) & 1u) ? fexp(s[0][r] - mn) : 0.f, p1 = ((ok1 >> r) & 1u) ? fexp(s[1][r] - mn) : 0.f; s[0][r] = p0; s[1][r] = p1; rs += p0 + p1; } \
      } \
      rs = xsum32(rs); \
      l = l * alpha + rs; \
      if (__any(mn != m)) { _Pragma("unroll") for (int r = 0; r < 16; ++r) { o[0][r] *= alpha; o[1][r] *= alpha; } } \
      m = mn; \
      nsa_pv(o, slot + NSA_KB, s, voff); } while (0)
    for (; it < itD; ++it) {
      NSA_STEP();
      const int j = it - itC;
      if ((U >> j) & 1ull) { const bool mine = (mym >> j) & 1ull; NSA_ONLINE(mine, -1, j); }
    }
    { const float f = p.gates[trow * 24 + hg * 3 + 1] / fmaxf(l, 1e-20f);
#pragma unroll
      for (int r = 0; r < 16; ++r) { obuf[r * 64] += f * o[0][r]; obuf[(16 + r) * 64] += f * o[1][r]; o[0][r] = 0.f; o[1][r] = 0.f; }
      m = -1e30f; l = 0.f; }
    for (; it < NI; ++it) {
      NSA_STEP();
      const int j = jw0 + it - itD;
      NSA_ONLINE(true, t - 512, j);
    }
#undef NSA_ONLINE
#undef NSA_STEP
#undef NSA_ISSUE
    asm volatile("s_waitcnt vmcnt(0)" ::: "memory");
    { const float f = p.gates[trow * 24 + hg * 3 + 2] / fmaxf(l, 1e-20f);
      bf16_t* orow = p.onsab + trow * 512 + hg * 64 + 4 * (lane0 >> 5);
#pragma unroll
      for (int dt = 0; dt < 2; ++dt)
#pragma unroll
        for (int a = 0; a < 4; ++a) { u32x2 w; const int r = 4 * a;
          w.x = pk2(obuf[(16 * dt + r) * 64] + f * o[dt][r], obuf[(16 * dt + r + 1) * 64] + f * o[dt][r + 1]); w.y = pk2(obuf[(16 * dt + r + 2) * 64] + f * o[dt][r + 2], obuf[(16 * dt + r + 3) * 64] + f * o[dt][r + 3]);
          *(u32x2*)(orow + dt * 32 + a * 8) = w; } }
    __syncthreads();
  }
}

__device__ __forceinline__ float ret_logg2(int h) { return logf(1.f - exp2f(-5.f - (float)h)); }
struct WLkminRows {
  typedef XRegB16<128> Regs; const bf16_t* rowp[1];
  __device__ __forceinline__ void load(Regs& R, int k0, int tid) const { xload_b16<128>(R, rowp, k0, tid); }
  __device__ __forceinline__ void store(const Regs& R, lptr img, int, int tid) const { xstore_b16<128>(R, img, tid); }
};
struct XLcmp {
  struct Regs { u32x4 r; }; const bf16_t* src; const float* pe; lptr ximg;
  __device__ __forceinline__ void load(Regs& R, int k0, int tid) const {
    if (tid < 256) { const int l = k0 >> 6, d0 = (k0 & 63) + (tid & 3) * 8;
      const u32x4 v = *(const u32x4*)(src + (size_t)l * PJW + (k0 & 63));
      const f32x4 p0 = *(const f32x4*)(pe + l * 64 + d0), p1 = *(const f32x4*)(pe + l * 64 + d0 + 4);
      R.r.x = pk2(bflo(v.x) + p0.x, bfhi(v.x) + p0.y); R.r.y = pk2(bflo(v.y) + p0.z, bfhi(v.y) + p0.w);
      R.r.z = pk2(bflo(v.z) + p1.x, bfhi(v.z) + p1.y); R.r.w = pk2(bflo(v.w) + p1.z, bfhi(v.w) + p1.w); }
  }
  __device__ __forceinline__ void store(const Regs& R, int tid) const { if (tid < 256) *(LAS u32x4*)(ximg + kmin_off(tid >> 2, tid & 3)) = R.r; }
  __device__ __forceinline__ lptr img(int) const { return ximg; }
};
struct XLretk {
  struct Regs { u32x4 r; }; const bf16_t* src; float lg; lptr ximg;
  __device__ __forceinline__ void load(Regs& R, int k0, int tid) const {
    const u32x4 v = *(const u32x4*)(src + (size_t)k0 * PJW);
    const float z = __expf(lg * (float)(127 - k0 - (tid >> 4)));
    R.r.x = pk2(bflo(v.x) * z, bfhi(v.x) * z); R.r.y = pk2(bflo(v.y) * z, bfhi(v.y) * z); R.r.z = pk2(bflo(v.z) * z, bfhi(v.z) * z); R.r.w = pk2(bflo(v.w) * z, bfhi(v.w) * z);
  }
  __device__ __forceinline__ void store(const Regs& R, int tid) const { *(LAS u32x4*)(ximg + (tid >> 4) * 320 + (tid & 15) * 16) = R.r; }
  __device__ __forceinline__ lptr img(int) const { return ximg; }
};
#define R1_BULK(NS, WSTORE, XSTORE, MMA) do { WSTORE(0, 0); XSTORE(0, 0); __syncthreads(); \
    _Pragma("unroll") for (int s_ = 0; s_ < (NS); ++s_) { if (s_ + 1 < (NS)) { WSTORE(s_ + 1, (s_ + 1) & 1); XSTORE(s_ + 1, (s_ + 1) & 1); } MMA(s_ & 1); __syncthreads(); } } while (0)
__device__ __forceinline__ void phase_r1(const P& p, lptr lds, int vcu, int G) {
  const int tid = threadIdx.x, wid = __builtin_amdgcn_readfirstlane(tid >> 6), lane = tid & 63, h = lane >> 5, l31 = lane & 31;
  lptr wimg = lds, ximg = lds + 20 * 1024;
  LAS float* pes = (LAS float*)(lds + 40 * 1024);
  for (int u = vcu; u < 256 + 512; u += G) {
    int td = tid; asm volatile("" : "+v"(td));
    if (u < 256) {
      const int isv = u >> 7, rt = (u >> 2) & 31, kq = u & 3, wn = wid >> 1, wt = wid & 1;
      f32x16 acc[1][1]; acc_zero<1, 1>(acc);
      WLb16<128> wl; wl.src = (isv ? p.cw1vb : p.cw1kb) + (size_t)kq * 512 * 128; wl.ld = 128;
      int r = rt * 64 + ((td >> 2) & 63); r = r < NCR ? r : NCR - 1; const int b = r / (2 * NC), g = (r / NC) & 1, c = r % NC;
      const bf16_t* src = p.projb + (size_t)(b * SEQ + 16 * c + kq * 8) * PJW + (isv ? J_VC : J_KC) + g * 64 + (td & 3) * 8;
      if (td < 128) *(LAS f32x4*)(pes + td * 4) = *(const f32x4*)((isv ? p.cpv : p.cpk) + kq * 512 + td * 4);
      WRegB16<128> wr[16]; u32x4 xr[16];
#pragma unroll
      for (int s4 = 0; s4 < 16; ++s4) { wl.load(wr[s4], 32 * s4, td); if (td < 256) xr[s4] = *(const u32x4*)(src + (size_t)(s4 >> 1) * PJW + (s4 & 1) * 32); }
      __syncthreads();
#define R1_WS(S, B) wl.store(wr[S], wimg + (B) * 10240, 128 * 2 + 64, td)
#define R1_XS(S, B) do { if (td < 256) { const LAS float* pq_ = pes + ((S) >> 1) * 64 + ((S) & 1) * 32 + (td & 3) * 8; const f32x4 p0 = *(const LAS f32x4*)pq_, p1 = *(const LAS f32x4*)(pq_ + 4); const u32x4 v = xr[S]; u32x4 o_; \
        o_.x = pk2(bflo(v.x) + p0.x, bfhi(v.x) + p0.y); o_.y = pk2(bflo(v.y) + p0.z, bfhi(v.y) + p0.w); o_.z = pk2(bflo(v.z) + p1.x, bfhi(v.z) + p1.y); o_.w = pk2(bflo(v.w) + p1.z, bfhi(v.w) + p1.w); \
        *(LAS u32x4*)(ximg + (B) * 10240 + kmin_off(td >> 2, td & 3)) = o_; } } while (0)
#define R1_MM(B) mma_step<1, 1, true, false>(acc, wimg + (B) * 10240, 128 * 2 + 64, wn * 32, ximg + (B) * 10240, 0, wt * 32, lane)
      R1_BULK(16, R1_WS, R1_XS, R1_MM);
#undef R1_WS
#undef R1_XS
#undef R1_MM
      int row = rt * 64 + wt * 32 + l31, nb = wn * 32 + 4 * h; asm volatile("" : "+v"(row), "+v"(nb));
      if (row < NCR) { float* o = p.hidp + (((size_t)(isv * 4 + kq) * 2048 + row) * 128) + nb;
#pragma unroll
        for (int a = 0; a < 4; ++a) { f32x4 v = {acc[0][0][4 * a], acc[0][0][4 * a + 1], acc[0][0][4 * a + 2], acc[0][0][4 * a + 3]}; *(f32x4*)(o + a * 8) = v; } }
    } else {
      const int chunk = u - 256, bh = chunk >> 5, b = bh >> 2, hh = bh & 3, s0 = (chunk & 31) * 128, wn = wid >> 1, wt = wid & 1;
      f32x16 acc[1][2]; acc_zero<1, 2>(acc);
      const bf16_t* base = p.projb + (size_t)(b * SEQ + s0) * PJW + hh * 128;
      WLb16<128> wl; wl.src = base + J_VR; wl.ld = PJW;
      const bf16_t* src = base + J_KR + (size_t)(td >> 4) * PJW + (td & 15) * 8;
      const float lg = ret_logg2(hh);
      WRegB16<128> wr[4]; u32x4 xr[4];
#pragma unroll
      for (int s4 = 0; s4 < 4; ++s4) { wl.load(wr[s4], 32 * s4, td); xr[s4] = *(const u32x4*)(src + (size_t)(32 * s4) * PJW); }
#define R1_WS(S, B) wl.store(wr[S], wimg + (B) * 10240, 128 * 2 + 64, td)
#define R1_XS(S, B) do { const float z = __expf(lg * (float)(127 - 32 * (S) - (td >> 4))); const u32x4 v = xr[S]; u32x4 o_; \
        o_.x = pk2(bflo(v.x) * z, bfhi(v.x) * z); o_.y = pk2(bflo(v.y) * z, bfhi(v.y) * z); o_.z = pk2(bflo(v.z) * z, bfhi(v.z) * z); o_.w = pk2(bflo(v.w) * z, bfhi(v.w) * z); \
        *(LAS u32x4*)(ximg + (B) * 10240 + (td >> 4) * 320 + (td & 15) * 16) = o_; } while (0)
#define R1_MM(B) mma_step<1, 2, true, true>(acc, wimg + (B) * 10240, 128 * 2 + 64, wn * 32, ximg + (B) * 10240, 320, wt * 64, lane)
      R1_BULK(4, R1_WS, R1_XS, R1_MM);
#undef R1_WS
#undef R1_XS
#undef R1_MM
      int dcol = wt * 64 + l31, nb = wn * 32 + 4 * h; asm volatile("" : "+v"(dcol), "+v"(nb));
#pragma unroll
      for (int tn = 0; tn < 2; ++tn) { float* o = p.kv + ((size_t)chunk * 128 + dcol + tn * 32) * 128 + nb;
#pragma unroll
        for (int a = 0; a < 4; ++a) { f32x4 v = {acc[0][tn][4 * a], acc[0][tn][4 * a + 1], acc[0][tn][4 * a + 2], acc[0][tn][4 * a + 3]}; *(f32x4*)(o + a * 8) = v; } }
    }
  }
}
#undef R1_BULK
__device__ __forceinline__ void phase_r2(const P& p, lptr lds, int vcu, int G) {
  const int tid = threadIdx.x;
  LAS float* hs = (LAS float*)lds;
  LAS float* os = hs + 1024;
  LAS float* w2s = (LAS float*)(lds + 8192);
  const LAS float* inv64 = (const LAS float*)(lds + LDS_INV64);
  for (int u = vcu; u < 2 * 255; u += G) {
    const int isv = u >= 255, r0 = (isv ? u - 255 : u) * 8;
    { const float* w2 = isv ? p.cw2v : p.cw2k;
#pragma unroll
      for (int q = 0; q < 4; ++q) *(LAS f32x4*)(w2s + (q * 512 + tid) * 4) = *(const f32x4*)(w2 + (q * 512 + tid) * 4); }
    { const int i = tid, row = r0 + (i >> 7), k = i & 127;
#pragma unroll
      for (int q = 0; q < 2; ++q) { const int rr = row + 4 * q; float a = 0.f;
#pragma unroll
        for (int kq = 0; kq < 4; ++kq) a += p.hidp[((size_t)(isv * 4 + kq) * 2048 + rr) * 128 + k];
        hs[(rr - r0) * 128 + k] = gelu_tanh(a); } }
    __syncthreads();
    { const int rl = tid >> 6, n = tid & 63; float a = 0.f;
#pragma unroll 8
      for (int k = 0; k < 128; ++k) a += hs[rl * 128 + k] * w2s[k * 64 + n];
      os[rl * 64 + n] = a; }
    __syncthreads();
    { const int rl = tid >> 6, n = tid & 63, row = r0 + rl; float y = os[rl * 64 + n];
      if (!isv) { const int b = row / (2 * NC), c = row % NC, i = n & 31;
        const float fr = __builtin_amdgcn_fractf((float)p.pos[b * SEQ + 16 * c + 31] * inv64[i]);
        const float sn = __builtin_amdgcn_sinf(fr), cs = __builtin_amdgcn_cosf(fr), x1 = os[rl * 64 + i], x2 = os[rl * 64 + i + 32];
        y = n < 32 ? x1 * cs - x2 * sn : x1 * sn + x2 * cs; }
      (isv ? p.vcmpb : p.kcmpb)[(size_t)row * 64 + n] = (bf16_t)(pk2(y, 0.f) & 0xffffu); }
    __syncthreads();
  }
  for (int id = vcu * 512 + tid; id < 16 * 16384; id += G * 512) {
    const int bh = id >> 14, de = id & 16383; const float gc = __expf(ret_logg2(bh & 3) * 128.f);
    float v[32];
#pragma unroll
    for (int n = 0; n < 32; ++n) v[n] = p.kv[(size_t)(bh * 32 + n) * 16384 + de];
    float st = 0.f;
#pragma unroll
    for (int n = 0; n < 32; ++n) { p.stateb[(size_t)(bh * 32 + n) * 16384 + de] = (bf16_t)(pk2(st, 0.f) & 0xffffu); st = st * gc + v[n]; }
  }
}
__device__ __forceinline__ void phase_r3(const P& p, lptr lds, int vcu, int G) {
  const int tid = threadIdx.x, wid = __builtin_amdgcn_readfirstlane(tid >> 6), lane = tid & 63, h = lane >> 5, l31 = lane & 31, wn = wid >> 2, wt = wid & 3;
  lptr wimg = lds, ximg = lds + 12 * 1024, scb = lds + 20 * 1024;
  LAS float* part = (LAS float*)(lds + 52 * 1024);
  for (int chunk = vcu; chunk < 512; chunk += G) {
    const int bh = chunk >> 5, b = bh >> 2, hh = bh & 3, s0 = (chunk & 31) * 128; const float lg = ret_logg2(hh);
    const bf16_t* base = p.projb + (size_t)(b * SEQ + s0) * PJW + hh * 128;
    f32x16 acc[2][1];
    acc_zero<2, 1>(acc);
    { WLkminRows wl; wl.rowp[0] = base + J_KR + (size_t)((tid >> 2) & 127) * PJW;
      XLrows<128> xl; xl.rowp[0] = base + J_QR + (size_t)((tid >> 2) & 127) * PJW; xl.ximg = ximg;
      gemm_loop<2, 1, WLkminRows, XLrows<128>, false, false>(acc, 128, wl, xl, wimg, 0, wn * 64, wt * 32, tid, lane); }
    { int i = wt * 32 + l31, jb = wn * 64 + 4 * h; asm volatile("" : "+v"(i), "+v"(jb));
#pragma unroll
      for (int tm = 0; tm < 2; ++tm)
#pragma unroll
        for (int a = 0; a < 4; ++a) { const int j = jb + tm * 32 + a * 8; float o[4];
#pragma unroll
          for (int q = 0; q < 4; ++q) o[q] = i >= j + q ? acc[tm][0][4 * a + q] * __expf(lg * (float)(i - j - q)) : 0.f;
          u32x2 w; w.x = pk2(o[0], o[1]); w.y = pk2(o[2], o[3]);
          *(LAS u32x2*)(scb + (j >> 5) * 8192 + kmin_off(i, (j & 31) >> 3) + (j & 7) * 2) = w; } }
    __syncthreads();
    acc_zero<2, 1>(acc);
    { WLb16<128> wl; wl.src = p.stateb + (size_t)chunk * 16384; wl.ld = 128;
      XLrows<128> xl; xl.rowp[0] = base + J_QR + (size_t)((tid >> 2) & 127) * PJW; xl.ximg = ximg;
      gemm_loop<2, 1>(acc, 128, wl, xl, wimg, 128 * 2 + 64, wn * 64, wt * 32, tid, lane); }
    { const float xi = __expf(lg * (float)(wt * 32 + l31 + 1));
#pragma unroll
      for (int tm = 0; tm < 2; ++tm)
#pragma unroll
        for (int r = 0; r < 16; ++r) acc[tm][0][r] *= xi; }
    { WLb16<128> wl; wl.src = base + J_VR; wl.ld = PJW;
      XLres xl; xl.base = scb; xl.bytes = 8192;
      gemm_loop<2, 1>(acc, 128, wl, xl, wimg, 128 * 2 + 64, wn * 64, wt * 32, tid, lane); }
    { float ss = 0.f;
#pragma unroll
      for (int tm = 0; tm < 2; ++tm)
#pragma unroll
        for (int r = 0; r < 16; ++r) ss += acc[tm][0][r] * acc[tm][0][r];
      ss += __shfl_xor(ss, 32);
      if (h == 0) part[wn * 128 + wt * 32 + l31] = ss; }
    __syncthreads();
    { int i = wt * 32 + l31, eb = wn * 64 + 4 * h; asm volatile("" : "+v"(i), "+v"(eb));
      const float rs = rsqrtf((part[i] + part[128 + i]) * (1.f / 128.f) + EPS);
      const size_t trow = (size_t)(b * SEQ + s0 + i);
#pragma unroll
      for (int tm = 0; tm < 2; ++tm)
#pragma unroll
        for (int a = 0; a < 4; ++a) { const int e = eb + tm * 32 + a * 8;
          const f32x4 gr = *(const f32x4*)(p.g_ret + hh * 128 + e); const u32x2 gt = *(const u32x2*)(p.projb + trow * PJW + J_GR + hh * 128 + e);
          u32x2 w; w.x = pk2(acc[tm][0][4 * a] * rs * gr.x * bflo(gt.x), acc[tm][0][4 * a + 1] * rs * gr.y * bfhi(gt.x));
          w.y = pk2(acc[tm][0][4 * a + 2] * rs * gr.z * bflo(gt.y), acc[tm][0][4 * a + 3] * rs * gr.w * bfhi(gt.y));
          *(u32x2*)(p.mixb + trow * D + 512 + hh * 128 + e) = w; } }
    __syncthreads();
  }
  for (int tok = vcu * 8 + wid; tok < T; tok += G * 8) {
    const u32x4 v = *(const u32x4*)(p.onsab + (size_t)tok * 512 + lane * 8);
    float x[8] = {bflo(v.x), bfhi(v.x), bflo(v.y), bfhi(v.y), bflo(v.z), bfhi(v.z), bflo(v.w), bfhi(v.w)};
    float ss = 0.f;
#pragma unroll
    for (int q = 0; q < 8; ++q) ss += x[q] * x[q];
    ss = wave_sum(ss);
    const float rs = rsqrtf(ss * (1.f / 512.f) + EPS);
    const f32x4 g0 = *(const f32x4*)(p.g_nsa + lane * 8), g1 = *(const f32x4*)(p.g_nsa + lane * 8 + 4);
    u32x4 w; w.x = pk2(x[0] * rs * g0.x, x[1] * rs * g0.y); w.y = pk2(x[2] * rs * g0.z, x[3] * rs * g0.w); w.z = pk2(x[4] * rs * g1.x, x[5] * rs * g1.y); w.w = pk2(x[6] * rs * g1.z, x[7] * rs * g1.w);
    *(u32x4*)(p.mixb + (size_t)tok * D + lane * 8) = w;
  }
}

__device__ __forceinline__ void phase5a(const P& p, lptr lds, int vcu, int G) {
  const int tid = threadIdx.x, wid = __builtin_amdgcn_readfirstlane(tid >> 6), lane = tid & 63, wn = wid >> 2, wt = wid & 3;
  for (int u = vcu; u < 4 * 64; u += G) {
    const int j = u & 3, t0 = (u >> 2) * 256, b = t0 / SEQ;
    f32x16 acc[4][2];
    { const bf16_t* wb = p.woutb + j * 256; const bf16_t* xb = p.mixb + (size_t)t0 * D;
      gemm256_dma(acc, wb + (size_t)g2_wrow(wid, 0, lane) * D + g2_wcol(wid, 0, lane), wb + (size_t)g2_wrow(wid, 1, lane) * D + g2_wcol(wid, 1, lane), (size_t)32 * D,
                  xb + (size_t)g2_xtok(wid, 0, lane) * D + g2_xk(wid, 0, lane), xb + (size_t)g2_xtok(wid, 1, lane) * D + g2_xk(wid, 1, lane), D, lds, wn, wt, wid, lane); }
#pragma unroll
    for (int tn = 0; tn < 2; ++tn) {
      { int rl = wt * 32 + (lane & 31), cb = (wn * 128 + 4 * (lane >> 5)) * 2; asm volatile("" : "+v"(rl), "+v"(cb));
#pragma unroll
        for (int tm = 0; tm < 4; ++tm)
#pragma unroll
          for (int a = 0; a < 4; ++a) { u32x2 o; o.x = pk2(acc[tm][tn][4 * a], acc[tm][tn][4 * a + 1]); o.y = pk2(acc[tm][tn][4 * a + 2], acc[tm][tn][4 * a + 3]);
            *(LAS u32x2*)(lds + rl * 528 + cb + (tm * 32 + a * 8) * 2) = o; } }
      __syncthreads();
#pragma unroll
      for (int rr = 0; rr < 8; ++rr) { const int row = wid * 16 + rr * 2 + (lane >> 5);
        *(u32x4*)(p.mixo + (size_t)(t0 + (row >> 5) * 64 + tn * 32 + (row & 31)) * D + j * 256 + (lane & 31) * 8) = *(const LAS u32x4*)(lds + row * 528 + (lane & 31) * 16); }
      __syncthreads();
    }
  }
}
#define DPP_INPLACE(op, v, ctrl) asm("s_nop 1\n\t" op " %0, %0, %0 " ctrl : "+v"(v))
#define DPP_OUT(op, d, v, ctrl) asm("s_nop 1\n\t" op " %0, %1, %1 " ctrl : "=v"(d) : "v"(v))
__device__ __forceinline__ float wave_max_dpp(float v) {
  DPP_INPLACE("v_max_f32_dpp", v, "quad_perm:[1,0,3,2] row_mask:0xf bank_mask:0xf");
  DPP_INPLACE("v_max_f32_dpp", v, "quad_perm:[2,3,0,1] row_mask:0xf bank_mask:0xf");
  DPP_INPLACE("v_max_f32_dpp", v, "row_ror:4 row_mask:0xf bank_mask:0xf");
  DPP_INPLACE("v_max_f32_dpp", v, "row_ror:8 row_mask:0xf bank_mask:0xf");
  DPP_INPLACE("v_max_f32_dpp", v, "row_bcast:15 row_mask:0xa bank_mask:0xf");
  DPP_INPLACE("v_max_f32_dpp", v, "row_bcast:31 row_mask:0xc bank_mask:0xf");
  return __int_as_float(__builtin_amdgcn_readlane(__float_as_int(v), 63));
}
__device__ __forceinline__ void glds16x2(const void* g0, const void* g1, unsigned d0) {
  unsigned keep;
  asm volatile("s_mov_b32 %0, m0\n\ts_mov_b32 m0, %3\n\ts_nop 0\n\tglobal_load_lds_dwordx4 %1, off\n\ts_add_u32 m0, m0, 0x400\n\ts_nop 0\n\tglobal_load_lds_dwordx4 %2, off\n\ts_mov_b32 m0, %0"
               : "=&s"(keep) : "v"(g0), "v"(g1), "s"(d0) : "memory", "scc");
}
__device__ __forceinline__ void phase5r(const P& p, lptr lds, int vcu, int G) {
  const int tid = threadIdx.x, wid = __builtin_amdgcn_readfirstlane(tid >> 6), lane = tid & 63;
  constexpr int LTS = 260;
  lptr ximg = lds, ring = lds + 65536;
  const unsigned ring0 = (unsigned)(uintptr_t)ring + (unsigned)wid * 2048u;
  LAS float* ltile = (LAS float*)ring;
  LAS float* stab = (LAS float*)(ring + 40 * 1024 + wid * 1024);
  const f32x4 rb = *(const f32x4*)(p.rbias + lane * 4);
  const int xq = (int)(xb_xcc_id() & (NXCD - 1)) * NE;
  const bf16_t* wq0 = p.wrb + (size_t)g2_wrow(wid, 0, lane) * NE + g2_wcol(wid, 0, lane);
  const bf16_t* wq1 = p.wrb + (size_t)g2_wrow(wid, 1, lane) * NE + g2_wcol(wid, 1, lane);
  for (int t0 = vcu * 32; t0 < T; t0 += G * 32) {
    const int b = t0 / SEQ;
#define P5R_ISSUE(ST) do { const int st_ = (ST) < 32 ? (ST) : 31; const unsigned sl_ = (unsigned)__builtin_amdgcn_readfirstlane((int)(ring0 + (unsigned)((ST) & 3) * 16384u)); \
      glds16x2(wq0 + (size_t)st_ * 32 * NE, wq1 + (size_t)st_ * 32 * NE, sl_); } while (0)
    P5R_ISSUE(0); P5R_ISSUE(1); P5R_ISSUE(2);
    f32x4 gs[4], sh[4];
    { int ln = lane; asm volatile("" : "+v"(ln));
#pragma unroll
      for (int j = 0; j < 4; ++j) { const int k = j * 256 + ln * 4;
        const f32x4 g = *(const f32x4*)(p.g_ffn + k), sc = *(const f32x4*)(p.mod + b * 6144 + 4096 + k); sh[j] = *(const f32x4*)(p.mod + b * 6144 + 3072 + k);
        gs[j].x = g.x * (1.f + sc.x); gs[j].y = g.y * (1.f + sc.y); gs[j].z = g.z * (1.f + sc.z); gs[j].w = g.w * (1.f + sc.w); } }
#pragma unroll 1
    for (int i0 = 0; i0 < 4; i0 += 2) {
      int ln = lane, rw = t0 + 4 * wid + i0; asm volatile("" : "+v"(ln), "+v"(rw));
      f32x4 v[2][4]; float rr[2];
      { f32x4 gt[4]; u32x2 mo[2][4];
#pragma unroll
        for (int j = 0; j < 4; ++j) gt[j] = *(const f32x4*)(p.mod + b * 6144 + 2048 + j * 256 + ln * 4);
#pragma unroll
        for (int i = 0; i < 2; ++i)
#pragma unroll
          for (int j = 0; j < 4; ++j) { const size_t o = (size_t)(rw + i) * D + j * 256 + ln * 4; v[i][j] = *(const f32x4*)(p.x + o); mo[i][j] = *(const u32x2*)(p.mixo + o); }
#pragma unroll
        for (int i = 0; i < 2; ++i) { float s = 0.f;
#pragma unroll
          for (int j = 0; j < 4; ++j) { v[i][j].x += gt[j].x * bflo(mo[i][j].x); v[i][j].y += gt[j].y * bfhi(mo[i][j].x); v[i][j].z += gt[j].z * bflo(mo[i][j].y); v[i][j].w += gt[j].w * bfhi(mo[i][j].y);
            s += v[i][j].x * v[i][j].x + v[i][j].y * v[i][j].y + v[i][j].z * v[i][j].z + v[i][j].w * v[i][j].w;
            { u32x2 xo; xo.x = pk2(v[i][j].x, v[i][j].y); xo.y = pk2(v[i][j].z, v[i][j].w); *(u32x2*)(p.x1b + (size_t)(rw + i) * D + j * 256 + ln * 4) = xo; } }
          rr[i] = rsqrtf(wave_sum(s) * (1.f / D) + EPS); } }
#pragma unroll
      for (int j = 0; j < 4; ++j) {
        const int k = j * 256 + ln * 4;
#pragma unroll
        for (int i = 0; i < 2; ++i) { const int tl = rw + i - t0; const float r = rr[i];
          u32x2 o; o.x = pk2(v[i][j].x * r * gs[j].x + sh[j].x, v[i][j].y * r * gs[j].y + sh[j].y); o.y = pk2(v[i][j].z * r * gs[j].z + sh[j].z, v[i][j].w * r * gs[j].w + sh[j].w);
          *(u32x2*)(p.h2b + (size_t)(rw + i) * D + k) = o;
          *(LAS u32x2*)(ximg + (j * 8 + (ln >> 3)) * 2048 + kmin_off(tl, (ln & 7) >> 1) + (ln & 1) * 8) = o; }
      } }
    f32x16 acc;
#pragma unroll
    for (int r = 0; r < 16; ++r) acc[r] = 0.f;
    { int ln = lane; asm volatile("" : "+v"(ln));
      asm volatile("s_waitcnt vmcnt(0) lgkmcnt(0)\n\ts_barrier" ::: "memory");
      for (int st = 0; st < 32; ++st) {
        lptr slot = ring + (st & 3) * 16384;
        const bf16x8 wf0 = frag_kmaj512(slot, 32 * wid, 0, ln), wf1 = frag_kmaj512(slot, 32 * wid, 1, ln);
        const bf16x8 xf0 = frag_kmin(ximg + st * 2048, 0, 0, ln), xf1 = frag_kmin(ximg + st * 2048, 0, 1, ln);
        acc = __builtin_amdgcn_mfma_f32_32x32x16_bf16(wf0, xf0, acc, 0, 0, 0);
        acc = __builtin_amdgcn_mfma_f32_32x32x16_bf16(wf1, xf1, acc, 0, 0, 0);
        asm volatile("s_waitcnt vmcnt(2)\n\ts_barrier" ::: "memory");
        P5R_ISSUE(st + 3);
      }
#undef P5R_ISSUE
      asm volatile("s_waitcnt vmcnt(0)\n\ts_barrier" ::: "memory");
#pragma unroll
      for (int a = 0; a < 4; ++a) { const f32x4 q = {acc[4 * a], acc[4 * a + 1], acc[4 * a + 2], acc[4 * a + 3]};
        *(LAS f32x4*)(ltile + (ln & 31) * LTS + 32 * wid + 8 * a + 4 * (ln >> 5)) = q; } }
    __syncthreads();
    int pslot = -1, ppos = 0, pe = 0;
#pragma unroll 1
    for (int i = 0; i < 4; ++i) {
      const int tok = t0 + 4 * wid + i;
      const f32x4 lv = *(const LAS f32x4*)(ltile + (4 * wid + i) * LTS + lane * 4);
      f32x4 sg;
      sg.x = __builtin_amdgcn_rcpf(1.f + __builtin_amdgcn_exp2f(-1.4426950408889634f * lv.x)); sg.y = __builtin_amdgcn_rcpf(1.f + __builtin_amdgcn_exp2f(-1.4426950408889634f * lv.y));
      sg.z = __builtin_amdgcn_rcpf(1.f + __builtin_amdgcn_exp2f(-1.4426950408889634f * lv.z)); sg.w = __builtin_amdgcn_rcpf(1.f + __builtin_amdgcn_exp2f(-1.4426950408889634f * lv.w));
      *(LAS f32x4*)(stab + lane * 4) = sg;
      float k0 = sg.x + rb.x, k1 = sg.y + rb.y, k2 = sg.z + rb.z, k3 = sg.w + rb.w;
      int i0 = lane * 4, i1 = lane * 4 + 1, i2 = lane * 4 + 2, i3 = lane * 4 + 3;
#define CEX(ka, ia, kb, ib) { const bool sw_ = kb > ka; const float tk_ = sw_ ? kb : ka; kb = sw_ ? ka : kb; ka = tk_; const int ti_ = sw_ ? ib : ia; ib = sw_ ? ia : ib; ia = ti_; }
      CEX(k0, i0, k1, i1) CEX(k1, i1, k2, i2) CEX(k2, i2, k3, i3) CEX(k0, i0, k1, i1) CEX(k1, i1, k2, i2) CEX(k0, i0, k1, i1)
#undef CEX
      float m1 = k0, m2 = k1;
#define TOP2_MERGE(ctrl) { float n1_, t_, u_; DPP_OUT("v_max_f32_dpp", n1_, m1, ctrl); DPP_OUT("v_min_f32_dpp", t_, m1, ctrl); DPP_OUT("v_max_f32_dpp", u_, m2, ctrl); \
        asm("v_max_f32 %0, %1, %2" : "=v"(m2) : "v"(t_), "v"(u_)); m1 = n1_; }
      TOP2_MERGE("quad_perm:[1,0,3,2] row_mask:0xf bank_mask:0xf") TOP2_MERGE("quad_perm:[2,3,0,1] row_mask:0xf bank_mask:0xf") TOP2_MERGE("row_half_mirror row_mask:0xf bank_mask:0xf")
#undef TOP2_MERGE
      const float gs = m1 + m2; const int myg = lane >> 3; int rank = 0;
#pragma unroll
      for (int g2 = 0; g2 < 8; ++g2) { const float og = __int_as_float(__builtin_amdgcn_readlane(__float_as_int(gs), g2 * 8)); rank += (og > gs || (og == gs && g2 < myg)) ? 1 : 0; }
      if (rank >= 4) { k0 = -INFINITY; k1 = -INFINITY; k2 = -INFINITY; k3 = -INFINITY; }
      int my_e = 0;
#pragma unroll
      for (int k = 0; k < 8; ++k) {
        const float mx = wave_max_dpp(k0);
        const int L = (int)__builtin_ctzll(__ballot(k0 == mx));
        const int li = __builtin_amdgcn_readlane(i0, L);
        asm("v_writelane_b32 %0, %1, %2" : "+v"(my_e) : "s"(li), "n"(k));
        const bool pop = lane == L;
        k0 = pop ? k1 : k0; k1 = pop ? k2 : k1; k2 = pop ? k3 : k2; k3 = pop ? -INFINITY : k3;
        i0 = pop ? i1 : i0; i1 = pop ? i2 : i1; i2 = pop ? i3 : i2;
      }
      float my_s = lane < 8 ? stab[my_e] : 0.f;
      float wsum = my_s;
      DPP_INPLACE("v_add_f32_dpp", wsum, "quad_perm:[1,0,3,2] row_mask:0xf bank_mask:0xf");
      DPP_INPLACE("v_add_f32_dpp", wsum, "quad_perm:[2,3,0,1] row_mask:0xf bank_mask:0xf");
      DPP_INPLACE("v_add_f32_dpp", wsum, "row_half_mirror row_mask:0xf bank_mask:0xf");
      if (lane < 8 && pslot >= 0 && ppos < XCAP) p.list[(size_t)(xq + pe) * XCAP + ppos] = pslot;
      if (lane < 8) { ppos = atomicAdd(&p.cnt[(xq + my_e) * CPAD], 1); pe = my_e; pslot = tok * 8 + lane; p.wts[pslot] = my_s / wsum * 2.5f; }
    }
    if (lane < 8 && pslot >= 0 && ppos < XCAP) p.list[(size_t)(xq + pe) * XCAP + ppos] = pslot;
    __syncthreads();
  }
}
#undef DPP_INPLACE
#undef DPP_OUT
constexpr int NPHASE = 11;
__global__ void __launch_bounds__(512) mega(P p, int lo, int hi) {
  extern __shared__ __attribute__((aligned(16))) char lds_raw[];
  lptr lds = (lptr)lds_raw;
  const int tid = threadIdx.x, G = gridDim.x;
  const int vcu = (G % 8 == 0) ? ((int)blockIdx.x % 8) * (G / 8) + (int)blockIdx.x / 8 : (int)blockIdx.x;
  if (tid < 32) ((LAS float*)(lds + LDS_INV64))[tid] = exp2f(-(float)(2 * tid) / 64.f * 13.287712379549449f) * 0.15915494309189535f;
  if (tid < 64) ((LAS float*)(lds + LDS_INV128))[tid] = exp2f(-(float)(2 * tid) / 128.f * 13.287712379549449f) * 0.15915494309189535f;
  if (tid < 4) ((LAS unsigned*)(lds + LDS_XB))[tid] = 0u;
  __syncthreads();
  XcdBarrier xb; xb.bar = p.bar; xb.x = 0; xb.st = (volatile LAS unsigned*)(lds + LDS_XB);
  if (hi - lo > 1) xb = xcd_barrier_post(p.bar, (volatile LAS unsigned*)(lds + LDS_XB));
#define PH(k, call) if (lo <= (k) && (k) < hi) { call; if ((k) + 1 < hi) xcd_barrier(xb); }
  PH(0, phase0a(p, lds, vcu, G));
  PH(1, phase0b(p, lds, vcu, G));
  PH(2, phase1(p, lds, vcu, G));
  PH(3, phase_r1(p, lds, vcu, G));
  PH(4, phase_r2(p, lds, vcu, G));
  PH(5, phase_nsa(p, lds, vcu, G));
  PH(6, phase_r3(p, lds, vcu, G));
  PH(7, phase5a(p, lds, vcu, G));
  PH(8, phase5r(p, lds, vcu, G));
  PH(9, phase6(p, lds, vcu, G));
  PH(10, phase7(p, lds, vcu, G));
#undef PH
}
}

extern "C" void kernel_launch(void* const* d_in, const int* in_sizes, int n_in, void* d_out, int out_size, void* d_ws, size_t ws_size, hipStream_t stream) {
  P p{};
  p.x = (const float*)d_in[0]; p.c = (const float*)d_in[1]; p.pos = (const int*)d_in[2];
  p.w_ada = (const float*)d_in[3]; p.b_ada = (const float*)d_in[4]; p.g_mix = (const float*)d_in[5]; p.w_in = (const float*)d_in[6];
  p.cpk = (const float*)d_in[7]; p.cw1k = (const float*)d_in[8]; p.cw2k = (const float*)d_in[9];
  p.cpv = (const float*)d_in[10]; p.cw1v = (const float*)d_in[11]; p.cw2v = (const float*)d_in[12];
  p.g_nsa = (const float*)d_in[13]; p.g_ret = (const float*)d_in[14]; p.w_out = (const float*)d_in[15]; p.g_ffn = (const float*)d_in[16];
  p.w_router = (const float*)d_in[17]; p.rbias = (const float*)d_in[18]; p.wg_e = (const float*)d_in[19]; p.wu_e = (const float*)d_in[20];
  p.wd_e = (const float*)d_in[21]; p.wg_s = (const float*)d_in[22]; p.wu_s = (const float*)d_in[23]; p.wd_s = (const float*)d_in[24];
  p.g_final = (const float*)d_in[25];
  p.out = (float*)d_out;
  char* w = (char*)d_ws; size_t off = 0;
  auto take = [&](size_t bytes) { char* r = w + off; off += (bytes + 255) & ~(size_t)255; return r; };
  p.bar = (unsigned*)take(XCD_BAR_WORDS * 4);
  const size_t zero_bytes = off;
  p.cnt = (int*)take((size_t)NXCD * NE * CPAD * 4);
  p.mod = (float*)take(BATCH * 6144 * 4);
  p.hidp = (float*)take((size_t)8 * 2048 * 128 * 4);
  p.kv = (float*)take((size_t)512 * 16384 * 4);
  p.stateb = (bf16_t*)take((size_t)512 * 16384 * 2);
  p.ysb = (bf16_t*)take((size_t)T * D * 2); p.mixo = (bf16_t*)take((size_t)T * D * 2); p.x1b = (bf16_t*)take((size_t)T * D * 2);
  p.wts = (float*)take((size_t)T * 8 * 4);
  p.list = (int*)take((size_t)NXCD * NE * XCAP * 4);
  p.gates = (float*)take((size_t)T * 24 * 4);
  p.winb = (bf16_t*)take((size_t)D * INW * 2); p.woutb = (bf16_t*)take((size_t)D * D * 2); p.wrb = (bf16_t*)take((size_t)D * NE * 2);
  p.cw1kb = (bf16_t*)take(2048 * 128 * 2); p.cw1vb = (bf16_t*)take(2048 * 128 * 2); p.cw2kb = (bf16_t*)take(128 * 64 * 2); p.cw2vb = (bf16_t*)take(128 * 64 * 2);
  p.hb = (bf16_t*)take((size_t)T * D * 2);
  p.projb = (bf16_t*)take((size_t)T * PJW * 2);
  p.mixb = (bf16_t*)take((size_t)T * D * 2); p.h2b = (bf16_t*)take((size_t)T * D * 2);
  p.slab = (bf16_t*)take((size_t)T * 8 * D * 2);
  p.kcmpb = (bf16_t*)take((2048 + 64) * 64 * 2); p.vcmpb = (bf16_t*)take((2048 + 64) * 64 * 2);
  p.onsab = (bf16_t*)take((size_t)T * 512 * 2);
  if (off > ws_size) { fprintf(stderr, "kernel_launch: workspace too small: need %zu have %zu\n", off, ws_size); return; }
  static int grid = 0;
  if (!grid) {
    int dev = 0, cus = 0, per_cu = 0;
    (void)hipGetDevice(&dev);
    (void)hipDeviceGetAttribute(&cus, hipDeviceAttributeMultiprocessorCount, dev);
    (void)hipFuncSetAttribute((const void*)mega, hipFuncAttributeMaxDynamicSharedMemorySize, LDS_BYTES);
    (void)hipOccupancyMaxActiveBlocksPerMultiprocessor(&per_cu, (const void*)mega, 512, LDS_BYTES);
    if (per_cu < 1) fprintf(stderr, "kernel_launch: occupancy query says %d blocks per CU\n", per_cu);
    grid = cus;
  }
  (void)hipMemsetAsync(d_ws, 0, zero_bytes, stream);
  hipLaunchKernelGGL(mega, dim3(grid), dim3(512), LDS_BYTES, stream, p, 0, NPHASE);
}
```
